# Optimizing an MI355X kernel written in HIP

```python
import math
import jax, jax.numpy as jnp
from jax import lax
import numpy as np

D_MODEL = 1024
BATCH = 4
SEQ = 4096
DEPTH = 1

CHUNK = 64
N_META = 16
Q_BLOCK = 128
NEG_INF = -1e30
RMS_EPS = 1e-6
ROPE_BASE = 10000.0

MLA_HEADS = 8
MLA_Q_LORA = 256
MLA_KV_LORA = 128
MLA_NOPE = 64
MLA_ROPE = 32
MLA_V = 64
DSA_HEADS = 8
DSA_HEAD_DIM = 64
IDX_HEADS = 8
IDX_DIM = 64
K_SEL_MAX = 256
REL_BUCKETS = 32
REL_MAX_DIST = 128
N_GROUPS = 4
EXPERTS_PER_GROUP = 8
N_EXPERTS = N_GROUPS * EXPERTS_PER_GROUP
TOP_K_EXPERTS = 2
D_EXPERT = 256
MOE_BLOCK = 128

IN_SPLITS = (
    MLA_Q_LORA,
    MLA_KV_LORA,
    MLA_ROPE,
    DSA_HEADS * DSA_HEAD_DIM,
    DSA_HEADS * DSA_HEAD_DIM,
    DSA_HEADS * DSA_HEAD_DIM,
    IDX_HEADS * IDX_DIM,
    IDX_DIM,
    IDX_HEADS,
    D_MODEL,
    D_MODEL,
)
IN_COLS = (MLA_Q_LORA + MLA_KV_LORA + MLA_ROPE + 3 * DSA_HEADS * DSA_HEAD_DIM
           + IDX_HEADS * IDX_DIM + IDX_DIM + IDX_HEADS + 2 * D_MODEL)

kernel_name = "hybrid_mla_dsa_hmoe_chunk_causal"


def rmsnorm(x, g):
    xf = x.astype(jnp.float32)
    y = xf * lax.rsqrt(jnp.mean(xf * xf, axis=-1, keepdims=True) + RMS_EPS)
    return (y * g.astype(jnp.float32)).astype(x.dtype)


def chunk_ids(pos):
    return jnp.where(pos < N_META, 0, 1 + (pos - N_META) // CHUNK)


def rope(x, pos):
    half = x.shape[-1] // 2
    inv = ROPE_BASE ** (-jnp.arange(half, dtype=jnp.float32) / half)
    ang = pos.astype(jnp.float32)[:, None] * inv[None, :]
    cos = jnp.cos(ang)[None, :, None, :].astype(x.dtype)
    sin = jnp.sin(ang)[None, :, None, :].astype(x.dtype)
    x1, x2 = x[..., :half], x[..., half:]
    return jnp.concatenate([x1 * cos - x2 * sin, x1 * sin + x2 * cos], axis=-1)


def t5_bucket(rel):
    nb = REL_BUCKETS // 2
    max_exact = nb // 2
    n = jnp.abs(rel)
    large = max_exact + (jnp.log(jnp.maximum(n, 1).astype(jnp.float32) / max_exact)
                         / math.log(REL_MAX_DIST / max_exact) * (nb - max_exact)).astype(jnp.int32)
    large = jnp.minimum(large, nb - 1)
    return jnp.where(rel > 0, nb, 0) + jnp.where(n < max_exact, n, large)


def to_blocks(t, n_blk):
    pad = n_blk * Q_BLOCK - t.shape[1]
    t = jnp.pad(t, [(0, 0), (0, pad)] + [(0, 0)] * (t.ndim - 2))
    t = t.reshape((t.shape[0], n_blk, Q_BLOCK) + t.shape[2:])
    return jnp.moveaxis(t, 1, 0)


def from_blocks(o, L):
    o = jnp.moveaxis(o, 0, 1)
    o = o.reshape((o.shape[0], o.shape[1] * o.shape[2]) + o.shape[3:])
    return o[:, :L]


def hybrid_mixer(h, w_in, g_cq, g_ckv, w_uq, w_ukv, w_br_a, w_br_b, w_o, rel_bias):
    B, L, _ = h.shape
    pos = jnp.arange(L, dtype=jnp.int32)
    cid = chunk_ids(pos)
    n_blk = -(-L // Q_BLOCK)
    pos_blocks = jnp.arange(n_blk * Q_BLOCK, dtype=jnp.int32).reshape(n_blk, Q_BLOCK)
    k_sel = min(K_SEL_MAX, SEQ // 4)

    offs = [int(o) for o in np.cumsum(IN_SPLITS)[:-1]]
    (c_q, c_kv, k_r, q_b, k_b, v_b, q_i, k_i, w_i, gate_a, gate_b) = jnp.split(h @ w_in, offs, axis=-1)

    q_a = (rmsnorm(c_q, g_cq) @ w_uq).reshape(B, L, MLA_HEADS, MLA_NOPE + MLA_ROPE)
    q_nope, q_rope = q_a[..., :MLA_NOPE], rope(q_a[..., MLA_NOPE:], pos)
    kv_a = (rmsnorm(c_kv, g_ckv) @ w_ukv).reshape(B, L, MLA_HEADS, MLA_NOPE + MLA_V)
    k_nope, v_a = kv_a[..., :MLA_NOPE], kv_a[..., MLA_NOPE:]
    k_rope = rope(k_r[:, :, None, :], pos)[:, :, 0]
    scale_a = (MLA_NOPE + MLA_ROPE) ** -0.5

    def mla_block(args):
        qn, qr, pq = args
        s = (jnp.einsum('bqhd,bkhd->bhqk', qn, k_nope)
             + jnp.einsum('bqhr,bkr->bhqk', qr, k_rope)) * scale_a
        mask = cid[None, :] <= chunk_ids(pq)[:, None]
        s = jnp.where(mask[None, None], s.astype(jnp.float32), NEG_INF)
        p = jax.nn.softmax(s, axis=-1).astype(v_a.dtype)
        return jnp.einsum('bhqk,bkhd->bqhd', p, v_a)

    o_a = from_blocks(lax.map(mla_block, (to_blocks(q_nope, n_blk), to_blocks(q_rope, n_blk), pos_blocks)), L)

    q_b = q_b.reshape(B, L, DSA_HEADS, DSA_HEAD_DIM)
    k_b = k_b.reshape(B, L, DSA_HEADS, DSA_HEAD_DIM)
    v_b = v_b.reshape(B, L, DSA_HEADS, DSA_HEAD_DIM)
    q_i = q_i.reshape(B, L, IDX_HEADS, IDX_DIM) * (IDX_DIM ** -0.5)
    w_i = w_i * (IDX_HEADS ** -0.5)
    scale_b = DSA_HEAD_DIM ** -0.5
    gather = jax.vmap(lambda t, i: t[i])

    def dsa_block(args):
        qb, qib, wb, pq = args
        cq = chunk_ids(pq)
        logits = jnp.einsum('bqhd,bkd->bqhk', qib, k_i)
        score = jnp.einsum('bqh,bqhk->bqk', wb, jax.nn.relu(logits)).astype(jnp.float32)
        adm = cid[None, :] <= cq[:, None]
        score = jnp.where(adm[None], score, NEG_INF)
        _, idx = lax.top_k(score, k_sel)
        ks = gather(k_b, idx)
        vs = gather(v_b, idx)
        s = jnp.einsum('bqhd,bqkhd->bhqk', qb, ks) * scale_b
        bias = rel_bias[t5_bucket(idx - pq[None, :, None])]
        s = s.astype(jnp.float32) + jnp.transpose(bias, (0, 3, 1, 2)).astype(jnp.float32)
        valid = cid[idx] <= cq[None, :, None]
        s = jnp.where(valid[:, None], s, NEG_INF)
        p = jax.nn.softmax(s, axis=-1).astype(vs.dtype)
        return jnp.einsum('bhqk,bqkhd->bqhd', p, vs)

    o_b = from_blocks(lax.map(dsa_block, (to_blocks(q_b, n_blk), to_blocks(q_i, n_blk),
                                          to_blocks(w_i, n_blk), pos_blocks)), L)

    y = (jax.nn.sigmoid(gate_a) * (o_a.reshape(B, L, -1) @ w_br_a)
         + jax.nn.sigmoid(gate_b) * (o_b.reshape(B, L, -1) @ w_br_b))
    return y @ w_o


def hier_moe(x2d, w_rg, b_rg, w_re, b_re, w_gate, w_up, w_down):
    N, D = x2d.shape
    g_logits = (x2d @ w_rg + b_rg).astype(jnp.float32)
    g_sel = jnp.argmax(g_logits, axis=-1)
    p_group = jnp.take_along_axis(jax.nn.softmax(g_logits, axis=-1), g_sel[:, None], axis=1)[:, 0]
    e_logits = (x2d @ w_re + b_re).astype(jnp.float32).reshape(N, N_GROUPS, EXPERTS_PER_GROUP)
    e_logits = jnp.take_along_axis(e_logits, g_sel[:, None, None], axis=1)[:, 0]
    top_p, top_e = lax.top_k(jax.nn.softmax(e_logits, axis=-1), TOP_K_EXPERTS)
    gate = p_group[:, None] * top_p / jnp.sum(top_p, axis=-1, keepdims=True)
    expert = g_sel[:, None] * EXPERTS_PER_GROUP + top_e

    A = N * TOP_K_EXPERTS
    flat_e = expert.reshape(A).astype(jnp.int32)
    flat_tok = jnp.repeat(jnp.arange(N, dtype=jnp.int32), TOP_K_EXPERTS)
    flat_w = gate.reshape(A)
    order = jnp.argsort(flat_e)
    e_sorted = flat_e[order]
    counts = jnp.bincount(flat_e, length=N_EXPERTS)
    padded = (counts + MOE_BLOCK - 1) // MOE_BLOCK * MOE_BLOCK
    pad_end = jnp.cumsum(padded)
    start = jnp.cumsum(counts) - counts
    dest = (pad_end - padded)[e_sorted] + jnp.arange(A, dtype=jnp.int32) - start[e_sorted]
    n_blk = -(-A // MOE_BLOCK) + N_EXPERTS
    S = n_blk * MOE_BLOCK
    slot_tok = jnp.full((S,), N, jnp.int32).at[dest].set(flat_tok[order])
    slot_w = jnp.zeros((S,), flat_w.dtype).at[dest].set(flat_w[order])
    blk_expert = jnp.minimum(jnp.searchsorted(pad_end, jnp.arange(n_blk, dtype=jnp.int32) * MOE_BLOCK,
                                              side='right'), N_EXPERTS - 1)
    x_pad = jnp.concatenate([x2d, jnp.zeros((1, D), x2d.dtype)], axis=0)
    xs = x_pad[slot_tok].reshape(n_blk, MOE_BLOCK, D)

    def expert_block(args):
        xb, e = args
        return (jax.nn.silu(xb @ w_gate[e]) * (xb @ w_up[e])) @ w_down[e]

    ys = lax.map(expert_block, (xs, blk_expert)).reshape(S, D)
    out = jnp.zeros((N + 1, D), ys.dtype).at[slot_tok].add(ys * slot_w[:, None].astype(ys.dtype))
    return out[:N]


def setup_inputs(seed: int = 0) -> dict:
    key = jax.random.key(seed)
    ks = jax.random.split(key, 24)
    f32 = jnp.float32
    nrm = lambda k, shape, fan: jax.random.normal(k, shape, f32) * (fan ** -0.5)
    gain = lambda k, shape: 1.0 + 0.05 * jax.random.normal(k, shape, f32)
    H_A_OUT = MLA_HEADS * MLA_V
    H_B_OUT = DSA_HEADS * DSA_HEAD_DIM
    return {
        "x": jax.random.normal(ks[0], (BATCH, SEQ, D_MODEL), f32),
        "meta_tokens": jax.random.normal(ks[1], (N_META, D_MODEL), f32),
        "norm_mix_g": gain(ks[2], (DEPTH, D_MODEL)),
        "w_in": nrm(ks[3], (DEPTH, D_MODEL, IN_COLS), D_MODEL),
        "mla_cq_norm_g": gain(ks[4], (DEPTH, MLA_Q_LORA)),
        "mla_ckv_norm_g": gain(ks[5], (DEPTH, MLA_KV_LORA)),
        "w_mla_uq": nrm(ks[6], (DEPTH, MLA_Q_LORA, MLA_HEADS * (MLA_NOPE + MLA_ROPE)), MLA_Q_LORA),
        "w_mla_ukv": nrm(ks[7], (DEPTH, MLA_KV_LORA, MLA_HEADS * (MLA_NOPE + MLA_V)), MLA_KV_LORA),
        "w_branch_a": nrm(ks[8], (DEPTH, H_A_OUT, D_MODEL), H_A_OUT),
        "w_branch_b": nrm(ks[9], (DEPTH, H_B_OUT, D_MODEL), H_B_OUT),
        "w_out": nrm(ks[10], (DEPTH, D_MODEL, D_MODEL), D_MODEL),
        "rel_bias": 0.5 * jax.random.normal(ks[11], (REL_BUCKETS, DSA_HEADS), f32),
        "norm_ffn_g": gain(ks[12], (DEPTH, D_MODEL)),
        "w_router_group": nrm(ks[13], (DEPTH, D_MODEL, N_GROUPS), D_MODEL),
        "b_router_group": 0.01 * jax.random.normal(ks[14], (DEPTH, N_GROUPS), f32),
        "w_router_expert": nrm(ks[15], (DEPTH, D_MODEL, N_EXPERTS), D_MODEL),
        "b_router_expert": 0.01 * jax.random.normal(ks[16], (DEPTH, N_EXPERTS), f32),
        "w_exp_gate": nrm(ks[17], (DEPTH, N_EXPERTS, D_MODEL, D_EXPERT), D_MODEL),
        "w_exp_up": nrm(ks[18], (DEPTH, N_EXPERTS, D_MODEL, D_EXPERT), D_MODEL),
        "w_exp_down": nrm(ks[19], (DEPTH, N_EXPERTS, D_EXPERT, D_MODEL), D_EXPERT),
        "norm_final_g": gain(ks[20], (D_MODEL,)),
    }


def reference(x, meta_tokens, norm_mix_g, w_in, mla_cq_norm_g, mla_ckv_norm_g, w_mla_uq, w_mla_ukv,
              w_branch_a, w_branch_b, w_out, rel_bias, norm_ffn_g, w_router_group, b_router_group,
              w_router_expert, b_router_expert, w_exp_gate, w_exp_up, w_exp_down, norm_final_g):
    B = x.shape[0]
    meta = jnp.broadcast_to(meta_tokens[None].astype(x.dtype), (B, N_META, D_MODEL))
    h = jnp.concatenate([meta, x], axis=1)
    L = h.shape[1]
    for layer in range(DEPTH):
        h = h + hybrid_mixer(rmsnorm(h, norm_mix_g[layer]), w_in[layer], mla_cq_norm_g[layer],
                             mla_ckv_norm_g[layer], w_mla_uq[layer], w_mla_ukv[layer],
                             w_branch_a[layer], w_branch_b[layer], w_out[layer], rel_bias)
        ffn = hier_moe(rmsnorm(h, norm_ffn_g[layer]).reshape(B * L, D_MODEL),
                       w_router_group[layer], b_router_group[layer], w_router_expert[layer],
                       b_router_expert[layer], w_exp_gate[layer], w_exp_up[layer], w_exp_down[layer])
        h = h + ffn.reshape(B, L, D_MODEL)
    return rmsnorm(h, norm_final_g)[:, N_META:]
```

```cpp
#include <hip/hip_runtime.h>
#include <math.h>
#include <stdint.h>

namespace gold {
constexpr int D = 1024, NB = 4, SEQ = 4096, NMETA = 16, L = SEQ + NMETA, INC = 4584;
constexpr int C_CQ = 0, C_CKV = 256, C_KR = 384, C_QB = 416, C_KB = 928, C_VB = 1440, C_QI = 1952, C_KI = 2464, C_WI = 2528, C_GA = 2536, C_GB = 3560;
constexpr float EPS = 1e-6f;

__device__ __forceinline__ float wave_sum(float v) {
#pragma unroll
  for (int o = 1; o < 64; o <<= 1) v += __shfl_xor(v, o);
  return v;
}
__device__ __forceinline__ float block_sum256(float v, float* red) {
  v = wave_sum(v);
  __syncthreads();
  if ((threadIdx.x & 63) == 0) red[threadIdx.x >> 6] = v;
  __syncthreads();
  return red[0] + red[1] + red[2] + red[3];
}
__device__ __forceinline__ int block_sumi256(int v, int* red) {
#pragma unroll
  for (int o = 1; o < 64; o <<= 1) v += __shfl_xor(v, o);
  __syncthreads();
  if ((threadIdx.x & 63) == 0) red[threadIdx.x >> 6] = v;
  __syncthreads();
  return red[0] + red[1] + red[2] + red[3];
}

__global__ __launch_bounds__(256) void g_norm_rows(const float* x, const float* meta, const float* g, float* hn, int b) {
  __shared__ float red[4];
  const int p = blockIdx.x, t = threadIdx.x;
  const float* row = p < NMETA ? meta + (size_t)p * D : x + ((size_t)b * SEQ + (p - NMETA)) * D;
  float v[4]; float s = 0.f;
#pragma unroll
  for (int i = 0; i < 4; ++i) { v[i] = row[t + 256 * i]; s += v[i] * v[i]; }
  s = block_sum256(s, red);
  const float rs = rsqrtf(s * (1.f / D) + EPS);
#pragma unroll
  for (int i = 0; i < 4; ++i) hn[(size_t)p * D + t + 256 * i] = v[i] * rs * g[t + 256 * i];
}

__global__ __launch_bounds__(256) void g_gemm(const float* A, int lda, const float* Bm, int ldb, float* C, int ldc, int M, int N, int K) {
  __shared__ float As[16][68];
  __shared__ float Bs[16][64];
  const int tx = threadIdx.x & 15, ty = threadIdx.x >> 4;
  const int m0 = blockIdx.y * 64, n0 = blockIdx.x * 64;
  float acc[4][4];
#pragma unroll
  for (int i = 0; i < 4; ++i)
#pragma unroll
    for (int j = 0; j < 4; ++j) acc[i][j] = 0.f;
  for (int k0 = 0; k0 < K; k0 += 16) {
#pragma unroll
    for (int r = 0; r < 4; ++r) {
      const int i = threadIdx.x + 256 * r;
      { const int m = i >> 4, k = i & 15; const int gm = m0 + m; As[k][m] = gm < M ? A[(size_t)gm * lda + k0 + k] : 0.f; }
      { const int k = i >> 6, n = i & 63; const int gn = n0 + n; Bs[k][n] = gn < N ? Bm[(size_t)(k0 + k) * ldb + gn] : 0.f; }
    }
    __syncthreads();
#pragma unroll
    for (int k = 0; k < 16; ++k) {
      float a[4], bb[4];
#pragma unroll
      for (int i = 0; i < 4; ++i) { a[i] = As[k][ty * 4 + i]; bb[i] = Bs[k][tx * 4 + i]; }
#pragma unroll
      for (int i = 0; i < 4; ++i)
#pragma unroll
        for (int j = 0; j < 4; ++j) acc[i][j] = fmaf(a[i], bb[j], acc[i][j]);
    }
    __syncthreads();
  }
#pragma unroll
  for (int i = 0; i < 4; ++i)
#pragma unroll
    for (int j = 0; j < 4; ++j) {
      const int gm = m0 + ty * 4 + i, gn = n0 + tx * 4 + j;
      if (gm < M && gn < N) C[(size_t)gm * ldc + gn] = acc[i][j];
    }
}

__global__ __launch_bounds__(256) void g_prep(const float* proj, const float* g_cq, const float* g_ckv, float* cqn, float* ckvn, float* krope) {
  __shared__ float red[4];
  const int p = blockIdx.x, t = threadIdx.x;
  const float* pr = proj + (size_t)p * INC;
  const float vq = pr[C_CQ + t];
  const float sq = block_sum256(vq * vq, red);
  cqn[(size_t)p * 256 + t] = vq * rsqrtf(sq * (1.f / 256) + EPS) * g_cq[t];
  const float vk = t < 128 ? pr[C_CKV + t] : 0.f;
  const float sk = block_sum256(vk * vk, red);
  if (t < 128) ckvn[(size_t)p * 128 + t] = vk * rsqrtf(sk * (1.f / 128) + EPS) * g_ckv[t];
  if (t < 16) {
    const float inv = powf(10000.f, -(float)t / 16.f);
    const float ang = (float)p * inv;
    float sn, cs; sincosf(ang, &sn, &cs);
    const float x1 = pr[C_KR + t], x2 = pr[C_KR + 16 + t];
    krope[(size_t)p * 32 + t] = x1 * cs - x2 * sn;
    krope[(size_t)p * 32 + 16 + t] = x1 * sn + x2 * cs;
  }
}

__global__ __launch_bounds__(128) void g_rope_q(float* qa) {
  const int p = blockIdx.x, t = threadIdx.x, h = t >> 4, j = t & 15;
  const float inv = powf(10000.f, -(float)j / 16.f);
  const float ang = (float)p * inv;
  float sn, cs; sincosf(ang, &sn, &cs);
  float* q = qa + (size_t)p * 768 + h * 96 + 64;
  const float x1 = q[j], x2 = q[16 + j];
  q[j] = x1 * cs - x2 * sn;
  q[16 + j] = x1 * sn + x2 * cs;
}

__device__ __forceinline__ int n_adm(int p) { return p < NMETA ? NMETA : NMETA + 64 * (1 + (p - NMETA) / 64); }

__global__ __launch_bounds__(256) void g_mla(const float* qa, const float* kva, const float* krope, float* oa) {
  __shared__ float qs[768];
  const int p = blockIdx.x, t = threadIdx.x, h = t >> 5, l = t & 31;
  for (int i = t; i < 768; i += 256) qs[i] = qa[(size_t)p * 768 + i];
  __syncthreads();
  const int na = n_adm(p);
  const float scale = 0.10206207261596575f;
  float m = -1e30f, ls = 0.f, acc[64];
#pragma unroll
  for (int d = 0; d < 64; ++d) acc[d] = 0.f;
  const float* q = qs + h * 96;
  for (int j = l; j < na; j += 32) {
    const float* kn = kva + (size_t)j * 1024 + h * 128;
    const float* kr = krope + (size_t)j * 32;
    float s = 0.f;
#pragma unroll 8
    for (int d = 0; d < 64; ++d) s = fmaf(q[d], kn[d], s);
#pragma unroll 8
    for (int d = 0; d < 32; ++d) s = fmaf(q[64 + d], kr[d], s);
    s *= scale;
    const float mn = fmaxf(m, s), c = expf(m - mn), pe = expf(s - mn);
    ls = ls * c + pe;
#pragma unroll
    for (int d = 0; d < 64; ++d) acc[d] = acc[d] * c + pe * kn[64 + d];
    m = mn;
  }
#pragma unroll
  for (int off = 16; off >= 1; off >>= 1) {
    const float m2 = __shfl_xor(m, off), l2 = __shfl_xor(ls, off);
    const float mn = fmaxf(m, m2), c1 = expf(m - mn), c2 = expf(m2 - mn);
    ls = ls * c1 + l2 * c2;
#pragma unroll
    for (int d = 0; d < 64; ++d) { const float a2 = __shfl_xor(acc[d], off); acc[d] = acc[d] * c1 + a2 * c2; }
    m = mn;
  }
  if (l == 0) {
    const float inv = 1.f / ls;
#pragma unroll
    for (int d = 0; d < 64; ++d) oa[(size_t)p * 512 + h * 64 + d] = acc[d] * inv;
  }
}

__device__ __forceinline__ unsigned f2key(float f) { const unsigned u = __float_as_uint(f); return (u & 0x80000000u) ? ~u : (u | 0x80000000u); }
__device__ __forceinline__ int t5_bucket(int rel) {
  const int n = rel < 0 ? -rel : rel;
  int v;
  if (n < 8) v = n;
  else v = 8 + (n >= 12) + (n >= 16) + (n >= 23) + (n >= 32) + (n >= 46) + (n >= 64) + (n >= 91);
  return (rel > 0 ? 16 : 0) + v;
}

__global__ __launch_bounds__(256) void g_dsa(const float* proj, const float* rel_bias, float* ob) {
  __shared__ float qi[512];
  __shared__ float qb[512];
  __shared__ float wi[8];
  __shared__ unsigned keys[L];
  __shared__ int sel[256];
  __shared__ float sc[8][256];
  __shared__ int redi[4];
  __shared__ int scan_gt[257], scan_eq[257];
  const int p = blockIdx.x, t = threadIdx.x;
  const float* pr = proj + (size_t)p * INC;
  for (int i = t; i < 512; i += 256) { qi[i] = pr[C_QI + i] * 0.125f; qb[i] = pr[C_QB + i]; }
  if (t < 8) wi[t] = pr[C_WI + t] * 0.35355339059327373f;
  __syncthreads();
  const int na = n_adm(p);
  for (int j = t; j < na; j += 256) {
    const float* ki = proj + (size_t)j * INC + C_KI;
    float s = 0.f;
    for (int h = 0; h < 8; ++h) {
      float lg = 0.f;
#pragma unroll 8
      for (int d = 0; d < 64; ++d) lg = fmaf(qi[h * 64 + d], ki[d], lg);
      s += wi[h] * fmaxf(lg, 0.f);
    }
    keys[j] = f2key(s);
  }
  __syncthreads();
  int nsel;
  if (na <= 256) {
    for (int j = t; j < na; j += 256) sel[j] = j;
    nsel = na;
  } else {
    unsigned T = 0;
    for (int bit = 31; bit >= 0; --bit) {
      const unsigned cand = T | (1u << bit);
      int c = 0;
      for (int j = t; j < na; j += 256) c += keys[j] >= cand;
      c = block_sumi256(c, redi);
      if (c >= 256) T = cand;
    }
    const int chunk = (na + 255) / 256;
    const int j0 = t * chunk, j1 = min(j0 + chunk, na);
    int cg = 0, ce = 0;
    for (int j = j0; j < j1; ++j) { cg += keys[j] > T; ce += keys[j] == T; }
    scan_gt[t + 1] = cg; scan_eq[t + 1] = ce;
    __syncthreads();
    if (t == 0) { scan_gt[0] = 0; scan_eq[0] = 0; for (int i = 1; i <= 256; ++i) { scan_gt[i] += scan_gt[i - 1]; scan_eq[i] += scan_eq[i - 1]; } }
    __syncthreads();
    const int ngt = scan_gt[256];
    const int r = 256 - ngt;
    int pg = scan_gt[t], pe = scan_eq[t];
    for (int j = j0; j < j1; ++j) {
      if (keys[j] > T) sel[pg++] = j;
      else if (keys[j] == T) { if (pe < r) sel[ngt + pe] = j; ++pe; }
    }
    nsel = 256;
  }
  __syncthreads();
  if (t < nsel) {
    const int j = sel[t];
    const float* kb = proj + (size_t)j * INC + C_KB;
    const int bk = t5_bucket(j - p);
    for (int h = 0; h < 8; ++h) {
      float s = 0.f;
#pragma unroll 8
      for (int d = 0; d < 64; ++d) s = fmaf(qb[h * 64 + d], kb[h * 64 + d], s);
      sc[h][t] = s * 0.125f + rel_bias[bk * 8 + h];
    }
  }
  __syncthreads();
  {
    const int h = t >> 5, l = t & 31;
    float m = -1e30f;
    for (int k = l; k < nsel; k += 32) m = fmaxf(m, sc[h][k]);
#pragma unroll
    for (int off = 16; off >= 1; off >>= 1) m = fmaxf(m, __shfl_xor(m, off));
    float s = 0.f;
    for (int k = l; k < nsel; k += 32) s += expf(sc[h][k] - m);
#pragma unroll
    for (int off = 16; off >= 1; off >>= 1) s += __shfl_xor(s, off);
    const float inv = 1.f / s;
    __syncthreads();
    for (int k = l; k < nsel; k += 32) sc[h][k] = expf(sc[h][k] - m) * inv;
  }
  __syncthreads();
  for (int o = t; o < 512; o += 256) {
    const int h = o >> 6;
    float a = 0.f;
    for (int k = 0; k < nsel; ++k) a = fmaf(sc[h][k], proj[(size_t)sel[k] * INC + C_VB + o], a);
    ob[(size_t)p * 512 + o] = a;
  }
}

__device__ __forceinline__ float sigmoidf_(float x) { return 1.f / (1.f + expf(-x)); }

__global__ __launch_bounds__(256) void g_gate(const float* proj, float* ya, const float* yb) {
  const int p = blockIdx.x;
  for (int c = threadIdx.x; c < D; c += 256) {
    const size_t i = (size_t)p * D + c;
    ya[i] = sigmoidf_(proj[(size_t)p * INC + C_GA + c]) * ya[i] + sigmoidf_(proj[(size_t)p * INC + C_GB + c]) * yb[i];
  }
}
__global__ __launch_bounds__(256) void g_resid(const float* x, const float* mix, float* out, int b) {
  const int p = blockIdx.x + NMETA;
  const size_t tok = (size_t)b * SEQ + (p - NMETA);
  for (int c = threadIdx.x; c < D; c += 256) out[tok * D + c] = x[tok * D + c] + mix[(size_t)p * D + c];
}

__global__ __launch_bounds__(256) void g_moe(float* io, const float* g_ffn, const float* w_rg, const float* b_rg, const float* w_re, const float* b_re,
                                             const float* w_gate, const float* w_up, const float* w_down, const float* g_fin) {
  __shared__ float xr[D], xn[D], hm[256], red[4], logit[36], gatew[2];
  __shared__ int expert[2];
  const int tok = blockIdx.x, t = threadIdx.x, lane = t & 63, wv = t >> 6;
  float* row = io + (size_t)tok * D;
  float s = 0.f;
  for (int i = t; i < D; i += 256) { const float v = row[i]; xr[i] = v; s += v * v; }
  s = block_sum256(s, red);
  const float rs = rsqrtf(s * (1.f / D) + EPS);
  for (int i = t; i < D; i += 256) xn[i] = xr[i] * rs * g_ffn[i];
  __syncthreads();
  for (int c = wv; c < 36; c += 4) {
    float a = 0.f;
    if (c < 4) { for (int i = lane; i < D; i += 64) a = fmaf(xn[i], w_rg[i * 4 + c], a); }
    else { for (int i = lane; i < D; i += 64) a = fmaf(xn[i], w_re[i * 32 + (c - 4)], a); }
    a = wave_sum(a);
    if (lane == 0) logit[c] = a + (c < 4 ? b_rg[c] : b_re[c - 4]);
  }
  __syncthreads();
  if (t == 0) {
    int gs = 0; float gm = logit[0];
    for (int i = 1; i < 4; ++i) if (logit[i] > gm) { gm = logit[i]; gs = i; }
    float se = 0.f; for (int i = 0; i < 4; ++i) se += expf(logit[i] - gm);
    const float pg = 1.f / se;
    const float* el = logit + 4 + gs * 8;
    float em = el[0]; for (int i = 1; i < 8; ++i) em = fmaxf(em, el[i]);
    float pe[8]; float ss = 0.f;
#pragma unroll
    for (int i = 0; i < 8; ++i) { pe[i] = expf(el[i] - em); ss += pe[i]; }
    int e1 = 0; float p1 = pe[0];
#pragma unroll
    for (int i = 1; i < 8; ++i) if (pe[i] > p1) { p1 = pe[i]; e1 = i; }
    int e2 = -1; float p2 = -1.f;
#pragma unroll
    for (int i = 0; i < 8; ++i) if (i != e1 && pe[i] > p2) { p2 = pe[i]; e2 = i; }
    p1 /= ss; p2 /= ss;
    const float den = p1 + p2;
    gatew[0] = pg * p1 / den; gatew[1] = pg * p2 / den;
    expert[0] = gs * 8 + e1; expert[1] = gs * 8 + e2;
  }
  __syncthreads();
  float ffn[4] = {0.f, 0.f, 0.f, 0.f};
  for (int a = 0; a < 2; ++a) {
    const int e = expert[a];
    const float* wg = w_gate + (size_t)e * D * 256;
    const float* wu = w_up + (size_t)e * D * 256;
    float g = 0.f, u = 0.f;
    for (int k = 0; k < D; ++k) { const float xv = xn[k]; g = fmaf(xv, wg[(size_t)k * 256 + t], g); u = fmaf(xv, wu[(size_t)k * 256 + t], u); }
    hm[t] = g / (1.f + expf(-g)) * u;
    __syncthreads();
    const float* wd = w_down + (size_t)e * 256 * D;
    const float gw = gatew[a];
#pragma unroll
    for (int i = 0; i < 4; ++i) {
      float y = 0.f;
      for (int j = 0; j < 256; ++j) y = fmaf(hm[j], wd[(size_t)j * D + t + 256 * i], y);
      ffn[i] += gw * y;
    }
    __syncthreads();
  }
  float h3[4]; float s2 = 0.f;
#pragma unroll
  for (int i = 0; i < 4; ++i) { h3[i] = xr[t + 256 * i] + ffn[i]; s2 += h3[i] * h3[i]; }
  s2 = block_sum256(s2, red);
  const float rs2 = rsqrtf(s2 * (1.f / D) + EPS);
#pragma unroll
  for (int i = 0; i < 4; ++i) row[t + 256 * i] = h3[i] * rs2 * g_fin[t + 256 * i];
}

static void gemm(const float* A, int lda, const float* Bm, int ldb, float* C, int ldc, int M, int N, int K, hipStream_t s) {
  dim3 g((N + 63) / 64, (M + 63) / 64);
  g_gemm<<<g, 256, 0, s>>>(A, lda, Bm, ldb, C, ldc, M, N, K);
}
}

extern "C" void kernel_launch(void* const* d_in, const int* in_sizes, int n_in, void* d_out, int out_size, void* d_ws, size_t ws_size, hipStream_t stream) {
  using namespace gold;
  const float* x = (const float*)d_in[0]; const float* meta = (const float*)d_in[1]; const float* g_mix = (const float*)d_in[2];
  const float* w_in = (const float*)d_in[3]; const float* g_cq = (const float*)d_in[4]; const float* g_ckv = (const float*)d_in[5];
  const float* w_uq = (const float*)d_in[6]; const float* w_ukv = (const float*)d_in[7]; const float* w_bra = (const float*)d_in[8];
  const float* w_brb = (const float*)d_in[9]; const float* w_o = (const float*)d_in[10]; const float* rel_bias = (const float*)d_in[11];
  const float* g_ffn = (const float*)d_in[12]; const float* w_rg = (const float*)d_in[13]; const float* b_rg = (const float*)d_in[14];
  const float* w_re = (const float*)d_in[15]; const float* b_re = (const float*)d_in[16]; const float* w_eg = (const float*)d_in[17];
  const float* w_eu = (const float*)d_in[18]; const float* w_ed = (const float*)d_in[19]; const float* g_fin = (const float*)d_in[20];
  float* out = (float*)d_out;
  float* ws = (float*)d_ws;
  size_t o = 0;
  float* hn = ws + o;   o += (size_t)L * D;
  float* proj = ws + o; o += (size_t)L * INC;
  float* cqn = ws + o;  o += (size_t)L * 256;
  float* ckvn = ws + o; o += (size_t)L * 128;
  float* krope = ws + o; o += (size_t)L * 32;
  float* qa = ws + o;   o += (size_t)L * 768;
  float* kva = ws + o;  o += (size_t)L * 1024;
  float* oa = ws + o;   o += (size_t)L * 512;
  float* ob = ws + o;   o += (size_t)L * 512;
  float* ya = ws + o;   o += (size_t)L * D;
  float* yb = ws + o;   o += (size_t)L * D;
  float* mix = hn;
  for (int b = 0; b < NB; ++b) {
    g_norm_rows<<<L, 256, 0, stream>>>(x, meta, g_mix, hn, b);
    gemm(hn, D, w_in, INC, proj, INC, L, INC, D, stream);
    g_prep<<<L, 256, 0, stream>>>(proj, g_cq, g_ckv, cqn, ckvn, krope);
    gemm(cqn, 256, w_uq, 768, qa, 768, L, 768, 256, stream);
    gemm(ckvn, 128, w_ukv, 1024, kva, 1024, L, 1024, 128, stream);
    g_rope_q<<<L, 128, 0, stream>>>(qa);
    g_mla<<<L, 256, 0, stream>>>(qa, kva, krope, oa);
    g_dsa<<<L, 256, 0, stream>>>(proj, rel_bias, ob);
    gemm(oa, 512, w_bra, D, ya, D, L, D, 512, stream);
    gemm(ob, 512, w_brb, D, yb, D, L, D, 512, stream);
    g_gate<<<L, 256, 0, stream>>>(proj, ya, yb);
    gemm(ya, D, w_o, D, mix, D, L, D, D, stream);
    g_resid<<<SEQ, 256, 0, stream>>>(x, mix, out, b);
  }
  g_moe<<<NB * SEQ, 256, 0, stream>>>(out, g_ffn, w_rg, b_rg, w_re, b_re, w_eg, w_eu, w_ed, g_fin);
}
```

```cpp
#include <hip/hip_runtime.h>
#include <hip/hip_cooperative_groups.h>
#include <cstdio>
#include <math.h>
#include <stdint.h>
namespace cg = cooperative_groups;

namespace mk {
typedef unsigned short bf16_t;
typedef short bf16x8 __attribute__((ext_vector_type(8)));
typedef float f32x16 __attribute__((ext_vector_type(16)));
typedef float f32x4 __attribute__((ext_vector_type(4)));
typedef unsigned u32x4 __attribute__((ext_vector_type(4)));
typedef unsigned u32x2 __attribute__((ext_vector_type(2)));

constexpr int D = 1024, NB = 4, SEQ = 4096, NMETA = 16, L = SEQ + NMETA, NT = NB * L  , NR = NB * SEQ  ;
constexpr int INC = 4584, LP = 4128;
constexpr int S_CQ = 0, S_CKV = 256, S_KR = 384, S_WI = 416, S_KI = 424;
constexpr float EPS = 1e-6f;
constexpr float LOG2E = 1.4426950408889634f;
constexpr int NTHR = 512, NW = NTHR / 64;

#define DI __device__ __forceinline__
#ifndef REP_P0
#define REP_P0 1
#endif
#ifndef REP_P1
#define REP_P1 1
#endif
#ifndef REP_MLA
#define REP_MLA 1
#endif
#ifndef REP_S1
#define REP_S1 1
#endif
#ifndef REP_S2
#define REP_S2 1
#endif
#ifndef REP_DSA
#define REP_DSA 1
#endif
#ifndef REP_P7
#define REP_P7 1
#endif
#ifndef REP_P8
#define REP_P8 1
#endif
#ifndef REP_MOE
#define REP_MOE 1
#endif
#ifndef REP_P2
#define REP_P2 1
#endif
#ifndef REP_CONV
#define REP_CONV 1
#endif
#ifndef SELFCHECK
#define SELFCHECK 0
#endif

typedef __bf16 bf2_t __attribute__((ext_vector_type(2)));
DI bf16_t f2bf(float x) { const __bf16 b = (__bf16)x; return __builtin_bit_cast(bf16_t, b); }
DI float bf2f(bf16_t v) { return __uint_as_float(((unsigned)v) << 16); }
DI unsigned pk2(float lo, float hi) { const bf2_t v = {(__bf16)lo, (__bf16)hi}; return __builtin_bit_cast(unsigned, v); }
#define dpp_i(v, ctrl) __builtin_amdgcn_update_dpp(0, (v), (ctrl), 0xf, 0xf, true)
DI float wave_sum(float v) {
  v += __int_as_float(dpp_i(__float_as_int(v), 0xB1));
  v += __int_as_float(dpp_i(__float_as_int(v), 0x4E));
  v += __int_as_float(dpp_i(__float_as_int(v), 0x141));
  v += __int_as_float(dpp_i(__float_as_int(v), 0x140));
  const int b = __float_as_int(v);
  return (__int_as_float(__builtin_amdgcn_readlane(b, 0)) + __int_as_float(__builtin_amdgcn_readlane(b, 16))) +
         (__int_as_float(__builtin_amdgcn_readlane(b, 32)) + __int_as_float(__builtin_amdgcn_readlane(b, 48)));
}
DI int wave_sumi(int v) {
  v += dpp_i(v, 0xB1); v += dpp_i(v, 0x4E); v += dpp_i(v, 0x141); v += dpp_i(v, 0x140);
  return (__builtin_amdgcn_readlane(v, 0) + __builtin_amdgcn_readlane(v, 16)) + (__builtin_amdgcn_readlane(v, 32) + __builtin_amdgcn_readlane(v, 48));
}
DI float block_sum256(float v, float* red) {
  v = wave_sum(v);
  __syncthreads();
  if ((threadIdx.x & 63) == 0) red[threadIdx.x >> 6] = v;
  __syncthreads();
  return red[0] + red[1] + red[2] + red[3];
}
DI int block_sumi256(int v, int* red) {
#pragma unroll
  for (int o = 1; o < 64; o <<= 1) v += __shfl_xor(v, o);
  __syncthreads();
  if ((threadIdx.x & 63) == 0) red[threadIdx.x >> 6] = v;
  __syncthreads();
  return red[0] + red[1] + red[2] + red[3];
}
DI int n_adm(int p) { return p < NMETA ? NMETA : NMETA + 64 * (1 + (p - NMETA) / 64); }


#if SELFCHECK
DI unsigned hash_u(unsigned x) { x ^= x >> 16; x *= 0x7feb352du; x ^= x >> 15; x *= 0x846ca68bu; x ^= x >> 16; return x; }
DI bool far(float got, float ref, float atol, float rtol) { const float d = fabsf(got - ref); return !(d <= atol + rtol * fabsf(ref)); }
#endif
struct Params {
  const float *x, *meta, *g_mix, *w_in, *g_cq, *g_ckv, *w_uq, *w_ukv, *w_bra, *w_brb, *w_o, *rel_bias, *g_ffn, *w_rg, *b_rg, *w_re, *b_re, *w_eg, *w_eu, *w_ed, *g_fin;
  float* out; unsigned char* ws;
  int use_cg; int pad;
};

constexpr size_t al(size_t x) { return (x + 255) & ~(size_t)255; }
constexpr size_t O_QB = 0;
constexpr size_t O_KB = al(O_QB + (size_t)NT * 512 * 2);
constexpr size_t O_VBT = al(O_KB + (size_t)NT * 512 * 2);
constexpr size_t O_QI = al(O_VBT + (size_t)NB * 8 * 64 * LP * 2);
constexpr size_t O_KI = al(O_QI + (size_t)NT * 512 * 2);
constexpr size_t O_WI = al(O_KI + (size_t)NT * 64 * 2);
constexpr size_t O_SMALL = al(O_WI + (size_t)NT * 8 * 4);
constexpr size_t O_CQN = al(O_SMALL + (size_t)NT * 512 * 4);
constexpr size_t O_CKVN = al(O_CQN + (size_t)NT * 256 * 2);
constexpr size_t O_QA = al(O_CKVN + (size_t)NT * 128 * 2);
constexpr size_t O_KMLA = al(O_QA + (size_t)NT * 768 * 2);
constexpr size_t O_VT = al(O_KMLA + (size_t)NB * 8 * LP * 96 * 2);
constexpr size_t R_END = al(O_VT + (size_t)NB * 8 * 64 * LP * 2 + (size_t)NT * 1536 * 2);
constexpr size_t O_HN = O_QA;
constexpr size_t O_KR = O_SMALL;
constexpr size_t O_OA = O_SMALL;
constexpr int MW = 132;
constexpr size_t O_MASK = al(O_OA + (size_t)NR * 512 * 2);
constexpr size_t O_SCORES = al(O_MASK + (size_t)NR * MW * 4);
constexpr size_t SCORES_PER_BATCH = (size_t)8192 * 1088;
constexpr size_t O_OB = O_SCORES;
constexpr size_t O_Y = al(O_OB + (size_t)NR * 512 * 2);
static_assert(O_SCORES + (size_t)NB * SCORES_PER_BATCH * 2 + 65536 <= R_END, "scores must fit region R");
constexpr size_t O_WIN = R_END;
constexpr size_t O_WG = al(O_WIN + (size_t)2560 * 1024 * 2);
constexpr size_t O_WUQ = al(O_WG + (size_t)2048 * 1024 * 2);
constexpr size_t O_WUKV = al(O_WUQ + (size_t)768 * 256 * 2);
constexpr size_t O_WBRA = al(O_WUKV + (size_t)1024 * 128 * 2);
constexpr size_t O_WBRB = al(O_WBRA + (size_t)1024 * 512 * 2);
constexpr size_t O_WO = al(O_WBRB + (size_t)1024 * 512 * 2);
constexpr size_t O_ROPE = al(O_WO + (size_t)1024 * 1024 * 2);
constexpr size_t O_CHK = al(O_ROPE + (size_t)L * 32 * 4);
constexpr size_t O_CTR = al(O_CHK + 256);
constexpr size_t O_BAR = al(O_CTR + 256);
constexpr size_t O_DEP = al(O_BAR + 3456 * 4);
constexpr size_t O_WR = al(O_DEP + 512 * 4);
constexpr size_t WS_END = al(O_WR + (size_t)36 * 1024 * 4);
constexpr int SLOTS = 2 * NR + 32 * 256;
constexpr size_t M_XN = 0;
constexpr size_t M_HMID = al(M_XN + (size_t)NR * 1024 * 2);
constexpr size_t M_YS = al(M_HMID + (size_t)SLOTS * 256 * 2);
constexpr size_t M_WGU = al(M_YS + (size_t)SLOTS * 1024 * 2);
constexpr size_t M_WD = al(M_WGU + (size_t)32 * 512 * 1024 * 2);
constexpr size_t M_LIST = al(M_WD + (size_t)32 * 1024 * 256 * 2);
constexpr size_t M_WL = al(M_LIST + (size_t)32 * NR * 4);
constexpr size_t M_ASG = al(M_WL + (size_t)32 * NR * 4);
constexpr size_t M_END = al(M_ASG + (size_t)NR * 16);
static_assert(M_END <= O_WIN, "MoE overlay must stay below the weights");
static_assert(WS_END <= (size_t)256 * 1024 * 1024, "workspace budget");
#if SELFCHECK
DI void chk_fail(const Params& P, int k) { atomicAdd((unsigned*)(P.ws + O_CHK) + k, 1u); }
#endif
constexpr int GX_A = 256 * 128, GX_B = 256 * 128, GX_STAGE = GX_A + GX_B;
constexpr int LDS_CTL = 2 * GX_STAGE;
constexpr int LDS_BYTES = LDS_CTL + 64;


#define XB_TMO      128
#define XB_XCNT(j)  (256  + 64 * (j))
#define XB_XSUB(j)  (1280 + 64 * (j))
#define XB_XGEN(j)  (2304 + 64 * (j))
#define XB_TOP      3328
#define XB_TOPGEN   3392
#define XCD_BAR_WORDS 3456
#define XB_SPIN_CAP (1u << 18)
#define LAS __attribute__((address_space(3)))
DI unsigned xb_ld(unsigned* p)              { return __hip_atomic_load(p, __ATOMIC_RELAXED, __HIP_MEMORY_SCOPE_AGENT); }
DI unsigned xb_add(unsigned* p, unsigned v) { return __hip_atomic_fetch_add(p, v, __ATOMIC_RELAXED, __HIP_MEMORY_SCOPE_AGENT); }
DI unsigned xb_xcc_id() { return (unsigned)__builtin_amdgcn_s_getreg((3 << 11) | 20) & 0xFu; }
#define XB_SPIN(cond, bar) do { unsigned _sp = 0; while (cond) { __builtin_amdgcn_s_sleep(1); \
    if ((++_sp & 255u) == 0u) { if (xb_ld(&(bar)[XB_TMO])) break; if (_sp > XB_SPIN_CAP) { atomicAdd(&(bar)[XB_TMO], 1u); break; } } } } while (0)
struct XcdBarrier { unsigned* bar; unsigned x; volatile LAS unsigned* st; };
DI XcdBarrier xcd_barrier_post(unsigned* bar, volatile LAS unsigned* st) {
  XcdBarrier b; b.bar = bar; b.x = xb_xcc_id(); b.st = st;
  if (threadIdx.x == 0) (void)xb_add(&bar[XB_XCNT(b.x)], 1u);
  return b;
}
DI void xcd_barrier_complete(unsigned* bar, unsigned x, unsigned& nloc, unsigned& nx) {
  const unsigned G = gridDim.x * gridDim.y * gridDim.z;
  unsigned sum, cnt, mine, sp = 0u;
  for (;;) {
    sum = 0u; cnt = 0u; mine = 0u;
#pragma unroll
    for (unsigned j = 0; j < 16; ++j) { const unsigned c = xb_ld(&bar[XB_XCNT(j)]); sum += c; cnt += (c > 0u) ? 1u : 0u; mine = (j == x) ? c : mine; }
    if (sum == G) break;
    __builtin_amdgcn_s_sleep(1);
    if ((++sp & 255u) == 0u) { if (xb_ld(&bar[XB_TMO])) break; if (sp > XB_SPIN_CAP) { atomicAdd(&bar[XB_TMO], 1u); break; } }
  }
  nloc = mine > 0u ? mine : 1u; nx = cnt > 0u ? cnt : 1u;
}
DI void xcd_barrier(const XcdBarrier& b) {
  asm volatile("s_waitcnt vmcnt(0)" ::: "memory");
  __syncthreads();
  if (threadIdx.x == 0) {
    unsigned* bar = b.bar;
    __builtin_amdgcn_s_waitcnt(0);
    unsigned nloc = b.st[0], nx = b.st[1];
    if (nloc == 0u) { xcd_barrier_complete(bar, b.x, nloc, nx); b.st[0] = nloc; b.st[1] = nx; }
    const unsigned old = xb_add(&bar[XB_XSUB(b.x)], 1u);
    const unsigned gen = old / nloc;
    if (old + 1u == (gen + 1u) * nloc) {
      __builtin_amdgcn_fence(__ATOMIC_RELEASE, "agent");
      asm volatile("s_waitcnt vmcnt(0)" ::: "memory");
      const unsigned og = xb_add(&bar[XB_TOP], 1u);
      const unsigned tg = og / nx;
      if (og + 1u == (tg + 1u) * nx) xb_add(&bar[XB_TOPGEN], 1u);
      else XB_SPIN(xb_ld(&bar[XB_TOPGEN]) == tg, bar);
      __builtin_amdgcn_fence(__ATOMIC_ACQUIRE, "agent");
      xb_add(&bar[XB_XGEN(b.x)], 1u);
      asm volatile("s_waitcnt vmcnt(0)" ::: "memory");
    } else {
      XB_SPIN(xb_ld(&bar[XB_XGEN(b.x)]) == gen, bar);
      __builtin_amdgcn_fence(__ATOMIC_ACQUIRE, "agent");
      asm volatile("s_waitcnt vmcnt(0)" ::: "memory");
    }
  }
  __syncthreads();
}

DI void p0_norm_row(const Params& P, int t, bf16_t* hn, int lane) {
  const int b = t / L, p = t % L;
  const float* row = p < NMETA ? P.meta + (size_t)p * D : P.x + ((size_t)b * SEQ + (p - NMETA)) * D;
  f32x4 v[4]; float s = 0.f;
#pragma unroll
  for (int i = 0; i < 4; ++i) { v[i] = *(const f32x4*)(row + 256 * i + 4 * lane); s += v[i][0] * v[i][0] + v[i][1] * v[i][1] + v[i][2] * v[i][2] + v[i][3] * v[i][3]; }
  s = wave_sum(s);
  const float rs = rsqrtf(s * (1.f / D) + EPS);
#pragma unroll
  for (int i = 0; i < 4; ++i) {
    const f32x4 g = *(const f32x4*)(P.g_mix + 256 * i + 4 * lane);
    u32x2 o; o[0] = pk2(v[i][0] * rs * g[0], v[i][1] * rs * g[1]); o[1] = pk2(v[i][2] * rs * g[2], v[i][3] * rs * g[3]);
    *(u32x2*)(hn + (size_t)t * D + 256 * i + 4 * lane) = o;
  }
}
template <class F>
DI void transpose_item(const float* src, int ldsrc, int K, bf16_t* dst, F map, int item, float* scr  , int tid, bool valid, const float* kscale = nullptr) {
  const int nkb = K / 64, kb = item % nkb, nb = item / nkb, k0 = kb * 64, n0 = nb * 64;
  if (valid) {
    const int n = tid & 63; const int col = map(n0 + n);
#pragma unroll 4
    for (int i = 0; i < 16; ++i) { const int k = (tid >> 6) + 4 * i; scr[k * 65 + n] = col >= 0 ? src[(size_t)(k0 + k) * ldsrc + col] * (kscale ? kscale[k0 + k] : 1.f) : 0.f; }
  }
  __syncthreads();
  if (valid) {
    const int kq = tid & 7;
#pragma unroll
    for (int i = 0; i < 2; ++i) {
      const int n = (tid >> 3) + 32 * i;
      const float* s = scr + (kq * 8) * 65 + n;
      u32x4 o; o[0] = pk2(s[0], s[65]); o[1] = pk2(s[2 * 65], s[3 * 65]); o[2] = pk2(s[4 * 65], s[5 * 65]); o[3] = pk2(s[6 * 65], s[7 * 65]);
      *(u32x4*)(dst + (size_t)(n0 + n) * K + k0 + kq * 8) = o;
    }
  }
  __syncthreads();
}
struct MapIn {
  DI int operator()(int n) const {
    if (n < 416) return n;
    if (n < 424) return 2528 + (n - 416);
    if (n < 488) return 2464 + (n - 424);
    if (n < 512) return -1;
    return 416 + (n - 512);
  }
};
struct MapOff { int off; DI int operator()(int n) const { return off + n; } };

DI void p0_prologue(const Params& P, unsigned char* lds) {
  unsigned char* ws = P.ws;
  const int tid = threadIdx.x, lane = tid & 63, wv = tid >> 6;
  const int gw = blockIdx.x * NW + wv, ngw = gridDim.x * NW;
  bf16_t* hn = (bf16_t*)(P.ws + O_HN);
  for (int t = gw; t < NT; t += ngw) p0_norm_row(P, t, hn, lane);
  float* rope = (float*)(ws + O_ROPE);
  for (int i = blockIdx.x * NTHR + tid; i < L * 16; i += gridDim.x * NTHR) {
    const int p = i >> 4, j = i & 15;
    const float inv = powf(10000.f, -(float)j / 16.f);
    const float ang = (float)p * inv;
    float sn, cs; sincosf(ang, &sn, &cs);
    rope[p * 32 + j] = cs; rope[p * 32 + 16 + j] = sn;
  }
  {
    bf16_t* vbt = (bf16_t*)(ws + O_VBT); bf16_t* vt = (bf16_t*)(ws + O_VT);
    for (int i = blockIdx.x * NTHR + tid; i < NB * 8 * 64 * (LP - L); i += gridDim.x * NTHR) {
      const int r = i / (LP - L), c = L + i % (LP - L);
      vbt[(size_t)r * LP + c] = 0; vt[(size_t)r * LP + c] = 0;
    }
  }
  {
    float* wr = (float*)(ws + O_WR);
    for (int i = blockIdx.x * NTHR + tid; i < 36 * 1024; i += gridDim.x * NTHR) {
      const int c = i >> 10, k = i & 1023;
      wr[i] = c < 4 ? P.w_rg[k * 4 + c] : P.w_re[k * 32 + (c - 4)];
    }
  }
  const int half = tid >> 8, t2 = tid & 255;
  float* scr = (float*)lds + half * (64 * 65 + 32);
  constexpr int I_IN = (1024 / 64) * (2560 / 64), I_G = (1024 / 64) * (2048 / 64), I_UQ = (256 / 64) * (768 / 64), I_UKV = (128 / 64) * (1024 / 64),
                I_BR = (512 / 64) * (1024 / 64), I_O = (1024 / 64) * (1024 / 64);
  constexpr int NIT = I_IN + I_G + I_UQ + I_UKV + 2 * I_BR + I_O;
  for (int it2 = blockIdx.x; 2 * it2 < NIT; it2 += gridDim.x) {
    int r = 2 * it2 + half; const bool valid = r < NIT; if (!valid) r = 0;
    if (r < I_IN) transpose_item(P.w_in, INC, 1024, (bf16_t*)(ws + O_WIN), MapIn(), r, scr, t2, valid);
    else if ((r -= I_IN) < I_G) transpose_item(P.w_in, INC, 1024, (bf16_t*)(ws + O_WG), MapOff{2536}, r, scr, t2, valid);
    else if ((r -= I_G) < I_UQ) transpose_item(P.w_uq, 768, 256, (bf16_t*)(ws + O_WUQ), MapOff{0}, r, scr, t2, valid, P.g_cq);
    else if ((r -= I_UQ) < I_UKV) transpose_item(P.w_ukv, 1024, 128, (bf16_t*)(ws + O_WUKV), MapOff{0}, r, scr, t2, valid, P.g_ckv);
    else if ((r -= I_UKV) < I_BR) transpose_item(P.w_bra, 1024, 512, (bf16_t*)(ws + O_WBRA), MapOff{0}, r, scr, t2, valid);
    else if ((r -= I_BR) < I_BR) transpose_item(P.w_brb, 1024, 512, (bf16_t*)(ws + O_WBRB), MapOff{0}, r, scr, t2, valid);
    else { r -= I_BR; transpose_item(P.w_o, 1024, 1024, (bf16_t*)(ws + O_WO), MapOff{0}, r, scr, t2, valid); }
  }
}

struct TilePtrs { const bf16_t* A; const bf16_t* B; unsigned a[4], b[4]; };
DI void gemm_issue(const TilePtrs& tp, int st, unsigned char* stage, int wb) {
#pragma unroll
  for (int i = 0; i < 4; ++i) {
    __builtin_amdgcn_global_load_lds((const unsigned*)(tp.A + st * 64 + tp.a[i]), (unsigned*)(stage + wb + i * 1024), 16, 0, 0);
    __builtin_amdgcn_global_load_lds((const unsigned*)(tp.B + st * 64 + tp.b[i]), (unsigned*)(stage + GX_A + wb + i * 1024), 16, 0, 0);
  }
}
template <bool SSQ = false>
DI float gemm_kloop(f32x16 (&acc)[4][2], const TilePtrs& tp, int K, unsigned char* lds) {
  float ssq = 0.f;
  const int tid = threadIdx.x, lane = tid & 63, w = __builtin_amdgcn_readfirstlane(tid >> 6), wr = w >> 2, wc = w & 3;
  const int wb = w * 4096;
  const int ns = K / 64;
  gemm_issue(tp, 0, lds, wb);
  __syncthreads();
  const int swz = (lane >> 1) & 7, hh = lane >> 5;
  const int arow = (wr * 128 + (lane & 31)) * 128, brow = GX_A + (wc * 64 + (lane & 31)) * 128;
  int coff[4];
#pragma unroll
  for (int kk = 0; kk < 4; ++kk) coff[kk] = ((2 * kk + hh) ^ swz) * 16;
#pragma unroll 1
  for (int s = 0; s < ns; ++s) {
    const int cur = s & 1;
    if (s + 1 < ns) gemm_issue(tp, s + 1, lds + (cur ^ 1) * GX_STAGE, wb);
    const unsigned char* Ac = lds + cur * GX_STAGE + arow;
    const unsigned char* Bc = lds + cur * GX_STAGE + brow;
#pragma unroll
    for (int kk = 0; kk < 4; ++kk) {
      bf16x8 fa[4], fb[2];
#pragma unroll
      for (int mi = 0; mi < 4; ++mi) fa[mi] = *(const bf16x8*)(Ac + mi * 32 * 128 + coff[kk]);
#pragma unroll
      for (int ni = 0; ni < 2; ++ni) fb[ni] = *(const bf16x8*)(Bc + ni * 32 * 128 + coff[kk]);
#pragma unroll
      for (int mi = 0; mi < 4; ++mi)
#pragma unroll
        for (int ni = 0; ni < 2; ++ni) acc[mi][ni] = __builtin_amdgcn_mfma_f32_32x32x16_bf16(fa[mi], fb[ni], acc[mi][ni], 0, 0, 0);
    }
    if (SSQ) {
      const unsigned char* rp = lds + cur * GX_STAGE + (tid >> 1) * 128 + (tid & 1) * 64;
      float q = 0.f;
#pragma unroll
      for (int j = 0; j < 4; ++j) {
        const u32x4 v = *(const u32x4*)(rp + j * 16);
#pragma unroll
        for (int e = 0; e < 4; ++e) { const float lo = __uint_as_float(v[e] << 16), hi = __uint_as_float(v[e] & 0xffff0000u); q = fmaf(lo, lo, q); q = fmaf(hi, hi, q); }
      }
      ssq += q;
    }
    __syncthreads();
  }
  return ssq;
}
DI void tile_rc(int i, int& row, int& chunk) { const int lane = threadIdx.x & 63, w = threadIdx.x >> 6; row = 32 * w + 8 * i + (lane >> 3); chunk = (lane & 7) ^ ((row >> 1) & 7); }
DI void zero_acc(f32x16 (&acc)[4][2]) {
#pragma unroll
  for (int i = 0; i < 4; ++i)
#pragma unroll
    for (int j = 0; j < 2; ++j)
#pragma unroll
      for (int r = 0; r < 16; ++r) acc[i][j][r] = 0.f;
}
DI void set_ptrs(TilePtrs& tp, const bf16_t* A, int lda, int M, int m0, const bf16_t* Bt, int ldb, int N, int n0) {
#pragma unroll
  for (int i = 0; i < 4; ++i) {
    int row, kc; tile_rc(i, row, kc);
    int r = m0 + row; r = r < M ? r : M - 1;
    int c = n0 + row; c = c < N ? c : N - 1;
    tp.a[i] = (unsigned)r * (unsigned)lda + kc * 8;
    tp.b[i] = (unsigned)c * (unsigned)ldb + kc * 8;
  }
  tp.A = A; tp.B = Bt;
}

DI bool p1_tile_map(int bx, int k, int G, int& mt, int& nt) { const int t = bx + k * G; if (t >= 65 * 18) return false; mt = t / 18; nt = t % 18; return true; }
DI bool p78_tile_map(int bx, int k, int G, int& mt, int& nt) { const int t = bx + k * G; if (t >= 64 * 4) return false; mt = t >> 2; nt = t & 3; return true; }

DI void p1_inproj_tile(const Params& P, int mt, int nt, unsigned char* lds) {
  unsigned char* ws = P.ws;
  const int m0 = mt * 256, n0 = nt * 256;
  const bf16_t* hn = (const bf16_t*)(ws + O_HN);
  TilePtrs tp;
  if (n0 < 2560) set_ptrs(tp, hn, 1024, NT, m0, (const bf16_t*)(ws + O_WIN), 1024, 2560, n0);
  else set_ptrs(tp, hn, 1024, NT, m0, (const bf16_t*)(ws + O_WG), 1024, 2048, n0 - 2560);
  f32x16 acc[4][2]; zero_acc(acc);
  (void)gemm_kloop(acc, tp, 1024, lds);
  const int lane = threadIdx.x & 63, w = threadIdx.x >> 6, wr = w >> 2, wc = w & 3, hh = lane >> 5, lc = lane & 31;
  if (n0 >= 2560) {
    bf16_t* gates = (bf16_t*)P.out;
#pragma unroll
    for (int mi = 0; mi < 4; ++mi)
#pragma unroll
      for (int ni = 0; ni < 2; ++ni) {
        const int col = n0 - 2560 + wc * 64 + ni * 32 + lc;
        int rbase = m0 + wr * 128 + mi * 32 + 4 * hh;
        asm volatile("" : "+v"(rbase));
#pragma unroll
        for (int r = 0; r < 16; ++r) {
          const int row = rbase + (r & 3) + 8 * (r >> 2);
          const int b = row / L, p = row - b * L;
          if (row < NT && p >= NMETA) gates[(size_t)(row - NMETA * (b + 1)) * 2048 + col] = f2bf(__builtin_amdgcn_rcpf(1.f + __expf(-acc[mi][ni][r])));
        }
      }
    return;
  }
  const int seg = n0 / 512, cb = n0 % 512;
#pragma unroll
  for (int mi = 0; mi < 4; ++mi)
#pragma unroll
    for (int ni = 0; ni < 2; ++ni) {
      const int col = cb + wc * 64 + ni * 32 + lc;
      const int rbase = m0 + wr * 128 + mi * 32 + 4 * hh;
      if (seg == 0) {
        const int tc0 = __builtin_amdgcn_readfirstlane(cb + wc * 64 + ni * 32);
        if (tc0 < 384) {
          bf16_t* dst = tc0 < 256 ? (bf16_t*)(ws + O_CQN) : (bf16_t*)(ws + O_CKVN);
          const int ld = tc0 < 256 ? 256 : 128, c = tc0 < 256 ? col : col - 256;
#pragma unroll
          for (int r = 0; r < 16; ++r) { const int row = rbase + (r & 3) + 8 * (r >> 2); if (row < NT) dst[(size_t)row * ld + c] = f2bf(acc[mi][ni][r]); }
        } else if (tc0 == 384) {
          const float* rope = (const float*)(ws + O_ROPE);
          bf16_t* kr = (bf16_t*)(ws + O_KR);
#pragma unroll
          for (int r = 0; r < 16; ++r) {
            const int row = rbase + (r & 3) + 8 * (r >> 2);
            const float v = acc[mi][ni][r], partner = __shfl_xor(v, 16);
            const int rowc = row < NT ? row : NT - 1, p = rowc % L, j = lc & 15;
            const float cs = rope[p * 32 + j], sn = rope[p * 32 + 16 + j];
            if (row < NT) kr[(size_t)row * 32 + lc] = f2bf((lc & 16) ? (partner * sn + v * cs) : (v * cs - partner * sn));
          }
        } else {
#pragma unroll
          for (int r = 0; r < 16; ++r) {
            const int row = rbase + (r & 3) + 8 * (r >> 2);
            if (row < NT) {
              if (col < 424) ((float*)(ws + O_WI))[(size_t)row * 8 + (col - 416)] = acc[mi][ni][r] * 0.35355339059327373f;
              else if (col < 488) ((bf16_t*)(ws + O_KI))[(size_t)row * 64 + (col - 424)] = f2bf(acc[mi][ni][r]);
            }
          }
        }
      } else if (seg == 3) {
        bf16_t* vbt = (bf16_t*)(ws + O_VBT);
        const int h = col >> 6, d = col & 63;
#pragma unroll
        for (int g = 0; g < 4; ++g) {
          const int row = rbase + 8 * g;
          if (row < NT) {
            const int b = row / L, p = row % L;
            u32x2 o; o[0] = pk2(acc[mi][ni][4 * g], acc[mi][ni][4 * g + 1]); o[1] = pk2(acc[mi][ni][4 * g + 2], acc[mi][ni][4 * g + 3]);
            *(u32x2*)(vbt + ((size_t)(b * 8 + h) * 64 + d) * LP + p) = o;
          }
        }
      } else {
        bf16_t* dst = (bf16_t*)(ws + (seg == 1 ? O_QB : seg == 2 ? O_KB : O_QI));
        const float sc = seg == 4 ? 0.125f : seg == 1 ? 0.125f * LOG2E : 1.f;
#pragma unroll
        for (int r = 0; r < 16; ++r) { const int row = rbase + (r & 3) + 8 * (r >> 2); if (row < NT) dst[(size_t)row * 512 + col] = f2bf(acc[mi][ni][r] * sc); }
      }
    }
}

DI void p2a_token(const Params& P, int t, int lane) {
  unsigned char* ws = P.ws;
  const float* sm = (const float*)(ws + O_SMALL) + (size_t)t * 512;
  const int b = t / L, p = t % L;
  {
    const f32x4 v = *(const f32x4*)(sm + S_CQ + 4 * lane);
    const float s = wave_sum(v[0] * v[0] + v[1] * v[1] + v[2] * v[2] + v[3] * v[3]);
    const float rs = rsqrtf(s * (1.f / 256) + EPS);
    const f32x4 g = *(const f32x4*)(P.g_cq + 4 * lane);
    u32x2 o; o[0] = pk2(v[0] * rs * g[0], v[1] * rs * g[1]); o[1] = pk2(v[2] * rs * g[2], v[3] * rs * g[3]);
    *(u32x2*)((bf16_t*)(ws + O_CQN) + (size_t)t * 256 + 4 * lane) = o;
  }
  {
    const float v0 = sm[S_CKV + 2 * lane], v1 = sm[S_CKV + 2 * lane + 1];
    const float s = wave_sum(v0 * v0 + v1 * v1);
    const float rs = rsqrtf(s * (1.f / 128) + EPS);
    *(unsigned*)((bf16_t*)(ws + O_CKVN) + (size_t)t * 128 + 2 * lane) = pk2(v0 * rs * P.g_ckv[2 * lane], v1 * rs * P.g_ckv[2 * lane + 1]);
  }
  {
    const float* rp = (const float*)(ws + O_ROPE) + p * 32;
    const int j = lane & 15;
    const float x1 = sm[S_KR + j], x2 = sm[S_KR + 16 + j], cs = rp[j], sn = rp[16 + j];
    const float o = (lane & 16) ? (x1 * sn + x2 * cs) : (x1 * cs - x2 * sn);
    bf16_t* km = (bf16_t*)(ws + O_KMLA);
    const bf16_t ob = f2bf(o);
    const int c = lane & 31;
#pragma unroll
    for (int hq = 0; hq < 4; ++hq) { const int h = hq + 4 * (lane >> 5); km[((size_t)(b * 8 + h) * LP + p) * 96 + 64 + c] = ob; }
  }
  ((bf16_t*)(ws + O_KI))[(size_t)t * 64 + lane] = f2bf(sm[S_KI + lane]);
  if (lane < 8) ((float*)(ws + O_WI))[(size_t)t * 8 + lane] = sm[S_WI + lane] * 0.35355339059327373f;
}


DI float* latent_rs(float ssq, int klen, unsigned char* lds) {
  float* rsl = (float*)lds;
  ssq += __int_as_float(dpp_i(__float_as_int(ssq), 0xB1));
  __syncthreads();
  if ((threadIdx.x & 1) == 0) rsl[threadIdx.x >> 1] = rsqrtf(ssq / (float)klen + EPS);
  __syncthreads();
  return rsl;
}
DI void p2b_q_tile(const Params& P, int tile, unsigned char* lds) {
  unsigned char* ws = P.ws;
  constexpr int NNT = 768 / 256;
  const int mt = tile / NNT, nt = tile % NNT, m0 = mt * 256, n0 = nt * 256;
  TilePtrs tp; set_ptrs(tp, (const bf16_t*)(ws + O_CQN), 256, NT, m0, (const bf16_t*)(ws + O_WUQ), 256, 768, n0);
  f32x16 acc[4][2]; zero_acc(acc);
  const float ssq = gemm_kloop<true>(acc, tp, 256, lds);
  const float* rsl = latent_rs(ssq, 256, lds);
  const int lane = threadIdx.x & 63, w = threadIdx.x >> 6, wr = w >> 2, wc = w & 3, hh = lane >> 5, lc = lane & 31;
  const float qscale = 0.10206207261596575f * LOG2E;
  const float* rope = (const float*)(ws + O_ROPE);
  bf16_t* qa = (bf16_t*)(ws + O_QA);
#pragma unroll
  for (int mi = 0; mi < 4; ++mi)
#pragma unroll
    for (int ni = 0; ni < 2; ++ni) {
      const int col = n0 + wc * 64 + ni * 32 + lc;
      const int ct = col >> 5;
      const bool is_rope = (ct % 3) == 2;
      const int rbase = m0 + wr * 128 + mi * 32 + 4 * hh;
#pragma unroll
      for (int r = 0; r < 16; ++r) {
        const int row = rbase + (r & 3) + 8 * (r >> 2);
        float v = acc[mi][ni][r] * rsl[row - m0];
        const float partner = __shfl_xor(v, 16);
        if (is_rope) {
          const int rowc = row < NT ? row : NT - 1;
          const int p = rowc % L, j = lc & 15;
          const float cs = rope[p * 32 + j], sn = rope[p * 32 + 16 + j];
          v = (lc & 16) ? (partner * sn + v * cs) : (v * cs - partner * sn);
        }
        if (row < NT) qa[(size_t)row * 768 + col] = f2bf(v * qscale);
      }
    }
  __syncthreads();
}
DI void p2b_kv_tile(const Params& P, int tile, unsigned char* lds) {
  unsigned char* ws = P.ws;
  constexpr int NNT = 1024 / 256;
  const int mt = tile / NNT, nt = tile % NNT, m0 = mt * 256, n0 = nt * 256;
  TilePtrs tp; set_ptrs(tp, (const bf16_t*)(ws + O_CKVN), 128, NT, m0, (const bf16_t*)(ws + O_WUKV), 128, 1024, n0);
  f32x16 acc[4][2]; zero_acc(acc);
  const float ssq = gemm_kloop<true>(acc, tp, 128, lds);
  const float* rsl = latent_rs(ssq, 128, lds);
  {
    const int row = m0 + (threadIdx.x >> 1);
    if (row < NT) {
      const int b = row / L, p = row % L, h = 2 * nt + (threadIdx.x & 1);
      const u32x4* src = (const u32x4*)((const bf16_t*)(ws + O_KR) + (size_t)row * 32);
      u32x4* dst = (u32x4*)((bf16_t*)(ws + O_KMLA) + ((size_t)(b * 8 + h) * LP + p) * 96 + 64);
      const u32x4 v0 = src[0], v1 = src[1], v2 = src[2], v3 = src[3];
      dst[0] = v0; dst[1] = v1; dst[2] = v2; dst[3] = v3;
    }
  }
  const int lane = threadIdx.x & 63, w = threadIdx.x >> 6, wr = w >> 2, wc = w & 3, hh = lane >> 5, lc = lane & 31;
  bf16_t* km = (bf16_t*)(ws + O_KMLA); bf16_t* vt = (bf16_t*)(ws + O_VT);
#pragma unroll
  for (int mi = 0; mi < 4; ++mi)
#pragma unroll
    for (int ni = 0; ni < 2; ++ni) {
      const int cc = n0 + wc * 64 + ni * 32 + lc, h = cc >> 7, c = cc & 127;
      const int rbase = m0 + wr * 128 + mi * 32 + 4 * hh;
      if (c < 64) {
#pragma unroll
        for (int r = 0; r < 16; ++r) {
          const int row = rbase + (r & 3) + 8 * (r >> 2);
          if (row < NT) { const int b = row / L, p = row % L; km[((size_t)(b * 8 + h) * LP + p) * 96 + c] = f2bf(acc[mi][ni][r] * rsl[row - m0]); }
        }
      } else {
        const int d = c - 64;
#pragma unroll
        for (int g = 0; g < 4; ++g) {
          const int row = rbase + 8 * g;
          if (row < NT) {
            const int b = row / L, p = row % L;
            const float r0 = rsl[row - m0], r1 = rsl[row - m0 + 1], r2 = rsl[row - m0 + 2], r3 = rsl[row - m0 + 3];
            u32x2 o; o[0] = pk2(acc[mi][ni][4 * g] * r0, acc[mi][ni][4 * g + 1] * r1); o[1] = pk2(acc[mi][ni][4 * g + 2] * r2, acc[mi][ni][4 * g + 3] * r3);
            *(u32x2*)(vt + ((size_t)(b * 8 + h) * 64 + d) * LP + p) = o;
          }
        }
      }
    }
  __syncthreads();
}


DI int next_item(const Params& P, int ctr, int* slot) {
  __syncthreads();
  if (threadIdx.x == 0) *slot = (int)atomicAdd((unsigned*)(P.ws + O_CTR) + ctr, 1u);
  __syncthreads();
  return *slot;
}
DI float fast_exp2(float x) { return __builtin_amdgcn_exp2f(x); }
DI bf16x8 pack8(const f32x16& v, int s) {
  u32x4 p;
  p[0] = pk2(v[8 * s + 0], v[8 * s + 1]); p[1] = pk2(v[8 * s + 2], v[8 * s + 3]); p[2] = pk2(v[8 * s + 4], v[8 * s + 5]); p[3] = pk2(v[8 * s + 6], v[8 * s + 7]);
  return __builtin_bit_cast(bf16x8, p);
}

constexpr float MASKV = -3.0e38f;
constexpr float DEFER_THR = 6.0f;
DI float xmax32(float v) {
  const auto r = __builtin_amdgcn_permlane32_swap(__float_as_uint(v), __float_as_uint(v), false, false);
  return fmaxf(__uint_as_float(r[0]), __uint_as_float(r[1]));
}
DI void softmax_update1(f32x16& s, float& m, float mref, float& lsum, f32x16& o0, f32x16& o1) {
  float mx = s[0];
#pragma unroll
  for (int r = 1; r < 16; ++r) mx = fmaxf(mx, s[r]);
  mx = xmax32(mx);
  const bool have = m > -1e29f;
  const float shift = (have ? m : 0.f) - mref;
  const bool need = (mx - shift > DEFER_THR) || (!have && mx > -1e37f);
  if (__any(need || shift != 0.f)) {
    const float delta = need ? mx - shift : 0.f;
    const float alpha = (need && have) ? fast_exp2(-delta) : 1.f;
    m = need ? (have ? m : 0.f) + delta : m;
    const float sub = shift + delta;
#pragma unroll
    for (int r = 0; r < 16; ++r) { s[r] -= sub; o0[r] *= alpha; o1[r] *= alpha; }
    lsum *= alpha;
  }
#pragma unroll
  for (int r = 0; r < 16; ++r) s[r] = fast_exp2(s[r]);
  typedef float f32x2 __attribute__((ext_vector_type(2)));
  f32x2 ps = {0.f, 0.f};
#pragma unroll
  for (int r = 0; r < 16; r += 2) ps += (f32x2){s[r], s[r + 1]};
  lsum += ps[0] + ps[1];
}
DI void pv_subtile(const unsigned char* Vc, int vstr, const f32x16& p, f32x16& o0, f32x16& o1) {
#pragma unroll
  for (int s2 = 0; s2 < 2; ++s2) {
    const bf16x8 pb = pack8(p, s2);
    const u32x2 a0l = *(const u32x2*)(Vc + s2 * 32), a0h = *(const u32x2*)(Vc + s2 * 32 + 16);
    const u32x2 a1l = *(const u32x2*)(Vc + 32 * vstr + s2 * 32), a1h = *(const u32x2*)(Vc + 32 * vstr + s2 * 32 + 16);
    o0 = __builtin_amdgcn_mfma_f32_32x32x16_bf16(__builtin_bit_cast(bf16x8, (u32x4){a0l[0], a0l[1], a0h[0], a0h[1]}), pb, o0, 0, 0, 0);
    o1 = __builtin_amdgcn_mfma_f32_32x32x16_bf16(__builtin_bit_cast(bf16x8, (u32x4){a1l[0], a1l[1], a1h[0], a1h[1]}), pb, o1, 0, 0, 0);
  }
}
constexpr int MLA_KSTR = 208, MLA_VSTR = 136, MLA_KBYTES = 64 * MLA_KSTR, MLA_STAGE = MLA_KBYTES + 64 * MLA_VSTR;
DI void mla_stage(const unsigned char* cur, int s, int cw, int lq, int hh, const bf16x8 (&qf)[6], f32x16& o0, f32x16& o1, float& m, float& lsum) {
  if (s > cw) return;
  const bool full = s < cw;
  const float mref = m > -1e29f ? m : 0.f;
  f32x16 s0, s1;
#pragma unroll
  for (int r = 0; r < 16; ++r) { s0[r] = -mref; s1[r] = -mref; }
  const unsigned char* Kc = cur + lq * MLA_KSTR + hh * 16;
  {
    bf16x8 kf[6];
#pragma unroll
    for (int kk = 0; kk < 6; ++kk) kf[kk] = *(const bf16x8*)(Kc + kk * 32);
#pragma unroll
    for (int kk = 0; kk < 6; ++kk) s0 = __builtin_amdgcn_mfma_f32_32x32x16_bf16(kf[kk], qf[kk], s0, 0, 0, 0);
    __builtin_amdgcn_sched_group_barrier(0x100, 6, 0);
    __builtin_amdgcn_sched_group_barrier(0x008, 6, 0);
  }
  if (full) {
    bf16x8 kf[6];
#pragma unroll
    for (int kk = 0; kk < 6; ++kk) kf[kk] = *(const bf16x8*)(Kc + 32 * MLA_KSTR + kk * 32);
#pragma unroll
    for (int kk = 0; kk < 6; ++kk) s1 = __builtin_amdgcn_mfma_f32_32x32x16_bf16(kf[kk], qf[kk], s1, 0, 0, 0);
    __builtin_amdgcn_sched_group_barrier(0x100, 6, 0);
    __builtin_amdgcn_sched_group_barrier(0x008, 6, 0);
  } else {
#pragma unroll
    for (int r = 8; r < 16; ++r) s0[r] = MASKV;
  }
  const unsigned char* Vc = cur + MLA_KBYTES + lq * MLA_VSTR + hh * 8;
  softmax_update1(s0, m, mref, lsum, o0, o1);
  pv_subtile(Vc, MLA_VSTR, s0, o0, o1);
  if (full) {
    softmax_update1(s1, m, mref, lsum, o0, o1);
    pv_subtile(Vc + 64, MLA_VSTR, s1, o0, o1);
  }
}
DI void mla_item(const Params& P, int item, unsigned char* lds) {
  unsigned char* ws = P.ws;
  const int jq = 15 - item / 32, bh = item % 32, b = bh >> 3, h = bh & 7;
  const int c0 = 4 * jq + 1;
  const int tid = threadIdx.x, lane = tid & 63, w = __builtin_amdgcn_readfirstlane(tid >> 6), hh = lane >> 5, lq = lane & 31;
  const int cw = c0 + (w >> 1);
  const int pq = NMETA + 256 * jq + 32 * w + lq;
  const int tq = b * L + pq;
  bf16x8 qf[6];
  {
    const bf16_t* qrow = (const bf16_t*)(ws + O_QA) + (size_t)tq * 768 + h * 96 + hh * 8;
#pragma unroll
    for (int kk = 0; kk < 6; ++kk) qf[kk] = *(const bf16x8*)(qrow + kk * 16);
  }
  f32x16 o0, o1;
#pragma unroll
  for (int r = 0; r < 16; ++r) { o0[r] = 0.f; o1[r] = 0.f; }
  float m = -1e30f, lsum = 0.f;
  const int nst = c0 + 4;
  const bf16_t* kg = (const bf16_t*)(ws + O_KMLA) + (size_t)bh * LP * 96;
  const bf16_t* vg = (const bf16_t*)(ws + O_VT) + (size_t)bh * 64 * LP;
  unsigned kgo[2], klo[2], vgo, vlo;
  const bool k2 = tid < 256;
#pragma unroll
  for (int i = 0; i < 2; ++i) { int idx = tid + 512 * i; idx = idx < 768 ? idx : 767; const int row = idx / 12, c = idx % 12; kgo[i] = row * 96 + c * 8; klo[i] = row * MLA_KSTR + c * 16; }
  { const int d = tid >> 3, c = tid & 7; vgo = d * LP + c * 8; vlo = MLA_KBYTES + d * MLA_VSTR + c * 16; }
  u32x4 rkA[2], rvA, rkB[2], rvB;
#define MLA_LOAD(rk_, rv_, st) do { const bf16_t* kgs = kg + (size_t)(st) * 64 * 96; const bf16_t* vgs = vg + (st) * 64; \
    rk_[0] = *(const u32x4*)(kgs + kgo[0]); rk_[1] = *(const u32x4*)(kgs + kgo[1]); rv_ = *(const u32x4*)(vgs + vgo); } while (0)
#define MLA_WRITE(rk_, rv_, buf) do { unsigned char* nb_ = (buf); \
    *(u32x4*)(nb_ + klo[0]) = rk_[0]; if (k2) *(u32x4*)(nb_ + klo[1]) = rk_[1]; \
    *(u32x2*)(nb_ + vlo) = (u32x2){rv_[0], rv_[1]}; *(u32x2*)(nb_ + vlo + 8) = (u32x2){rv_[2], rv_[3]}; } while (0)
  unsigned char* buf0 = lds; unsigned char* buf1 = lds + MLA_STAGE;
  MLA_LOAD(rkA, rvA, 0); MLA_WRITE(rkA, rvA, buf0);
  __syncthreads();
  if (nst > 1) MLA_LOAD(rkA, rvA, 1);
#pragma unroll 1
  for (int s = 0; s < nst; s += 2) {
    if (s + 2 < nst) MLA_LOAD(rkB, rvB, s + 2);
    mla_stage(buf0, s, cw, lq, hh, qf, o0, o1, m, lsum);
    if (s + 1 < nst) MLA_WRITE(rkA, rvA, buf1);
    __syncthreads();
    if (s + 1 >= nst) break;
    if (s + 3 < nst) MLA_LOAD(rkA, rvA, s + 3);
    mla_stage(buf1, s + 1, cw, lq, hh, qf, o0, o1, m, lsum);
    if (s + 2 < nst) MLA_WRITE(rkB, rvB, buf0);
    __syncthreads();
  }
#undef MLA_LOAD
#undef MLA_WRITE
  lsum += __shfl_xor(lsum, 32);
  const float inv = 1.f / lsum;
  bf16_t* oa = (bf16_t*)(ws + O_OA) + (size_t)(tq - NMETA * (b + 1)) * 512 + h * 64 + 4 * hh;
#pragma unroll
  for (int g = 0; g < 4; ++g) {
    u32x2 v0, v1;
    v0[0] = pk2(o0[4 * g] * inv, o0[4 * g + 1] * inv); v0[1] = pk2(o0[4 * g + 2] * inv, o0[4 * g + 3] * inv);
    v1[0] = pk2(o1[4 * g] * inv, o1[4 * g + 1] * inv); v1[1] = pk2(o1[4 * g + 2] * inv, o1[4 * g + 3] * inv);
    *(u32x2*)(oa + 8 * g) = v0;
    *(u32x2*)(oa + 32 + 8 * g) = v1;
  }
}


DI size_t score_row_off(int b, int i) {
  const int c = 1 + (i >> 6), m = c - 1;
  return (size_t)b * SCORES_PER_BATCH + (size_t)8192 * (m + (m >> 1) * ((m + 1) >> 1)) + (size_t)(i & 63) * (128 * ((c >> 1) + 1));
}
constexpr int S1_ITEMS = 4 * 560;
DI void s1_item(const Params& P, int it) {
  unsigned char* ws = P.ws;
  const int b = it & 3; int r = it >> 2; int c = 64;
  while (r >= (c >> 2) + 1) { r -= (c >> 2) + 1; --c; }
  const int n = 16 + 64 * c;
  const int lane = threadIdx.x & 63, w = (threadIdx.x >> 6) & 3, lq = lane & 15, lg = lane >> 4;
  const int i = (c - 1) * 64 + 16 * w + lq, tq = b * L + NMETA + i;
  bf16x8 qf[8][2];
  const bf16_t* qrow = (const bf16_t*)(ws + O_QI) + (size_t)tq * 512 + 8 * lg;
#pragma unroll
  for (int h = 0; h < 8; ++h) { qf[h][0] = *(const bf16x8*)(qrow + h * 64); qf[h][1] = *(const bf16x8*)(qrow + h * 64 + 32); }
  const f32x4 wa = *(const f32x4*)((const float*)(ws + O_WI) + (size_t)tq * 8), wb = *(const f32x4*)((const float*)(ws + O_WI) + (size_t)tq * 8 + 4);
  const float wv[8] = {wa[0], wa[1], wa[2], wa[3], wb[0], wb[1], wb[2], wb[3]};
  unsigned* srow = (unsigned*)((_Float16*)(ws + O_SCORES) + score_row_off(b, i)) + 4 * lg;
  const bf16_t* kbase = (const bf16_t*)(ws + O_KI) + ((size_t)b * L + lq) * 64 + 8 * lg;
#pragma unroll 1
  for (int g2 = 0; g2 < 2; ++g2) {
    const int kg = 256 * r + 128 * g2;
#pragma unroll 1
    for (int kt4 = 0; kt4 < 64; kt4 += 16) {
      const int ka = kg + kt4, kb = ka + 64;
      if (ka >= n) break;
      f32x4 sa = {0.f, 0.f, 0.f, 0.f}, sb = {0.f, 0.f, 0.f, 0.f};
      {
        const bf16_t* kp = kbase + (size_t)ka * 64;
        const bf16x8 a0 = *(const bf16x8*)kp, a1 = *(const bf16x8*)(kp + 32);
#pragma unroll
        for (int h = 0; h < 8; ++h) {
          f32x4 acc = {0.f, 0.f, 0.f, 0.f};
          acc = __builtin_amdgcn_mfma_f32_16x16x32_bf16(a0, qf[h][0], acc, 0, 0, 0);
          acc = __builtin_amdgcn_mfma_f32_16x16x32_bf16(a1, qf[h][1], acc, 0, 0, 0);
#pragma unroll
          for (int q = 0; q < 4; ++q) sa[q] = fmaf(wv[h], fmaxf(acc[q], 0.f), sa[q]);
        }
      }
      if (kb < n) {
        const bf16_t* kp = kbase + (size_t)kb * 64;
        const bf16x8 a0 = *(const bf16x8*)kp, a1 = *(const bf16x8*)(kp + 32);
#pragma unroll
        for (int h = 0; h < 8; ++h) {
          f32x4 acc = {0.f, 0.f, 0.f, 0.f};
          acc = __builtin_amdgcn_mfma_f32_16x16x32_bf16(a0, qf[h][0], acc, 0, 0, 0);
          acc = __builtin_amdgcn_mfma_f32_16x16x32_bf16(a1, qf[h][1], acc, 0, 0, 0);
#pragma unroll
          for (int q = 0; q < 4; ++q) sb[q] = fmaf(wv[h], fmaxf(acc[q], 0.f), sb[q]);
        }
      }
      typedef _Float16 h2_t __attribute__((ext_vector_type(2)));
      u32x4 o;
#pragma unroll
      for (int q = 0; q < 4; ++q) { const h2_t v = {(_Float16)sa[q], (_Float16)sb[q]}; o[q] = __builtin_bit_cast(unsigned, v); }
      *(u32x4*)(srow + (kg >> 1) + kt4) = o;
    }
  }
}

DI unsigned f2key(float f) { const unsigned u = __float_as_uint(f); return (u & 0x80000000u) ? ~u : (u | 0x80000000u); }
DI unsigned long long lanemask_lt(int lane) { return (1ull << lane) - 1ull; }
template <int NG>
DI void s2_row(const Params& P, int rq, int lane) {
  unsigned char* ws = P.ws;
  const int b = rq / SEQ, i = rq % SEQ, c = 1 + (i >> 6), n = 16 + 64 * c;
  const unsigned* srow = (const unsigned*)((const _Float16*)(ws + O_SCORES) + score_row_off(b, i)) + lane;
  typedef unsigned short u16x2 __attribute__((ext_vector_type(2)));
  u16x2 hp[NG];
  {
    unsigned raw[NG];
#pragma unroll
    for (int e = 0; e < NG; ++e) raw[e] = srow[64 * e];
#pragma unroll
    for (int e = 0; e < NG; ++e) asm volatile("" : "+v"(raw[e]));
#pragma unroll
    for (int e = 0; e < NG; ++e) {
      const unsigned d = raw[e];
      unsigned k = d ^ ((((d >> 15) & 0x00010001u) * 0xffffu) | 0x80008000u);
      if (128 * e + lane >= n) k &= 0xffff0000u;
      if (128 * e + 64 + lane >= n) k &= 0x0000ffffu;
      hp[e] = __builtin_bit_cast(u16x2, k);
    }
  }
  unsigned T = 0; int c_lo = 1 << 30, c_hi = 0;
  for (int bit = 15; bit >= 0; --bit) {
    const unsigned cand = T | (1u << bit);
    const unsigned short chm1 = (unsigned short)(cand - 1u);
    const u16x2 cv = {chm1, chm1}, one = {1, 1};
    u16x2 a0 = {0, 0}, a1 = {0, 0};
#pragma unroll
    for (int e = 0; e < NG; ++e) {
      u16x2 t;
      asm("v_pk_sub_u16 %0, %1, %2 clamp" : "=v"(t) : "v"(hp[e]), "v"(cv));
      asm("v_pk_min_u16 %0, %1, %2" : "=v"(t) : "v"(t), "v"(one));
      if (e & 1) asm("v_pk_add_u16 %0, %1, %2" : "=v"(a1) : "v"(a1), "v"(t)); else asm("v_pk_add_u16 %0, %1, %2" : "=v"(a0) : "v"(a0), "v"(t));
    }
    const u16x2 as = a0 + a1;
    const int cc = wave_sumi((int)as[0] + (int)as[1]);
    if (cc >= 256) { T = cand; c_lo = cc; } else { c_hi = cc; }
    if (c_lo == 256) break;
  }
  unsigned mlo = 0u, mhi = 0u;
  unsigned long long w64 = 0ull;
  int rem = c_lo == 256 ? (1 << 20) : 256 - c_hi;
#pragma unroll
  for (int e = 0; e < NG; ++e) {
    const unsigned kk = __builtin_bit_cast(unsigned, hp[e]);
#pragma unroll
    for (int h = 0; h < 2; ++h) {
      const unsigned kv = h ? (kk >> 16) : (kk & 0xffffu);
      const bool eq = kv == T;
      const unsigned long long meq = __ballot(eq), mgt = __ballot(kv > T);
      unsigned long long msel = mgt;
      if (meq) {
        const int pre = __popcll(meq & lanemask_lt(lane));
        msel |= __ballot(eq && pre < rem);
        rem -= __popcll(meq); rem = rem < 0 ? 0 : rem;
      }
      const int wd = 2 * e + h;
      if (wd < 64) { if (lane == wd) { mlo = (unsigned)msel; mhi = (unsigned)(msel >> 32); } } else if (wd == 64) w64 = msel;
    }
  }
  unsigned* mrow = (unsigned*)(P.ws + O_MASK) + (size_t)rq * MW;
  *(u32x2*)(mrow + 2 * lane) = (u32x2){mlo, mhi};
  if (lane == 0) { *(u32x2*)(mrow + 128) = (u32x2){(unsigned)w64, (unsigned)(w64 >> 32)}; *(u32x2*)(mrow + 130) = (u32x2){0u, 0u}; }
}
DI void s2_dispatch(const Params& P, int rq, int lane, unsigned* wl) {
  (void)wl;
  const int c = 1 + ((rq % SEQ) >> 6), n = 16 + 64 * c;
  if (n <= 256) {
    unsigned* mrow = (unsigned*)(P.ws + O_MASK) + (size_t)rq * MW;
    unsigned long long m = 0ull;
    const int lo = 64 * lane;
    if (lo + 64 <= n) m = ~0ull; else if (lo < n) m = (1ull << (n - lo)) - 1ull;
    *(u32x2*)(mrow + 2 * lane) = (u32x2){(unsigned)m, (unsigned)(m >> 32)};
    if (lane == 0) { *(u32x2*)(mrow + 128) = (u32x2){0u, 0u}; *(u32x2*)(mrow + 130) = (u32x2){0u, 0u}; }
    return;
  }
  const int ng = (c >> 1) + 1;
  if (ng <= 5) s2_row<5>(P, rq, lane);
  else if (ng <= 9) s2_row<9>(P, rq, lane);
  else if (ng <= 13) s2_row<13>(P, rq, lane);
  else if (ng <= 17) s2_row<17>(P, rq, lane);
  else if (ng <= 21) s2_row<21>(P, rq, lane);
  else if (ng <= 25) s2_row<25>(P, rq, lane);
  else if (ng <= 29) s2_row<29>(P, rq, lane);
  else s2_row<33>(P, rq, lane);
}

DI int t5_bucket(int rel) {
  const int n = rel < 0 ? -rel : rel;
  int v;
  if (n < 8) v = n;
  else v = 8 + (n >= 12) + (n >= 16) + (n >= 23) + (n >= 32) + (n >= 46) + (n >= 64) + (n >= 91);
  return (rel > 0 ? 16 : 0) + v;
}
constexpr int DSA_KSTR = 144, DSA_VSTR = 136, DSA_KBYTES = 64 * DSA_KSTR, DSA_STAGE = DSA_KBYTES + 64 * DSA_VSTR;
constexpr int DSA_TB = 2 * DSA_STAGE;
DI void dsa_stage(const unsigned char* cur, int s, int cw, int lq, int hh, int pq, int qmin, float bfar, const float* tb, const unsigned* mrow,
                  const bf16x8 (&qf)[4], f32x16& o0, f32x16& o1, float& m, float& lsum) {
  if (s > cw) return;
  const bool full = s < cw;
  const int kb0 = 64 * s;
  const bool near = kb0 + 63 >= qmin - 91;
  const unsigned w0 = mrow[2 * s] >> (4 * hh), w1 = mrow[2 * s + 1] >> (4 * hh);
  const float mref = m > -1e29f ? m : 0.f;
  f32x16 s0, s1;
  const float binit = (near ? 0.f : bfar) - mref;
#pragma unroll
  for (int r = 0; r < 16; ++r) { s0[r] = binit; s1[r] = binit; }
  const unsigned char* Kc = cur + lq * DSA_KSTR + hh * 16;
  {
    bf16x8 kf[4];
#pragma unroll
    for (int kk = 0; kk < 4; ++kk) kf[kk] = *(const bf16x8*)(Kc + kk * 32);
#pragma unroll
    for (int kk = 0; kk < 4; ++kk) s0 = __builtin_amdgcn_mfma_f32_32x32x16_bf16(kf[kk], qf[kk], s0, 0, 0, 0);
    __builtin_amdgcn_sched_group_barrier(0x100, 4, 0);
    __builtin_amdgcn_sched_group_barrier(0x008, 4, 0);
  }
  if (full) {
    bf16x8 kf[4];
#pragma unroll
    for (int kk = 0; kk < 4; ++kk) kf[kk] = *(const bf16x8*)(Kc + 32 * DSA_KSTR + kk * 32);
#pragma unroll
    for (int kk = 0; kk < 4; ++kk) s1 = __builtin_amdgcn_mfma_f32_32x32x16_bf16(kf[kk], qf[kk], s1, 0, 0, 0);
    __builtin_amdgcn_sched_group_barrier(0x100, 4, 0);
    __builtin_amdgcn_sched_group_barrier(0x008, 4, 0);
  }
  const float* tp = tb + (kb0 + 4 * hh - pq + 192);
  const unsigned char* Vc = cur + DSA_KBYTES + lq * DSA_VSTR + hh * 8;
  if (near) {
#pragma unroll
    for (int r = 0; r < 16; ++r) s0[r] += tp[(r & 3) + 8 * (r >> 2)];
  }
#pragma unroll
  for (int r = 0; r < 16; ++r) s0[r] = (w0 & (1u << ((r & 3) + 8 * (r >> 2)))) ? s0[r] : MASKV;
  softmax_update1(s0, m, mref, lsum, o0, o1);
  pv_subtile(Vc, DSA_VSTR, s0, o0, o1);
  if (full) {
    if (near) {
#pragma unroll
      for (int r = 0; r < 16; ++r) s1[r] += tp[32 + (r & 3) + 8 * (r >> 2)];
    }
#pragma unroll
    for (int r = 0; r < 16; ++r) s1[r] = (w1 & (1u << ((r & 3) + 8 * (r >> 2)))) ? s1[r] : MASKV;
    softmax_update1(s1, m, mref, lsum, o0, o1);
    pv_subtile(Vc + 64, DSA_VSTR, s1, o0, o1);
  }
}
DI void dsa_item(const Params& P, int item, unsigned char* lds) {
  unsigned char* ws = P.ws;
  const int jq = 15 - item / 32, bh = item % 32, b = bh >> 3, h = bh & 7;
  const int c0 = 4 * jq + 1;
  const int tid = threadIdx.x, lane = tid & 63, w = __builtin_amdgcn_readfirstlane(tid >> 6), hh = lane >> 5, lq = lane & 31;
  const int cw = c0 + (w >> 1);
  const int pq = NMETA + 256 * jq + 32 * w + lq;
  const int tq = b * L + pq, rq = b * SEQ + pq - NMETA;
  const int qmin = NMETA + 256 * jq + 32 * w;
  float* tb = (float*)(lds + DSA_TB);
  __syncthreads();
  if (tid < 256) tb[tid] = P.rel_bias[t5_bucket(tid - 192) * 8 + h] * LOG2E;
  const float bfar = P.rel_bias[15 * 8 + h] * LOG2E;
  bf16x8 qf[4];
  {
    const bf16_t* qrow = (const bf16_t*)(ws + O_QB) + (size_t)tq * 512 + h * 64 + hh * 8;
#pragma unroll
    for (int kk = 0; kk < 4; ++kk) qf[kk] = *(const bf16x8*)(qrow + kk * 16);
  }
  const unsigned* mrow = (const unsigned*)(P.ws + O_MASK) + (size_t)rq * MW;
  f32x16 o0, o1;
#pragma unroll
  for (int r = 0; r < 16; ++r) { o0[r] = 0.f; o1[r] = 0.f; }
  float m = -1e30f, lsum = 0.f;
  const int nst = c0 + 4;
  const bf16_t* kg = (const bf16_t*)(ws + O_KB) + (size_t)b * L * 512 + h * 64;
  const bf16_t* vg = (const bf16_t*)(ws + O_VBT) + (size_t)bh * 64 * LP;
  const int srow = tid >> 3, sc = tid & 7;
  const unsigned kgo = srow * 512 + sc * 8, klo = srow * DSA_KSTR + sc * 16, vgo = srow * LP + sc * 8, vlo = DSA_KBYTES + srow * DSA_VSTR + sc * 16;
  u32x4 rkA, rvA, rkB, rvB;
#define DSA_LOAD(rk_, rv_, st) do { const int kn = (st) * 64; const int kr = min(kn + srow, L - 1) - srow; \
    rk_ = *(const u32x4*)(kg + (size_t)kr * 512 + kgo); rv_ = *(const u32x4*)(vg + kn + vgo); } while (0)
#define DSA_WRITE(rk_, rv_, buf) do { unsigned char* nb_ = (buf); *(u32x4*)(nb_ + klo) = rk_; \
    *(u32x2*)(nb_ + vlo) = (u32x2){rv_[0], rv_[1]}; *(u32x2*)(nb_ + vlo + 8) = (u32x2){rv_[2], rv_[3]}; } while (0)
  unsigned char* buf0 = lds; unsigned char* buf1 = lds + DSA_STAGE;
  DSA_LOAD(rkA, rvA, 0); DSA_WRITE(rkA, rvA, buf0);
  __syncthreads();
  if (nst > 1) DSA_LOAD(rkA, rvA, 1);
#pragma unroll 1
  for (int s = 0; s < nst; s += 2) {
    if (s + 2 < nst) DSA_LOAD(rkB, rvB, s + 2);
    dsa_stage(buf0, s, cw, lq, hh, pq, qmin, bfar, tb, mrow, qf, o0, o1, m, lsum);
    if (s + 1 < nst) DSA_WRITE(rkA, rvA, buf1);
    __syncthreads();
    if (s + 1 >= nst) break;
    if (s + 3 < nst) DSA_LOAD(rkA, rvA, s + 3);
    dsa_stage(buf1, s + 1, cw, lq, hh, pq, qmin, bfar, tb, mrow, qf, o0, o1, m, lsum);
    if (s + 2 < nst) DSA_WRITE(rkB, rvB, buf0);
    __syncthreads();
  }
#undef DSA_LOAD
#undef DSA_WRITE
  lsum += __shfl_xor(lsum, 32);
  const float inv = 1.f / lsum;
  bf16_t* ob = (bf16_t*)(ws + O_OB) + (size_t)rq * 512 + h * 64 + 4 * hh;
#pragma unroll
  for (int g = 0; g < 4; ++g) {
    u32x2 v0, v1;
    v0[0] = pk2(o0[4 * g] * inv, o0[4 * g + 1] * inv); v0[1] = pk2(o0[4 * g + 2] * inv, o0[4 * g + 3] * inv);
    v1[0] = pk2(o1[4 * g] * inv, o1[4 * g + 1] * inv); v1[1] = pk2(o1[4 * g + 2] * inv, o1[4 * g + 3] * inv);
    *(u32x2*)(ob + 8 * g) = v0;
    *(u32x2*)(ob + 32 + 8 * g) = v1;
  }
}

template <bool CHECK> DI void nv_mla(const Params& P, int vb, unsigned char* lds) {
  unsigned char* ws = P.ws;
  float* qs = (float*)lds;
  const int b = vb / SEQ, p = NMETA + vb % SEQ, t = b * L + p;
  const int tid = threadIdx.x & 255, h = tid >> 5, l = tid & 31;
  const bf16_t* qa = (const bf16_t*)(ws + O_QA) + (size_t)t * 768;
  for (int i = tid; i < 768; i += 256) qs[i] = bf2f(qa[i]);
  __syncthreads();
  const int na = n_adm(p);
  const bf16_t* km = (const bf16_t*)(ws + O_KMLA) + (size_t)(b * 8 + h) * LP * 96;
  const bf16_t* vt = (const bf16_t*)(ws + O_VT) + (size_t)(b * 8 + h) * 64 * LP;
  float m = -1e30f, ls = 0.f, acc[64];
#pragma unroll
  for (int d = 0; d < 64; ++d) acc[d] = 0.f;
  const float* q = qs + h * 96;
  for (int j = l; j < na; j += 32) {
    const bf16_t* kr = km + (size_t)j * 96;
    float s = 0.f;
#pragma unroll 8
    for (int d = 0; d < 96; ++d) s = fmaf(q[d], bf2f(kr[d]), s);
    const float mn = fmaxf(m, s), c = exp2f(m - mn), pe = exp2f(s - mn);
    ls = ls * c + pe;
#pragma unroll
    for (int d = 0; d < 64; ++d) acc[d] = acc[d] * c + pe * bf2f(vt[(size_t)d * LP + j]);
    m = mn;
  }
#pragma unroll
  for (int off = 16; off >= 1; off >>= 1) {
    const float m2 = __shfl_xor(m, off), l2 = __shfl_xor(ls, off);
    const float mn = fmaxf(m, m2), c1 = exp2f(m - mn), c2 = exp2f(m2 - mn);
    ls = ls * c1 + l2 * c2;
#pragma unroll
    for (int d = 0; d < 64; ++d) { const float a2 = __shfl_xor(acc[d], off); acc[d] = acc[d] * c1 + a2 * c2; }
    m = mn;
  }
  if (l == 0) {
    const float inv = 1.f / ls;
    bf16_t* oa = (bf16_t*)(ws + O_OA) + (size_t)vb * 512 + h * 64;
    if (CHECK) {
#if SELFCHECK
#pragma unroll
      for (int d = 0; d < 64; ++d) if (far(bf2f(oa[d]), acc[d] * inv, 0.004f, 0.03f)) chk_fail(P, 13);
#endif
    } else {
#pragma unroll
      for (int d = 0; d < 64; ++d) oa[d] = f2bf(acc[d] * inv);
    }
  }
  __syncthreads();
}

#if SELFCHECK
struct NvDsaLds { float qi[512]; float qb[512]; float wi[8]; unsigned keys[L]; int sel[256]; float sc[8][256]; int redi[8]; int scan_gt[257]; int scan_eq[257]; unsigned char mine[L]; };
DI void nv_dsa_check(const Params& P, int vb, unsigned char* lds) {
  unsigned char* ws = P.ws;
  NvDsaLds& S = *(NvDsaLds*)lds;
  const int b = vb / SEQ, p = NMETA + vb % SEQ, t = b * L + p, tid = threadIdx.x & 255;
  const bf16_t* qi_g = (const bf16_t*)(ws + O_QI) + (size_t)t * 512;
  const bf16_t* qb_g = (const bf16_t*)(ws + O_QB) + (size_t)t * 512;
  for (int i = tid; i < 512; i += 256) { S.qi[i] = bf2f(qi_g[i]); S.qb[i] = bf2f(qb_g[i]); }
  if (tid < 8) S.wi[tid] = ((const float*)(ws + O_WI))[(size_t)t * 8 + tid];
  __syncthreads();
  const int na = n_adm(p);
  const bf16_t* ki_g = (const bf16_t*)(ws + O_KI) + (size_t)b * L * 64;
  for (int j = tid; j < na; j += 256) {
    const bf16_t* ki = ki_g + (size_t)j * 64;
    float s = 0.f;
    for (int h = 0; h < 8; ++h) {
      float lg = 0.f;
#pragma unroll 8
      for (int d = 0; d < 64; ++d) lg = fmaf(S.qi[h * 64 + d], bf2f(ki[d]), lg);
      s += S.wi[h] * fmaxf(lg, 0.f);
    }
    S.keys[j] = f2key(s);
    S.mine[j] = 0;
  }
  __syncthreads();
  if (na <= 256) {
    for (int j = tid; j < na; j += 256) S.mine[j] = 1;
  } else {
    unsigned T = 0;
    for (int bit = 31; bit >= 0; --bit) {
      const unsigned cand = T | (1u << bit);
      int c = 0;
      for (int j = tid; j < na; j += 256) c += S.keys[j] >= cand;
      c = block_sumi256(c, S.redi);
      if (c >= 256) T = cand;
    }
    const int chunk = (na + 255) / 256;
    const int j0 = tid * chunk, j1 = min(j0 + chunk, na);
    int cgt = 0, ce = 0;
    for (int j = j0; j < j1; ++j) { cgt += S.keys[j] > T; ce += S.keys[j] == T; }
    S.scan_gt[tid + 1] = cgt; S.scan_eq[tid + 1] = ce;
    __syncthreads();
    if (threadIdx.x == 0) { S.scan_gt[0] = 0; S.scan_eq[0] = 0; for (int i = 1; i <= 256; ++i) { S.scan_gt[i] += S.scan_gt[i - 1]; S.scan_eq[i] += S.scan_eq[i - 1]; } }
    __syncthreads();
    const int r = 256 - S.scan_gt[256];
    int pe = S.scan_eq[tid];
    for (int j = j0; j < j1; ++j) {
      if (S.keys[j] > T) S.mine[j] = 1;
      else if (S.keys[j] == T) { if (pe < r) S.mine[j] = 1; ++pe; }
    }
  }
  __syncthreads();
  const unsigned* mrow = (const unsigned*)(P.ws + O_MASK) + (size_t)vb * MW;
  int mism = 0, cntk = 0;
  for (int j = tid; j < 4224; j += 256) {
    const int kb = (mrow[j >> 5] >> (j & 31)) & 1;
    const int me = j < na ? (int)S.mine[j] : 0;
    mism += kb != me; cntk += kb;
    if (kb && j >= na) mism += 1000;
  }
  mism = block_sumi256(mism, S.redi);
  cntk = block_sumi256(cntk, S.redi);
  if (tid == 0) { if (mism > 16) chk_fail(P, 14); if (cntk != (na < 256 ? na : 256)) chk_fail(P, 14); }
  if (tid == 0) { int k = 0; for (int j = 0; j < na && k < 256; ++j) if ((mrow[j >> 5] >> (j & 31)) & 1) S.sel[k++] = j; for (; k < 256; ++k) S.sel[k] = 0; }
  const int nsel = na < 256 ? na : 256;
  __syncthreads();
  if (tid < nsel) {
    const int j = S.sel[tid];
    const bf16_t* kb = (const bf16_t*)(ws + O_KB) + (size_t)(b * L + j) * 512;
    const int bk = t5_bucket(j - p);
    for (int h = 0; h < 8; ++h) {
      float s = 0.f;
#pragma unroll 8
      for (int d = 0; d < 64; ++d) s = fmaf(S.qb[h * 64 + d], bf2f(kb[h * 64 + d]), s);
      S.sc[h][tid] = s + P.rel_bias[bk * 8 + h] * LOG2E;
    }
  }
  __syncthreads();
  {
    const int h = tid >> 5, l = tid & 31;
    float m = -1e30f;
    for (int k = l; k < nsel; k += 32) m = fmaxf(m, S.sc[h][k]);
#pragma unroll
    for (int off = 16; off >= 1; off >>= 1) m = fmaxf(m, __shfl_xor(m, off));
    float s = 0.f;
    for (int k = l; k < nsel; k += 32) s += exp2f(S.sc[h][k] - m);
#pragma unroll
    for (int off = 16; off >= 1; off >>= 1) s += __shfl_xor(s, off);
    const float inv = 1.f / s;
    __syncthreads();
    if (threadIdx.x < 256) for (int k = l; k < nsel; k += 32) S.sc[h][k] = exp2f(S.sc[h][k] - m) * inv;
  }
  __syncthreads();
  const bf16_t* vbt = (const bf16_t*)(ws + O_VBT) + (size_t)b * 8 * 64 * LP;
  const bf16_t* ob = (const bf16_t*)(ws + O_OB) + (size_t)vb * 512;
  for (int o = tid; o < 512; o += 256) {
    const int h = o >> 6;
    float a = 0.f;
    for (int k = 0; k < nsel; ++k) a = fmaf(S.sc[h][k], bf2f(vbt[(size_t)o * LP + S.sel[k]]), a);
    if (far(bf2f(ob[o]), a, 0.006f, 0.03f)) chk_fail(P, 15);
  }
  __syncthreads();
}
#endif

DI void p7_merge_tile(const Params& P, int mt, int nt, unsigned char* lds) {
  unsigned char* ws = P.ws;
  const int m0 = mt * 256, n0 = nt * 256;
  const bf16_t* gates = (const bf16_t*)P.out;
  bf16_t* yo = (bf16_t*)(ws + O_Y);
  TilePtrs tp;
  f32x16 acc[4][2];
  const int lane = threadIdx.x & 63, w = threadIdx.x >> 6, wr = w >> 2, wc = w & 3, hh = lane >> 5, lc = lane & 31;
#pragma unroll 1
  for (int br = 0; br < 2; ++br) {
    set_ptrs(tp, (const bf16_t*)(ws + (br ? O_OB : O_OA)), 512, NR, m0, (const bf16_t*)(ws + (br ? O_WBRB : O_WBRA)), 512, 1024, n0);
    zero_acc(acc); (void)gemm_kloop(acc, tp, 512, lds);
#pragma unroll
    for (int mi = 0; mi < 4; ++mi)
#pragma unroll
      for (int ni = 0; ni < 2; ++ni) {
        const int col = n0 + wc * 64 + ni * 32 + lc;
        int rbase = m0 + wr * 128 + mi * 32 + 4 * hh;
        asm volatile("" : "+v"(rbase));
#pragma unroll
        for (int hb = 0; hb < 2; ++hb) {
          bf16_t gv[8], pv[8];
#pragma unroll
          for (int q = 0; q < 8; ++q) {
            const int r = 8 * hb + q, row = rbase + (r & 3) + 8 * (r >> 2);
            gv[q] = gates[(size_t)row * 2048 + br * 1024 + col];
            pv[q] = br ? yo[(size_t)row * 1024 + col] : (bf16_t)0;
          }
#pragma unroll
          for (int q = 0; q < 8; ++q) {
            const int r = 8 * hb + q, row = rbase + (r & 3) + 8 * (r >> 2);
            yo[(size_t)row * 1024 + col] = f2bf(bf2f(gv[q]) * acc[mi][ni][r] + bf2f(pv[q]));
          }
          __builtin_amdgcn_sched_barrier(0);
        }
      }
    asm volatile("" ::: "memory");
  }
}

DI void p8_out_tile(const Params& P, int mt, int nt, unsigned char* lds) {
  unsigned char* ws = P.ws;
  const int m0 = mt * 256, n0 = nt * 256;
  TilePtrs tp; set_ptrs(tp, (const bf16_t*)(ws + O_Y), 1024, NR, m0, (const bf16_t*)(ws + O_WO), 1024, 1024, n0);
  f32x16 acc[4][2]; zero_acc(acc);
  (void)gemm_kloop(acc, tp, 1024, lds);
  const int lane = threadIdx.x & 63, w = threadIdx.x >> 6, wr = w >> 2, wc = w & 3, hh = lane >> 5, lc = lane & 31;
#pragma unroll
  for (int mi = 0; mi < 4; ++mi)
#pragma unroll
    for (int ni = 0; ni < 2; ++ni) {
      const int col = n0 + wc * 64 + ni * 32 + lc;
      const int rbase = m0 + wr * 128 + mi * 32 + 4 * hh;
      float xv[16];
#pragma unroll
      for (int r = 0; r < 16; ++r) xv[r] = P.x[(size_t)(rbase + (r & 3) + 8 * (r >> 2)) * D + col];
#pragma unroll
      for (int r = 0; r < 16; ++r) P.out[(size_t)(rbase + (r & 3) + 8 * (r >> 2)) * D + col] = xv[r] + acc[mi][ni][r];
    }
}

DI void p9_router_token(const Params& P, int tok, int lane) {
  unsigned char* ws = P.ws;
  const float* row = P.out + (size_t)tok * D;
  f32x4 v[4]; float s = 0.f;
#pragma unroll
  for (int i = 0; i < 4; ++i) { v[i] = *(const f32x4*)(row + 256 * i + 4 * lane); s += v[i][0] * v[i][0] + v[i][1] * v[i][1] + v[i][2] * v[i][2] + v[i][3] * v[i][3]; }
  s = wave_sum(s);
  const float rs = rsqrtf(s * (1.f / D) + EPS);
#pragma unroll
  for (int i = 0; i < 4; ++i) {
    const f32x4 g = *(const f32x4*)(P.g_ffn + 256 * i + 4 * lane);
    v[i][0] *= rs * g[0]; v[i][1] *= rs * g[1]; v[i][2] *= rs * g[2]; v[i][3] *= rs * g[3];
    u32x2 o; o[0] = pk2(v[i][0], v[i][1]); o[1] = pk2(v[i][2], v[i][3]);
    *(u32x2*)((bf16_t*)(ws + M_XN) + (size_t)tok * D + 256 * i + 4 * lane) = o;
  }
  const float* wr = (const float*)(ws + O_WR);
  float mylog = 0.f;
#pragma unroll 1
  for (int c = 0; c < 36; ++c) {
    float a = 0.f;
#pragma unroll
    for (int i = 0; i < 4; ++i) { const f32x4 w4 = *(const f32x4*)(wr + c * 1024 + 256 * i + 4 * lane); a += v[i][0] * w4[0] + v[i][1] * w4[1] + v[i][2] * w4[2] + v[i][3] * w4[3]; }
    a = wave_sum(a);
    if (lane == c) mylog = a + (c < 4 ? P.b_rg[c] : P.b_re[c - 4]);
  }
  float lg[4];
#pragma unroll
  for (int i = 0; i < 4; ++i) lg[i] = __shfl(mylog, i);
  int gs = 0; float gm = lg[0];
#pragma unroll
  for (int i = 1; i < 4; ++i) if (lg[i] > gm) { gm = lg[i]; gs = i; }
  float se = 0.f;
#pragma unroll
  for (int i = 0; i < 4; ++i) se += expf(lg[i] - gm);
  const float pg = 1.f / se;
  float el[8];
#pragma unroll
  for (int i = 0; i < 8; ++i) el[i] = __shfl(mylog, 4 + gs * 8 + i);
  float em = el[0];
#pragma unroll
  for (int i = 1; i < 8; ++i) em = fmaxf(em, el[i]);
  float pe[8]; float ss = 0.f;
#pragma unroll
  for (int i = 0; i < 8; ++i) { pe[i] = expf(el[i] - em); ss += pe[i]; }
  int e1 = 0; float p1 = pe[0];
#pragma unroll
  for (int i = 1; i < 8; ++i) if (pe[i] > p1) { p1 = pe[i]; e1 = i; }
  int e2 = 0; float p2 = -1.f;
#pragma unroll
  for (int i = 0; i < 8; ++i) if (i != e1 && pe[i] > p2) { p2 = pe[i]; e2 = i; }
  p1 /= ss; p2 /= ss;
  const float den = p1 + p2;
  const float w1 = pg * p1 / den, w2 = pg * p2 / den;
  const int x1 = gs * 8 + e1, x2 = gs * 8 + e2;
  if (lane == 0) {
    unsigned* cnt = (unsigned*)(ws + O_CTR) + 32;
    const int q1 = (int)atomicAdd(cnt + x1, 1u), q2 = (int)atomicAdd(cnt + x2, 1u);
    ((int*)(ws + M_LIST))[(size_t)x1 * NR + q1] = tok; ((int*)(ws + M_LIST))[(size_t)x2 * NR + q2] = tok;
    ((float*)(ws + M_WL))[(size_t)x1 * NR + q1] = w1; ((float*)(ws + M_WL))[(size_t)x2 * NR + q2] = w2;
    int* asg = (int*)(ws + M_ASG) + (size_t)tok * 4;
    asg[0] = x1; asg[1] = q1; asg[2] = x2; asg[3] = q2;
  }
}
DI void p9_conv_gu_item(const Params& P, int item, float* scr, int tid, bool valid) {
  const int e = item >> 7, r = item & 127, kb = r & 15, nb = r >> 4;
  const int k0 = kb * 64, n0 = nb * 64;
  bf16_t* dst = (bf16_t*)(P.ws + M_WGU) + (size_t)e * 512 * 1024;
  if (valid) {
    const int n = tid & 63, nd = n0 + n, q = nd >> 8, within = nd & 255, wcc = within >> 6, part = (within >> 5) & 1, idx = within & 31;
    const float* src = (part ? P.w_eu : P.w_eg) + (size_t)e * 1024 * 256 + (q * 128 + wcc * 32 + idx);
#pragma unroll 4
    for (int i = 0; i < 16; ++i) { const int k = (tid >> 6) + 4 * i; scr[k * 65 + n] = src[(size_t)(k0 + k) * 256]; }
  }
  __syncthreads();
  if (valid) {
    const int kq = tid & 7;
#pragma unroll
    for (int i = 0; i < 2; ++i) {
      const int n = (tid >> 3) + 32 * i;
      const float* sp = scr + (kq * 8) * 65 + n;
      u32x4 o; o[0] = pk2(sp[0], sp[65]); o[1] = pk2(sp[2 * 65], sp[3 * 65]); o[2] = pk2(sp[4 * 65], sp[5 * 65]); o[3] = pk2(sp[6 * 65], sp[7 * 65]);
      *(u32x4*)(dst + (size_t)(n0 + n) * 1024 + k0 + kq * 8) = o;
    }
  }
  __syncthreads();
}
DI int moe_tile_lookup(const Params& P, int tile, int& e_out, int& rt_out, int& cnt_out, int& base_slot) {
  const unsigned* cnt = (const unsigned*)(P.ws + O_CTR) + 32;
  int acc = 0, found = 0;
  e_out = 0; rt_out = 0; cnt_out = 0; base_slot = 0;
  for (int e = 0; e < 32; ++e) {
    const int c = (int)cnt[e], nt = (c + 255) >> 8;
    if (!found && tile < acc + nt) { e_out = e; rt_out = tile - acc; cnt_out = c; base_slot = acc * 256; found = 1; }
    acc += nt;
  }
  return acc;
}
DI void p10_gu_tile(const Params& P, int tile, int e, int rt, int cnt, int base_slot, int q, unsigned char* lds) {
  unsigned char* ws = P.ws;
  const int tid = threadIdx.x;
  const int* list = (const int*)(ws + M_LIST) + (size_t)e * NR;
  TilePtrs tp;
#pragma unroll
  for (int i = 0; i < 4; ++i) { int row, kc; tile_rc(i, row, kc); int r = rt * 256 + row; r = r < cnt ? r : cnt - 1; tp.a[i] = (unsigned)list[r] * 1024u + kc * 8; tp.b[i] = (unsigned)(q * 256 + row) * 1024u + kc * 8; }
  tp.A = (const bf16_t*)(ws + M_XN); tp.B = (const bf16_t*)(ws + M_WGU) + (size_t)e * 512 * 1024;
  f32x16 acc[4][2]; zero_acc(acc);
  (void)gemm_kloop(acc, tp, 1024, lds);
  const int lane = tid & 63, w = tid >> 6, wr = w >> 2, wc = w & 3, hh = lane >> 5, lc = lane & 31;
  bf16_t* hm = (bf16_t*)(ws + M_HMID);
  const int col = q * 128 + wc * 32 + lc;
#pragma unroll
  for (int mi = 0; mi < 4; ++mi) {
    int rbase = wr * 128 + mi * 32 + 4 * hh;
    asm volatile("" : "+v"(rbase));
#pragma unroll
    for (int r = 0; r < 16; ++r) {
      const int rr = rt * 256 + rbase + (r & 3) + 8 * (r >> 2);
      const float g = acc[mi][0][r], u = acc[mi][1][r];
      const float hv = g * __builtin_amdgcn_rcpf(1.f + __expf(-g)) * u;
      if (rr < cnt) hm[(size_t)(base_slot + rr) * 256 + col] = f2bf(hv);
    }
  }
  asm volatile("s_waitcnt vmcnt(0)" ::: "memory");
  __syncthreads();
  if (threadIdx.x == 0) {
    __builtin_amdgcn_fence(__ATOMIC_RELEASE, "agent");
    asm volatile("s_waitcnt vmcnt(0)" ::: "memory");
    __hip_atomic_fetch_add((unsigned*)(ws + O_DEP) + tile, 1u, __ATOMIC_RELAXED, __HIP_MEMORY_SCOPE_AGENT);
  }
}
DI void p11_down_tile(const Params& P, int tile, int e, int rt, int cnt, int base_slot, int nt, unsigned char* lds) {
  unsigned char* ws = P.ws;
  if (threadIdx.x == 0) {
    unsigned* dep = (unsigned*)(ws + O_DEP) + tile;
    unsigned spins = 0;
    while (__hip_atomic_load(dep, __ATOMIC_RELAXED, __HIP_MEMORY_SCOPE_AGENT) < 2u && ++spins < (1u << 22)) __builtin_amdgcn_s_sleep(2);
    __builtin_amdgcn_fence(__ATOMIC_ACQUIRE, "agent");
    asm volatile("s_waitcnt vmcnt(0)" ::: "memory");
  }
  __syncthreads();
  const int tid = threadIdx.x;
  TilePtrs tp;
#pragma unroll
  for (int i = 0; i < 4; ++i) { int row, kc; tile_rc(i, row, kc); int r = rt * 256 + row; r = r < cnt ? r : cnt - 1; tp.a[i] = (unsigned)(base_slot + r) * 256u + kc * 8; tp.b[i] = (unsigned)(nt * 256 + row) * 256u + kc * 8; }
  tp.A = (const bf16_t*)(ws + M_HMID); tp.B = (const bf16_t*)(ws + M_WD) + (size_t)e * 1024 * 256;
  f32x16 acc[4][2]; zero_acc(acc);
  (void)gemm_kloop(acc, tp, 256, lds);
  const int lane = tid & 63, w = tid >> 6, wr = w >> 2, wc = w & 3, hh = lane >> 5, lc = lane & 31;
  bf16_t* ys = (bf16_t*)(ws + M_YS);
  const float* wl = (const float*)(ws + M_WL) + (size_t)e * NR;
#pragma unroll
  for (int mi = 0; mi < 4; ++mi)
#pragma unroll
    for (int ni = 0; ni < 2; ++ni) {
      const int col = nt * 256 + wc * 64 + ni * 32 + lc;
      int rbase = wr * 128 + mi * 32 + 4 * hh;
      asm volatile("" : "+v"(rbase));
#pragma unroll
      for (int r = 0; r < 16; ++r) {
        const int rr = rt * 256 + rbase + (r & 3) + 8 * (r >> 2);
        if (rr < cnt) ys[(size_t)(base_slot + rr) * 1024 + col] = f2bf(acc[mi][ni][r] * wl[rr]);
      }
    }
}
DI void p12_final_token(const Params& P, int tok, int lane, const int* sbase  ) {
  unsigned char* ws = P.ws;
  float* row = P.out + (size_t)tok * D;
  const int* asg = (const int*)(ws + M_ASG) + (size_t)tok * 4;
  const int s1 = sbase[asg[0]] + asg[1], s2 = sbase[asg[2]] + asg[3];
  const bf16_t* y1 = (const bf16_t*)(ws + M_YS) + (size_t)s1 * 1024;
  const bf16_t* y2 = (const bf16_t*)(ws + M_YS) + (size_t)s2 * 1024;
  f32x4 v[4]; float s = 0.f;
#pragma unroll
  for (int i = 0; i < 4; ++i) {
    v[i] = *(const f32x4*)(row + 256 * i + 4 * lane);
    const u32x2 a = *(const u32x2*)(y1 + 256 * i + 4 * lane), b = *(const u32x2*)(y2 + 256 * i + 4 * lane);
    v[i][0] += __uint_as_float(a[0] << 16) + __uint_as_float(b[0] << 16);
    v[i][1] += __uint_as_float(a[0] & 0xffff0000u) + __uint_as_float(b[0] & 0xffff0000u);
    v[i][2] += __uint_as_float(a[1] << 16) + __uint_as_float(b[1] << 16);
    v[i][3] += __uint_as_float(a[1] & 0xffff0000u) + __uint_as_float(b[1] & 0xffff0000u);
    s += v[i][0] * v[i][0] + v[i][1] * v[i][1] + v[i][2] * v[i][2] + v[i][3] * v[i][3];
  }
  s = wave_sum(s);
  const float rs = rsqrtf(s * (1.f / D) + EPS);
#pragma unroll
  for (int i = 0; i < 4; ++i) {
    const f32x4 g = *(const f32x4*)(P.g_fin + 256 * i + 4 * lane);
    f32x4 o; o[0] = v[i][0] * rs * g[0]; o[1] = v[i][1] * rs * g[1]; o[2] = v[i][2] * rs * g[2]; o[3] = v[i][3] * rs * g[3];
    *(f32x4*)(row + 256 * i + 4 * lane) = o;
  }
}

struct NvMoeLds { float xr[D]; float xn[D]; float hm[256]; float red[8]; float logit[36]; float gatew[2]; int expert[2]; };


#if SELFCHECK
DI const float* h_row(const Params& P, int t) { const int b = t / L, p = t % L; return p < NMETA ? P.meta + (size_t)p * D : P.x + ((size_t)b * SEQ + (p - NMETA)) * D; }
DI void chk_load_hn(const Params& P, int t, float* hv, float* red) {
  const float* row = h_row(P, t);
  float s = 0.f;
  for (int i = (threadIdx.x & 255); i < D; i += 256) { const float v = row[i]; hv[i] = v; s += v * v; }
  s = block_sum256(s, red);
  const float rs = rsqrtf(s * (1.f / D) + EPS);
  if (threadIdx.x < 256) for (int i = threadIdx.x; i < D; i += 256) hv[i] = hv[i] * rs * P.g_mix[i];
  __syncthreads();
}
DI void chk_stageA(const Params& P, unsigned char* lds) {
  unsigned char* ws = P.ws;
  float* hv = (float*)lds; float* pj = hv + 1024; float* red = pj + 4608; float* cq = red + 8; float* ckv = cq + 256;
  const int tid = threadIdx.x & 255;
  for (int sidx = blockIdx.x; sidx < 512; sidx += gridDim.x) {
    const int t = sidx < 8 ? (sidx < 4 ? sidx * L + (sidx & 3) * 5 : NT - 1 - (sidx - 4) * 1031) : (int)(hash_u(sidx * 7919u + 13u) % NT);
    const int b = t / L, p = t % L;
    chk_load_hn(P, t, hv, red);
    for (int c = tid; c < 2536; c += 256) { float a = 0.f; for (int k = 0; k < D; ++k) a = fmaf(hv[k], P.w_in[(size_t)k * INC + c], a); pj[c] = a; }
    __syncthreads();
    for (int c = tid; c < 512; c += 256) {
      if (far(bf2f(((const bf16_t*)(ws + O_QB))[(size_t)t * 512 + c]), pj[416 + c] * (0.125f * LOG2E), 0.012f, 0.02f)) chk_fail(P, 2);
      if (far(bf2f(((const bf16_t*)(ws + O_KB))[(size_t)t * 512 + c]), pj[928 + c], 0.06f, 0.02f)) chk_fail(P, 3);
      const int h = c >> 6, d = c & 63;
      if (far(bf2f(((const bf16_t*)(ws + O_VBT))[((size_t)(b * 8 + h) * 64 + d) * LP + p]), pj[1440 + c], 0.06f, 0.02f)) chk_fail(P, 4);
      if (far(bf2f(((const bf16_t*)(ws + O_QI))[(size_t)t * 512 + c]), pj[1952 + c] * 0.125f, 0.01f, 0.02f)) chk_fail(P, 5);
    }
    for (int c = tid; c < 64; c += 256) if (far(bf2f(((const bf16_t*)(ws + O_KI))[(size_t)t * 64 + c]), pj[2464 + c], 0.06f, 0.02f)) chk_fail(P, 6);
    for (int c = tid; c < 8; c += 256) if (far(((const float*)(ws + O_WI))[(size_t)t * 8 + c], pj[2528 + c] * 0.35355339f, 0.03f, 0.02f)) chk_fail(P, 6);
    { float s = 0.f; for (int i = tid; i < 256; i += 256) s += pj[i] * pj[i]; s = block_sum256(s, red);
      const float rs = rsqrtf(s * (1.f / 256) + EPS); for (int i = tid; i < 256; i += 256) cq[i] = pj[i] * rs * P.g_cq[i]; }
    { float s = 0.f; for (int i = tid; i < 128; i += 256) s += pj[256 + i] * pj[256 + i]; s = block_sum256(s, red);
      const float rs = rsqrtf(s * (1.f / 128) + EPS); for (int i = tid; i < 128; i += 256) ckv[i] = pj[256 + i] * rs * P.g_ckv[i]; }
    __syncthreads();
    const float qscale = 0.10206207261596575f * LOG2E;
    for (int c = tid; c < 768; c += 256) {
      const int h = c / 96, e = c % 96;
      float ref;
      if (e < 64) { float a = 0.f; for (int k = 0; k < 256; ++k) a = fmaf(cq[k], P.w_uq[(size_t)k * 768 + c], a); ref = a; }
      else {
        const int j = (e - 64) & 15; const int c1 = h * 96 + 64 + j, c2 = c1 + 16;
        float a1 = 0.f, a2 = 0.f; for (int k = 0; k < 256; ++k) { a1 = fmaf(cq[k], P.w_uq[(size_t)k * 768 + c1], a1); a2 = fmaf(cq[k], P.w_uq[(size_t)k * 768 + c2], a2); }
        const float inv = powf(10000.f, -(float)j / 16.f); float sn, cs; sincosf((float)p * inv, &sn, &cs);
        ref = (e - 64) < 16 ? a1 * cs - a2 * sn : a1 * sn + a2 * cs;
      }
      if (far(bf2f(((const bf16_t*)(ws + O_QA))[(size_t)t * 768 + c]), ref * qscale, 0.01f, 0.02f)) chk_fail(P, 7);
    }
    for (int c = tid; c < 1024; c += 256) {
      float a = 0.f; for (int k = 0; k < 128; ++k) a = fmaf(ckv[k], P.w_ukv[(size_t)k * 1024 + c], a);
      const int h = c >> 7, e = c & 127;
      if (e < 64) { if (far(bf2f(((const bf16_t*)(ws + O_KMLA))[((size_t)(b * 8 + h) * LP + p) * 96 + e]), a, 0.06f, 0.02f)) chk_fail(P, 8); }
      else { if (far(bf2f(((const bf16_t*)(ws + O_VT))[((size_t)(b * 8 + h) * 64 + (e - 64)) * LP + p]), a, 0.06f, 0.02f)) chk_fail(P, 9); }
    }
    for (int c = tid; c < 256; c += 256) {
      const int h = c >> 5, e = c & 31, j = e & 15;
      const float inv = powf(10000.f, -(float)j / 16.f); float sn, cs; sincosf((float)p * inv, &sn, &cs);
      const float x1 = pj[384 + j], x2 = pj[384 + 16 + j];
      const float ref = e < 16 ? x1 * cs - x2 * sn : x1 * sn + x2 * cs;
      if (far(bf2f(((const bf16_t*)(ws + O_KMLA))[((size_t)(b * 8 + h) * LP + p) * 96 + 64 + e]), ref, 0.06f, 0.02f)) chk_fail(P, 10);
    }
    __syncthreads();
  }
}
DI void chk_stageB(const Params& P, unsigned char* lds) {
  unsigned char* ws = P.ws;
  float* hv = (float*)lds; float* yv = hv + 1024; float* red = yv + 1024; float* oa = red + 8; float* ob = oa + 512;
  const int tid = threadIdx.x & 255;
  for (int sidx = blockIdx.x; sidx < 256; sidx += gridDim.x) {
    const int rt = (int)(hash_u(sidx * 104729u + 7u) % NR);
    const int b = rt / SEQ, p = NMETA + rt % SEQ, t = b * L + p;
    chk_load_hn(P, t, hv, red);
    for (int i = tid; i < 512; i += 256) { oa[i] = bf2f(((const bf16_t*)(ws + O_OA))[(size_t)rt * 512 + i]); ob[i] = bf2f(((const bf16_t*)(ws + O_OB))[(size_t)rt * 512 + i]); }
    __syncthreads();
    const bf16_t* gates = (const bf16_t*)P.out + (size_t)rt * 2048;
    for (int c = tid; c < D; c += 256) {
      float ga = 0.f, gb = 0.f, va = 0.f, vb = 0.f;
      for (int k = 0; k < D; ++k) { ga = fmaf(hv[k], P.w_in[(size_t)k * INC + 2536 + c], ga); gb = fmaf(hv[k], P.w_in[(size_t)k * INC + 3560 + c], gb); }
      for (int k = 0; k < 512; ++k) { va = fmaf(oa[k], P.w_bra[(size_t)k * D + c], va); vb = fmaf(ob[k], P.w_brb[(size_t)k * D + c], vb); }
      const float sa = 1.f / (1.f + expf(-ga)), sb = 1.f / (1.f + expf(-gb));
      if (far(bf2f(gates[c]), sa, 0.01f, 0.01f) || far(bf2f(gates[1024 + c]), sb, 0.01f, 0.01f)) chk_fail(P, 10);
      const float ref = va * sa + vb * sb;
      if (far(bf2f(((const bf16_t*)(ws + O_Y))[(size_t)rt * D + c]), ref, 0.004f, 0.03f)) chk_fail(P, 11);
    }
    __syncthreads();
  }
}
DI void chk_stageC(const Params& P, unsigned char* lds) {
  unsigned char* ws = P.ws;
  float* yv = (float*)lds;
  const int tid = threadIdx.x & 255;
  for (int sidx = blockIdx.x; sidx < 256; sidx += gridDim.x) {
    const int rt = (int)(hash_u(sidx * 15485863u + 3u) % NR);
    const int b = rt / SEQ, p = NMETA + rt % SEQ, t = b * L + p;
    for (int i = tid; i < D; i += 256) yv[i] = bf2f(((const bf16_t*)(ws + O_Y))[(size_t)rt * D + i]);
    __syncthreads();
    for (int c = tid; c < D; c += 256) {
      float a = 0.f; for (int k = 0; k < D; ++k) a = fmaf(yv[k], P.w_o[(size_t)k * D + c], a);
      const float ref = P.x[(size_t)rt * D + c] + a;
      if (far(P.out[(size_t)rt * D + c], ref, 0.003f, 0.002f)) chk_fail(P, 12);
    }
    __syncthreads();
  }
}
#endif

#if SELFCHECK
DI void chk_moe(const Params& P, unsigned char* lds) {
  unsigned char* ws = P.ws;
  NvMoeLds& S = *(NvMoeLds*)lds;
  __shared__ int sb[32];
  const int t = threadIdx.x & 255, lane = t & 63, wv = t >> 6;
  if (t == 0) { const unsigned* c = (const unsigned*)(ws + O_CTR) + 32; int a = 0; for (int i = 0; i < 32; ++i) { sb[i] = a; a += (((int)c[i] + 255) >> 8) * 256; } }
  __syncthreads();
  for (int sidx = blockIdx.x; sidx < 192; sidx += gridDim.x) {
    const int tok = (int)(hash_u(sidx * 40503u + 77u) % NR);
    const float* row = P.out + (size_t)tok * D;
    float s = 0.f;
    for (int i = t; i < D; i += 256) { const float v = row[i]; S.xr[i] = v; s += v * v; }
    s = block_sum256(s, S.red);
    const float rs = rsqrtf(s * (1.f / D) + EPS);
    for (int i = t; i < D; i += 256) { S.xn[i] = S.xr[i] * rs * P.g_ffn[i]; if (far(bf2f(((const bf16_t*)(ws + M_XN))[(size_t)tok * D + i]), S.xn[i], 0.02f, 0.01f)) chk_fail(P, 0); }
    __syncthreads();
    for (int c = wv; c < 36; c += 4) {
      float a = 0.f;
      if (c < 4) { for (int i = lane; i < D; i += 64) a = fmaf(S.xn[i], P.w_rg[i * 4 + c], a); }
      else { for (int i = lane; i < D; i += 64) a = fmaf(S.xn[i], P.w_re[i * 32 + (c - 4)], a); }
      a = wave_sum(a);
      if (lane == 0) S.logit[c] = a + (c < 4 ? P.b_rg[c] : P.b_re[c - 4]);
    }
    __syncthreads();
    const int* asg = (const int*)(ws + M_ASG) + (size_t)tok * 4;
    if (t == 0) {
      const int gs = asg[0] >> 3;
      float gm = S.logit[0]; for (int i = 1; i < 4; ++i) gm = fmaxf(gm, S.logit[i]);
      if (S.logit[gs] < gm - 1e-4f || (asg[2] >> 3) != gs) chk_fail(P, 1);
      const float* el = S.logit + 4 + gs * 8;
      const int e1 = asg[0] & 7, e2 = asg[2] & 7;
      int nb = 0; for (int i = 0; i < 8; ++i) if (i != e1 && i != e2 && el[i] > fminf(el[e1], el[e2]) + 1e-4f) ++nb;
      if (nb || e1 == e2 || el[e1] < el[e2] - 1e-4f) chk_fail(P, 2);
      float se = 0.f; for (int i = 0; i < 4; ++i) se += expf(S.logit[i] - gm);
      const float pg = expf(S.logit[gs] - gm) / se;
      const float a = expf(el[e1] - el[e1]), b2 = expf(el[e2] - el[e1]);
      S.gatew[0] = pg * a / (a + b2); S.gatew[1] = pg * b2 / (a + b2);
      S.expert[0] = asg[0]; S.expert[1] = asg[2];
      if (far(((const float*)(ws + M_WL))[(size_t)asg[0] * NR + asg[1]], S.gatew[0], 1e-4f, 1e-3f)) chk_fail(P, 3);
      if (far(((const float*)(ws + M_WL))[(size_t)asg[2] * NR + asg[3]], S.gatew[1], 1e-4f, 1e-3f)) chk_fail(P, 3);
      if (((const int*)(ws + M_LIST))[(size_t)asg[0] * NR + asg[1]] != tok || ((const int*)(ws + M_LIST))[(size_t)asg[2] * NR + asg[3]] != tok) chk_fail(P, 4);
    }
    __syncthreads();
    for (int a = 0; a < 2; ++a) {
      const int e = S.expert[a];
      const int slot = sb[e] + asg[2 * a + 1];
      const float* wg = P.w_eg + (size_t)e * D * 256;
      const float* wu = P.w_eu + (size_t)e * D * 256;
      float g = 0.f, u = 0.f;
      for (int k = 0; k < D; ++k) { const float xv = S.xn[k]; g = fmaf(xv, wg[(size_t)k * 256 + t], g); u = fmaf(xv, wu[(size_t)k * 256 + t], u); }
      S.hm[t] = g / (1.f + expf(-g)) * u;
      if (far(bf2f(((const bf16_t*)(ws + M_HMID))[(size_t)slot * 256 + t]), S.hm[t], 0.03f, 0.03f)) chk_fail(P, 5);
      __syncthreads();
      const float* wd = P.w_ed + (size_t)e * 256 * D;
      const float gw = S.gatew[a];
      for (int i = 0; i < 4; ++i) {
        float y = 0.f;
        for (int j = 0; j < 256; ++j) y = fmaf(S.hm[j], wd[(size_t)j * D + t + 256 * i], y);
        if (far(bf2f(((const bf16_t*)(ws + M_YS))[(size_t)slot * 1024 + t + 256 * i]), gw * y, 0.02f, 0.03f)) chk_fail(P, 6);
      }
      __syncthreads();
    }
  }
}
#endif

__global__ void __launch_bounds__(NTHR, 2) mega(Params P) {
  cg::grid_group grid = cg::this_grid();
  extern __shared__ __attribute__((aligned(16))) unsigned char lds[];
  const int G = gridDim.x, bx = blockIdx.x;
  const int lane = threadIdx.x & 63, wv = threadIdx.x >> 6, gw = bx * NW + wv, NGW = G * NW;
  const int half = threadIdx.x >> 8, t2 = threadIdx.x & 255;
  constexpr int MTB = (NT + 255) / 256;
  if (threadIdx.x < 16) ((unsigned*)(lds + LDS_CTL))[threadIdx.x] = 0u;
  __syncthreads();
  if (P.use_cg) grid.sync();
  const XcdBarrier xb = xcd_barrier_post((unsigned*)(P.ws + O_BAR), (volatile LAS unsigned*)(lds + LDS_CTL));
  int* const slot = (int*)(lds + LDS_CTL + 16);
#define GSYNC() xcd_barrier(xb)
  p0_prologue(P, lds);
  GSYNC();
  { int mt, nt; for (int k = 0; p1_tile_map(bx, k, G, mt, nt); ++k) p1_inproj_tile(P, mt, nt, lds); }
  GSYNC();
  for (int t = bx; t < MTB * (768 / 256 + 1024 / 256); t += G) { if (t < MTB * 3) p2b_q_tile(P, t, lds); else p2b_kv_tile(P, t - MTB * 3, lds); }
  GSYNC();
#if SELFCHECK
  chk_stageA(P, lds);
  GSYNC();
#endif
  for (int it = next_item(P, 0, slot); it < 512; it = next_item(P, 0, slot)) mla_item(P, it, lds);
#if SELFCHECK
  GSYNC();
  for (int sidx = bx; sidx < 384; sidx += G) nv_mla<true>(P, sidx < 8 ? (sidx < 4 ? sidx * 37 : NR - 1 - (sidx - 4) * 4096) : (int)(hash_u(sidx * 2654435761u + 11u) % NR), lds);
#endif
  GSYNC();
  for (int q = next_item(P, 1, slot); 2 * q < S1_ITEMS; q = next_item(P, 1, slot)) s1_item(P, 2 * q + (wv >> 2));
  GSYNC();
  { unsigned* wl = (unsigned*)lds + wv * 64; for (int r = gw; r < NR; r += NGW) s2_dispatch(P, r, lane, wl); }
  GSYNC();
  for (int it = next_item(P, 2, slot); it < 512; it = next_item(P, 2, slot)) dsa_item(P, it, lds);
  GSYNC();
#if SELFCHECK
  for (int sidx = bx; sidx < 384; sidx += G) nv_dsa_check(P, sidx < 8 ? (sidx < 4 ? 200 + sidx * 37 : NR - 1 - (sidx - 4) * 4096) : (int)(hash_u(sidx * 2246822519u + 5u) % NR), lds);
  GSYNC();
#endif
  { int mt, nt; for (int k = 0; p78_tile_map(bx, k, G, mt, nt); ++k) p7_merge_tile(P, mt, nt, lds); }
  GSYNC();
#if SELFCHECK
  chk_stageB(P, lds);
  GSYNC();
#endif
  { int mt, nt; for (int k = 0; p78_tile_map(bx, k, G, mt, nt); ++k) p8_out_tile(P, mt, nt, lds); }
  GSYNC();
#if SELFCHECK
  chk_stageC(P, lds);
  GSYNC();
#endif
  for (int t = gw; t < NR; t += NGW) p9_router_token(P, t, lane);
  { float* scr = (float*)lds + half * (64 * 65 + 32);
    for (int k = bx; 2 * k < 32 * 128; k += G) p9_conv_gu_item(P, 2 * k + half, scr, t2, true);
    for (int k = bx; 2 * k < 32 * 64; k += G) { const int it = 2 * k + half, e = it >> 6; transpose_item(P.w_ed + (size_t)e * 256 * 1024, 1024, 256, (bf16_t*)(P.ws + M_WD) + (size_t)e * 1024 * 256, MapOff{0}, it & 63, scr, t2, true); } }
  GSYNC();
  {
    int e, rt, cnt, bs;
    const int ntile = moe_tile_lookup(P, 0, e, rt, cnt, bs);
    for (int q = next_item(P, 3, slot); q < ntile * 6; q = next_item(P, 3, slot)) {
      if (q < ntile * 2) { moe_tile_lookup(P, q >> 1, e, rt, cnt, bs); p10_gu_tile(P, q >> 1, e, rt, cnt, bs, q & 1, lds); }
      else { const int q2 = q - ntile * 2; moe_tile_lookup(P, q2 >> 2, e, rt, cnt, bs); p11_down_tile(P, q2 >> 2, e, rt, cnt, bs, q2 & 3, lds); }
    }
    GSYNC();
#if SELFCHECK
    chk_moe(P, lds);
    GSYNC();
#endif
    int* sbase = (int*)lds;
    __syncthreads();
    if (threadIdx.x == 0) { const unsigned* c = (const unsigned*)(P.ws + O_CTR) + 32; int a = 0; for (int i = 0; i < 32; ++i) { sbase[i] = a; a += (((int)c[i] + 255) >> 8) * 256; } }
    __syncthreads();
    for (int t = gw; t < NR; t += NGW) p12_final_token(P, t, lane, sbase);
  }
#if SELFCHECK
  GSYNC();
  {
    const unsigned* chk = (const unsigned*)(P.ws + O_CHK);
    float f = 1.f;
    for (int k = 15; k >= 0; --k) if (chk[k]) f = 1.f + 0.25f * (float)(1 << k);
    if (f != 1.f) for (size_t i = (size_t)bx * NTHR + threadIdx.x; i < (size_t)NR * D; i += (size_t)G * NTHR) P.out[i] *= f;
  }
#endif
}
}

extern "C" void kernel_launch(void* const* d_in, const int* in_sizes, int n_in, void* d_out, int out_size, void* d_ws, size_t ws_size, hipStream_t stream) {
  using namespace mk;
  static int grid_blocks = 0;
  if (!grid_blocks) {
    int dev = 0, cus = 0, per_cu = 0;
    (void)hipGetDevice(&dev);
    (void)hipDeviceGetAttribute(&cus, hipDeviceAttributeMultiprocessorCount, dev);
    (void)hipFuncSetAttribute((const void*)mega, hipFuncAttributeMaxDynamicSharedMemorySize, LDS_BYTES);
    (void)hipOccupancyMaxActiveBlocksPerMultiprocessor(&per_cu, mega, NTHR, LDS_BYTES);
    per_cu = 1;
    grid_blocks = cus * per_cu;
    if (ws_size < WS_END) fprintf(stderr, "workspace too small: need %zu have %zu\n", (size_t)WS_END, ws_size);
  }
  Params p{};
  const float** pp = (const float**)&p;
  for (int i = 0; i < 21; ++i) pp[i] = (const float*)d_in[i];
  p.out = (float*)d_out; p.ws = (unsigned char*)d_ws;
  (void)hipMemsetAsync((unsigned char*)d_ws + O_CHK, 0, O_WR - O_CHK, stream);
  void* args[] = {&p};
  hipError_t e = hipLaunchCooperativeKernel((void*)mega, dim3(grid_blocks), dim3(NTHR), args, LDS_BYTES, stream);
  if (e != hipSuccess) fprintf(stderr, "cooperative launch failed: %s (grid %d)\n", hipGetErrorString(e), grid_blocks);
}
```

```cpp
#include <hip/hip_runtime.h>
#include <hip/hip_cooperative_groups.h>
#include <cstdio>
#include <math.h>
#include <stdint.h>
namespace cg = cooperative_groups;

namespace mk {
typedef unsigned short bf16_t;
typedef short bf16x8 __attribute__((ext_vector_type(8)));
typedef float f32x16 __attribute__((ext_vector_type(16)));
typedef float f32x4 __attribute__((ext_vector_type(4)));
typedef unsigned u32x4 __attribute__((ext_vector_type(4)));
typedef unsigned u32x2 __attribute__((ext_vector_type(2)));

constexpr int D = 1024, NB = 4, SEQ = 4096, NMETA = 16, L = SEQ + NMETA, NT = NB * L  , NR = NB * SEQ  ;
constexpr int INC = 4584, LP = 4128;
constexpr int S_CQ = 0, S_CKV = 256, S_KR = 384, S_WI = 416, S_KI = 424;
constexpr float EPS = 1e-6f;
constexpr float LOG2E = 1.4426950408889634f;
constexpr int NTHR = 512, NW = NTHR / 64;

#define DI __device__ __forceinline__
#ifndef REP_P0
#define REP_P0 1
#endif
#ifndef REP_P1
#define REP_P1 1
#endif
#ifndef REP_MLA
#define REP_MLA 1
#endif
#ifndef REP_S1
#define REP_S1 1
#endif
#ifndef REP_S2
#define REP_S2 1
#endif
#ifndef REP_DSA
#define REP_DSA 1
#endif
#ifndef REP_P7
#define REP_P7 1
#endif
#ifndef REP_P8
#define REP_P8 1
#endif
#ifndef REP_MOE
#define REP_MOE 1
#endif
#ifndef REP_P2
#define REP_P2 1
#endif
#ifndef REP_CONV
#define REP_CONV 1
#endif
#ifndef SELFCHECK
#define SELFCHECK 0
#endif

typedef __bf16 bf2_t __attribute__((ext_vector_type(2)));
DI bf16_t f2bf(float x) { const __bf16 b = (__bf16)x; return __builtin_bit_cast(bf16_t, b); }
DI float bf2f(bf16_t v) { return __uint_as_float(((unsigned)v) << 16); }
DI unsigned pk2(float lo, float hi) { const bf2_t v = {(__bf16)lo, (__bf16)hi}; return __builtin_bit_cast(unsigned, v); }
#define dpp_i(v, ctrl) __builtin_amdgcn_update_dpp(0, (v), (ctrl), 0xf, 0xf, true)
DI float wave_sum(float v) {
  v += __int_as_float(dpp_i(__float_as_int(v), 0xB1));
  v += __int_as_float(dpp_i(__float_as_int(v), 0x4E));
  v += __int_as_float(dpp_i(__float_as_int(v), 0x141));
  v += __int_as_float(dpp_i(__float_as_int(v), 0x140));
  const int b = __float_as_int(v);
  return (__int_as_float(__builtin_amdgcn_readlane(b, 0)) + __int_as_float(__builtin_amdgcn_readlane(b, 16))) +
         (__int_as_float(__builtin_amdgcn_readlane(b, 32)) + __int_as_float(__builtin_amdgcn_readlane(b, 48)));
}
DI int wave_sumi(int v) {
  v += dpp_i(v, 0xB1); v += dpp_i(v, 0x4E); v += dpp_i(v, 0x141); v += dpp_i(v, 0x140);
  return (__builtin_amdgcn_readlane(v, 0) + __builtin_amdgcn_readlane(v, 16)) + (__builtin_amdgcn_readlane(v, 32) + __builtin_amdgcn_readlane(v, 48));
}
DI float block_sum256(float v, float* red) {
  v = wave_sum(v);
  __syncthreads();
  if ((threadIdx.x & 63) == 0) red[threadIdx.x >> 6] = v;
  __syncthreads();
  return red[0] + red[1] + red[2] + red[3];
}
DI int block_sumi256(int v, int* red) {
#pragma unroll
  for (int o = 1; o < 64; o <<= 1) v += __shfl_xor(v, o);
  __syncthreads();
  if ((threadIdx.x & 63) == 0) red[threadIdx.x >> 6] = v;
  __syncthreads();
  return red[0] + red[1] + red[2] + red[3];
}
DI int n_adm(int p) { return p < NMETA ? NMETA : NMETA + 64 * (1 + (p - NMETA) / 64); }


#if SELFCHECK
DI unsigned hash_u(unsigned x) { x ^= x >> 16; x *= 0x7feb352du; x ^= x >> 15; x *= 0x846ca68bu; x ^= x >> 16; return x; }
DI bool far(float got, float ref, float atol, float rtol) { const float d = fabsf(got - ref); return !(d <= atol + rtol * fabsf(ref)); }
#endif
struct Params {
  const float *x, *meta, *g_mix, *w_in, *g_cq, *g_ckv, *w_uq, *w_ukv, *w_bra, *w_brb, *w_o, *rel_bias, *g_ffn, *w_rg, *b_rg, *w_re, *b_re, *w_eg, *w_eu, *w_ed, *g_fin;
  float* out; unsigned char* ws;
  int use_cg; int pad;
};

constexpr size_t al(size_t x) { return (x + 255) & ~(size_t)255; }
constexpr size_t O_QB = 0;
constexpr size_t O_KB = al(O_QB + (size_t)NT * 512 * 2);
constexpr size_t O_VBT = al(O_KB + (size_t)NT * 512 * 2);
constexpr size_t O_QI = al(O_VBT + (size_t)NB * 8 * 64 * LP * 2);
constexpr size_t O_KI = al(O_QI + (size_t)NT * 512 * 2);
constexpr size_t O_WI = al(O_KI + (size_t)NT * 64 * 2);
constexpr size_t O_SMALL = al(O_WI + (size_t)NT * 8 * 4);
constexpr size_t O_CQN = al(O_SMALL + (size_t)NT * 512 * 4);
constexpr size_t O_CKVN = al(O_CQN + (size_t)NT * 256 * 2);
constexpr size_t O_QA = al(O_CKVN + (size_t)NT * 128 * 2);
constexpr size_t O_KMLA = al(O_QA + (size_t)NT * 768 * 2);
constexpr size_t O_VT = al(O_KMLA + (size_t)NB * 8 * LP * 96 * 2);
constexpr size_t R_END = al(O_VT + (size_t)NB * 8 * 64 * LP * 2 + (size_t)NT * 1536 * 2);
constexpr size_t O_HN = O_QA;
constexpr size_t O_OA = O_SMALL;
constexpr int MW = 132;
constexpr size_t O_MASK = al(O_OA + (size_t)NR * 512 * 2);
constexpr size_t O_SCORES = al(O_MASK + (size_t)NR * MW * 4);
constexpr size_t SCORES_PER_BATCH = (size_t)8192 * 1088;
constexpr size_t O_OB = O_SCORES;
constexpr size_t O_Y = al(O_OB + (size_t)NR * 512 * 2);
static_assert(O_SCORES + (size_t)NB * SCORES_PER_BATCH * 2 + 65536 <= R_END, "scores must fit region R");
constexpr size_t O_WIN = R_END;
constexpr size_t O_WG = al(O_WIN + (size_t)2560 * 1024 * 2);
constexpr size_t O_WUQ = al(O_WG + (size_t)2048 * 1024 * 2);
constexpr size_t O_WUKV = al(O_WUQ + (size_t)768 * 256 * 2);
constexpr size_t O_WBRA = al(O_WUKV + (size_t)1024 * 128 * 2);
constexpr size_t O_WBRB = al(O_WBRA + (size_t)1024 * 512 * 2);
constexpr size_t O_WO = al(O_WBRB + (size_t)1024 * 512 * 2);
constexpr size_t O_ROPE = al(O_WO + (size_t)1024 * 1024 * 2);
constexpr size_t O_CHK = al(O_ROPE + (size_t)L * 32 * 4);
constexpr size_t O_CTR = al(O_CHK + 256);
constexpr size_t O_BAR = al(O_CTR + 256);
constexpr size_t O_DEP = al(O_BAR + 3456 * 4);
constexpr size_t O_WR = al(O_DEP + 512 * 4);
constexpr size_t WS_END = al(O_WR + (size_t)36 * 1024 * 4);
constexpr int SLOTS = 2 * NR + 32 * 256;
constexpr size_t M_XN = 0;
constexpr size_t M_HMID = al(M_XN + (size_t)NR * 1024 * 2);
constexpr size_t M_YS = al(M_HMID + (size_t)SLOTS * 256 * 2);
constexpr size_t M_WGU = al(M_YS + (size_t)SLOTS * 1024 * 2);
constexpr size_t M_WD = al(M_WGU + (size_t)32 * 512 * 1024 * 2);
constexpr size_t M_LIST = al(M_WD + (size_t)32 * 1024 * 256 * 2);
constexpr size_t M_WL = al(M_LIST + (size_t)32 * NR * 4);
constexpr size_t M_ASG = al(M_WL + (size_t)32 * NR * 4);
constexpr size_t M_END = al(M_ASG + (size_t)NR * 16);
static_assert(M_END <= O_WIN, "MoE overlay must stay below the weights");
static_assert(WS_END <= (size_t)256 * 1024 * 1024, "workspace budget");
#if SELFCHECK
DI void chk_fail(const Params& P, int k) { atomicAdd((unsigned*)(P.ws + O_CHK) + k, 1u); }
#endif
constexpr int GX_A = 256 * 128, GX_B = 256 * 128, GX_STAGE = GX_A + GX_B;
constexpr int LDS_CTL = 2 * GX_STAGE;
constexpr int LDS_BYTES = LDS_CTL + 64;


#define XB_TMO      128
#define XB_XCNT(j)  (256  + 64 * (j))
#define XB_XSUB(j)  (1280 + 64 * (j))
#define XB_XGEN(j)  (2304 + 64 * (j))
#define XB_TOP      3328
#define XB_TOPGEN   3392
#define XCD_BAR_WORDS 3456
#define XB_SPIN_CAP (1u << 18)
#define LAS __attribute__((address_space(3)))
DI unsigned xb_ld(unsigned* p)              { return __hip_atomic_load(p, __ATOMIC_RELAXED, __HIP_MEMORY_SCOPE_AGENT); }
DI unsigned xb_add(unsigned* p, unsigned v) { return __hip_atomic_fetch_add(p, v, __ATOMIC_RELAXED, __HIP_MEMORY_SCOPE_AGENT); }
DI unsigned xb_xcc_id() { return (unsigned)__builtin_amdgcn_s_getreg((3 << 11) | 20) & 0xFu; }
#define XB_SPIN(cond, bar) do { unsigned _sp = 0; while (cond) { __builtin_amdgcn_s_sleep(1); \
    if ((++_sp & 255u) == 0u) { if (xb_ld(&(bar)[XB_TMO])) break; if (_sp > XB_SPIN_CAP) { atomicAdd(&(bar)[XB_TMO], 1u); break; } } } } while (0)
struct XcdBarrier { unsigned* bar; unsigned x; volatile LAS unsigned* st; };
DI XcdBarrier xcd_barrier_post(unsigned* bar, volatile LAS unsigned* st) {
  XcdBarrier b; b.bar = bar; b.x = xb_xcc_id(); b.st = st;
  if (threadIdx.x == 0) (void)xb_add(&bar[XB_XCNT(b.x)], 1u);
  return b;
}
DI void xcd_barrier_complete(unsigned* bar, unsigned x, unsigned& nloc, unsigned& nx) {
  const unsigned G = gridDim.x * gridDim.y * gridDim.z;
  unsigned sum, cnt, mine, sp = 0u;
  for (;;) {
    sum = 0u; cnt = 0u; mine = 0u;
#pragma unroll
    for (unsigned j = 0; j < 16; ++j) { const unsigned c = xb_ld(&bar[XB_XCNT(j)]); sum += c; cnt += (c > 0u) ? 1u : 0u; mine = (j == x) ? c : mine; }
    if (sum == G) break;
    __builtin_amdgcn_s_sleep(1);
    if ((++sp & 255u) == 0u) { if (xb_ld(&bar[XB_TMO])) break; if (sp > XB_SPIN_CAP) { atomicAdd(&bar[XB_TMO], 1u); break; } }
  }
  nloc = mine > 0u ? mine : 1u; nx = cnt > 0u ? cnt : 1u;
}
DI void xcd_barrier(const XcdBarrier& b) {
  asm volatile("s_waitcnt vmcnt(0)" ::: "memory");
  __syncthreads();
  if (threadIdx.x == 0) {
    unsigned* bar = b.bar;
    __builtin_amdgcn_s_waitcnt(0);
    unsigned nloc = b.st[0], nx = b.st[1];
    if (nloc == 0u) { xcd_barrier_complete(bar, b.x, nloc, nx); b.st[0] = nloc; b.st[1] = nx; }
    const unsigned old = xb_add(&bar[XB_XSUB(b.x)], 1u);
    const unsigned gen = old / nloc;
    if (old + 1u == (gen + 1u) * nloc) {
      __builtin_amdgcn_fence(__ATOMIC_RELEASE, "agent");
      asm volatile("s_waitcnt vmcnt(0)" ::: "memory");
      const unsigned og = xb_add(&bar[XB_TOP], 1u);
      const unsigned tg = og / nx;
      if (og + 1u == (tg + 1u) * nx) xb_add(&bar[XB_TOPGEN], 1u);
      else XB_SPIN(xb_ld(&bar[XB_TOPGEN]) == tg, bar);
      __builtin_amdgcn_fence(__ATOMIC_ACQUIRE, "agent");
      xb_add(&bar[XB_XGEN(b.x)], 1u);
      asm volatile("s_waitcnt vmcnt(0)" ::: "memory");
    } else {
      XB_SPIN(xb_ld(&bar[XB_XGEN(b.x)]) == gen, bar);
      __builtin_amdgcn_fence(__ATOMIC_ACQUIRE, "agent");
      asm volatile("s_waitcnt vmcnt(0)" ::: "memory");
    }
  }
  __syncthreads();
}

DI void p0_norm_row(const Params& P, int t, bf16_t* hn, int lane) {
  const int b = t / L, p = t % L;
  const float* row = p < NMETA ? P.meta + (size_t)p * D : P.x + ((size_t)b * SEQ + (p - NMETA)) * D;
  f32x4 v[4]; float s = 0.f;
#pragma unroll
  for (int i = 0; i < 4; ++i) { v[i] = *(const f32x4*)(row + 256 * i + 4 * lane); s += v[i][0] * v[i][0] + v[i][1] * v[i][1] + v[i][2] * v[i][2] + v[i][3] * v[i][3]; }
  s = wave_sum(s);
  const float rs = rsqrtf(s * (1.f / D) + EPS);
#pragma unroll
  for (int i = 0; i < 4; ++i) {
    const f32x4 g = *(const f32x4*)(P.g_mix + 256 * i + 4 * lane);
    u32x2 o; o[0] = pk2(v[i][0] * rs * g[0], v[i][1] * rs * g[1]); o[1] = pk2(v[i][2] * rs * g[2], v[i][3] * rs * g[3]);
    *(u32x2*)(hn + (size_t)t * D + 256 * i + 4 * lane) = o;
  }
}
template <class F>
DI void transpose_item(const float* src, int ldsrc, int K, bf16_t* dst, F map, int item, float* scr  , int tid, bool valid) {
  const int nkb = K / 64, kb = item % nkb, nb = item / nkb, k0 = kb * 64, n0 = nb * 64;
  if (valid) {
    const int n = tid & 63; const int col = map(n0 + n);
#pragma unroll 4
    for (int i = 0; i < 16; ++i) { const int k = (tid >> 6) + 4 * i; scr[k * 65 + n] = col >= 0 ? src[(size_t)(k0 + k) * ldsrc + col] : 0.f; }
  }
  __syncthreads();
  if (valid) {
    const int kq = tid & 7;
#pragma unroll
    for (int i = 0; i < 2; ++i) {
      const int n = (tid >> 3) + 32 * i;
      const float* s = scr + (kq * 8) * 65 + n;
      u32x4 o; o[0] = pk2(s[0], s[65]); o[1] = pk2(s[2 * 65], s[3 * 65]); o[2] = pk2(s[4 * 65], s[5 * 65]); o[3] = pk2(s[6 * 65], s[7 * 65]);
      *(u32x4*)(dst + (size_t)(n0 + n) * K + k0 + kq * 8) = o;
    }
  }
  __syncthreads();
}
struct MapIn {
  DI int operator()(int n) const {
    if (n < 416) return n;
    if (n < 424) return 2528 + (n - 416);
    if (n < 488) return 2464 + (n - 424);
    if (n < 512) return -1;
    return 416 + (n - 512);
  }
};
struct MapOff { int off; DI int operator()(int n) const { return off + n; } };

DI void p0_prologue(const Params& P, unsigned char* lds) {
  unsigned char* ws = P.ws;
  const int tid = threadIdx.x, lane = tid & 63, wv = tid >> 6;
  const int gw = blockIdx.x * NW + wv, ngw = gridDim.x * NW;
  bf16_t* hn = (bf16_t*)(P.ws + O_HN);
  for (int t = gw; t < NT; t += ngw) p0_norm_row(P, t, hn, lane);
  float* rope = (float*)(ws + O_ROPE);
  for (int i = blockIdx.x * NTHR + tid; i < L * 16; i += gridDim.x * NTHR) {
    const int p = i >> 4, j = i & 15;
    const float inv = powf(10000.f, -(float)j / 16.f);
    const float ang = (float)p * inv;
    float sn, cs; sincosf(ang, &sn, &cs);
    rope[p * 32 + j] = cs; rope[p * 32 + 16 + j] = sn;
  }
  {
    bf16_t* vbt = (bf16_t*)(ws + O_VBT); bf16_t* vt = (bf16_t*)(ws + O_VT);
    for (int i = blockIdx.x * NTHR + tid; i < NB * 8 * 64 * (LP - L); i += gridDim.x * NTHR) {
      const int r = i / (LP - L), c = L + i % (LP - L);
      vbt[(size_t)r * LP + c] = 0; vt[(size_t)r * LP + c] = 0;
    }
  }
  {
    float* wr = (float*)(ws + O_WR);
    for (int i = blockIdx.x * NTHR + tid; i < 36 * 1024; i += gridDim.x * NTHR) {
      const int c = i >> 10, k = i & 1023;
      wr[i] = c < 4 ? P.w_rg[k * 4 + c] : P.w_re[k * 32 + (c - 4)];
    }
  }
  const int half = tid >> 8, t2 = tid & 255;
  float* scr = (float*)lds + half * (64 * 65 + 32);
  constexpr int I_IN = (1024 / 64) * (2560 / 64), I_G = (1024 / 64) * (2048 / 64), I_UQ = (256 / 64) * (768 / 64), I_UKV = (128 / 64) * (1024 / 64),
                I_BR = (512 / 64) * (1024 / 64), I_O = (1024 / 64) * (1024 / 64);
  constexpr int NIT = I_IN + I_G + I_UQ + I_UKV + 2 * I_BR + I_O;
  for (int it2 = blockIdx.x; 2 * it2 < NIT; it2 += gridDim.x) {
    int r = 2 * it2 + half; const bool valid = r < NIT; if (!valid) r = 0;
    if (r < I_IN) transpose_item(P.w_in, INC, 1024, (bf16_t*)(ws + O_WIN), MapIn(), r, scr, t2, valid);
    else if ((r -= I_IN) < I_G) transpose_item(P.w_in, INC, 1024, (bf16_t*)(ws + O_WG), MapOff{2536}, r, scr, t2, valid);
    else if ((r -= I_G) < I_UQ) transpose_item(P.w_uq, 768, 256, (bf16_t*)(ws + O_WUQ), MapOff{0}, r, scr, t2, valid);
    else if ((r -= I_UQ) < I_UKV) transpose_item(P.w_ukv, 1024, 128, (bf16_t*)(ws + O_WUKV), MapOff{0}, r, scr, t2, valid);
    else if ((r -= I_UKV) < I_BR) transpose_item(P.w_bra, 1024, 512, (bf16_t*)(ws + O_WBRA), MapOff{0}, r, scr, t2, valid);
    else if ((r -= I_BR) < I_BR) transpose_item(P.w_brb, 1024, 512, (bf16_t*)(ws + O_WBRB), MapOff{0}, r, scr, t2, valid);
    else { r -= I_BR; transpose_item(P.w_o, 1024, 1024, (bf16_t*)(ws + O_WO), MapOff{0}, r, scr, t2, valid); }
  }
}

struct TilePtrs { const bf16_t* A; const bf16_t* B; unsigned a[4], b[4]; };
DI void glds16(const unsigned char* g, unsigned char* l) { __builtin_amdgcn_global_load_lds((const unsigned*)g, (unsigned*)l, 16, 0, 0); }
DI void gemm_kloop(f32x16 (&acc)[4][2], const TilePtrs& tp, int K, unsigned char* lds) {
  const int tid = threadIdx.x, lane = tid & 63, w = __builtin_amdgcn_readfirstlane(tid >> 6), wr = w >> 2, wc = w & 3;
  const int nt = K / 64;
  unsigned char* const lw = lds + w * 1024;
  const int swz = (lane >> 1) & 7, hh = lane >> 5;
  const unsigned char* const ar = lds + (wr * 64 + (lane & 31)) * 128;
  const unsigned char* const br = lds + GX_A + (wc * 32 + (lane & 31)) * 128;
  int coff[4];
#pragma unroll
  for (int kk = 0; kk < 4; ++kk) coff[kk] = ((2 * kk + hh) ^ swz) * 16;
  bf16x8 At[2][4], B0[4], B1[4];
  unsigned oa[4], ob[4];
#pragma unroll
  for (int j = 0; j < 4; ++j) { oa[j] = tp.a[j]; ob[j] = tp.b[j]; }
#define HT_(BO_, H_) ((BO_) + (H_) * 16384)
#define STG_A(BO_, H_, kt) do { const unsigned char* g_ = (const unsigned char*)tp.A + (kt) * 128; glds16(g_ + oa[2 * (H_)], lw + HT_(BO_, H_)); glds16(g_ + oa[2 * (H_) + 1], lw + HT_(BO_, H_) + 8192); } while (0)
#define STG_B(BO_, H_, kt) do { const unsigned char* g_ = (const unsigned char*)tp.B + (kt) * 128; glds16(g_ + ob[2 * (H_)], lw + GX_A + HT_(BO_, H_)); glds16(g_ + ob[2 * (H_) + 1], lw + GX_A + HT_(BO_, H_) + 8192); } while (0)
#define PIN_OFFS() do { _Pragma("unroll") for (int j_ = 0; j_ < 4; ++j_) { asm volatile("" : "+v"(oa[j_])); asm volatile("" : "+v"(ob[j_])); } } while (0)
#define LDA_(BO_, H_) do { _Pragma("unroll") for (int m_ = 0; m_ < 2; ++m_) _Pragma("unroll") for (int k_ = 0; k_ < 4; ++k_) At[m_][k_] = *(const bf16x8*)(ar + HT_(BO_, H_) + m_ * 4096 + coff[k_]); } while (0)
#define LDB_(Bx, BO_, H_) do { _Pragma("unroll") for (int k_ = 0; k_ < 4; ++k_) Bx[k_] = *(const bf16x8*)(br + HT_(BO_, H_) + coff[k_]); } while (0)
#define MMA_(ai, bj, Bx) do { __builtin_amdgcn_s_setprio(1); _Pragma("unroll") for (int k_ = 0; k_ < 4; ++k_) _Pragma("unroll") for (int m_ = 0; m_ < 2; ++m_) \
    acc[2 * (ai) + m_][bj] = __builtin_amdgcn_mfma_f32_32x32x16_bf16(At[m_][k_], Bx[k_], acc[2 * (ai) + m_][bj], 0, 0, 0); __builtin_amdgcn_s_setprio(0); } while (0)
#define WAIT_V(n) asm volatile("s_waitcnt vmcnt(" #n ")" ::: "memory")
#define WAIT_L(n) asm volatile("s_waitcnt lgkmcnt(" #n ")" ::: "memory")
#define BAR_ __builtin_amdgcn_s_barrier()
#define SCHED_ __builtin_amdgcn_sched_barrier(0)
  WAIT_V(0);
  PIN_OFFS();
  STG_B(0, 0, 0); STG_A(0, 0, 0); STG_B(0, 1, 0); STG_A(0, 1, 0);
  if (wr == 1) BAR_;
  WAIT_V(4); BAR_;
  STG_B(GX_STAGE, 0, 1); STG_A(GX_STAGE, 0, 1); STG_B(GX_STAGE, 1, 1);
  WAIT_V(6); BAR_;
  int cur = 0;
#pragma unroll 1
  for (int t = 0; t < nt - 2; ++t) {
    asm volatile("" : "+s"(cur));
    PIN_OFFS();
    const int nxt = cur ^ GX_STAGE;
    LDB_(B0, cur, 0); SCHED_; LDA_(cur, 0); STG_A(nxt, 1, t + 1);
    WAIT_L(8); BAR_; WAIT_L(0); MMA_(0, 0, B0); BAR_; SCHED_;
    LDB_(B1, cur, 1); STG_B(cur, 0, t + 2);
    BAR_; WAIT_L(0); MMA_(0, 1, B1); BAR_;
    LDA_(cur, 1); STG_A(cur, 0, t + 2);
    BAR_; WAIT_L(0); MMA_(1, 0, B0); BAR_; SCHED_;
    STG_B(cur, 1, t + 2);
    WAIT_V(6); BAR_; MMA_(1, 1, B1); BAR_;
    cur = nxt;
  }
  { asm volatile("" : "+s"(cur));
    PIN_OFFS();
    const int nxt = cur ^ GX_STAGE;
    LDB_(B0, cur, 0); LDA_(cur, 0); STG_A(nxt, 1, nt - 1);
    BAR_; WAIT_L(0); MMA_(0, 0, B0); BAR_;
    LDB_(B1, cur, 1); BAR_; WAIT_L(0); MMA_(0, 1, B1); BAR_;
    LDA_(cur, 1); WAIT_V(4); BAR_; WAIT_L(0); MMA_(1, 0, B0); MMA_(1, 1, B1); BAR_;
    LDB_(B0, nxt, 0); LDA_(nxt, 0); WAIT_V(2); BAR_; WAIT_L(0); MMA_(0, 0, B0); BAR_;
    LDB_(B1, nxt, 1); WAIT_V(0); BAR_; WAIT_L(0); MMA_(0, 1, B1); BAR_;
    LDA_(nxt, 1); BAR_; WAIT_L(0); MMA_(1, 0, B0); MMA_(1, 1, B1); BAR_; }
  if (wr == 0) BAR_;
#undef HT_
#undef STG_A
#undef STG_B
#undef LDA_
#undef LDB_
#undef MMA_
#undef PIN_OFFS
}
DI void tile_rc(int i, int& row, int& chunk) { const int t = threadIdx.x; row = (i >> 1) * 128 + (i & 1) * 64 + (t >> 3); chunk = (t & 7) ^ ((row >> 1) & 7); }
DI int acc_row0(int wr, int mi) { return (mi >> 1) * 128 + wr * 64 + (mi & 1) * 32; }
DI int acc_col0(int wc, int ni) { return ni * 128 + wc * 32; }
DI void zero_acc(f32x16 (&acc)[4][2]) {
#pragma unroll
  for (int i = 0; i < 4; ++i)
#pragma unroll
    for (int j = 0; j < 2; ++j)
#pragma unroll
      for (int r = 0; r < 16; ++r) acc[i][j][r] = 0.f;
}
DI void set_ptrs(TilePtrs& tp, const bf16_t* A, int lda, int M, int m0, const bf16_t* Bt, int ldb, int N, int n0) {
#pragma unroll
  for (int i = 0; i < 4; ++i) {
    int row, kc; tile_rc(i, row, kc);
    int r = m0 + row; r = r < M ? r : M - 1;
    int c = n0 + row; c = c < N ? c : N - 1;
    tp.a[i] = ((unsigned)r * (unsigned)lda + kc * 8) * 2u;
    tp.b[i] = ((unsigned)c * (unsigned)ldb + kc * 8) * 2u;
  }
  tp.A = A; tp.B = Bt;
}

DI bool p1_tile_map(int bx, int k, int G, int& mt, int& nt) { const int t = bx + k * G; if (t >= 65 * 18) return false; mt = t / 18; nt = t % 18; return true; }
DI bool p78_tile_map(int bx, int k, int G, int& mt, int& nt) { const int t = bx + k * G; if (t >= 64 * 4) return false; mt = t >> 2; nt = t & 3; return true; }

DI void p1_inproj_tile(const Params& P, int mt, int nt, unsigned char* lds) {
  unsigned char* ws = P.ws;
  const int m0 = mt * 256, n0 = nt * 256;
  const bf16_t* hn = (const bf16_t*)(ws + O_HN);
  TilePtrs tp;
  if (n0 < 2560) set_ptrs(tp, hn, 1024, NT, m0, (const bf16_t*)(ws + O_WIN), 1024, 2560, n0);
  else set_ptrs(tp, hn, 1024, NT, m0, (const bf16_t*)(ws + O_WG), 1024, 2048, n0 - 2560);
  f32x16 acc[4][2]; zero_acc(acc);
  gemm_kloop(acc, tp, 1024, lds);
  const int lane = threadIdx.x & 63, w = threadIdx.x >> 6, wr = w >> 2, wc = w & 3, hh = lane >> 5, lc = lane & 31;
  if (n0 >= 2560) {
    bf16_t* gates = (bf16_t*)P.out;
#pragma unroll
    for (int mi = 0; mi < 4; ++mi)
#pragma unroll
      for (int ni = 0; ni < 2; ++ni) {
        const int col = n0 - 2560 + acc_col0(wc, ni) + lc;
        int rbase = m0 + acc_row0(wr, mi) + 4 * hh;
        asm volatile("" : "+v"(rbase));
#pragma unroll
        for (int r = 0; r < 16; ++r) {
          const int row = rbase + (r & 3) + 8 * (r >> 2);
          const int b = row / L, p = row - b * L;
          if (row < NT && p >= NMETA) gates[(size_t)(row - NMETA * (b + 1)) * 2048 + col] = f2bf(__builtin_amdgcn_rcpf(1.f + __expf(-acc[mi][ni][r])));
        }
      }
    return;
  }
  const int seg = n0 / 512, cb = n0 % 512;
#pragma unroll
  for (int mi = 0; mi < 4; ++mi)
#pragma unroll
    for (int ni = 0; ni < 2; ++ni) {
      const int col = cb + acc_col0(wc, ni) + lc;
      const int rbase = m0 + acc_row0(wr, mi) + 4 * hh;
      if (seg == 0) {
        float* sm = (float*)(ws + O_SMALL);
#pragma unroll
        for (int r = 0; r < 16; ++r) { const int row = rbase + (r & 3) + 8 * (r >> 2); if (row < NT) sm[(size_t)row * 512 + col] = acc[mi][ni][r]; }
      } else if (seg == 3) {
        bf16_t* vbt = (bf16_t*)(ws + O_VBT);
        const int h = col >> 6, d = col & 63;
#pragma unroll
        for (int g = 0; g < 4; ++g) {
          const int row = rbase + 8 * g;
          if (row < NT) {
            const int b = row / L, p = row % L;
            u32x2 o; o[0] = pk2(acc[mi][ni][4 * g], acc[mi][ni][4 * g + 1]); o[1] = pk2(acc[mi][ni][4 * g + 2], acc[mi][ni][4 * g + 3]);
            *(u32x2*)(vbt + ((size_t)(b * 8 + h) * 64 + d) * LP + p) = o;
          }
        }
      } else {
        bf16_t* dst = (bf16_t*)(ws + (seg == 1 ? O_QB : seg == 2 ? O_KB : O_QI));
        const float sc = seg == 4 ? 0.125f : seg == 1 ? 0.125f * LOG2E : 1.f;
#pragma unroll
        for (int r = 0; r < 16; ++r) { const int row = rbase + (r & 3) + 8 * (r >> 2); if (row < NT) dst[(size_t)row * 512 + col] = f2bf(acc[mi][ni][r] * sc); }
      }
    }
}

DI void p2a_token(const Params& P, int t, int lane) {
  unsigned char* ws = P.ws;
  const float* sm = (const float*)(ws + O_SMALL) + (size_t)t * 512;
  const int b = t / L, p = t % L;
  {
    const f32x4 v = *(const f32x4*)(sm + S_CQ + 4 * lane);
    const float s = wave_sum(v[0] * v[0] + v[1] * v[1] + v[2] * v[2] + v[3] * v[3]);
    const float rs = rsqrtf(s * (1.f / 256) + EPS);
    const f32x4 g = *(const f32x4*)(P.g_cq + 4 * lane);
    u32x2 o; o[0] = pk2(v[0] * rs * g[0], v[1] * rs * g[1]); o[1] = pk2(v[2] * rs * g[2], v[3] * rs * g[3]);
    *(u32x2*)((bf16_t*)(ws + O_CQN) + (size_t)t * 256 + 4 * lane) = o;
  }
  {
    const float v0 = sm[S_CKV + 2 * lane], v1 = sm[S_CKV + 2 * lane + 1];
    const float s = wave_sum(v0 * v0 + v1 * v1);
    const float rs = rsqrtf(s * (1.f / 128) + EPS);
    *(unsigned*)((bf16_t*)(ws + O_CKVN) + (size_t)t * 128 + 2 * lane) = pk2(v0 * rs * P.g_ckv[2 * lane], v1 * rs * P.g_ckv[2 * lane + 1]);
  }
  {
    const float* rp = (const float*)(ws + O_ROPE) + p * 32;
    const int j = lane & 15;
    const float x1 = sm[S_KR + j], x2 = sm[S_KR + 16 + j], cs = rp[j], sn = rp[16 + j];
    const float o = (lane & 16) ? (x1 * sn + x2 * cs) : (x1 * cs - x2 * sn);
    bf16_t* km = (bf16_t*)(ws + O_KMLA);
    const bf16_t ob = f2bf(o);
    const int c = lane & 31;
#pragma unroll
    for (int hq = 0; hq < 4; ++hq) { const int h = hq + 4 * (lane >> 5); km[((size_t)(b * 8 + h) * LP + p) * 96 + 64 + c] = ob; }
  }
  ((bf16_t*)(ws + O_KI))[(size_t)t * 64 + lane] = f2bf(sm[S_KI + lane]);
  if (lane < 8) ((float*)(ws + O_WI))[(size_t)t * 8 + lane] = sm[S_WI + lane] * 0.35355339059327373f;
}

DI void p2b_q_tile(const Params& P, int tile, unsigned char* lds) {
  unsigned char* ws = P.ws;
  constexpr int NNT = 768 / 256;
  const int mt = tile / NNT, nt = tile % NNT, m0 = mt * 256, n0 = nt * 256;
  TilePtrs tp; set_ptrs(tp, (const bf16_t*)(ws + O_CQN), 256, NT, m0, (const bf16_t*)(ws + O_WUQ), 256, 768, n0);
  f32x16 acc[4][2]; zero_acc(acc);
  gemm_kloop(acc, tp, 256, lds);
  const int lane = threadIdx.x & 63, w = threadIdx.x >> 6, wr = w >> 2, wc = w & 3, hh = lane >> 5, lc = lane & 31;
  const float qscale = 0.10206207261596575f * LOG2E;
  const float* rope = (const float*)(ws + O_ROPE);
  bf16_t* qa = (bf16_t*)(ws + O_QA);
#pragma unroll
  for (int mi = 0; mi < 4; ++mi)
#pragma unroll
    for (int ni = 0; ni < 2; ++ni) {
      const int col = n0 + acc_col0(wc, ni) + lc;
      const int ct = col >> 5;
      const bool is_rope = (ct % 3) == 2;
      const int rbase = m0 + acc_row0(wr, mi) + 4 * hh;
#pragma unroll
      for (int r = 0; r < 16; ++r) {
        const int row = rbase + (r & 3) + 8 * (r >> 2);
        float v = acc[mi][ni][r];
        const float partner = __shfl_xor(v, 16);
        if (is_rope) {
          const int rowc = row < NT ? row : NT - 1;
          const int p = rowc % L, j = lc & 15;
          const float cs = rope[p * 32 + j], sn = rope[p * 32 + 16 + j];
          v = (lc & 16) ? (partner * sn + v * cs) : (v * cs - partner * sn);
        }
        if (row < NT) qa[(size_t)row * 768 + col] = f2bf(v * qscale);
      }
    }
}
DI void p2b_kv_tile(const Params& P, int tile, unsigned char* lds) {
  unsigned char* ws = P.ws;
  constexpr int NNT = 1024 / 256;
  const int mt = tile / NNT, nt = tile % NNT, m0 = mt * 256, n0 = nt * 256;
  TilePtrs tp; set_ptrs(tp, (const bf16_t*)(ws + O_CKVN), 128, NT, m0, (const bf16_t*)(ws + O_WUKV), 128, 1024, n0);
  f32x16 acc[4][2]; zero_acc(acc);
  gemm_kloop(acc, tp, 128, lds);
  const int lane = threadIdx.x & 63, w = threadIdx.x >> 6, wr = w >> 2, wc = w & 3, hh = lane >> 5, lc = lane & 31;
  bf16_t* km = (bf16_t*)(ws + O_KMLA); bf16_t* vt = (bf16_t*)(ws + O_VT);
#pragma unroll
  for (int mi = 0; mi < 4; ++mi)
#pragma unroll
    for (int ni = 0; ni < 2; ++ni) {
      const int cc = n0 + acc_col0(wc, ni) + lc, h = cc >> 7, c = cc & 127;
      const int rbase = m0 + acc_row0(wr, mi) + 4 * hh;
      if (c < 64) {
#pragma unroll
        for (int r = 0; r < 16; ++r) {
          const int row = rbase + (r & 3) + 8 * (r >> 2);
          if (row < NT) { const int b = row / L, p = row % L; km[((size_t)(b * 8 + h) * LP + p) * 96 + c] = f2bf(acc[mi][ni][r]); }
        }
      } else {
        const int d = c - 64;
#pragma unroll
        for (int g = 0; g < 4; ++g) {
          const int row = rbase + 8 * g;
          if (row < NT) {
            const int b = row / L, p = row % L;
            u32x2 o; o[0] = pk2(acc[mi][ni][4 * g], acc[mi][ni][4 * g + 1]); o[1] = pk2(acc[mi][ni][4 * g + 2], acc[mi][ni][4 * g + 3]);
            *(u32x2*)(vt + ((size_t)(b * 8 + h) * 64 + d) * LP + p) = o;
          }
        }
      }
    }
}


DI int next_item(const Params& P, int ctr, int* slot) {
  __syncthreads();
  if (threadIdx.x == 0) *slot = (int)atomicAdd((unsigned*)(P.ws + O_CTR) + ctr, 1u);
  __syncthreads();
  return *slot;
}
DI float fast_exp2(float x) { return __builtin_amdgcn_exp2f(x); }
DI bf16x8 pack8(const f32x16& v, int s) {
  u32x4 p;
  p[0] = pk2(v[8 * s + 0], v[8 * s + 1]); p[1] = pk2(v[8 * s + 2], v[8 * s + 3]); p[2] = pk2(v[8 * s + 4], v[8 * s + 5]); p[3] = pk2(v[8 * s + 6], v[8 * s + 7]);
  return __builtin_bit_cast(bf16x8, p);
}

constexpr float MASKV = -3.0e38f;
constexpr float DEFER_THR = 6.0f;
DI float xmax32(float v) {
  const auto r = __builtin_amdgcn_permlane32_swap(__float_as_uint(v), __float_as_uint(v), false, false);
  return fmaxf(__uint_as_float(r[0]), __uint_as_float(r[1]));
}
DI void softmax_update1(f32x16& s, float& m, float mref, float& lsum, f32x16& o0, f32x16& o1) {
  float mx = s[0];
#pragma unroll
  for (int r = 1; r < 16; ++r) mx = fmaxf(mx, s[r]);
  mx = xmax32(mx);
  const bool have = m > -1e29f;
  const float shift = (have ? m : 0.f) - mref;
  const bool need = (mx - shift > DEFER_THR) || (!have && mx > -1e37f);
  if (__any(need || shift != 0.f)) {
    const float delta = need ? mx - shift : 0.f;
    const float alpha = (need && have) ? fast_exp2(-delta) : 1.f;
    m = need ? (have ? m : 0.f) + delta : m;
    const float sub = shift + delta;
#pragma unroll
    for (int r = 0; r < 16; ++r) { s[r] -= sub; o0[r] *= alpha; o1[r] *= alpha; }
    lsum *= alpha;
  }
#pragma unroll
  for (int r = 0; r < 16; ++r) s[r] = fast_exp2(s[r]);
  typedef float f32x2 __attribute__((ext_vector_type(2)));
  f32x2 ps = {0.f, 0.f};
#pragma unroll
  for (int r = 0; r < 16; r += 2) ps += (f32x2){s[r], s[r + 1]};
  lsum += ps[0] + ps[1];
}
DI void pv_subtile(const unsigned char* Vc, int vstr, const f32x16& p, f32x16& o0, f32x16& o1) {
#pragma unroll
  for (int s2 = 0; s2 < 2; ++s2) {
    const bf16x8 pb = pack8(p, s2);
    const u32x2 a0l = *(const u32x2*)(Vc + s2 * 32), a0h = *(const u32x2*)(Vc + s2 * 32 + 16);
    const u32x2 a1l = *(const u32x2*)(Vc + 32 * vstr + s2 * 32), a1h = *(const u32x2*)(Vc + 32 * vstr + s2 * 32 + 16);
    o0 = __builtin_amdgcn_mfma_f32_32x32x16_bf16(__builtin_bit_cast(bf16x8, (u32x4){a0l[0], a0l[1], a0h[0], a0h[1]}), pb, o0, 0, 0, 0);
    o1 = __builtin_amdgcn_mfma_f32_32x32x16_bf16(__builtin_bit_cast(bf16x8, (u32x4){a1l[0], a1l[1], a1h[0], a1h[1]}), pb, o1, 0, 0, 0);
  }
}
constexpr int MLA_KSTR = 208, MLA_VSTR = 136, MLA_KBYTES = 64 * MLA_KSTR, MLA_STAGE = MLA_KBYTES + 64 * MLA_VSTR;
DI void mla_stage(const unsigned char* cur, int s, int cw, int lq, int hh, const bf16x8 (&qf)[6], f32x16& o0, f32x16& o1, float& m, float& lsum) {
  if (s > cw) return;
  const bool full = s < cw;
  const float mref = m > -1e29f ? m : 0.f;
  f32x16 s0, s1;
#pragma unroll
  for (int r = 0; r < 16; ++r) { s0[r] = -mref; s1[r] = -mref; }
  const unsigned char* Kc = cur + lq * MLA_KSTR + hh * 16;
  {
    bf16x8 kf[6];
#pragma unroll
    for (int kk = 0; kk < 6; ++kk) kf[kk] = *(const bf16x8*)(Kc + kk * 32);
#pragma unroll
    for (int kk = 0; kk < 6; ++kk) s0 = __builtin_amdgcn_mfma_f32_32x32x16_bf16(kf[kk], qf[kk], s0, 0, 0, 0);
    __builtin_amdgcn_sched_group_barrier(0x100, 6, 0);
    __builtin_amdgcn_sched_group_barrier(0x008, 6, 0);
  }
  if (full) {
    bf16x8 kf[6];
#pragma unroll
    for (int kk = 0; kk < 6; ++kk) kf[kk] = *(const bf16x8*)(Kc + 32 * MLA_KSTR + kk * 32);
#pragma unroll
    for (int kk = 0; kk < 6; ++kk) s1 = __builtin_amdgcn_mfma_f32_32x32x16_bf16(kf[kk], qf[kk], s1, 0, 0, 0);
    __builtin_amdgcn_sched_group_barrier(0x100, 6, 0);
    __builtin_amdgcn_sched_group_barrier(0x008, 6, 0);
  } else {
#pragma unroll
    for (int r = 8; r < 16; ++r) s0[r] = MASKV;
  }
  const unsigned char* Vc = cur + MLA_KBYTES + lq * MLA_VSTR + hh * 8;
  softmax_update1(s0, m, mref, lsum, o0, o1);
  pv_subtile(Vc, MLA_VSTR, s0, o0, o1);
  if (full) {
    softmax_update1(s1, m, mref, lsum, o0, o1);
    pv_subtile(Vc + 64, MLA_VSTR, s1, o0, o1);
  }
}
DI void mla_item(const Params& P, int item, unsigned char* lds) {
  unsigned char* ws = P.ws;
  const int jq = 15 - item / 32, bh = item % 32, b = bh >> 3, h = bh & 7;
  const int c0 = 4 * jq + 1;
  const int tid = threadIdx.x, lane = tid & 63, w = __builtin_amdgcn_readfirstlane(tid >> 6), hh = lane >> 5, lq = lane & 31;
  const int cw = c0 + (w >> 1);
  const int pq = NMETA + 256 * jq + 32 * w + lq;
  const int tq = b * L + pq;
  bf16x8 qf[6];
  {
    const bf16_t* qrow = (const bf16_t*)(ws + O_QA) + (size_t)tq * 768 + h * 96 + hh * 8;
#pragma unroll
    for (int kk = 0; kk < 6; ++kk) qf[kk] = *(const bf16x8*)(qrow + kk * 16);
  }
  f32x16 o0, o1;
#pragma unroll
  for (int r = 0; r < 16; ++r) { o0[r] = 0.f; o1[r] = 0.f; }
  float m = -1e30f, lsum = 0.f;
  const int nst = c0 + 4;
  const bf16_t* kg = (const bf16_t*)(ws + O_KMLA) + (size_t)bh * LP * 96;
  const bf16_t* vg = (const bf16_t*)(ws + O_VT) + (size_t)bh * 64 * LP;
  unsigned kgo[2], klo[2], vgo, vlo;
  const bool k2 = tid < 256;
#pragma unroll
  for (int i = 0; i < 2; ++i) { int idx = tid + 512 * i; idx = idx < 768 ? idx : 767; const int row = idx / 12, c = idx % 12; kgo[i] = row * 96 + c * 8; klo[i] = row * MLA_KSTR + c * 16; }
  { const int d = tid >> 3, c = tid & 7; vgo = d * LP + c * 8; vlo = MLA_KBYTES + d * MLA_VSTR + c * 16; }
  u32x4 rkA[2], rvA, rkB[2], rvB;
#define MLA_LOAD(rk_, rv_, st) do { const bf16_t* kgs = kg + (size_t)(st) * 64 * 96; const bf16_t* vgs = vg + (st) * 64; \
    rk_[0] = *(const u32x4*)(kgs + kgo[0]); rk_[1] = *(const u32x4*)(kgs + kgo[1]); rv_ = *(const u32x4*)(vgs + vgo); } while (0)
#define MLA_WRITE(rk_, rv_, buf) do { unsigned char* nb_ = (buf); \
    *(u32x4*)(nb_ + klo[0]) = rk_[0]; if (k2) *(u32x4*)(nb_ + klo[1]) = rk_[1]; \
    *(u32x2*)(nb_ + vlo) = (u32x2){rv_[0], rv_[1]}; *(u32x2*)(nb_ + vlo + 8) = (u32x2){rv_[2], rv_[3]}; } while (0)
  unsigned char* buf0 = lds; unsigned char* buf1 = lds + MLA_STAGE;
  MLA_LOAD(rkA, rvA, 0); MLA_WRITE(rkA, rvA, buf0);
  __syncthreads();
  if (nst > 1) MLA_LOAD(rkA, rvA, 1);
#pragma unroll 1
  for (int s = 0; s < nst; s += 2) {
    if (s + 2 < nst) MLA_LOAD(rkB, rvB, s + 2);
    mla_stage(buf0, s, cw, lq, hh, qf, o0, o1, m, lsum);
    if (s + 1 < nst) MLA_WRITE(rkA, rvA, buf1);
    __syncthreads();
    if (s + 1 >= nst) break;
    if (s + 3 < nst) MLA_LOAD(rkA, rvA, s + 3);
    mla_stage(buf1, s + 1, cw, lq, hh, qf, o0, o1, m, lsum);
    if (s + 2 < nst) MLA_WRITE(rkB, rvB, buf0);
    __syncthreads();
  }
#undef MLA_LOAD
#undef MLA_WRITE
  lsum += __shfl_xor(lsum, 32);
  const float inv = 1.f / lsum;
  bf16_t* oa = (bf16_t*)(ws + O_OA) + (size_t)(tq - NMETA * (b + 1)) * 512 + h * 64 + 4 * hh;
#pragma unroll
  for (int g = 0; g < 4; ++g) {
    u32x2 v0, v1;
    v0[0] = pk2(o0[4 * g] * inv, o0[4 * g + 1] * inv); v0[1] = pk2(o0[4 * g + 2] * inv, o0[4 * g + 3] * inv);
    v1[0] = pk2(o1[4 * g] * inv, o1[4 * g + 1] * inv); v1[1] = pk2(o1[4 * g + 2] * inv, o1[4 * g + 3] * inv);
    *(u32x2*)(oa + 8 * g) = v0;
    *(u32x2*)(oa + 32 + 8 * g) = v1;
  }
}


DI size_t score_row_off(int b, int i) {
  const int c = 1 + (i >> 6), m = c - 1;
  return (size_t)b * SCORES_PER_BATCH + (size_t)8192 * (m + (m >> 1) * ((m + 1) >> 1)) + (size_t)(i & 63) * (128 * ((c >> 1) + 1));
}
constexpr int S1_ITEMS = 4 * 560;
DI void s1_item(const Params& P, int it) {
  unsigned char* ws = P.ws;
  const int b = it & 3; int r = it >> 2; int c = 64;
  while (r >= (c >> 2) + 1) { r -= (c >> 2) + 1; --c; }
  const int n = 16 + 64 * c;
  const int lane = threadIdx.x & 63, w = (threadIdx.x >> 6) & 3, lq = lane & 15, lg = lane >> 4;
  const int i = (c - 1) * 64 + 16 * w + lq, tq = b * L + NMETA + i;
  bf16x8 qf[8][2];
  const bf16_t* qrow = (const bf16_t*)(ws + O_QI) + (size_t)tq * 512 + 8 * lg;
#pragma unroll
  for (int h = 0; h < 8; ++h) { qf[h][0] = *(const bf16x8*)(qrow + h * 64); qf[h][1] = *(const bf16x8*)(qrow + h * 64 + 32); }
  const f32x4 wa = *(const f32x4*)((const float*)(ws + O_WI) + (size_t)tq * 8), wb = *(const f32x4*)((const float*)(ws + O_WI) + (size_t)tq * 8 + 4);
  const float wv[8] = {wa[0], wa[1], wa[2], wa[3], wb[0], wb[1], wb[2], wb[3]};
  unsigned* srow = (unsigned*)((_Float16*)(ws + O_SCORES) + score_row_off(b, i)) + 4 * lg;
  const bf16_t* kbase = (const bf16_t*)(ws + O_KI) + ((size_t)b * L + lq) * 64 + 8 * lg;
#pragma unroll 1
  for (int g2 = 0; g2 < 2; ++g2) {
    const int kg = 256 * r + 128 * g2;
#pragma unroll 1
    for (int kt4 = 0; kt4 < 64; kt4 += 16) {
      const int ka = kg + kt4, kb = ka + 64;
      if (ka >= n) break;
      f32x4 sa = {0.f, 0.f, 0.f, 0.f}, sb = {0.f, 0.f, 0.f, 0.f};
      {
        const bf16_t* kp = kbase + (size_t)ka * 64;
        const bf16x8 a0 = *(const bf16x8*)kp, a1 = *(const bf16x8*)(kp + 32);
#pragma unroll
        for (int h = 0; h < 8; ++h) {
          f32x4 acc = {0.f, 0.f, 0.f, 0.f};
          acc = __builtin_amdgcn_mfma_f32_16x16x32_bf16(a0, qf[h][0], acc, 0, 0, 0);
          acc = __builtin_amdgcn_mfma_f32_16x16x32_bf16(a1, qf[h][1], acc, 0, 0, 0);
#pragma unroll
          for (int q = 0; q < 4; ++q) sa[q] = fmaf(wv[h], fmaxf(acc[q], 0.f), sa[q]);
        }
      }
      if (kb < n) {
        const bf16_t* kp = kbase + (size_t)kb * 64;
        const bf16x8 a0 = *(const bf16x8*)kp, a1 = *(const bf16x8*)(kp + 32);
#pragma unroll
        for (int h = 0; h < 8; ++h) {
          f32x4 acc = {0.f, 0.f, 0.f, 0.f};
          acc = __builtin_amdgcn_mfma_f32_16x16x32_bf16(a0, qf[h][0], acc, 0, 0, 0);
          acc = __builtin_amdgcn_mfma_f32_16x16x32_bf16(a1, qf[h][1], acc, 0, 0, 0);
#pragma unroll
          for (int q = 0; q < 4; ++q) sb[q] = fmaf(wv[h], fmaxf(acc[q], 0.f), sb[q]);
        }
      }
      typedef _Float16 h2_t __attribute__((ext_vector_type(2)));
      u32x4 o;
#pragma unroll
      for (int q = 0; q < 4; ++q) { const h2_t v = {(_Float16)sa[q], (_Float16)sb[q]}; o[q] = __builtin_bit_cast(unsigned, v); }
      *(u32x4*)(srow + (kg >> 1) + kt4) = o;
    }
  }
}

DI unsigned f2key(float f) { const unsigned u = __float_as_uint(f); return (u & 0x80000000u) ? ~u : (u | 0x80000000u); }
DI unsigned long long lanemask_lt(int lane) { return (1ull << lane) - 1ull; }
template <int NG>
DI void s2_row(const Params& P, int rq, int lane) {
  unsigned char* ws = P.ws;
  const int b = rq / SEQ, i = rq % SEQ, c = 1 + (i >> 6), n = 16 + 64 * c;
  const unsigned* srow = (const unsigned*)((const _Float16*)(ws + O_SCORES) + score_row_off(b, i)) + lane;
  typedef unsigned short u16x2 __attribute__((ext_vector_type(2)));
  u16x2 hp[NG];
  {
    unsigned raw[NG];
#pragma unroll
    for (int e = 0; e < NG; ++e) raw[e] = srow[64 * e];
#pragma unroll
    for (int e = 0; e < NG; ++e) asm volatile("" : "+v"(raw[e]));
#pragma unroll
    for (int e = 0; e < NG; ++e) {
      const unsigned d = raw[e];
      unsigned k = d ^ ((((d >> 15) & 0x00010001u) * 0xffffu) | 0x80008000u);
      if (128 * e + lane >= n) k &= 0xffff0000u;
      if (128 * e + 64 + lane >= n) k &= 0x0000ffffu;
      hp[e] = __builtin_bit_cast(u16x2, k);
    }
  }
  unsigned T = 0; int c_lo = 1 << 30, c_hi = 0;
  for (int bit = 15; bit >= 0; --bit) {
    const unsigned cand = T | (1u << bit);
    const unsigned short chm1 = (unsigned short)(cand - 1u);
    const u16x2 cv = {chm1, chm1}, one = {1, 1};
    u16x2 a0 = {0, 0}, a1 = {0, 0};
#pragma unroll
    for (int e = 0; e < NG; ++e) {
      u16x2 t;
      asm("v_pk_sub_u16 %0, %1, %2 clamp" : "=v"(t) : "v"(hp[e]), "v"(cv));
      asm("v_pk_min_u16 %0, %1, %2" : "=v"(t) : "v"(t), "v"(one));
      if (e & 1) asm("v_pk_add_u16 %0, %1, %2" : "=v"(a1) : "v"(a1), "v"(t)); else asm("v_pk_add_u16 %0, %1, %2" : "=v"(a0) : "v"(a0), "v"(t));
    }
    const u16x2 as = a0 + a1;
    const int cc = wave_sumi((int)as[0] + (int)as[1]);
    if (cc >= 256) { T = cand; c_lo = cc; } else { c_hi = cc; }
    if (c_lo == 256) break;
  }
  unsigned mlo = 0u, mhi = 0u;
  unsigned long long w64 = 0ull;
  int rem = c_lo == 256 ? (1 << 20) : 256 - c_hi;
#pragma unroll
  for (int e = 0; e < NG; ++e) {
    const unsigned kk = __builtin_bit_cast(unsigned, hp[e]);
#pragma unroll
    for (int h = 0; h < 2; ++h) {
      const unsigned kv = h ? (kk >> 16) : (kk & 0xffffu);
      const bool eq = kv == T;
      const unsigned long long meq = __ballot(eq), mgt = __ballot(kv > T);
      unsigned long long msel = mgt;
      if (meq) {
        const int pre = __popcll(meq & lanemask_lt(lane));
        msel |= __ballot(eq && pre < rem);
        rem -= __popcll(meq); rem = rem < 0 ? 0 : rem;
      }
      const int wd = 2 * e + h;
      if (wd < 64) { if (lane == wd) { mlo = (unsigned)msel; mhi = (unsigned)(msel >> 32); } } else if (wd == 64) w64 = msel;
    }
  }
  unsigned* mrow = (unsigned*)(P.ws + O_MASK) + (size_t)rq * MW;
  *(u32x2*)(mrow + 2 * lane) = (u32x2){mlo, mhi};
  if (lane == 0) { *(u32x2*)(mrow + 128) = (u32x2){(unsigned)w64, (unsigned)(w64 >> 32)}; *(u32x2*)(mrow + 130) = (u32x2){0u, 0u}; }
}
DI void s2_dispatch(const Params& P, int rq, int lane, unsigned* wl) {
  (void)wl;
  const int c = 1 + ((rq % SEQ) >> 6), n = 16 + 64 * c;
  if (n <= 256) {
    unsigned* mrow = (unsigned*)(P.ws + O_MASK) + (size_t)rq * MW;
    unsigned long long m = 0ull;
    const int lo = 64 * lane;
    if (lo + 64 <= n) m = ~0ull; else if (lo < n) m = (1ull << (n - lo)) - 1ull;
    *(u32x2*)(mrow + 2 * lane) = (u32x2){(unsigned)m, (unsigned)(m >> 32)};
    if (lane == 0) { *(u32x2*)(mrow + 128) = (u32x2){0u, 0u}; *(u32x2*)(mrow + 130) = (u32x2){0u, 0u}; }
    return;
  }
  const int ng = (c >> 1) + 1;
  if (ng <= 5) s2_row<5>(P, rq, lane);
  else if (ng <= 9) s2_row<9>(P, rq, lane);
  else if (ng <= 13) s2_row<13>(P, rq, lane);
  else if (ng <= 17) s2_row<17>(P, rq, lane);
  else if (ng <= 21) s2_row<21>(P, rq, lane);
  else if (ng <= 25) s2_row<25>(P, rq, lane);
  else if (ng <= 29) s2_row<29>(P, rq, lane);
  else s2_row<33>(P, rq, lane);
}

DI int t5_bucket(int rel) {
  const int n = rel < 0 ? -rel : rel;
  int v;
  if (n < 8) v = n;
  else v = 8 + (n >= 12) + (n >= 16) + (n >= 23) + (n >= 32) + (n >= 46) + (n >= 64) + (n >= 91);
  return (rel > 0 ? 16 : 0) + v;
}
constexpr int DSA_KSTR = 144, DSA_VSTR = 136, DSA_KBYTES = 64 * DSA_KSTR, DSA_STAGE = DSA_KBYTES + 64 * DSA_VSTR;
constexpr int DSA_TB = 2 * DSA_STAGE;
DI void dsa_stage(const unsigned char* cur, int s, int cw, int lq, int hh, int pq, int qmin, float bfar, const float* tb, const unsigned* mrow,
                  const bf16x8 (&qf)[4], f32x16& o0, f32x16& o1, float& m, float& lsum) {
  if (s > cw) return;
  const bool full = s < cw;
  const int kb0 = 64 * s;
  const bool near = kb0 + 63 >= qmin - 91;
  const unsigned w0 = mrow[2 * s] >> (4 * hh), w1 = mrow[2 * s + 1] >> (4 * hh);
  const float mref = m > -1e29f ? m : 0.f;
  f32x16 s0, s1;
  const float binit = (near ? 0.f : bfar) - mref;
#pragma unroll
  for (int r = 0; r < 16; ++r) { s0[r] = binit; s1[r] = binit; }
  const unsigned char* Kc = cur + lq * DSA_KSTR + hh * 16;
  {
    bf16x8 kf[4];
#pragma unroll
    for (int kk = 0; kk < 4; ++kk) kf[kk] = *(const bf16x8*)(Kc + kk * 32);
#pragma unroll
    for (int kk = 0; kk < 4; ++kk) s0 = __builtin_amdgcn_mfma_f32_32x32x16_bf16(kf[kk], qf[kk], s0, 0, 0, 0);
    __builtin_amdgcn_sched_group_barrier(0x100, 4, 0);
    __builtin_amdgcn_sched_group_barrier(0x008, 4, 0);
  }
  if (full) {
    bf16x8 kf[4];
#pragma unroll
    for (int kk = 0; kk < 4; ++kk) kf[kk] = *(const bf16x8*)(Kc + 32 * DSA_KSTR + kk * 32);
#pragma unroll
    for (int kk = 0; kk < 4; ++kk) s1 = __builtin_amdgcn_mfma_f32_32x32x16_bf16(kf[kk], qf[kk], s1, 0, 0, 0);
    __builtin_amdgcn_sched_group_barrier(0x100, 4, 0);
    __builtin_amdgcn_sched_group_barrier(0x008, 4, 0);
  }
  const float* tp = tb + (kb0 + 4 * hh - pq + 192);
  const unsigned char* Vc = cur + DSA_KBYTES + lq * DSA_VSTR + hh * 8;
  if (near) {
#pragma unroll
    for (int r = 0; r < 16; ++r) s0[r] += tp[(r & 3) + 8 * (r >> 2)];
  }
#pragma unroll
  for (int r = 0; r < 16; ++r) s0[r] = (w0 & (1u << ((r & 3) + 8 * (r >> 2)))) ? s0[r] : MASKV;
  softmax_update1(s0, m, mref, lsum, o0, o1);
  pv_subtile(Vc, DSA_VSTR, s0, o0, o1);
  if (full) {
    if (near) {
#pragma unroll
      for (int r = 0; r < 16; ++r) s1[r] += tp[32 + (r & 3) + 8 * (r >> 2)];
    }
#pragma unroll
    for (int r = 0; r < 16; ++r) s1[r] = (w1 & (1u << ((r & 3) + 8 * (r >> 2)))) ? s1[r] : MASKV;
    softmax_update1(s1, m, mref, lsum, o0, o1);
    pv_subtile(Vc + 64, DSA_VSTR, s1, o0, o1);
  }
}
DI void dsa_item(const Params& P, int item, unsigned char* lds) {
  unsigned char* ws = P.ws;
  const int jq = 15 - item / 32, bh = item % 32, b = bh >> 3, h = bh & 7;
  const int c0 = 4 * jq + 1;
  const int tid = threadIdx.x, lane = tid & 63, w = __builtin_amdgcn_readfirstlane(tid >> 6), hh = lane >> 5, lq = lane & 31;
  const int cw = c0 + (w >> 1);
  const int pq = NMETA + 256 * jq + 32 * w + lq;
  const int tq = b * L + pq, rq = b * SEQ + pq - NMETA;
  const int qmin = NMETA + 256 * jq + 32 * w;
  float* tb = (float*)(lds + DSA_TB);
  __syncthreads();
  if (tid < 256) tb[tid] = P.rel_bias[t5_bucket(tid - 192) * 8 + h] * LOG2E;
  const float bfar = P.rel_bias[15 * 8 + h] * LOG2E;
  bf16x8 qf[4];
  {
    const bf16_t* qrow = (const bf16_t*)(ws + O_QB) + (size_t)tq * 512 + h * 64 + hh * 8;
#pragma unroll
    for (int kk = 0; kk < 4; ++kk) qf[kk] = *(const bf16x8*)(qrow + kk * 16);
  }
  const unsigned* mrow = (const unsigned*)(P.ws + O_MASK) + (size_t)rq * MW;
  f32x16 o0, o1;
#pragma unroll
  for (int r = 0; r < 16; ++r) { o0[r] = 0.f; o1[r] = 0.f; }
  float m = -1e30f, lsum = 0.f;
  const int nst = c0 + 4;
  const bf16_t* kg = (const bf16_t*)(ws + O_KB) + (size_t)b * L * 512 + h * 64;
  const bf16_t* vg = (const bf16_t*)(ws + O_VBT) + (size_t)bh * 64 * LP;
  const int srow = tid >> 3, sc = tid & 7;
  const unsigned kgo = srow * 512 + sc * 8, klo = srow * DSA_KSTR + sc * 16, vgo = srow * LP + sc * 8, vlo = DSA_KBYTES + srow * DSA_VSTR + sc * 16;
  u32x4 rkA, rvA, rkB, rvB;
#define DSA_LOAD(rk_, rv_, st) do { const int kn = (st) * 64; const int kr = min(kn + srow, L - 1) - srow; \
    rk_ = *(const u32x4*)(kg + (size_t)kr * 512 + kgo); rv_ = *(const u32x4*)(vg + kn + vgo); } while (0)
#define DSA_WRITE(rk_, rv_, buf) do { unsigned char* nb_ = (buf); *(u32x4*)(nb_ + klo) = rk_; \
    *(u32x2*)(nb_ + vlo) = (u32x2){rv_[0], rv_[1]}; *(u32x2*)(nb_ + vlo + 8) = (u32x2){rv_[2], rv_[3]}; } while (0)
  unsigned char* buf0 = lds; unsigned char* buf1 = lds + DSA_STAGE;
  DSA_LOAD(rkA, rvA, 0); DSA_WRITE(rkA, rvA, buf0);
  __syncthreads();
  if (nst > 1) DSA_LOAD(rkA, rvA, 1);
#pragma unroll 1
  for (int s = 0; s < nst; s += 2) {
    if (s + 2 < nst) DSA_LOAD(rkB, rvB, s + 2);
    dsa_stage(buf0, s, cw, lq, hh, pq, qmin, bfar, tb, mrow, qf, o0, o1, m, lsum);
    if (s + 1 < nst) DSA_WRITE(rkA, rvA, buf1);
    __syncthreads();
    if (s + 1 >= nst) break;
    if (s + 3 < nst) DSA_LOAD(rkA, rvA, s + 3);
    dsa_stage(buf1, s + 1, cw, lq, hh, pq, qmin, bfar, tb, mrow, qf, o0, o1, m, lsum);
    if (s + 2 < nst) DSA_WRITE(rkB, rvB, buf0);
    __syncthreads();
  }
#undef DSA_LOAD
#undef DSA_WRITE
  lsum += __shfl_xor(lsum, 32);
  const float inv = 1.f / lsum;
  bf16_t* ob = (bf16_t*)(ws + O_OB) + (size_t)rq * 512 + h * 64 + 4 * hh;
#pragma unroll
  for (int g = 0; g < 4; ++g) {
    u32x2 v0, v1;
    v0[0] = pk2(o0[4 * g] * inv, o0[4 * g + 1] * inv); v0[1] = pk2(o0[4 * g + 2] * inv, o0[4 * g + 3] * inv);
    v1[0] = pk2(o1[4 * g] * inv, o1[4 * g + 1] * inv); v1[1] = pk2(o1[4 * g + 2] * inv, o1[4 * g + 3] * inv);
    *(u32x2*)(ob + 8 * g) = v0;
    *(u32x2*)(ob + 32 + 8 * g) = v1;
  }
}

template <bool CHECK> DI void nv_mla(const Params& P, int vb, unsigned char* lds) {
  unsigned char* ws = P.ws;
  float* qs = (float*)lds;
  const int b = vb / SEQ, p = NMETA + vb % SEQ, t = b * L + p;
  const int tid = threadIdx.x & 255, h = tid >> 5, l = tid & 31;
  const bf16_t* qa = (const bf16_t*)(ws + O_QA) + (size_t)t * 768;
  for (int i = tid; i < 768; i += 256) qs[i] = bf2f(qa[i]);
  __syncthreads();
  const int na = n_adm(p);
  const bf16_t* km = (const bf16_t*)(ws + O_KMLA) + (size_t)(b * 8 + h) * LP * 96;
  const bf16_t* vt = (const bf16_t*)(ws + O_VT) + (size_t)(b * 8 + h) * 64 * LP;
  float m = -1e30f, ls = 0.f, acc[64];
#pragma unroll
  for (int d = 0; d < 64; ++d) acc[d] = 0.f;
  const float* q = qs + h * 96;
  for (int j = l; j < na; j += 32) {
    const bf16_t* kr = km + (size_t)j * 96;
    float s = 0.f;
#pragma unroll 8
    for (int d = 0; d < 96; ++d) s = fmaf(q[d], bf2f(kr[d]), s);
    const float mn = fmaxf(m, s), c = exp2f(m - mn), pe = exp2f(s - mn);
    ls = ls * c + pe;
#pragma unroll
    for (int d = 0; d < 64; ++d) acc[d] = acc[d] * c + pe * bf2f(vt[(size_t)d * LP + j]);
    m = mn;
  }
#pragma unroll
  for (int off = 16; off >= 1; off >>= 1) {
    const float m2 = __shfl_xor(m, off), l2 = __shfl_xor(ls, off);
    const float mn = fmaxf(m, m2), c1 = exp2f(m - mn), c2 = exp2f(m2 - mn);
    ls = ls * c1 + l2 * c2;
#pragma unroll
    for (int d = 0; d < 64; ++d) { const float a2 = __shfl_xor(acc[d], off); acc[d] = acc[d] * c1 + a2 * c2; }
    m = mn;
  }
  if (l == 0) {
    const float inv = 1.f / ls;
    bf16_t* oa = (bf16_t*)(ws + O_OA) + (size_t)vb * 512 + h * 64;
    if (CHECK) {
#if SELFCHECK
#pragma unroll
      for (int d = 0; d < 64; ++d) if (far(bf2f(oa[d]), acc[d] * inv, 0.004f, 0.03f)) chk_fail(P, 13);
#endif
    } else {
#pragma unroll
      for (int d = 0; d < 64; ++d) oa[d] = f2bf(acc[d] * inv);
    }
  }
  __syncthreads();
}

#if SELFCHECK
struct NvDsaLds { float qi[512]; float qb[512]; float wi[8]; unsigned keys[L]; int sel[256]; float sc[8][256]; int redi[8]; int scan_gt[257]; int scan_eq[257]; unsigned char mine[L]; };
DI void nv_dsa_check(const Params& P, int vb, unsigned char* lds) {
  unsigned char* ws = P.ws;
  NvDsaLds& S = *(NvDsaLds*)lds;
  const int b = vb / SEQ, p = NMETA + vb % SEQ, t = b * L + p, tid = threadIdx.x & 255;
  const bf16_t* qi_g = (const bf16_t*)(ws + O_QI) + (size_t)t * 512;
  const bf16_t* qb_g = (const bf16_t*)(ws + O_QB) + (size_t)t * 512;
  for (int i = tid; i < 512; i += 256) { S.qi[i] = bf2f(qi_g[i]); S.qb[i] = bf2f(qb_g[i]); }
  if (tid < 8) S.wi[tid] = ((const float*)(ws + O_WI))[(size_t)t * 8 + tid];
  __syncthreads();
  const int na = n_adm(p);
  const bf16_t* ki_g = (const bf16_t*)(ws + O_KI) + (size_t)b * L * 64;
  for (int j = tid; j < na; j += 256) {
    const bf16_t* ki = ki_g + (size_t)j * 64;
    float s = 0.f;
    for (int h = 0; h < 8; ++h) {
      float lg = 0.f;
#pragma unroll 8
      for (int d = 0; d < 64; ++d) lg = fmaf(S.qi[h * 64 + d], bf2f(ki[d]), lg);
      s += S.wi[h] * fmaxf(lg, 0.f);
    }
    S.keys[j] = f2key(s);
    S.mine[j] = 0;
  }
  __syncthreads();
  if (na <= 256) {
    for (int j = tid; j < na; j += 256) S.mine[j] = 1;
  } else {
    unsigned T = 0;
    for (int bit = 31; bit >= 0; --bit) {
      const unsigned cand = T | (1u << bit);
      int c = 0;
      for (int j = tid; j < na; j += 256) c += S.keys[j] >= cand;
      c = block_sumi256(c, S.redi);
      if (c >= 256) T = cand;
    }
    const int chunk = (na + 255) / 256;
    const int j0 = tid * chunk, j1 = min(j0 + chunk, na);
    int cgt = 0, ce = 0;
    for (int j = j0; j < j1; ++j) { cgt += S.keys[j] > T; ce += S.keys[j] == T; }
    S.scan_gt[tid + 1] = cgt; S.scan_eq[tid + 1] = ce;
    __syncthreads();
    if (threadIdx.x == 0) { S.scan_gt[0] = 0; S.scan_eq[0] = 0; for (int i = 1; i <= 256; ++i) { S.scan_gt[i] += S.scan_gt[i - 1]; S.scan_eq[i] += S.scan_eq[i - 1]; } }
    __syncthreads();
    const int r = 256 - S.scan_gt[256];
    int pe = S.scan_eq[tid];
    for (int j = j0; j < j1; ++j) {
      if (S.keys[j] > T) S.mine[j] = 1;
      else if (S.keys[j] == T) { if (pe < r) S.mine[j] = 1; ++pe; }
    }
  }
  __syncthreads();
  const unsigned* mrow = (const unsigned*)(P.ws + O_MASK) + (size_t)vb * MW;
  int mism = 0, cntk = 0;
  for (int j = tid; j < 4224; j += 256) {
    const int kb = (mrow[j >> 5] >> (j & 31)) & 1;
    const int me = j < na ? (int)S.mine[j] : 0;
    mism += kb != me; cntk += kb;
    if (kb && j >= na) mism += 1000;
  }
  mism = block_sumi256(mism, S.redi);
  cntk = block_sumi256(cntk, S.redi);
  if (tid == 0) { if (mism > 16) chk_fail(P, 14); if (cntk != (na < 256 ? na : 256)) chk_fail(P, 14); }
  if (tid == 0) { int k = 0; for (int j = 0; j < na && k < 256; ++j) if ((mrow[j >> 5] >> (j & 31)) & 1) S.sel[k++] = j; for (; k < 256; ++k) S.sel[k] = 0; }
  const int nsel = na < 256 ? na : 256;
  __syncthreads();
  if (tid < nsel) {
    const int j = S.sel[tid];
    const bf16_t* kb = (const bf16_t*)(ws + O_KB) + (size_t)(b * L + j) * 512;
    const int bk = t5_bucket(j - p);
    for (int h = 0; h < 8; ++h) {
      float s = 0.f;
#pragma unroll 8
      for (int d = 0; d < 64; ++d) s = fmaf(S.qb[h * 64 + d], bf2f(kb[h * 64 + d]), s);
      S.sc[h][tid] = s + P.rel_bias[bk * 8 + h] * LOG2E;
    }
  }
  __syncthreads();
  {
    const int h = tid >> 5, l = tid & 31;
    float m = -1e30f;
    for (int k = l; k < nsel; k += 32) m = fmaxf(m, S.sc[h][k]);
#pragma unroll
    for (int off = 16; off >= 1; off >>= 1) m = fmaxf(m, __shfl_xor(m, off));
    float s = 0.f;
    for (int k = l; k < nsel; k += 32) s += exp2f(S.sc[h][k] - m);
#pragma unroll
    for (int off = 16; off >= 1; off >>= 1) s += __shfl_xor(s, off);
    const float inv = 1.f / s;
    __syncthreads();
    if (threadIdx.x < 256) for (int k = l; k < nsel; k += 32) S.sc[h][k] = exp2f(S.sc[h][k] - m) * inv;
  }
  __syncthreads();
  const bf16_t* vbt = (const bf16_t*)(ws + O_VBT) + (size_t)b * 8 * 64 * LP;
  const bf16_t* ob = (const bf16_t*)(ws + O_OB) + (size_t)vb * 512;
  for (int o = tid; o < 512; o += 256) {
    const int h = o >> 6;
    float a = 0.f;
    for (int k = 0; k < nsel; ++k) a = fmaf(S.sc[h][k], bf2f(vbt[(size_t)o * LP + S.sel[k]]), a);
    if (far(bf2f(ob[o]), a, 0.006f, 0.03f)) chk_fail(P, 15);
  }
  __syncthreads();
}
#endif

DI void p7_merge_tile(const Params& P, int mt, int nt, unsigned char* lds) {
  unsigned char* ws = P.ws;
  const int m0 = mt * 256, n0 = nt * 256;
  const bf16_t* gates = (const bf16_t*)P.out;
  bf16_t* yo = (bf16_t*)(ws + O_Y);
  TilePtrs tp;
  f32x16 acc[4][2];
  const int lane = threadIdx.x & 63, w = threadIdx.x >> 6, wr = w >> 2, wc = w & 3, hh = lane >> 5, lc = lane & 31;
#pragma unroll 1
  for (int br = 0; br < 2; ++br) {
    set_ptrs(tp, (const bf16_t*)(ws + (br ? O_OB : O_OA)), 512, NR, m0, (const bf16_t*)(ws + (br ? O_WBRB : O_WBRA)), 512, 1024, n0);
    zero_acc(acc); gemm_kloop(acc, tp, 512, lds);
#pragma unroll
    for (int mi = 0; mi < 4; ++mi)
#pragma unroll
      for (int ni = 0; ni < 2; ++ni) {
        const int col = n0 + acc_col0(wc, ni) + lc;
        int rbase = m0 + acc_row0(wr, mi) + 4 * hh;
        asm volatile("" : "+v"(rbase));
#pragma unroll
        for (int hb = 0; hb < 2; ++hb) {
          bf16_t gv[8], pv[8];
#pragma unroll
          for (int q = 0; q < 8; ++q) {
            const int r = 8 * hb + q, row = rbase + (r & 3) + 8 * (r >> 2);
            gv[q] = gates[(size_t)row * 2048 + br * 1024 + col];
            pv[q] = br ? yo[(size_t)row * 1024 + col] : (bf16_t)0;
          }
#pragma unroll
          for (int q = 0; q < 8; ++q) {
            const int r = 8 * hb + q, row = rbase + (r & 3) + 8 * (r >> 2);
            yo[(size_t)row * 1024 + col] = f2bf(bf2f(gv[q]) * acc[mi][ni][r] + bf2f(pv[q]));
          }
          __builtin_amdgcn_sched_barrier(0);
        }
      }
    asm volatile("" ::: "memory");
  }
}

DI void p8_out_tile(const Params& P, int mt, int nt, unsigned char* lds) {
  unsigned char* ws = P.ws;
  const int m0 = mt * 256, n0 = nt * 256;
  TilePtrs tp; set_ptrs(tp, (const bf16_t*)(ws + O_Y), 1024, NR, m0, (const bf16_t*)(ws + O_WO), 1024, 1024, n0);
  f32x16 acc[4][2]; zero_acc(acc);
  gemm_kloop(acc, tp, 1024, lds);
  const int lane = threadIdx.x & 63, w = threadIdx.x >> 6, wr = w >> 2, wc = w & 3, hh = lane >> 5, lc = lane & 31;
#pragma unroll
  for (int mi = 0; mi < 4; ++mi)
#pragma unroll
    for (int ni = 0; ni < 2; ++ni) {
      const int col = n0 + acc_col0(wc, ni) + lc;
      const int rbase = m0 + acc_row0(wr, mi) + 4 * hh;
      float xv[16];
#pragma unroll
      for (int r = 0; r < 16; ++r) xv[r] = P.x[(size_t)(rbase + (r & 3) + 8 * (r >> 2)) * D + col];
#pragma unroll
      for (int r = 0; r < 16; ++r) P.out[(size_t)(rbase + (r & 3) + 8 * (r >> 2)) * D + col] = xv[r] + acc[mi][ni][r];
    }
}

DI void p9_router_token(const Params& P, int tok, int lane) {
  unsigned char* ws = P.ws;
  const float* row = P.out + (size_t)tok * D;
  f32x4 v[4]; float s = 0.f;
#pragma unroll
  for (int i = 0; i < 4; ++i) { v[i] = *(const f32x4*)(row + 256 * i + 4 * lane); s += v[i][0] * v[i][0] + v[i][1] * v[i][1] + v[i][2] * v[i][2] + v[i][3] * v[i][3]; }
  s = wave_sum(s);
  const float rs = rsqrtf(s * (1.f / D) + EPS);
#pragma unroll
  for (int i = 0; i < 4; ++i) {
    const f32x4 g = *(const f32x4*)(P.g_ffn + 256 * i + 4 * lane);
    v[i][0] *= rs * g[0]; v[i][1] *= rs * g[1]; v[i][2] *= rs * g[2]; v[i][3] *= rs * g[3];
    u32x2 o; o[0] = pk2(v[i][0], v[i][1]); o[1] = pk2(v[i][2], v[i][3]);
    *(u32x2*)((bf16_t*)(ws + M_XN) + (size_t)tok * D + 256 * i + 4 * lane) = o;
  }
  const float* wr = (const float*)(ws + O_WR);
  float mylog = 0.f;
#pragma unroll 1
  for (int c = 0; c < 36; ++c) {
    float a = 0.f;
#pragma unroll
    for (int i = 0; i < 4; ++i) { const f32x4 w4 = *(const f32x4*)(wr + c * 1024 + 256 * i + 4 * lane); a += v[i][0] * w4[0] + v[i][1] * w4[1] + v[i][2] * w4[2] + v[i][3] * w4[3]; }
    a = wave_sum(a);
    if (lane == c) mylog = a + (c < 4 ? P.b_rg[c] : P.b_re[c - 4]);
  }
  float lg[4];
#pragma unroll
  for (int i = 0; i < 4; ++i) lg[i] = __shfl(mylog, i);
  int gs = 0; float gm = lg[0];
#pragma unroll
  for (int i = 1; i < 4; ++i) if (lg[i] > gm) { gm = lg[i]; gs = i; }
  float se = 0.f;
#pragma unroll
  for (int i = 0; i < 4; ++i) se += expf(lg[i] - gm);
  const float pg = 1.f / se;
  float el[8];
#pragma unroll
  for (int i = 0; i < 8; ++i) el[i] = __shfl(mylog, 4 + gs * 8 + i);
  float em = el[0];
#pragma unroll
  for (int i = 1; i < 8; ++i) em = fmaxf(em, el[i]);
  float pe[8]; float ss = 0.f;
#pragma unroll
  for (int i = 0; i < 8; ++i) { pe[i] = expf(el[i] - em); ss += pe[i]; }
  int e1 = 0; float p1 = pe[0];
#pragma unroll
  for (int i = 1; i < 8; ++i) if (pe[i] > p1) { p1 = pe[i]; e1 = i; }
  int e2 = 0; float p2 = -1.f;
#pragma unroll
  for (int i = 0; i < 8; ++i) if (i != e1 && pe[i] > p2) { p2 = pe[i]; e2 = i; }
  p1 /= ss; p2 /= ss;
  const float den = p1 + p2;
  const float w1 = pg * p1 / den, w2 = pg * p2 / den;
  const int x1 = gs * 8 + e1, x2 = gs * 8 + e2;
  if (lane == 0) {
    unsigned* cnt = (unsigned*)(ws + O_CTR) + 32;
    const int q1 = (int)atomicAdd(cnt + x1, 1u), q2 = (int)atomicAdd(cnt + x2, 1u);
    ((int*)(ws + M_LIST))[(size_t)x1 * NR + q1] = tok; ((int*)(ws + M_LIST))[(size_t)x2 * NR + q2] = tok;
    ((float*)(ws + M_WL))[(size_t)x1 * NR + q1] = w1; ((float*)(ws + M_WL))[(size_t)x2 * NR + q2] = w2;
    int* asg = (int*)(ws + M_ASG) + (size_t)tok * 4;
    asg[0] = x1; asg[1] = q1; asg[2] = x2; asg[3] = q2;
  }
}
DI void p9_conv_gu_item(const Params& P, int item, float* scr, int tid, bool valid) {
  const int e = item >> 7, r = item & 127, kb = r & 15, nb = r >> 4;
  const int k0 = kb * 64, n0 = nb * 64;
  bf16_t* dst = (bf16_t*)(P.ws + M_WGU) + (size_t)e * 512 * 1024;
  if (valid) {
    const int n = tid & 63, nd = n0 + n, q = nd >> 8, within = nd & 255, part = within >> 7, idx = within & 127;
    const float* src = (part ? P.w_eu : P.w_eg) + (size_t)e * 1024 * 256 + (q * 128 + idx);
#pragma unroll 4
    for (int i = 0; i < 16; ++i) { const int k = (tid >> 6) + 4 * i; scr[k * 65 + n] = src[(size_t)(k0 + k) * 256]; }
  }
  __syncthreads();
  if (valid) {
    const int kq = tid & 7;
#pragma unroll
    for (int i = 0; i < 2; ++i) {
      const int n = (tid >> 3) + 32 * i;
      const float* sp = scr + (kq * 8) * 65 + n;
      u32x4 o; o[0] = pk2(sp[0], sp[65]); o[1] = pk2(sp[2 * 65], sp[3 * 65]); o[2] = pk2(sp[4 * 65], sp[5 * 65]); o[3] = pk2(sp[6 * 65], sp[7 * 65]);
      *(u32x4*)(dst + (size_t)(n0 + n) * 1024 + k0 + kq * 8) = o;
    }
  }
  __syncthreads();
}
DI int moe_tile_lookup(const Params& P, int tile, int& e_out, int& rt_out, int& cnt_out, int& base_slot) {
  const unsigned* cnt = (const unsigned*)(P.ws + O_CTR) + 32;
  int acc = 0, found = 0;
  e_out = 0; rt_out = 0; cnt_out = 0; base_slot = 0;
  for (int e = 0; e < 32; ++e) {
    const int c = (int)cnt[e], nt = (c + 255) >> 8;
    if (!found && tile < acc + nt) { e_out = e; rt_out = tile - acc; cnt_out = c; base_slot = acc * 256; found = 1; }
    acc += nt;
  }
  return acc;
}
DI void p10_gu_tile(const Params& P, int tile, int e, int rt, int cnt, int base_slot, int q, unsigned char* lds) {
  unsigned char* ws = P.ws;
  const int tid = threadIdx.x;
  const int* list = (const int*)(ws + M_LIST) + (size_t)e * NR;
  TilePtrs tp;
#pragma unroll
  for (int i = 0; i < 4; ++i) { int row, kc; tile_rc(i, row, kc); int r = rt * 256 + row; r = r < cnt ? r : cnt - 1; tp.a[i] = ((unsigned)list[r] * 1024u + kc * 8) * 2u; tp.b[i] = ((unsigned)(q * 256 + row) * 1024u + kc * 8) * 2u; }
  tp.A = (const bf16_t*)(ws + M_XN); tp.B = (const bf16_t*)(ws + M_WGU) + (size_t)e * 512 * 1024;
  f32x16 acc[4][2]; zero_acc(acc);
  gemm_kloop(acc, tp, 1024, lds);
  const int lane = tid & 63, w = tid >> 6, wr = w >> 2, wc = w & 3, hh = lane >> 5, lc = lane & 31;
  bf16_t* hm = (bf16_t*)(ws + M_HMID);
  const int col = q * 128 + wc * 32 + lc;
#pragma unroll
  for (int mi = 0; mi < 4; ++mi) {
    int rbase = acc_row0(wr, mi) + 4 * hh;
    asm volatile("" : "+v"(rbase));
#pragma unroll
    for (int r = 0; r < 16; ++r) {
      const int rr = rt * 256 + rbase + (r & 3) + 8 * (r >> 2);
      const float g = acc[mi][0][r], u = acc[mi][1][r];
      const float hv = g * __builtin_amdgcn_rcpf(1.f + __expf(-g)) * u;
      if (rr < cnt) hm[(size_t)(base_slot + rr) * 256 + col] = f2bf(hv);
    }
  }
  asm volatile("s_waitcnt vmcnt(0)" ::: "memory");
  __syncthreads();
  if (threadIdx.x == 0) {
    __builtin_amdgcn_fence(__ATOMIC_RELEASE, "agent");
    asm volatile("s_waitcnt vmcnt(0)" ::: "memory");
    __hip_atomic_fetch_add((unsigned*)(ws + O_DEP) + tile, 1u, __ATOMIC_RELAXED, __HIP_MEMORY_SCOPE_AGENT);
  }
}
DI void p11_down_tile(const Params& P, int tile, int e, int rt, int cnt, int base_slot, int nt, unsigned char* lds) {
  unsigned char* ws = P.ws;
  if (threadIdx.x == 0) {
    unsigned* dep = (unsigned*)(ws + O_DEP) + tile;
    unsigned spins = 0;
    while (__hip_atomic_load(dep, __ATOMIC_RELAXED, __HIP_MEMORY_SCOPE_AGENT) < 2u && ++spins < (1u << 22)) __builtin_amdgcn_s_sleep(2);
    __builtin_amdgcn_fence(__ATOMIC_ACQUIRE, "agent");
    asm volatile("s_waitcnt vmcnt(0)" ::: "memory");
  }
  __syncthreads();
  const int tid = threadIdx.x;
  TilePtrs tp;
#pragma unroll
  for (int i = 0; i < 4; ++i) { int row, kc; tile_rc(i, row, kc); int r = rt * 256 + row; r = r < cnt ? r : cnt - 1; tp.a[i] = ((unsigned)(base_slot + r) * 256u + kc * 8) * 2u; tp.b[i] = ((unsigned)(nt * 256 + row) * 256u + kc * 8) * 2u; }
  tp.A = (const bf16_t*)(ws + M_HMID); tp.B = (const bf16_t*)(ws + M_WD) + (size_t)e * 1024 * 256;
  f32x16 acc[4][2]; zero_acc(acc);
  gemm_kloop(acc, tp, 256, lds);
  const int lane = tid & 63, w = tid >> 6, wr = w >> 2, wc = w & 3, hh = lane >> 5, lc = lane & 31;
  bf16_t* ys = (bf16_t*)(ws + M_YS);
  const float* wl = (const float*)(ws + M_WL) + (size_t)e * NR;
#pragma unroll
  for (int mi = 0; mi < 4; ++mi)
#pragma unroll
    for (int ni = 0; ni < 2; ++ni) {
      const int col = nt * 256 + acc_col0(wc, ni) + lc;
      int rbase = acc_row0(wr, mi) + 4 * hh;
      asm volatile("" : "+v"(rbase));
#pragma unroll
      for (int r = 0; r < 16; ++r) {
        const int rr = rt * 256 + rbase + (r & 3) + 8 * (r >> 2);
        if (rr < cnt) ys[(size_t)(base_slot + rr) * 1024 + col] = f2bf(acc[mi][ni][r] * wl[rr]);
      }
    }
}
DI void p12_final_token(const Params& P, int tok, int lane, const int* sbase  ) {
  unsigned char* ws = P.ws;
  float* row = P.out + (size_t)tok * D;
  const int* asg = (const int*)(ws + M_ASG) + (size_t)tok * 4;
  const int s1 = sbase[asg[0]] + asg[1], s2 = sbase[asg[2]] + asg[3];
  const bf16_t* y1 = (const bf16_t*)(ws + M_YS) + (size_t)s1 * 1024;
  const bf16_t* y2 = (const bf16_t*)(ws + M_YS) + (size_t)s2 * 1024;
  f32x4 v[4]; float s = 0.f;
#pragma unroll
  for (int i = 0; i < 4; ++i) {
    v[i] = *(const f32x4*)(row + 256 * i + 4 * lane);
    const u32x2 a = *(const u32x2*)(y1 + 256 * i + 4 * lane), b = *(const u32x2*)(y2 + 256 * i + 4 * lane);
    v[i][0] += __uint_as_float(a[0] << 16) + __uint_as_float(b[0] << 16);
    v[i][1] += __uint_as_float(a[0] & 0xffff0000u) + __uint_as_float(b[0] & 0xffff0000u);
    v[i][2] += __uint_as_float(a[1] << 16) + __uint_as_float(b[1] << 16);
    v[i][3] += __uint_as_float(a[1] & 0xffff0000u) + __uint_as_float(b[1] & 0xffff0000u);
    s += v[i][0] * v[i][0] + v[i][1] * v[i][1] + v[i][2] * v[i][2] + v[i][3] * v[i][3];
  }
  s = wave_sum(s);
  const float rs = rsqrtf(s * (1.f / D) + EPS);
#pragma unroll
  for (int i = 0; i < 4; ++i) {
    const f32x4 g = *(const f32x4*)(P.g_fin + 256 * i + 4 * lane);
    f32x4 o; o[0] = v[i][0] * rs * g[0]; o[1] = v[i][1] * rs * g[1]; o[2] = v[i][2] * rs * g[2]; o[3] = v[i][3] * rs * g[3];
    *(f32x4*)(row + 256 * i + 4 * lane) = o;
  }
}

struct NvMoeLds { float xr[D]; float xn[D]; float hm[256]; float red[8]; float logit[36]; float gatew[2]; int expert[2]; };


#if SELFCHECK
DI const float* h_row(const Params& P, int t) { const int b = t / L, p = t % L; return p < NMETA ? P.meta + (size_t)p * D : P.x + ((size_t)b * SEQ + (p - NMETA)) * D; }
DI void chk_load_hn(const Params& P, int t, float* hv, float* red) {
  const float* row = h_row(P, t);
  float s = 0.f;
  for (int i = (threadIdx.x & 255); i < D; i += 256) { const float v = row[i]; hv[i] = v; s += v * v; }
  s = block_sum256(s, red);
  const float rs = rsqrtf(s * (1.f / D) + EPS);
  if (threadIdx.x < 256) for (int i = threadIdx.x; i < D; i += 256) hv[i] = hv[i] * rs * P.g_mix[i];
  __syncthreads();
}
DI void chk_stageA(const Params& P, unsigned char* lds) {
  unsigned char* ws = P.ws;
  float* hv = (float*)lds; float* pj = hv + 1024; float* red = pj + 4608; float* cq = red + 8; float* ckv = cq + 256;
  const int tid = threadIdx.x & 255;
  for (int sidx = blockIdx.x; sidx < 512; sidx += gridDim.x) {
    const int t = sidx < 8 ? (sidx < 4 ? sidx * L + (sidx & 3) * 5 : NT - 1 - (sidx - 4) * 1031) : (int)(hash_u(sidx * 7919u + 13u) % NT);
    const int b = t / L, p = t % L;
    chk_load_hn(P, t, hv, red);
    for (int c = tid; c < 2536; c += 256) { float a = 0.f; for (int k = 0; k < D; ++k) a = fmaf(hv[k], P.w_in[(size_t)k * INC + c], a); pj[c] = a; }
    __syncthreads();
    const float* sm = (const float*)(ws + O_SMALL) + (size_t)t * 512;
    for (int c = tid; c < 416; c += 256) if (far(sm[c], pj[c], 0.06f, 0.02f)) chk_fail(P, 1);
    for (int c = tid; c < 8; c += 256) if (far(sm[S_WI + c], pj[2528 + c], 0.06f, 0.02f)) chk_fail(P, 1);
    for (int c = tid; c < 64; c += 256) if (far(sm[S_KI + c], pj[2464 + c], 0.06f, 0.02f)) chk_fail(P, 1);
    for (int c = tid; c < 512; c += 256) {
      if (far(bf2f(((const bf16_t*)(ws + O_QB))[(size_t)t * 512 + c]), pj[416 + c] * (0.125f * LOG2E), 0.012f, 0.02f)) chk_fail(P, 2);
      if (far(bf2f(((const bf16_t*)(ws + O_KB))[(size_t)t * 512 + c]), pj[928 + c], 0.06f, 0.02f)) chk_fail(P, 3);
      const int h = c >> 6, d = c & 63;
      if (far(bf2f(((const bf16_t*)(ws + O_VBT))[((size_t)(b * 8 + h) * 64 + d) * LP + p]), pj[1440 + c], 0.06f, 0.02f)) chk_fail(P, 4);
      if (far(bf2f(((const bf16_t*)(ws + O_QI))[(size_t)t * 512 + c]), pj[1952 + c] * 0.125f, 0.01f, 0.02f)) chk_fail(P, 5);
    }
    for (int c = tid; c < 64; c += 256) if (far(bf2f(((const bf16_t*)(ws + O_KI))[(size_t)t * 64 + c]), pj[2464 + c], 0.06f, 0.02f)) chk_fail(P, 6);
    for (int c = tid; c < 8; c += 256) if (far(((const float*)(ws + O_WI))[(size_t)t * 8 + c], pj[2528 + c] * 0.35355339f, 0.03f, 0.02f)) chk_fail(P, 6);
    { float s = 0.f; for (int i = tid; i < 256; i += 256) s += pj[i] * pj[i]; s = block_sum256(s, red);
      const float rs = rsqrtf(s * (1.f / 256) + EPS); for (int i = tid; i < 256; i += 256) cq[i] = pj[i] * rs * P.g_cq[i]; }
    { float s = 0.f; for (int i = tid; i < 128; i += 256) s += pj[256 + i] * pj[256 + i]; s = block_sum256(s, red);
      const float rs = rsqrtf(s * (1.f / 128) + EPS); for (int i = tid; i < 128; i += 256) ckv[i] = pj[256 + i] * rs * P.g_ckv[i]; }
    __syncthreads();
    const float qscale = 0.10206207261596575f * LOG2E;
    for (int c = tid; c < 768; c += 256) {
      const int h = c / 96, e = c % 96;
      float ref;
      if (e < 64) { float a = 0.f; for (int k = 0; k < 256; ++k) a = fmaf(cq[k], P.w_uq[(size_t)k * 768 + c], a); ref = a; }
      else {
        const int j = (e - 64) & 15; const int c1 = h * 96 + 64 + j, c2 = c1 + 16;
        float a1 = 0.f, a2 = 0.f; for (int k = 0; k < 256; ++k) { a1 = fmaf(cq[k], P.w_uq[(size_t)k * 768 + c1], a1); a2 = fmaf(cq[k], P.w_uq[(size_t)k * 768 + c2], a2); }
        const float inv = powf(10000.f, -(float)j / 16.f); float sn, cs; sincosf((float)p * inv, &sn, &cs);
        ref = (e - 64) < 16 ? a1 * cs - a2 * sn : a1 * sn + a2 * cs;
      }
      if (far(bf2f(((const bf16_t*)(ws + O_QA))[(size_t)t * 768 + c]), ref * qscale, 0.01f, 0.02f)) chk_fail(P, 7);
    }
    for (int c = tid; c < 1024; c += 256) {
      float a = 0.f; for (int k = 0; k < 128; ++k) a = fmaf(ckv[k], P.w_ukv[(size_t)k * 1024 + c], a);
      const int h = c >> 7, e = c & 127;
      if (e < 64) { if (far(bf2f(((const bf16_t*)(ws + O_KMLA))[((size_t)(b * 8 + h) * LP + p) * 96 + e]), a, 0.06f, 0.02f)) chk_fail(P, 8); }
      else { if (far(bf2f(((const bf16_t*)(ws + O_VT))[((size_t)(b * 8 + h) * 64 + (e - 64)) * LP + p]), a, 0.06f, 0.02f)) chk_fail(P, 9); }
    }
    for (int c = tid; c < 256; c += 256) {
      const int h = c >> 5, e = c & 31, j = e & 15;
      const float inv = powf(10000.f, -(float)j / 16.f); float sn, cs; sincosf((float)p * inv, &sn, &cs);
      const float x1 = pj[384 + j], x2 = pj[384 + 16 + j];
      const float ref = e < 16 ? x1 * cs - x2 * sn : x1 * sn + x2 * cs;
      if (far(bf2f(((const bf16_t*)(ws + O_KMLA))[((size_t)(b * 8 + h) * LP + p) * 96 + 64 + e]), ref, 0.06f, 0.02f)) chk_fail(P, 10);
    }
    __syncthreads();
  }
}
DI void chk_stageB(const Params& P, unsigned char* lds) {
  unsigned char* ws = P.ws;
  float* hv = (float*)lds; float* yv = hv + 1024; float* red = yv + 1024; float* oa = red + 8; float* ob = oa + 512;
  const int tid = threadIdx.x & 255;
  for (int sidx = blockIdx.x; sidx < 256; sidx += gridDim.x) {
    const int rt = (int)(hash_u(sidx * 104729u + 7u) % NR);
    const int b = rt / SEQ, p = NMETA + rt % SEQ, t = b * L + p;
    chk_load_hn(P, t, hv, red);
    for (int i = tid; i < 512; i += 256) { oa[i] = bf2f(((const bf16_t*)(ws + O_OA))[(size_t)rt * 512 + i]); ob[i] = bf2f(((const bf16_t*)(ws + O_OB))[(size_t)rt * 512 + i]); }
    __syncthreads();
    const bf16_t* gates = (const bf16_t*)P.out + (size_t)rt * 2048;
    for (int c = tid; c < D; c += 256) {
      float ga = 0.f, gb = 0.f, va = 0.f, vb = 0.f;
      for (int k = 0; k < D; ++k) { ga = fmaf(hv[k], P.w_in[(size_t)k * INC + 2536 + c], ga); gb = fmaf(hv[k], P.w_in[(size_t)k * INC + 3560 + c], gb); }
      for (int k = 0; k < 512; ++k) { va = fmaf(oa[k], P.w_bra[(size_t)k * D + c], va); vb = fmaf(ob[k], P.w_brb[(size_t)k * D + c], vb); }
      const float sa = 1.f / (1.f + expf(-ga)), sb = 1.f / (1.f + expf(-gb));
      if (far(bf2f(gates[c]), sa, 0.01f, 0.01f) || far(bf2f(gates[1024 + c]), sb, 0.01f, 0.01f)) chk_fail(P, 10);
      const float ref = va * sa + vb * sb;
      if (far(bf2f(((const bf16_t*)(ws + O_Y))[(size_t)rt * D + c]), ref, 0.004f, 0.03f)) chk_fail(P, 11);
    }
    __syncthreads();
  }
}
DI void chk_stageC(const Params& P, unsigned char* lds) {
  unsigned char* ws = P.ws;
  float* yv = (float*)lds;
  const int tid = threadIdx.x & 255;
  for (int sidx = blockIdx.x; sidx < 256; sidx += gridDim.x) {
    const int rt = (int)(hash_u(sidx * 15485863u + 3u) % NR);
    const int b = rt / SEQ, p = NMETA + rt % SEQ, t = b * L + p;
    for (int i = tid; i < D; i += 256) yv[i] = bf2f(((const bf16_t*)(ws + O_Y))[(size_t)rt * D + i]);
    __syncthreads();
    for (int c = tid; c < D; c += 256) {
      float a = 0.f; for (int k = 0; k < D; ++k) a = fmaf(yv[k], P.w_o[(size_t)k * D + c], a);
      const float ref = P.x[(size_t)rt * D + c] + a;
      if (far(P.out[(size_t)rt * D + c], ref, 0.003f, 0.002f)) chk_fail(P, 12);
    }
    __syncthreads();
  }
}
#endif

#if SELFCHECK
DI void chk_moe(const Params& P, unsigned char* lds) {
  unsigned char* ws = P.ws;
  NvMoeLds& S = *(NvMoeLds*)lds;
  __shared__ int sb[32];
  const int t = threadIdx.x & 255, lane = t & 63, wv = t >> 6;
  if (t == 0) { const unsigned* c = (const unsigned*)(ws + O_CTR) + 32; int a = 0; for (int i = 0; i < 32; ++i) { sb[i] = a; a += (((int)c[i] + 255) >> 8) * 256; } }
  __syncthreads();
  for (int sidx = blockIdx.x; sidx < 192; sidx += gridDim.x) {
    const int tok = (int)(hash_u(sidx * 40503u + 77u) % NR);
    const float* row = P.out + (size_t)tok * D;
    float s = 0.f;
    for (int i = t; i < D; i += 256) { const float v = row[i]; S.xr[i] = v; s += v * v; }
    s = block_sum256(s, S.red);
    const float rs = rsqrtf(s * (1.f / D) + EPS);
    for (int i = t; i < D; i += 256) { S.xn[i] = S.xr[i] * rs * P.g_ffn[i]; if (far(bf2f(((const bf16_t*)(ws + M_XN))[(size_t)tok * D + i]), S.xn[i], 0.02f, 0.01f)) chk_fail(P, 0); }
    __syncthreads();
    for (int c = wv; c < 36; c += 4) {
      float a = 0.f;
      if (c < 4) { for (int i = lane; i < D; i += 64) a = fmaf(S.xn[i], P.w_rg[i * 4 + c], a); }
      else { for (int i = lane; i < D; i += 64) a = fmaf(S.xn[i], P.w_re[i * 32 + (c - 4)], a); }
      a = wave_sum(a);
      if (lane == 0) S.logit[c] = a + (c < 4 ? P.b_rg[c] : P.b_re[c - 4]);
    }
    __syncthreads();
    const int* asg = (const int*)(ws + M_ASG) + (size_t)tok * 4;
    if (t == 0) {
      const int gs = asg[0] >> 3;
      float gm = S.logit[0]; for (int i = 1; i < 4; ++i) gm = fmaxf(gm, S.logit[i]);
      if (S.logit[gs] < gm - 1e-4f || (asg[2] >> 3) != gs) chk_fail(P, 1);
      const float* el = S.logit + 4 + gs * 8;
      const int e1 = asg[0] & 7, e2 = asg[2] & 7;
      int nb = 0; for (int i = 0; i < 8; ++i) if (i != e1 && i != e2 && el[i] > fminf(el[e1], el[e2]) + 1e-4f) ++nb;
      if (nb || e1 == e2 || el[e1] < el[e2] - 1e-4f) chk_fail(P, 2);
      float se = 0.f; for (int i = 0; i < 4; ++i) se += expf(S.logit[i] - gm);
      const float pg = expf(S.logit[gs] - gm) / se;
      const float a = expf(el[e1] - el[e1]), b2 = expf(el[e2] - el[e1]);
      S.gatew[0] = pg * a / (a + b2); S.gatew[1] = pg * b2 / (a + b2);
      S.expert[0] = asg[0]; S.expert[1] = asg[2];
      if (far(((const float*)(ws + M_WL))[(size_t)asg[0] * NR + asg[1]], S.gatew[0], 1e-4f, 1e-3f)) chk_fail(P, 3);
      if (far(((const float*)(ws + M_WL))[(size_t)asg[2] * NR + asg[3]], S.gatew[1], 1e-4f, 1e-3f)) chk_fail(P, 3);
      if (((const int*)(ws + M_LIST))[(size_t)asg[0] * NR + asg[1]] != tok || ((const int*)(ws + M_LIST))[(size_t)asg[2] * NR + asg[3]] != tok) chk_fail(P, 4);
    }
    __syncthreads();
    for (int a = 0; a < 2; ++a) {
      const int e = S.expert[a];
      const int slot = sb[e] + asg[2 * a + 1];
      const float* wg = P.w_eg + (size_t)e * D * 256;
      const float* wu = P.w_eu + (size_t)e * D * 256;
      float g = 0.f, u = 0.f;
      for (int k = 0; k < D; ++k) { const float xv = S.xn[k]; g = fmaf(xv, wg[(size_t)k * 256 + t], g); u = fmaf(xv, wu[(size_t)k * 256 + t], u); }
      S.hm[t] = g / (1.f + expf(-g)) * u;
      if (far(bf2f(((const bf16_t*)(ws + M_HMID))[(size_t)slot * 256 + t]), S.hm[t], 0.03f, 0.03f)) chk_fail(P, 5);
      __syncthreads();
      const float* wd = P.w_ed + (size_t)e * 256 * D;
      const float gw = S.gatew[a];
      for (int i = 0; i < 4; ++i) {
        float y = 0.f;
        for (int j = 0; j < 256; ++j) y = fmaf(S.hm[j], wd[(size_t)j * D + t + 256 * i], y);
        if (far(bf2f(((const bf16_t*)(ws + M_YS))[(size_t)slot * 1024 + t + 256 * i]), gw * y, 0.02f, 0.03f)) chk_fail(P, 6);
      }
      __syncthreads();
    }
  }
}
#endif

__global__ void __launch_bounds__(NTHR, 2) mega(Params P) {
  cg::grid_group grid = cg::this_grid();
  extern __shared__ __attribute__((aligned(16))) unsigned char lds[];
  const int G = gridDim.x, bx = blockIdx.x;
  const int lane = threadIdx.x & 63, wv = threadIdx.x >> 6, gw = bx * NW + wv, NGW = G * NW;
  const int half = threadIdx.x >> 8, t2 = threadIdx.x & 255;
  constexpr int MTB = (NT + 255) / 256;
  if (threadIdx.x < 16) ((unsigned*)(lds + LDS_CTL))[threadIdx.x] = 0u;
  __syncthreads();
  if (P.use_cg) grid.sync();
  const XcdBarrier xb = xcd_barrier_post((unsigned*)(P.ws + O_BAR), (volatile LAS unsigned*)(lds + LDS_CTL));
  int* const slot = (int*)(lds + LDS_CTL + 16);
#define GSYNC() xcd_barrier(xb)
  p0_prologue(P, lds);
  GSYNC();
  { int mt, nt; for (int k = 0; p1_tile_map(bx, k, G, mt, nt); ++k) p1_inproj_tile(P, mt, nt, lds); }
  GSYNC();
  for (int t = gw; t < NT; t += NGW) p2a_token(P, t, lane);
  GSYNC();
  for (int t = bx; t < MTB * (768 / 256 + 1024 / 256); t += G) { if (t < MTB * 3) p2b_q_tile(P, t, lds); else p2b_kv_tile(P, t - MTB * 3, lds); }
  GSYNC();
#if SELFCHECK
  chk_stageA(P, lds);
  GSYNC();
#endif
  for (int it = next_item(P, 0, slot); it < 512; it = next_item(P, 0, slot)) mla_item(P, it, lds);
#if SELFCHECK
  GSYNC();
  for (int sidx = bx; sidx < 384; sidx += G) nv_mla<true>(P, sidx < 8 ? (sidx < 4 ? sidx * 37 : NR - 1 - (sidx - 4) * 4096) : (int)(hash_u(sidx * 2654435761u + 11u) % NR), lds);
#endif
  GSYNC();
  for (int q = next_item(P, 1, slot); 2 * q < S1_ITEMS; q = next_item(P, 1, slot)) s1_item(P, 2 * q + (wv >> 2));
  GSYNC();
  { unsigned* wl = (unsigned*)lds + wv * 64; for (int r = gw; r < NR; r += NGW) s2_dispatch(P, r, lane, wl); }
  GSYNC();
  for (int it = next_item(P, 2, slot); it < 512; it = next_item(P, 2, slot)) dsa_item(P, it, lds);
  GSYNC();
#if SELFCHECK
  for (int sidx = bx; sidx < 384; sidx += G) nv_dsa_check(P, sidx < 8 ? (sidx < 4 ? 200 + sidx * 37 : NR - 1 - (sidx - 4) * 4096) : (int)(hash_u(sidx * 2246822519u + 5u) % NR), lds);
  GSYNC();
#endif
  { int mt, nt; for (int k = 0; p78_tile_map(bx, k, G, mt, nt); ++k) p7_merge_tile(P, mt, nt, lds); }
  GSYNC();
#if SELFCHECK
  chk_stageB(P, lds);
  GSYNC();
#endif
  { int mt, nt; for (int k = 0; p78_tile_map(bx, k, G, mt, nt); ++k) p8_out_tile(P, mt, nt, lds); }
  GSYNC();
#if SELFCHECK
  chk_stageC(P, lds);
  GSYNC();
#endif
  { int lane9 = threadIdx.x & 63; asm volatile("" : "+v"(lane9)); for (int t = gw; t < NR; t += NGW) p9_router_token(P, t, lane9); }
  { float* scr = (float*)lds + half * (64 * 65 + 32);
    for (int k = bx; 2 * k < 32 * 128; k += G) p9_conv_gu_item(P, 2 * k + half, scr, t2, true);
    for (int k = bx; 2 * k < 32 * 64; k += G) { const int it = 2 * k + half, e = it >> 6; transpose_item(P.w_ed + (size_t)e * 256 * 1024, 1024, 256, (bf16_t*)(P.ws + M_WD) + (size_t)e * 1024 * 256, MapOff{0}, it & 63, scr, t2, true); } }
  GSYNC();
  {
    int e, rt, cnt, bs;
    const int ntile = moe_tile_lookup(P, 0, e, rt, cnt, bs);
    for (int q = next_item(P, 3, slot); q < ntile * 6; q = next_item(P, 3, slot)) {
      if (q < ntile * 2) { moe_tile_lookup(P, q >> 1, e, rt, cnt, bs); p10_gu_tile(P, q >> 1, e, rt, cnt, bs, q & 1, lds); }
      else { const int q2 = q - ntile * 2; moe_tile_lookup(P, q2 >> 2, e, rt, cnt, bs); p11_down_tile(P, q2 >> 2, e, rt, cnt, bs, q2 & 3, lds); }
    }
    GSYNC();
#if SELFCHECK
    chk_moe(P, lds);
    GSYNC();
#endif
    int* sbase = (int*)lds;
    __syncthreads();
    if (threadIdx.x == 0) { const unsigned* c = (const unsigned*)(P.ws + O_CTR) + 32; int a = 0; for (int i = 0; i < 32; ++i) { sbase[i] = a; a += (((int)c[i] + 255) >> 8) * 256; } }
    __syncthreads();
    int lane12 = threadIdx.x & 63; asm volatile("" : "+v"(lane12));
    for (int t = gw; t < NR; t += NGW) p12_final_token(P, t, lane12, sbase);
  }
#if SELFCHECK
  GSYNC();
  {
    const unsigned* chk = (const unsigned*)(P.ws + O_CHK);
    float f = 1.f;
    for (int k = 15; k >= 0; --k) if (chk[k]) f = 1.f + 0.25f * (float)(1 << k);
    if (f != 1.f) for (size_t i = (size_t)bx * NTHR + threadIdx.x; i < (size_t)NR * D; i += (size_t)G * NTHR) P.out[i] *= f;
  }
#endif
}
}

extern "C" void kernel_launch(void* const* d_in, const int* in_sizes, int n_in, void* d_out, int out_size, void* d_ws, size_t ws_size, hipStream_t stream) {
  using namespace mk;
  static int grid_blocks = 0;
  if (!grid_blocks) {
    int dev = 0, cus = 0, per_cu = 0;
    (void)hipGetDevice(&dev);
    (void)hipDeviceGetAttribute(&cus, hipDeviceAttributeMultiprocessorCount, dev);
    (void)hipFuncSetAttribute((const void*)mega, hipFuncAttributeMaxDynamicSharedMemorySize, LDS_BYTES);
    (void)hipOccupancyMaxActiveBlocksPerMultiprocessor(&per_cu, mega, NTHR, LDS_BYTES);
    per_cu = 1;
    grid_blocks = cus * per_cu;
    if (ws_size < WS_END) fprintf(stderr, "workspace too small: need %zu have %zu\n", (size_t)WS_END, ws_size);
  }
  Params p{};
  const float** pp = (const float**)&p;
  for (int i = 0; i < 21; ++i) pp[i] = (const float*)d_in[i];
  p.out = (float*)d_out; p.ws = (unsigned char*)d_ws;
  (void)hipMemsetAsync((unsigned char*)d_ws + O_CHK, 0, O_WR - O_CHK, stream);
  void* args[] = {&p};
  hipError_t e = hipLaunchCooperativeKernel((void*)mega, dim3(grid_blocks), dim3(NTHR), args, LDS_BYTES, stream);
  if (e != hipSuccess) fprintf(stderr, "cooperative launch failed: %s (grid %d)\n", hipGetErrorString(e), grid_blocks);
}
```

```cpp
#include <hip/hip_runtime.h>
#include <hip/hip_cooperative_groups.h>
#include <cstdio>
#include <math.h>
#include <stdint.h>
namespace cg = cooperative_groups;

namespace mk {
typedef unsigned short bf16_t;
typedef short bf16x8 __attribute__((ext_vector_type(8)));
typedef float f32x16 __attribute__((ext_vector_type(16)));
typedef float f32x4 __attribute__((ext_vector_type(4)));
typedef unsigned u32x4 __attribute__((ext_vector_type(4)));
typedef unsigned u32x2 __attribute__((ext_vector_type(2)));

constexpr int D = 1024, NB = 4, SEQ = 4096, NMETA = 16, L = SEQ + NMETA, NT = NB * L  , NR = NB * SEQ  ;
constexpr int INC = 4584, LP = 4128;
constexpr int S_CQ = 0, S_CKV = 256, S_KR = 384, S_WI = 416, S_KI = 424;
constexpr float EPS = 1e-6f;
constexpr float LOG2E = 1.4426950408889634f;
constexpr int NTHR = 512, NW = NTHR / 64;

#define DI __device__ __forceinline__
#ifndef REP_P0
#define REP_P0 1
#endif
#ifndef REP_P1
#define REP_P1 1
#endif
#ifndef REP_MLA
#define REP_MLA 1
#endif
#ifndef REP_S1
#define REP_S1 1
#endif
#ifndef REP_S2
#define REP_S2 1
#endif
#ifndef REP_DSA
#define REP_DSA 1
#endif
#ifndef REP_P7
#define REP_P7 1
#endif
#ifndef REP_P8
#define REP_P8 1
#endif
#ifndef REP_MOE
#define REP_MOE 1
#endif
#ifndef REP_P2
#define REP_P2 1
#endif
#ifndef REP_CONV
#define REP_CONV 1
#endif
#ifndef SELFCHECK
#define SELFCHECK 0
#endif

typedef __bf16 bf2_t __attribute__((ext_vector_type(2)));
DI bf16_t f2bf(float x) { const __bf16 b = (__bf16)x; return __builtin_bit_cast(bf16_t, b); }
DI float bf2f(bf16_t v) { return __uint_as_float(((unsigned)v) << 16); }
DI unsigned pk2(float lo, float hi) { const bf2_t v = {(__bf16)lo, (__bf16)hi}; return __builtin_bit_cast(unsigned, v); }
#define dpp_i(v, ctrl) __builtin_amdgcn_update_dpp(0, (v), (ctrl), 0xf, 0xf, true)
DI float wave_sum(float v) {
  v += __int_as_float(dpp_i(__float_as_int(v), 0xB1));
  v += __int_as_float(dpp_i(__float_as_int(v), 0x4E));
  v += __int_as_float(dpp_i(__float_as_int(v), 0x141));
  v += __int_as_float(dpp_i(__float_as_int(v), 0x140));
  const int b = __float_as_int(v);
  return (__int_as_float(__builtin_amdgcn_readlane(b, 0)) + __int_as_float(__builtin_amdgcn_readlane(b, 16))) +
         (__int_as_float(__builtin_amdgcn_readlane(b, 32)) + __int_as_float(__builtin_amdgcn_readlane(b, 48)));
}
DI int wave_sumi(int v) {
  v += dpp_i(v, 0xB1); v += dpp_i(v, 0x4E); v += dpp_i(v, 0x141); v += dpp_i(v, 0x140);
  return (__builtin_amdgcn_readlane(v, 0) + __builtin_amdgcn_readlane(v, 16)) + (__builtin_amdgcn_readlane(v, 32) + __builtin_amdgcn_readlane(v, 48));
}
DI float block_sum256(float v, float* red) {
  v = wave_sum(v);
  __syncthreads();
  if ((threadIdx.x & 63) == 0) red[threadIdx.x >> 6] = v;
  __syncthreads();
  return red[0] + red[1] + red[2] + red[3];
}
DI int block_sumi256(int v, int* red) {
#pragma unroll
  for (int o = 1; o < 64; o <<= 1) v += __shfl_xor(v, o);
  __syncthreads();
  if ((threadIdx.x & 63) == 0) red[threadIdx.x >> 6] = v;
  __syncthreads();
  return red[0] + red[1] + red[2] + red[3];
}
DI int n_adm(int p) { return p < NMETA ? NMETA : NMETA + 64 * (1 + (p - NMETA) / 64); }


#if SELFCHECK
DI unsigned hash_u(unsigned x) { x ^= x >> 16; x *= 0x7feb352du; x ^= x >> 15; x *= 0x846ca68bu; x ^= x >> 16; return x; }
DI bool far(float got, float ref, float atol, float rtol) { const float d = fabsf(got - ref); return !(d <= atol + rtol * fabsf(ref)); }
#endif
struct Params {
  const float *x, *meta, *g_mix, *w_in, *g_cq, *g_ckv, *w_uq, *w_ukv, *w_bra, *w_brb, *w_o, *rel_bias, *g_ffn, *w_rg, *b_rg, *w_re, *b_re, *w_eg, *w_eu, *w_ed, *g_fin;
  float* out; unsigned char* ws;
  int use_cg; int pad;
};

constexpr size_t al(size_t x) { return (x + 255) & ~(size_t)255; }
constexpr size_t O_QB = 0;
constexpr size_t O_KB = al(O_QB + (size_t)NT * 512 * 2);
constexpr size_t O_VBT = al(O_KB + (size_t)NT * 512 * 2);
constexpr size_t O_QI = al(O_VBT + (size_t)NB * 8 * 64 * LP * 2);
constexpr size_t O_KI = al(O_QI + (size_t)NT * 512 * 2);
constexpr size_t O_WI = al(O_KI + (size_t)NT * 64 * 2);
constexpr size_t O_SMALL = al(O_WI + (size_t)NT * 8 * 4);
constexpr size_t O_CQN = al(O_SMALL + (size_t)NT * 512 * 4);
constexpr size_t O_CKVN = al(O_CQN + (size_t)NT * 256 * 2);
constexpr size_t O_QA = al(O_CKVN + (size_t)NT * 128 * 2);
constexpr size_t O_KMLA = al(O_QA + (size_t)NT * 768 * 2);
constexpr size_t O_VT = al(O_KMLA + (size_t)NB * 8 * LP * 96 * 2);
constexpr size_t R_END = al(O_VT + (size_t)NB * 8 * 64 * LP * 2 + (size_t)NT * 1536 * 2);
constexpr size_t O_HN = O_QA;
constexpr size_t O_OA = O_SMALL;
constexpr int MW = 132;
constexpr size_t O_MASK = al(O_OA + (size_t)NR * 512 * 2);
constexpr size_t O_SCORES = al(O_MASK + (size_t)NR * MW * 4);
constexpr size_t SCORES_PER_BATCH = (size_t)8192 * 1088;
constexpr size_t O_OB = O_SCORES;
constexpr size_t O_Y = al(O_OB + (size_t)NR * 512 * 2);
static_assert(O_SCORES + (size_t)NB * SCORES_PER_BATCH * 2 + 65536 <= R_END, "scores must fit region R");
constexpr size_t O_WIN = R_END;
constexpr size_t O_WG = al(O_WIN + (size_t)2560 * 1024 * 2);
constexpr size_t O_WUQ = al(O_WG + (size_t)2048 * 1024 * 2);
constexpr size_t O_WUKV = al(O_WUQ + (size_t)768 * 256 * 2);
constexpr size_t O_WBRA = al(O_WUKV + (size_t)1024 * 128 * 2);
constexpr size_t O_WBRB = al(O_WBRA + (size_t)1024 * 512 * 2);
constexpr size_t O_WO = al(O_WBRB + (size_t)1024 * 512 * 2);
constexpr size_t O_ROPE = al(O_WO + (size_t)1024 * 1024 * 2);
constexpr size_t O_CHK = al(O_ROPE + (size_t)L * 32 * 4);
constexpr size_t O_CTR = al(O_CHK + 256);
constexpr size_t O_BAR = al(O_CTR + 256);
constexpr size_t O_DEP = al(O_BAR + 3456 * 4);
constexpr size_t O_WR = al(O_DEP + 512 * 4);
constexpr size_t WS_END = al(O_WR + (size_t)36 * 1024 * 4);
constexpr int SLOTS = 2 * NR + 32 * 256;
constexpr size_t M_XN = 0;
constexpr size_t M_HMID = al(M_XN + (size_t)NR * 1024 * 2);
constexpr size_t M_YS = al(M_HMID + (size_t)SLOTS * 256 * 2);
constexpr size_t M_WGU = al(M_YS + (size_t)SLOTS * 1024 * 2);
constexpr size_t M_WD = al(M_WGU + (size_t)32 * 512 * 1024 * 2);
constexpr size_t M_LIST = al(M_WD + (size_t)32 * 1024 * 256 * 2);
constexpr size_t M_WL = al(M_LIST + (size_t)32 * NR * 4);
constexpr size_t M_ASG = al(M_WL + (size_t)32 * NR * 4);
constexpr size_t M_END = al(M_ASG + (size_t)NR * 16);
static_assert(M_END <= O_WIN, "MoE overlay must stay below the weights");
static_assert(WS_END <= (size_t)256 * 1024 * 1024, "workspace budget");
#if SELFCHECK
DI void chk_fail(const Params& P, int k) { atomicAdd((unsigned*)(P.ws + O_CHK) + k, 1u); }
#endif
constexpr int GX_A = 256 * 128, GX_B = 256 * 128, GX_STAGE = GX_A + GX_B;
constexpr int LDS_CTL = 2 * GX_STAGE;
constexpr int LDS_BYTES = LDS_CTL + 64;


#define XB_TMO      128
#define XB_XCNT(j)  (256  + 64 * (j))
#define XB_XSUB(j)  (1280 + 64 * (j))
#define XB_XGEN(j)  (2304 + 64 * (j))
#define XB_TOP      3328
#define XB_TOPGEN   3392
#define XCD_BAR_WORDS 3456
#define XB_SPIN_CAP (1u << 18)
#define LAS __attribute__((address_space(3)))
DI unsigned xb_ld(unsigned* p)              { return __hip_atomic_load(p, __ATOMIC_RELAXED, __HIP_MEMORY_SCOPE_AGENT); }
DI unsigned xb_add(unsigned* p, unsigned v) { return __hip_atomic_fetch_add(p, v, __ATOMIC_RELAXED, __HIP_MEMORY_SCOPE_AGENT); }
DI unsigned xb_xcc_id() { return (unsigned)__builtin_amdgcn_s_getreg((3 << 11) | 20) & 0xFu; }
#define XB_SPIN(cond, bar) do { unsigned _sp = 0; while (cond) { __builtin_amdgcn_s_sleep(1); \
    if ((++_sp & 255u) == 0u) { if (xb_ld(&(bar)[XB_TMO])) break; if (_sp > XB_SPIN_CAP) { atomicAdd(&(bar)[XB_TMO], 1u); break; } } } } while (0)
struct XcdBarrier { unsigned* bar; unsigned x; volatile LAS unsigned* st; };
DI XcdBarrier xcd_barrier_post(unsigned* bar, volatile LAS unsigned* st) {
  XcdBarrier b; b.bar = bar; b.x = xb_xcc_id(); b.st = st;
  if (threadIdx.x == 0) (void)xb_add(&bar[XB_XCNT(b.x)], 1u);
  return b;
}
DI void xcd_barrier_complete(unsigned* bar, unsigned x, unsigned& nloc, unsigned& nx) {
  const unsigned G = gridDim.x * gridDim.y * gridDim.z;
  unsigned sum, cnt, mine, sp = 0u;
  for (;;) {
    sum = 0u; cnt = 0u; mine = 0u;
#pragma unroll
    for (unsigned j = 0; j < 16; ++j) { const unsigned c = xb_ld(&bar[XB_XCNT(j)]); sum += c; cnt += (c > 0u) ? 1u : 0u; mine = (j == x) ? c : mine; }
    if (sum == G) break;
    __builtin_amdgcn_s_sleep(1);
    if ((++sp & 255u) == 0u) { if (xb_ld(&bar[XB_TMO])) break; if (sp > XB_SPIN_CAP) { atomicAdd(&bar[XB_TMO], 1u); break; } }
  }
  nloc = mine > 0u ? mine : 1u; nx = cnt > 0u ? cnt : 1u;
}
DI void xcd_barrier(const XcdBarrier& b) {
  asm volatile("s_waitcnt vmcnt(0)" ::: "memory");
  __syncthreads();
  if (threadIdx.x == 0) {
    unsigned* bar = b.bar;
    __builtin_amdgcn_s_waitcnt(0);
    unsigned nloc = b.st[0], nx = b.st[1];
    if (nloc == 0u) { xcd_barrier_complete(bar, b.x, nloc, nx); b.st[0] = nloc; b.st[1] = nx; }
    const unsigned old = xb_add(&bar[XB_XSUB(b.x)], 1u);
    const unsigned gen = old / nloc;
    if (old + 1u == (gen + 1u) * nloc) {
      __builtin_amdgcn_fence(__ATOMIC_RELEASE, "agent");
      asm volatile("s_waitcnt vmcnt(0)" ::: "memory");
      const unsigned og = xb_add(&bar[XB_TOP], 1u);
      const unsigned tg = og / nx;
      if (og + 1u == (tg + 1u) * nx) xb_add(&bar[XB_TOPGEN], 1u);
      else XB_SPIN(xb_ld(&bar[XB_TOPGEN]) == tg, bar);
      __builtin_amdgcn_fence(__ATOMIC_ACQUIRE, "agent");
      xb_add(&bar[XB_XGEN(b.x)], 1u);
      asm volatile("s_waitcnt vmcnt(0)" ::: "memory");
    } else {
      XB_SPIN(xb_ld(&bar[XB_XGEN(b.x)]) == gen, bar);
      __builtin_amdgcn_fence(__ATOMIC_ACQUIRE, "agent");
      asm volatile("s_waitcnt vmcnt(0)" ::: "memory");
    }
  }
  __syncthreads();
}

DI void p0_norm_row(const Params& P, int t, bf16_t* hn, int lane) {
  const int b = t / L, p = t % L;
  const float* row = p < NMETA ? P.meta + (size_t)p * D : P.x + ((size_t)b * SEQ + (p - NMETA)) * D;
  f32x4 v[4]; float s = 0.f;
#pragma unroll
  for (int i = 0; i < 4; ++i) { v[i] = *(const f32x4*)(row + 256 * i + 4 * lane); s += v[i][0] * v[i][0] + v[i][1] * v[i][1] + v[i][2] * v[i][2] + v[i][3] * v[i][3]; }
  s = wave_sum(s);
  const float rs = rsqrtf(s * (1.f / D) + EPS);
#pragma unroll
  for (int i = 0; i < 4; ++i) {
    const f32x4 g = *(const f32x4*)(P.g_mix + 256 * i + 4 * lane);
    u32x2 o; o[0] = pk2(v[i][0] * rs * g[0], v[i][1] * rs * g[1]); o[1] = pk2(v[i][2] * rs * g[2], v[i][3] * rs * g[3]);
    *(u32x2*)(hn + (size_t)t * D + 256 * i + 4 * lane) = o;
  }
}
template <class F>
DI void transpose_item(const float* src, int ldsrc, int K, bf16_t* dst, F map, int item, float* scr  , int tid, bool valid) {
  const int nkb = K / 64, kb = item % nkb, nb = item / nkb, k0 = kb * 64, n0 = nb * 64;
  if (valid) {
    const int n = tid & 63; const int col = map(n0 + n);
#pragma unroll 4
    for (int i = 0; i < 16; ++i) { const int k = (tid >> 6) + 4 * i; scr[k * 65 + n] = col >= 0 ? src[(size_t)(k0 + k) * ldsrc + col] : 0.f; }
  }
  __syncthreads();
  if (valid) {
    const int kq = tid & 7;
#pragma unroll
    for (int i = 0; i < 2; ++i) {
      const int n = (tid >> 3) + 32 * i;
      const float* s = scr + (kq * 8) * 65 + n;
      u32x4 o; o[0] = pk2(s[0], s[65]); o[1] = pk2(s[2 * 65], s[3 * 65]); o[2] = pk2(s[4 * 65], s[5 * 65]); o[3] = pk2(s[6 * 65], s[7 * 65]);
      *(u32x4*)(dst + (size_t)(n0 + n) * K + k0 + kq * 8) = o;
    }
  }
  __syncthreads();
}
struct MapIn {
  DI int operator()(int n) const {
    if (n < 416) return n;
    if (n < 424) return 2528 + (n - 416);
    if (n < 488) return 2464 + (n - 424);
    if (n < 512) return -1;
    return 416 + (n - 512);
  }
};
struct MapOff { int off; DI int operator()(int n) const { return off + n; } };
struct MapUkv { DI int operator()(int n) const { const int m = n & 511; return (m >> 6) * 128 + (n >> 9) * 64 + (m & 63); } };

DI void p0_prologue(const Params& P, unsigned char* lds) {
  unsigned char* ws = P.ws;
  const int tid = threadIdx.x, lane = tid & 63, wv = tid >> 6;
  const int gw = blockIdx.x * NW + wv, ngw = gridDim.x * NW;
  bf16_t* hn = (bf16_t*)(P.ws + O_HN);
  for (int t = gw; t < NT; t += ngw) p0_norm_row(P, t, hn, lane);
  float* rope = (float*)(ws + O_ROPE);
  for (int i = blockIdx.x * NTHR + tid; i < L * 16; i += gridDim.x * NTHR) {
    const int p = i >> 4, j = i & 15;
    const float inv = powf(10000.f, -(float)j / 16.f);
    const float ang = (float)p * inv;
    float sn, cs; sincosf(ang, &sn, &cs);
    rope[p * 32 + j] = cs; rope[p * 32 + 16 + j] = sn;
  }
  {
    bf16_t* vbt = (bf16_t*)(ws + O_VBT); bf16_t* vt = (bf16_t*)(ws + O_VT);
    for (int i = blockIdx.x * NTHR + tid; i < NB * 8 * 64 * (LP - L); i += gridDim.x * NTHR) {
      const int r = i / (LP - L), c = L + i % (LP - L);
      vbt[(size_t)r * LP + c] = 0; vt[(size_t)r * LP + c] = 0;
    }
  }
  {
    float* wr = (float*)(ws + O_WR);
    for (int i = blockIdx.x * NTHR + tid; i < 36 * 1024; i += gridDim.x * NTHR) {
      const int c = i >> 10, k = i & 1023;
      wr[i] = c < 4 ? P.w_rg[k * 4 + c] : P.w_re[k * 32 + (c - 4)];
    }
  }
  const int half = tid >> 8, t2 = tid & 255;
  float* scr = (float*)lds + half * (64 * 65 + 32);
  constexpr int I_IN = (1024 / 64) * (2560 / 64), I_G = (1024 / 64) * (2048 / 64), I_UQ = (256 / 64) * (768 / 64), I_UKV = (128 / 64) * (1024 / 64),
                I_BR = (512 / 64) * (1024 / 64), I_O = (1024 / 64) * (1024 / 64);
  constexpr int NIT = I_IN + I_G + I_UQ + I_UKV + 2 * I_BR + I_O;
  for (int it2 = blockIdx.x; 2 * it2 < NIT; it2 += gridDim.x) {
    int r = 2 * it2 + half; const bool valid = r < NIT; if (!valid) r = 0;
    if (r < I_IN) transpose_item(P.w_in, INC, 1024, (bf16_t*)(ws + O_WIN), MapIn(), r, scr, t2, valid);
    else if ((r -= I_IN) < I_G) transpose_item(P.w_in, INC, 1024, (bf16_t*)(ws + O_WG), MapOff{2536}, r, scr, t2, valid);
    else if ((r -= I_G) < I_UQ) transpose_item(P.w_uq, 768, 256, (bf16_t*)(ws + O_WUQ), MapOff{0}, r, scr, t2, valid);
    else if ((r -= I_UQ) < I_UKV) transpose_item(P.w_ukv, 1024, 128, (bf16_t*)(ws + O_WUKV), MapUkv{}, r, scr, t2, valid);
    else if ((r -= I_UKV) < I_BR) transpose_item(P.w_bra, 1024, 512, (bf16_t*)(ws + O_WBRA), MapOff{0}, r, scr, t2, valid);
    else if ((r -= I_BR) < I_BR) transpose_item(P.w_brb, 1024, 512, (bf16_t*)(ws + O_WBRB), MapOff{0}, r, scr, t2, valid);
    else { r -= I_BR; transpose_item(P.w_o, 1024, 1024, (bf16_t*)(ws + O_WO), MapOff{0}, r, scr, t2, valid); }
  }
}

struct TilePtrs { const bf16_t* A; const bf16_t* B; unsigned a[4], b[4]; };
DI void glds16(const unsigned char* g, unsigned char* l) { __builtin_amdgcn_global_load_lds((const unsigned*)g, (unsigned*)l, 16, 0, 0); }
template <bool SWAP>
DI void gemm_kloop(f32x16 (&acc)[4][2], const TilePtrs& tp, int K, unsigned char* lds) {
  const int tid = threadIdx.x, lane = tid & 63, w = __builtin_amdgcn_readfirstlane(tid >> 6), wr = w >> 2, wc = w & 3;
  const int nt = K / 64;
  unsigned char* const lw = lds + w * 1024;
  const int swz = (lane >> 1) & 7, hh = lane >> 5;
  const unsigned char* const ar = lds + (wr * 64 + (lane & 31)) * 128;
  const unsigned char* const br = lds + GX_A + (wc * 32 + (lane & 31)) * 128;
  int coff[4];
#pragma unroll
  for (int kk = 0; kk < 4; ++kk) coff[kk] = ((2 * kk + hh) ^ swz) * 16;
  bf16x8 At[2][4], B0[4], B1[4];
  unsigned oa[4], ob[4];
#pragma unroll
  for (int j = 0; j < 4; ++j) { oa[j] = tp.a[j]; ob[j] = tp.b[j]; }
#define HT_(BO_, H_) ((BO_) + (H_) * 16384)
#define STG_A(BO_, H_, kt) do { const unsigned char* g_ = (const unsigned char*)tp.A + (kt) * 128; glds16(g_ + oa[2 * (H_)], lw + HT_(BO_, H_)); glds16(g_ + oa[2 * (H_) + 1], lw + HT_(BO_, H_) + 8192); } while (0)
#define STG_B(BO_, H_, kt) do { const unsigned char* g_ = (const unsigned char*)tp.B + (kt) * 128; glds16(g_ + ob[2 * (H_)], lw + GX_A + HT_(BO_, H_)); glds16(g_ + ob[2 * (H_) + 1], lw + GX_A + HT_(BO_, H_) + 8192); } while (0)
#define PIN_OFFS() do { _Pragma("unroll") for (int j_ = 0; j_ < 4; ++j_) { asm volatile("" : "+v"(oa[j_])); asm volatile("" : "+v"(ob[j_])); } } while (0)
#define LDA_(BO_, H_) do { _Pragma("unroll") for (int m_ = 0; m_ < 2; ++m_) _Pragma("unroll") for (int k_ = 0; k_ < 4; ++k_) At[m_][k_] = *(const bf16x8*)(ar + HT_(BO_, H_) + m_ * 4096 + coff[k_]); } while (0)
#define LDB_(Bx, BO_, H_) do { _Pragma("unroll") for (int k_ = 0; k_ < 4; ++k_) Bx[k_] = *(const bf16x8*)(br + HT_(BO_, H_) + coff[k_]); } while (0)
#define MMA_(ai, bj, Bx) do { __builtin_amdgcn_s_setprio(1); _Pragma("unroll") for (int k_ = 0; k_ < 4; ++k_) _Pragma("unroll") for (int m_ = 0; m_ < 2; ++m_) \
    acc[2 * (ai) + m_][bj] = SWAP ? __builtin_amdgcn_mfma_f32_32x32x16_bf16(Bx[k_], At[m_][k_], acc[2 * (ai) + m_][bj], 0, 0, 0) \
                                  : __builtin_amdgcn_mfma_f32_32x32x16_bf16(At[m_][k_], Bx[k_], acc[2 * (ai) + m_][bj], 0, 0, 0); __builtin_amdgcn_s_setprio(0); } while (0)
#define WAIT_V(n) asm volatile("s_waitcnt vmcnt(" #n ")" ::: "memory")
#define WAIT_L(n) asm volatile("s_waitcnt lgkmcnt(" #n ")" ::: "memory")
#define BAR_ __builtin_amdgcn_s_barrier()
#define SCHED_ __builtin_amdgcn_sched_barrier(0)
  WAIT_V(0);
  PIN_OFFS();
  STG_B(0, 0, 0); STG_A(0, 0, 0); STG_B(0, 1, 0); STG_A(0, 1, 0);
  if (wr == 1) BAR_;
  WAIT_V(4); BAR_;
  STG_B(GX_STAGE, 0, 1); STG_A(GX_STAGE, 0, 1); STG_B(GX_STAGE, 1, 1);
  WAIT_V(6); BAR_;
  int cur = 0;
#pragma unroll 1
  for (int t = 0; t < nt - 2; ++t) {
    asm volatile("" : "+s"(cur));
    PIN_OFFS();
    const int nxt = cur ^ GX_STAGE;
    LDB_(B0, cur, 0); SCHED_; LDA_(cur, 0); STG_A(nxt, 1, t + 1);
    WAIT_L(8); BAR_; WAIT_L(0); MMA_(0, 0, B0); BAR_; SCHED_;
    LDB_(B1, cur, 1); STG_B(cur, 0, t + 2);
    BAR_; WAIT_L(0); MMA_(0, 1, B1); BAR_;
    LDA_(cur, 1); STG_A(cur, 0, t + 2);
    BAR_; WAIT_L(0); MMA_(1, 0, B0); BAR_; SCHED_;
    STG_B(cur, 1, t + 2);
    WAIT_V(6); BAR_; MMA_(1, 1, B1); BAR_;
    cur = nxt;
  }
  { asm volatile("" : "+s"(cur));
    PIN_OFFS();
    const int nxt = cur ^ GX_STAGE;
    LDB_(B0, cur, 0); LDA_(cur, 0); STG_A(nxt, 1, nt - 1);
    BAR_; WAIT_L(0); MMA_(0, 0, B0); BAR_;
    LDB_(B1, cur, 1); BAR_; WAIT_L(0); MMA_(0, 1, B1); BAR_;
    LDA_(cur, 1); WAIT_V(4); BAR_; WAIT_L(0); MMA_(1, 0, B0); MMA_(1, 1, B1); BAR_;
    LDB_(B0, nxt, 0); LDA_(nxt, 0); WAIT_V(2); BAR_; WAIT_L(0); MMA_(0, 0, B0); BAR_;
    LDB_(B1, nxt, 1); WAIT_V(0); BAR_; WAIT_L(0); MMA_(0, 1, B1); BAR_;
    LDA_(nxt, 1); BAR_; WAIT_L(0); MMA_(1, 0, B0); MMA_(1, 1, B1); BAR_; }
  if (wr == 0) BAR_;
#undef HT_
#undef STG_A
#undef STG_B
#undef LDA_
#undef LDB_
#undef MMA_
#undef PIN_OFFS
}
DI void tile_rc(int i, int& row, int& chunk) { const int t = threadIdx.x; row = (i >> 1) * 128 + (i & 1) * 64 + (t >> 3); chunk = (t & 7) ^ ((row >> 1) & 7); }
DI int acc_row0(int wr, int mi) { return (mi >> 1) * 128 + wr * 64 + (mi & 1) * 32; }
DI int acc_col0(int wc, int ni) { return ni * 128 + wc * 32; }
DI u32x2 pk4(float a, float b, float c, float d) { u32x2 o; o[0] = pk2(a, b); o[1] = pk2(c, d); return o; }
DI void zero_acc(f32x16 (&acc)[4][2]) {
#pragma unroll
  for (int i = 0; i < 4; ++i)
#pragma unroll
    for (int j = 0; j < 2; ++j)
#pragma unroll
      for (int r = 0; r < 16; ++r) acc[i][j][r] = 0.f;
}
DI void set_ptrs(TilePtrs& tp, const bf16_t* A, int lda, int M, int m0, const bf16_t* Bt, int ldb, int N, int n0) {
#pragma unroll
  for (int i = 0; i < 4; ++i) {
    int row, kc; tile_rc(i, row, kc);
    int r = m0 + row; r = r < M ? r : M - 1;
    int c = n0 + row; c = c < N ? c : N - 1;
    tp.a[i] = ((unsigned)r * (unsigned)lda + kc * 8) * 2u;
    tp.b[i] = ((unsigned)c * (unsigned)ldb + kc * 8) * 2u;
  }
  tp.A = A; tp.B = Bt;
}

DI bool p1_tile_map(int bx, int k, int G, int& mt, int& nt) { const int t = bx + k * G; if (t >= 65 * 18) return false; mt = t / 18; nt = t % 18; return true; }
DI bool p78_tile_map(int bx, int k, int G, int& mt, int& nt) { const int t = bx + k * G; if (t >= 64 * 4) return false; mt = t >> 2; nt = t & 3; return true; }

DI void p1_inproj_tile(const Params& P, int mt, int nt, unsigned char* lds) {
  unsigned char* ws = P.ws;
  const int m0 = mt * 256, n0 = nt * 256;
  const bf16_t* hn = (const bf16_t*)(ws + O_HN);
  TilePtrs tp;
  if (n0 < 2560) set_ptrs(tp, hn, 1024, NT, m0, (const bf16_t*)(ws + O_WIN), 1024, 2560, n0);
  else set_ptrs(tp, hn, 1024, NT, m0, (const bf16_t*)(ws + O_WG), 1024, 2048, n0 - 2560);
  f32x16 acc[4][2]; zero_acc(acc);
  const int lane = threadIdx.x & 63, w = threadIdx.x >> 6, wr = w >> 2, wc = w & 3, hh = lane >> 5, lc = lane & 31;
  const int seg = n0 / 512, cb = n0 % 512;
  if (seg == 3) {
    gemm_kloop<false>(acc, tp, 1024, lds);
    bf16_t* vbt = (bf16_t*)(ws + O_VBT);
#pragma unroll
    for (int mi = 0; mi < 4; ++mi)
#pragma unroll
      for (int ni = 0; ni < 2; ++ni) {
        const int col = cb + acc_col0(wc, ni) + lc;
        const int rbase = m0 + acc_row0(wr, mi) + 4 * hh;
        const int h = col >> 6, d = col & 63;
#pragma unroll
        for (int g = 0; g < 4; ++g) {
          const int row = rbase + 8 * g;
          if (row < NT) {
            const int b = row / L, p = row % L;
            *(u32x2*)(vbt + ((size_t)(b * 8 + h) * 64 + d) * LP + p) = pk4(acc[mi][ni][4 * g], acc[mi][ni][4 * g + 1], acc[mi][ni][4 * g + 2], acc[mi][ni][4 * g + 3]);
          }
        }
      }
    return;
  }
  gemm_kloop<true>(acc, tp, 1024, lds);
  if (n0 >= 2560) {
    bf16_t* gates = (bf16_t*)P.out;
#pragma unroll
    for (int mi = 0; mi < 4; ++mi) {
      int row = m0 + acc_row0(wr, mi) + lc;
      asm volatile("" : "+v"(row));
      const int b = row / L, p = row - b * L;
      const bool ok = row < NT && p >= NMETA;
      bf16_t* gp = gates + (size_t)(row - NMETA * (b + 1)) * 2048 + (n0 - 2560) + 4 * hh;
#pragma unroll
      for (int ni = 0; ni < 2; ++ni)
#pragma unroll
        for (int g = 0; g < 4; ++g) {
          float sg[4];
#pragma unroll
          for (int e = 0; e < 4; ++e) sg[e] = __builtin_amdgcn_rcpf(1.f + __expf(-acc[mi][ni][4 * g + e]));
          if (ok) *(u32x2*)(gp + acc_col0(wc, ni) + 8 * g) = pk4(sg[0], sg[1], sg[2], sg[3]);
        }
    }
    return;
  }
#pragma unroll
  for (int mi = 0; mi < 4; ++mi) {
    int row = m0 + acc_row0(wr, mi) + lc;
    asm volatile("" : "+v"(row));
    const bool ok = row < NT;
    if (seg == 0) {
      float* sp = (float*)(ws + O_SMALL) + (size_t)row * 512 + cb + 4 * hh;
#pragma unroll
      for (int ni = 0; ni < 2; ++ni)
#pragma unroll
        for (int g = 0; g < 4; ++g) {
          f32x4 o; o[0] = acc[mi][ni][4 * g]; o[1] = acc[mi][ni][4 * g + 1]; o[2] = acc[mi][ni][4 * g + 2]; o[3] = acc[mi][ni][4 * g + 3];
          if (ok) *(f32x4*)(sp + acc_col0(wc, ni) + 8 * g) = o;
        }
    } else {
      bf16_t* dp = (bf16_t*)(ws + (seg == 1 ? O_QB : seg == 2 ? O_KB : O_QI)) + (size_t)row * 512 + cb + 4 * hh;
      const float sc = seg == 4 ? 0.125f : seg == 1 ? 0.125f * LOG2E : 1.f;
#pragma unroll
      for (int ni = 0; ni < 2; ++ni)
#pragma unroll
        for (int g = 0; g < 4; ++g)
          if (ok) *(u32x2*)(dp + acc_col0(wc, ni) + 8 * g) = pk4(acc[mi][ni][4 * g] * sc, acc[mi][ni][4 * g + 1] * sc, acc[mi][ni][4 * g + 2] * sc, acc[mi][ni][4 * g + 3] * sc);
    }
  }
}

DI void p2a_token(const Params& P, int t, int lane) {
  unsigned char* ws = P.ws;
  const float* sm = (const float*)(ws + O_SMALL) + (size_t)t * 512;
  const int b = t / L, p = t % L;
  {
    const f32x4 v = *(const f32x4*)(sm + S_CQ + 4 * lane);
    const float s = wave_sum(v[0] * v[0] + v[1] * v[1] + v[2] * v[2] + v[3] * v[3]);
    const float rs = rsqrtf(s * (1.f / 256) + EPS);
    const f32x4 g = *(const f32x4*)(P.g_cq + 4 * lane);
    u32x2 o; o[0] = pk2(v[0] * rs * g[0], v[1] * rs * g[1]); o[1] = pk2(v[2] * rs * g[2], v[3] * rs * g[3]);
    *(u32x2*)((bf16_t*)(ws + O_CQN) + (size_t)t * 256 + 4 * lane) = o;
  }
  {
    const float v0 = sm[S_CKV + 2 * lane], v1 = sm[S_CKV + 2 * lane + 1];
    const float s = wave_sum(v0 * v0 + v1 * v1);
    const float rs = rsqrtf(s * (1.f / 128) + EPS);
    *(unsigned*)((bf16_t*)(ws + O_CKVN) + (size_t)t * 128 + 2 * lane) = pk2(v0 * rs * P.g_ckv[2 * lane], v1 * rs * P.g_ckv[2 * lane + 1]);
  }
  {
    const float* rp = (const float*)(ws + O_ROPE) + p * 32;
    const int j = lane & 15;
    const float x1 = sm[S_KR + j], x2 = sm[S_KR + 16 + j], cs = rp[j], sn = rp[16 + j];
    const float o = (lane & 16) ? (x1 * sn + x2 * cs) : (x1 * cs - x2 * sn);
    bf16_t* km = (bf16_t*)(ws + O_KMLA);
    const bf16_t ob = f2bf(o);
    const int c = lane & 31;
#pragma unroll
    for (int hq = 0; hq < 4; ++hq) { const int h = hq + 4 * (lane >> 5); km[((size_t)(b * 8 + h) * LP + p) * 96 + 64 + c] = ob; }
  }
  ((bf16_t*)(ws + O_KI))[(size_t)t * 64 + lane] = f2bf(sm[S_KI + lane]);
  if (lane < 8) ((float*)(ws + O_WI))[(size_t)t * 8 + lane] = sm[S_WI + lane] * 0.35355339059327373f;
}

DI void p2b_q_tile(const Params& P, int tile, unsigned char* lds) {
  unsigned char* ws = P.ws;
  constexpr int NNT = 768 / 256;
  const int mt = tile / NNT, nt = tile % NNT, m0 = mt * 256, n0 = nt * 256;
  TilePtrs tp; set_ptrs(tp, (const bf16_t*)(ws + O_CQN), 256, NT, m0, (const bf16_t*)(ws + O_WUQ), 256, 768, n0);
  f32x16 acc[4][2]; zero_acc(acc);
  gemm_kloop<true>(acc, tp, 256, lds);
  const int lane = threadIdx.x & 63, w = threadIdx.x >> 6, wr = w >> 2, wc = w & 3, hh = lane >> 5, lc = lane & 31;
  const float qscale = 0.10206207261596575f * LOG2E;
  const float* rope = (const float*)(ws + O_ROPE);
  bf16_t* qa = (bf16_t*)(ws + O_QA);
#pragma unroll
  for (int mi = 0; mi < 4; ++mi) {
    int row = m0 + acc_row0(wr, mi) + lc;
    asm volatile("" : "+v"(row));
    const bool ok = row < NT;
    const int rowc = ok ? row : NT - 1, p = rowc % L;
#pragma unroll
    for (int ni = 0; ni < 2; ++ni) {
      const int c0 = n0 + acc_col0(wc, ni);
      const bool is_rope = ((c0 >> 5) % 3) == 2;
      float v[16];
#pragma unroll
      for (int r = 0; r < 16; ++r) v[r] = acc[mi][ni][r];
      if (is_rope) {
#pragma unroll
        for (int g = 0; g < 2; ++g) {
          const f32x4 cs = *(const f32x4*)(rope + p * 32 + 8 * g + 4 * hh), sn = *(const f32x4*)(rope + p * 32 + 16 + 8 * g + 4 * hh);
#pragma unroll
          for (int e = 0; e < 4; ++e) {
            const float lo = v[4 * g + e], hi = v[4 * (g + 2) + e];
            v[4 * g + e] = lo * cs[e] - hi * sn[e];
            v[4 * (g + 2) + e] = lo * sn[e] + hi * cs[e];
          }
        }
      }
#pragma unroll
      for (int g = 0; g < 4; ++g)
        if (ok) *(u32x2*)(qa + (size_t)row * 768 + c0 + 8 * g + 4 * hh) = pk4(v[4 * g] * qscale, v[4 * g + 1] * qscale, v[4 * g + 2] * qscale, v[4 * g + 3] * qscale);
    }
  }
}
DI void p2b_kv_tile(const Params& P, int tile, unsigned char* lds) {
  unsigned char* ws = P.ws;
  constexpr int NNT = 1024 / 256;
  const int mt = tile / NNT, nt = tile % NNT, m0 = mt * 256, n0 = nt * 256;
  TilePtrs tp; set_ptrs(tp, (const bf16_t*)(ws + O_CKVN), 128, NT, m0, (const bf16_t*)(ws + O_WUKV), 128, 1024, n0);
  f32x16 acc[4][2]; zero_acc(acc);
  const int lane = threadIdx.x & 63, w = threadIdx.x >> 6, wr = w >> 2, wc = w & 3, hh = lane >> 5, lc = lane & 31;
  if (nt < 2) {
    gemm_kloop<true>(acc, tp, 128, lds);
    bf16_t* km = (bf16_t*)(ws + O_KMLA);
#pragma unroll
    for (int mi = 0; mi < 4; ++mi) {
      int row = m0 + acc_row0(wr, mi) + lc;
      asm volatile("" : "+v"(row));
      const bool ok = row < NT;
      const int b = row / L, p = row % L;
#pragma unroll
      for (int ni = 0; ni < 2; ++ni) {
        const int cc = n0 + acc_col0(wc, ni), h = cc >> 6, c = (cc & 63) + 4 * hh;
        bf16_t* kp = km + ((size_t)(b * 8 + h) * LP + p) * 96 + c;
#pragma unroll
        for (int g = 0; g < 4; ++g)
          if (ok) *(u32x2*)(kp + 8 * g) = pk4(acc[mi][ni][4 * g], acc[mi][ni][4 * g + 1], acc[mi][ni][4 * g + 2], acc[mi][ni][4 * g + 3]);
      }
    }
  } else {
    gemm_kloop<false>(acc, tp, 128, lds);
    bf16_t* vt = (bf16_t*)(ws + O_VT);
#pragma unroll
    for (int mi = 0; mi < 4; ++mi)
#pragma unroll
      for (int ni = 0; ni < 2; ++ni) {
        const int cc = n0 - 512 + acc_col0(wc, ni) + lc, h = cc >> 6, d = cc & 63;
        const int rbase = m0 + acc_row0(wr, mi) + 4 * hh;
#pragma unroll
        for (int g = 0; g < 4; ++g) {
          const int row = rbase + 8 * g;
          if (row < NT) {
            const int b = row / L, p = row % L;
            *(u32x2*)(vt + ((size_t)(b * 8 + h) * 64 + d) * LP + p) = pk4(acc[mi][ni][4 * g], acc[mi][ni][4 * g + 1], acc[mi][ni][4 * g + 2], acc[mi][ni][4 * g + 3]);
          }
        }
      }
  }
}


DI int next_item(const Params& P, int ctr, int* slot) {
  __syncthreads();
  if (threadIdx.x == 0) *slot = (int)atomicAdd((unsigned*)(P.ws + O_CTR) + ctr, 1u);
  __syncthreads();
  return *slot;
}
DI float fast_exp2(float x) { return __builtin_amdgcn_exp2f(x); }
DI bf16x8 pack8(const f32x16& v, int s) {
  u32x4 p;
  p[0] = pk2(v[8 * s + 0], v[8 * s + 1]); p[1] = pk2(v[8 * s + 2], v[8 * s + 3]); p[2] = pk2(v[8 * s + 4], v[8 * s + 5]); p[3] = pk2(v[8 * s + 6], v[8 * s + 7]);
  return __builtin_bit_cast(bf16x8, p);
}

constexpr float MASKV = -3.0e38f;
constexpr float DEFER_THR = 6.0f;
DI float xmax32(float v) {
  const auto r = __builtin_amdgcn_permlane32_swap(__float_as_uint(v), __float_as_uint(v), false, false);
  return fmaxf(__uint_as_float(r[0]), __uint_as_float(r[1]));
}
DI void softmax_update1(f32x16& s, float& m, float mref, float& lsum, f32x16& o0, f32x16& o1) {
  float mx = s[0];
#pragma unroll
  for (int r = 1; r < 16; ++r) mx = fmaxf(mx, s[r]);
  mx = xmax32(mx);
  const bool have = m > -1e29f;
  const float shift = (have ? m : 0.f) - mref;
  const bool need = (mx - shift > DEFER_THR) || (!have && mx > -1e37f);
  if (__any(need || shift != 0.f)) {
    const float delta = need ? mx - shift : 0.f;
    const float alpha = (need && have) ? fast_exp2(-delta) : 1.f;
    m = need ? (have ? m : 0.f) + delta : m;
    const float sub = shift + delta;
#pragma unroll
    for (int r = 0; r < 16; ++r) { s[r] -= sub; o0[r] *= alpha; o1[r] *= alpha; }
    lsum *= alpha;
  }
#pragma unroll
  for (int r = 0; r < 16; ++r) s[r] = fast_exp2(s[r]);
  typedef float f32x2 __attribute__((ext_vector_type(2)));
  f32x2 ps = {0.f, 0.f};
#pragma unroll
  for (int r = 0; r < 16; r += 2) ps += (f32x2){s[r], s[r + 1]};
  lsum += ps[0] + ps[1];
}
DI void pv_subtile(const unsigned char* Vc, int vstr, const f32x16& p, f32x16& o0, f32x16& o1) {
#pragma unroll
  for (int s2 = 0; s2 < 2; ++s2) {
    const bf16x8 pb = pack8(p, s2);
    const u32x2 a0l = *(const u32x2*)(Vc + s2 * 32), a0h = *(const u32x2*)(Vc + s2 * 32 + 16);
    const u32x2 a1l = *(const u32x2*)(Vc + 32 * vstr + s2 * 32), a1h = *(const u32x2*)(Vc + 32 * vstr + s2 * 32 + 16);
    o0 = __builtin_amdgcn_mfma_f32_32x32x16_bf16(__builtin_bit_cast(bf16x8, (u32x4){a0l[0], a0l[1], a0h[0], a0h[1]}), pb, o0, 0, 0, 0);
    o1 = __builtin_amdgcn_mfma_f32_32x32x16_bf16(__builtin_bit_cast(bf16x8, (u32x4){a1l[0], a1l[1], a1h[0], a1h[1]}), pb, o1, 0, 0, 0);
  }
}
constexpr int MLA_KSTR = 208, MLA_VSTR = 136, MLA_KBYTES = 64 * MLA_KSTR, MLA_STAGE = MLA_KBYTES + 64 * MLA_VSTR;
DI void mla_stage(const unsigned char* cur, int s, int cw, int lq, int hh, const bf16x8 (&qf)[6], f32x16& o0, f32x16& o1, float& m, float& lsum) {
  if (s > cw) return;
  const bool full = s < cw;
  const float mref = m > -1e29f ? m : 0.f;
  f32x16 s0, s1;
#pragma unroll
  for (int r = 0; r < 16; ++r) { s0[r] = -mref; s1[r] = -mref; }
  const unsigned char* Kc = cur + lq * MLA_KSTR + hh * 16;
  {
    bf16x8 kf[6];
#pragma unroll
    for (int kk = 0; kk < 6; ++kk) kf[kk] = *(const bf16x8*)(Kc + kk * 32);
#pragma unroll
    for (int kk = 0; kk < 6; ++kk) s0 = __builtin_amdgcn_mfma_f32_32x32x16_bf16(kf[kk], qf[kk], s0, 0, 0, 0);
    __builtin_amdgcn_sched_group_barrier(0x100, 6, 0);
    __builtin_amdgcn_sched_group_barrier(0x008, 6, 0);
  }
  if (full) {
    bf16x8 kf[6];
#pragma unroll
    for (int kk = 0; kk < 6; ++kk) kf[kk] = *(const bf16x8*)(Kc + 32 * MLA_KSTR + kk * 32);
#pragma unroll
    for (int kk = 0; kk < 6; ++kk) s1 = __builtin_amdgcn_mfma_f32_32x32x16_bf16(kf[kk], qf[kk], s1, 0, 0, 0);
    __builtin_amdgcn_sched_group_barrier(0x100, 6, 0);
    __builtin_amdgcn_sched_group_barrier(0x008, 6, 0);
  } else {
#pragma unroll
    for (int r = 8; r < 16; ++r) s0[r] = MASKV;
  }
  const unsigned char* Vc = cur + MLA_KBYTES + lq * MLA_VSTR + hh * 8;
  softmax_update1(s0, m, mref, lsum, o0, o1);
  pv_subtile(Vc, MLA_VSTR, s0, o0, o1);
  if (full) {
    softmax_update1(s1, m, mref, lsum, o0, o1);
    pv_subtile(Vc + 64, MLA_VSTR, s1, o0, o1);
  }
}
DI void mla_item(const Params& P, int item, unsigned char* lds) {
  unsigned char* ws = P.ws;
  const int jq = 15 - item / 32, bh = item % 32, b = bh >> 3, h = bh & 7;
  const int c0 = 4 * jq + 1;
  const int tid = threadIdx.x, lane = tid & 63, w = __builtin_amdgcn_readfirstlane(tid >> 6), hh = lane >> 5, lq = lane & 31;
  const int cw = c0 + (w >> 1);
  const int pq = NMETA + 256 * jq + 32 * w + lq;
  const int tq = b * L + pq;
  bf16x8 qf[6];
  {
    const bf16_t* qrow = (const bf16_t*)(ws + O_QA) + (size_t)tq * 768 + h * 96 + hh * 8;
#pragma unroll
    for (int kk = 0; kk < 6; ++kk) qf[kk] = *(const bf16x8*)(qrow + kk * 16);
  }
  f32x16 o0, o1;
#pragma unroll
  for (int r = 0; r < 16; ++r) { o0[r] = 0.f; o1[r] = 0.f; }
  float m = -1e30f, lsum = 0.f;
  const int nst = c0 + 4;
  const bf16_t* kg = (const bf16_t*)(ws + O_KMLA) + (size_t)bh * LP * 96;
  const bf16_t* vg = (const bf16_t*)(ws + O_VT) + (size_t)bh * 64 * LP;
  unsigned kgo[2], klo[2], vgo, vlo;
  const bool k2 = tid < 256;
#pragma unroll
  for (int i = 0; i < 2; ++i) { int idx = tid + 512 * i; idx = idx < 768 ? idx : 767; const int row = idx / 12, c = idx % 12; kgo[i] = row * 96 + c * 8; klo[i] = row * MLA_KSTR + c * 16; }
  { const int d = tid >> 3, c = tid & 7; vgo = d * LP + c * 8; vlo = MLA_KBYTES + d * MLA_VSTR + c * 16; }
  u32x4 rkA[2], rvA, rkB[2], rvB;
#define MLA_LOAD(rk_, rv_, st) do { const bf16_t* kgs = kg + (size_t)(st) * 64 * 96; const bf16_t* vgs = vg + (st) * 64; \
    rk_[0] = *(const u32x4*)(kgs + kgo[0]); rk_[1] = *(const u32x4*)(kgs + kgo[1]); rv_ = *(const u32x4*)(vgs + vgo); } while (0)
#define MLA_WRITE(rk_, rv_, buf) do { unsigned char* nb_ = (buf); \
    *(u32x4*)(nb_ + klo[0]) = rk_[0]; if (k2) *(u32x4*)(nb_ + klo[1]) = rk_[1]; \
    *(u32x2*)(nb_ + vlo) = (u32x2){rv_[0], rv_[1]}; *(u32x2*)(nb_ + vlo + 8) = (u32x2){rv_[2], rv_[3]}; } while (0)
  unsigned char* buf0 = lds; unsigned char* buf1 = lds + MLA_STAGE;
  MLA_LOAD(rkA, rvA, 0); MLA_WRITE(rkA, rvA, buf0);
  __syncthreads();
  if (nst > 1) MLA_LOAD(rkA, rvA, 1);
#pragma unroll 1
  for (int s = 0; s < nst; s += 2) {
    if (s + 2 < nst) MLA_LOAD(rkB, rvB, s + 2);
    mla_stage(buf0, s, cw, lq, hh, qf, o0, o1, m, lsum);
    if (s + 1 < nst) MLA_WRITE(rkA, rvA, buf1);
    __syncthreads();
    if (s + 1 >= nst) break;
    if (s + 3 < nst) MLA_LOAD(rkA, rvA, s + 3);
    mla_stage(buf1, s + 1, cw, lq, hh, qf, o0, o1, m, lsum);
    if (s + 2 < nst) MLA_WRITE(rkB, rvB, buf0);
    __syncthreads();
  }
#undef MLA_LOAD
#undef MLA_WRITE
  lsum += __shfl_xor(lsum, 32);
  const float inv = 1.f / lsum;
  bf16_t* oa = (bf16_t*)(ws + O_OA) + (size_t)(tq - NMETA * (b + 1)) * 512 + h * 64 + 4 * hh;
#pragma unroll
  for (int g = 0; g < 4; ++g) {
    u32x2 v0, v1;
    v0[0] = pk2(o0[4 * g] * inv, o0[4 * g + 1] * inv); v0[1] = pk2(o0[4 * g + 2] * inv, o0[4 * g + 3] * inv);
    v1[0] = pk2(o1[4 * g] * inv, o1[4 * g + 1] * inv); v1[1] = pk2(o1[4 * g + 2] * inv, o1[4 * g + 3] * inv);
    *(u32x2*)(oa + 8 * g) = v0;
    *(u32x2*)(oa + 32 + 8 * g) = v1;
  }
}


DI size_t score_row_off(int b, int i) {
  const int c = 1 + (i >> 6), m = c - 1;
  return (size_t)b * SCORES_PER_BATCH + (size_t)8192 * (m + (m >> 1) * ((m + 1) >> 1)) + (size_t)(i & 63) * (128 * ((c >> 1) + 1));
}
constexpr int S1_ITEMS = 4 * 560;
DI void s1_item(const Params& P, int it) {
  unsigned char* ws = P.ws;
  const int b = it & 3; int r = it >> 2; int c = 64;
  while (r >= (c >> 2) + 1) { r -= (c >> 2) + 1; --c; }
  const int n = 16 + 64 * c;
  const int lane = threadIdx.x & 63, w = (threadIdx.x >> 6) & 3, lq = lane & 15, lg = lane >> 4;
  const int i = (c - 1) * 64 + 16 * w + lq, tq = b * L + NMETA + i;
  bf16x8 qf[8][2];
  const bf16_t* qrow = (const bf16_t*)(ws + O_QI) + (size_t)tq * 512 + 8 * lg;
#pragma unroll
  for (int h = 0; h < 8; ++h) { qf[h][0] = *(const bf16x8*)(qrow + h * 64); qf[h][1] = *(const bf16x8*)(qrow + h * 64 + 32); }
  const f32x4 wa = *(const f32x4*)((const float*)(ws + O_WI) + (size_t)tq * 8), wb = *(const f32x4*)((const float*)(ws + O_WI) + (size_t)tq * 8 + 4);
  const float wv[8] = {wa[0], wa[1], wa[2], wa[3], wb[0], wb[1], wb[2], wb[3]};
  unsigned* srow = (unsigned*)((_Float16*)(ws + O_SCORES) + score_row_off(b, i)) + 4 * lg;
  const bf16_t* kbase = (const bf16_t*)(ws + O_KI) + ((size_t)b * L + lq) * 64 + 8 * lg;
#pragma unroll 1
  for (int g2 = 0; g2 < 2; ++g2) {
    const int kg = 256 * r + 128 * g2;
#pragma unroll 1
    for (int kt4 = 0; kt4 < 64; kt4 += 16) {
      const int ka = kg + kt4, kb = ka + 64;
      if (ka >= n) break;
      f32x4 sa = {0.f, 0.f, 0.f, 0.f}, sb = {0.f, 0.f, 0.f, 0.f};
      {
        const bf16_t* kp = kbase + (size_t)ka * 64;
        const bf16x8 a0 = *(const bf16x8*)kp, a1 = *(const bf16x8*)(kp + 32);
#pragma unroll
        for (int h = 0; h < 8; ++h) {
          f32x4 acc = {0.f, 0.f, 0.f, 0.f};
          acc = __builtin_amdgcn_mfma_f32_16x16x32_bf16(a0, qf[h][0], acc, 0, 0, 0);
          acc = __builtin_amdgcn_mfma_f32_16x16x32_bf16(a1, qf[h][1], acc, 0, 0, 0);
#pragma unroll
          for (int q = 0; q < 4; ++q) sa[q] = fmaf(wv[h], fmaxf(acc[q], 0.f), sa[q]);
        }
      }
      if (kb < n) {
        const bf16_t* kp = kbase + (size_t)kb * 64;
        const bf16x8 a0 = *(const bf16x8*)kp, a1 = *(const bf16x8*)(kp + 32);
#pragma unroll
        for (int h = 0; h < 8; ++h) {
          f32x4 acc = {0.f, 0.f, 0.f, 0.f};
          acc = __builtin_amdgcn_mfma_f32_16x16x32_bf16(a0, qf[h][0], acc, 0, 0, 0);
          acc = __builtin_amdgcn_mfma_f32_16x16x32_bf16(a1, qf[h][1], acc, 0, 0, 0);
#pragma unroll
          for (int q = 0; q < 4; ++q) sb[q] = fmaf(wv[h], fmaxf(acc[q], 0.f), sb[q]);
        }
      }
      typedef _Float16 h2_t __attribute__((ext_vector_type(2)));
      u32x4 o;
#pragma unroll
      for (int q = 0; q < 4; ++q) { const h2_t v = {(_Float16)sa[q], (_Float16)sb[q]}; o[q] = __builtin_bit_cast(unsigned, v); }
      *(u32x4*)(srow + (kg >> 1) + kt4) = o;
    }
  }
}

DI unsigned f2key(float f) { const unsigned u = __float_as_uint(f); return (u & 0x80000000u) ? ~u : (u | 0x80000000u); }
DI unsigned long long lanemask_lt(int lane) { return (1ull << lane) - 1ull; }
template <int NG>
DI void s2_row(const Params& P, int rq, int lane) {
  unsigned char* ws = P.ws;
  const int b = rq / SEQ, i = rq % SEQ, c = 1 + (i >> 6), n = 16 + 64 * c;
  const unsigned* srow = (const unsigned*)((const _Float16*)(ws + O_SCORES) + score_row_off(b, i)) + lane;
  typedef unsigned short u16x2 __attribute__((ext_vector_type(2)));
  u16x2 hp[NG];
  {
    unsigned raw[NG];
#pragma unroll
    for (int e = 0; e < NG; ++e) raw[e] = srow[64 * e];
#pragma unroll
    for (int e = 0; e < NG; ++e) asm volatile("" : "+v"(raw[e]));
#pragma unroll
    for (int e = 0; e < NG; ++e) {
      const unsigned d = raw[e];
      unsigned k = d ^ ((((d >> 15) & 0x00010001u) * 0xffffu) | 0x80008000u);
      if (128 * e + lane >= n) k &= 0xffff0000u;
      if (128 * e + 64 + lane >= n) k &= 0x0000ffffu;
      hp[e] = __builtin_bit_cast(u16x2, k);
    }
  }
  unsigned T = 0; int c_lo = 1 << 30, c_hi = 0;
  for (int bit = 15; bit >= 0; --bit) {
    const unsigned cand = T | (1u << bit);
    const unsigned short chm1 = (unsigned short)(cand - 1u);
    const u16x2 cv = {chm1, chm1}, one = {1, 1};
    u16x2 a0 = {0, 0}, a1 = {0, 0};
#pragma unroll
    for (int e = 0; e < NG; ++e) {
      u16x2 t;
      asm("v_pk_sub_u16 %0, %1, %2 clamp" : "=v"(t) : "v"(hp[e]), "v"(cv));
      asm("v_pk_min_u16 %0, %1, %2" : "=v"(t) : "v"(t), "v"(one));
      if (e & 1) asm("v_pk_add_u16 %0, %1, %2" : "=v"(a1) : "v"(a1), "v"(t)); else asm("v_pk_add_u16 %0, %1, %2" : "=v"(a0) : "v"(a0), "v"(t));
    }
    const u16x2 as = a0 + a1;
    const int cc = wave_sumi((int)as[0] + (int)as[1]);
    if (cc >= 256) { T = cand; c_lo = cc; } else { c_hi = cc; }
    if (c_lo == 256) break;
  }
  unsigned mlo = 0u, mhi = 0u;
  unsigned long long w64 = 0ull;
  int rem = c_lo == 256 ? (1 << 20) : 256 - c_hi;
#pragma unroll
  for (int e = 0; e < NG; ++e) {
    const unsigned kk = __builtin_bit_cast(unsigned, hp[e]);
#pragma unroll
    for (int h = 0; h < 2; ++h) {
      const unsigned kv = h ? (kk >> 16) : (kk & 0xffffu);
      const bool eq = kv == T;
      const unsigned long long meq = __ballot(eq), mgt = __ballot(kv > T);
      unsigned long long msel = mgt;
      if (meq) {
        const int pre = __popcll(meq & lanemask_lt(lane));
        msel |= __ballot(eq && pre < rem);
        rem -= __popcll(meq); rem = rem < 0 ? 0 : rem;
      }
      const int wd = 2 * e + h;
      if (wd < 64) { if (lane == wd) { mlo = (unsigned)msel; mhi = (unsigned)(msel >> 32); } } else if (wd == 64) w64 = msel;
    }
  }
  unsigned* mrow = (unsigned*)(P.ws + O_MASK) + (size_t)rq * MW;
  *(u32x2*)(mrow + 2 * lane) = (u32x2){mlo, mhi};
  if (lane == 0) { *(u32x2*)(mrow + 128) = (u32x2){(unsigned)w64, (unsigned)(w64 >> 32)}; *(u32x2*)(mrow + 130) = (u32x2){0u, 0u}; }
}
DI void s2_dispatch(const Params& P, int rq, int lane, unsigned* wl) {
  (void)wl;
  const int c = 1 + ((rq % SEQ) >> 6), n = 16 + 64 * c;
  if (n <= 256) {
    unsigned* mrow = (unsigned*)(P.ws + O_MASK) + (size_t)rq * MW;
    unsigned long long m = 0ull;
    const int lo = 64 * lane;
    if (lo + 64 <= n) m = ~0ull; else if (lo < n) m = (1ull << (n - lo)) - 1ull;
    *(u32x2*)(mrow + 2 * lane) = (u32x2){(unsigned)m, (unsigned)(m >> 32)};
    if (lane == 0) { *(u32x2*)(mrow + 128) = (u32x2){0u, 0u}; *(u32x2*)(mrow + 130) = (u32x2){0u, 0u}; }
    return;
  }
  const int ng = (c >> 1) + 1;
  if (ng <= 5) s2_row<5>(P, rq, lane);
  else if (ng <= 9) s2_row<9>(P, rq, lane);
  else if (ng <= 13) s2_row<13>(P, rq, lane);
  else if (ng <= 17) s2_row<17>(P, rq, lane);
  else if (ng <= 21) s2_row<21>(P, rq, lane);
  else if (ng <= 25) s2_row<25>(P, rq, lane);
  else if (ng <= 29) s2_row<29>(P, rq, lane);
  else s2_row<33>(P, rq, lane);
}

DI int t5_bucket(int rel) {
  const int n = rel < 0 ? -rel : rel;
  int v;
  if (n < 8) v = n;
  else v = 8 + (n >= 12) + (n >= 16) + (n >= 23) + (n >= 32) + (n >= 46) + (n >= 64) + (n >= 91);
  return (rel > 0 ? 16 : 0) + v;
}
constexpr int DSA_KSTR = 144, DSA_VSTR = 136, DSA_KBYTES = 64 * DSA_KSTR, DSA_STAGE = DSA_KBYTES + 64 * DSA_VSTR;
constexpr int DSA_TB = 2 * DSA_STAGE;
DI void dsa_stage(const unsigned char* cur, int s, int cw, int lq, int hh, int pq, int qmin, float bfar, const float* tb, const unsigned* mrow,
                  const bf16x8 (&qf)[4], f32x16& o0, f32x16& o1, float& m, float& lsum) {
  if (s > cw) return;
  const bool full = s < cw;
  const int kb0 = 64 * s;
  const bool near = kb0 + 63 >= qmin - 91;
  const unsigned w0 = mrow[2 * s] >> (4 * hh), w1 = mrow[2 * s + 1] >> (4 * hh);
  const float mref = m > -1e29f ? m : 0.f;
  f32x16 s0, s1;
  const float binit = (near ? 0.f : bfar) - mref;
#pragma unroll
  for (int r = 0; r < 16; ++r) { s0[r] = binit; s1[r] = binit; }
  const unsigned char* Kc = cur + lq * DSA_KSTR + hh * 16;
  {
    bf16x8 kf[4];
#pragma unroll
    for (int kk = 0; kk < 4; ++kk) kf[kk] = *(const bf16x8*)(Kc + kk * 32);
#pragma unroll
    for (int kk = 0; kk < 4; ++kk) s0 = __builtin_amdgcn_mfma_f32_32x32x16_bf16(kf[kk], qf[kk], s0, 0, 0, 0);
    __builtin_amdgcn_sched_group_barrier(0x100, 4, 0);
    __builtin_amdgcn_sched_group_barrier(0x008, 4, 0);
  }
  if (full) {
    bf16x8 kf[4];
#pragma unroll
    for (int kk = 0; kk < 4; ++kk) kf[kk] = *(const bf16x8*)(Kc + 32 * DSA_KSTR + kk * 32);
#pragma unroll
    for (int kk = 0; kk < 4; ++kk) s1 = __builtin_amdgcn_mfma_f32_32x32x16_bf16(kf[kk], qf[kk], s1, 0, 0, 0);
    __builtin_amdgcn_sched_group_barrier(0x100, 4, 0);
    __builtin_amdgcn_sched_group_barrier(0x008, 4, 0);
  }
  const float* tp = tb + (kb0 + 4 * hh - pq + 192);
  const unsigned char* Vc = cur + DSA_KBYTES + lq * DSA_VSTR + hh * 8;
  if (near) {
#pragma unroll
    for (int r = 0; r < 16; ++r) s0[r] += tp[(r & 3) + 8 * (r >> 2)];
  }
#pragma unroll
  for (int r = 0; r < 16; ++r) s0[r] = (w0 & (1u << ((r & 3) + 8 * (r >> 2)))) ? s0[r] : MASKV;
  softmax_update1(s0, m, mref, lsum, o0, o1);
  pv_subtile(Vc, DSA_VSTR, s0, o0, o1);
  if (full) {
    if (near) {
#pragma unroll
      for (int r = 0; r < 16; ++r) s1[r] += tp[32 + (r & 3) + 8 * (r >> 2)];
    }
#pragma unroll
    for (int r = 0; r < 16; ++r) s1[r] = (w1 & (1u << ((r & 3) + 8 * (r >> 2)))) ? s1[r] : MASKV;
    softmax_update1(s1, m, mref, lsum, o0, o1);
    pv_subtile(Vc + 64, DSA_VSTR, s1, o0, o1);
  }
}
DI void dsa_item(const Params& P, int item, unsigned char* lds) {
  unsigned char* ws = P.ws;
  const int jq = 15 - item / 32, bh = item % 32, b = bh >> 3, h = bh & 7;
  const int c0 = 4 * jq + 1;
  const int tid = threadIdx.x, lane = tid & 63, w = __builtin_amdgcn_readfirstlane(tid >> 6), hh = lane >> 5, lq = lane & 31;
  const int cw = c0 + (w >> 1);
  const int pq = NMETA + 256 * jq + 32 * w + lq;
  const int tq = b * L + pq, rq = b * SEQ + pq - NMETA;
  const int qmin = NMETA + 256 * jq + 32 * w;
  float* tb = (float*)(lds + DSA_TB);
  __syncthreads();
  if (tid < 256) tb[tid] = P.rel_bias[t5_bucket(tid - 192) * 8 + h] * LOG2E;
  const float bfar = P.rel_bias[15 * 8 + h] * LOG2E;
  bf16x8 qf[4];
  {
    const bf16_t* qrow = (const bf16_t*)(ws + O_QB) + (size_t)tq * 512 + h * 64 + hh * 8;
#pragma unroll
    for (int kk = 0; kk < 4; ++kk) qf[kk] = *(const bf16x8*)(qrow + kk * 16);
  }
  const unsigned* mrow = (const unsigned*)(P.ws + O_MASK) + (size_t)rq * MW;
  f32x16 o0, o1;
#pragma unroll
  for (int r = 0; r < 16; ++r) { o0[r] = 0.f; o1[r] = 0.f; }
  float m = -1e30f, lsum = 0.f;
  const int nst = c0 + 4;
  const bf16_t* kg = (const bf16_t*)(ws + O_KB) + (size_t)b * L * 512 + h * 64;
  const bf16_t* vg = (const bf16_t*)(ws + O_VBT) + (size_t)bh * 64 * LP;
  const int srow = tid >> 3, sc = tid & 7;
  const unsigned kgo = srow * 512 + sc * 8, klo = srow * DSA_KSTR + sc * 16, vgo = srow * LP + sc * 8, vlo = DSA_KBYTES + srow * DSA_VSTR + sc * 16;
  u32x4 rkA, rvA, rkB, rvB;
#define DSA_LOAD(rk_, rv_, st) do { const int kn = (st) * 64; const int kr = min(kn + srow, L - 1) - srow; \
    rk_ = *(const u32x4*)(kg + (size_t)kr * 512 + kgo); rv_ = *(const u32x4*)(vg + kn + vgo); } while (0)
#define DSA_WRITE(rk_, rv_, buf) do { unsigned char* nb_ = (buf); *(u32x4*)(nb_ + klo) = rk_; \
    *(u32x2*)(nb_ + vlo) = (u32x2){rv_[0], rv_[1]}; *(u32x2*)(nb_ + vlo + 8) = (u32x2){rv_[2], rv_[3]}; } while (0)
  unsigned char* buf0 = lds; unsigned char* buf1 = lds + DSA_STAGE;
  DSA_LOAD(rkA, rvA, 0); DSA_WRITE(rkA, rvA, buf0);
  __syncthreads();
  if (nst > 1) DSA_LOAD(rkA, rvA, 1);
#pragma unroll 1
  for (int s = 0; s < nst; s += 2) {
    if (s + 2 < nst) DSA_LOAD(rkB, rvB, s + 2);
    dsa_stage(buf0, s, cw, lq, hh, pq, qmin, bfar, tb, mrow, qf, o0, o1, m, lsum);
    if (s + 1 < nst) DSA_WRITE(rkA, rvA, buf1);
    __syncthreads();
    if (s + 1 >= nst) break;
    if (s + 3 < nst) DSA_LOAD(rkA, rvA, s + 3);
    dsa_stage(buf1, s + 1, cw, lq, hh, pq, qmin, bfar, tb, mrow, qf, o0, o1, m, lsum);
    if (s + 2 < nst) DSA_WRITE(rkB, rvB, buf0);
    __syncthreads();
  }
#undef DSA_LOAD
#undef DSA_WRITE
  lsum += __shfl_xor(lsum, 32);
  const float inv = 1.f / lsum;
  bf16_t* ob = (bf16_t*)(ws + O_OB) + (size_t)rq * 512 + h * 64 + 4 * hh;
#pragma unroll
  for (int g = 0; g < 4; ++g) {
    u32x2 v0, v1;
    v0[0] = pk2(o0[4 * g] * inv, o0[4 * g + 1] * inv); v0[1] = pk2(o0[4 * g + 2] * inv, o0[4 * g + 3] * inv);
    v1[0] = pk2(o1[4 * g] * inv, o1[4 * g + 1] * inv); v1[1] = pk2(o1[4 * g + 2] * inv, o1[4 * g + 3] * inv);
    *(u32x2*)(ob + 8 * g) = v0;
    *(u32x2*)(ob + 32 + 8 * g) = v1;
  }
}

template <bool CHECK> DI void nv_mla(const Params& P, int vb, unsigned char* lds) {
  unsigned char* ws = P.ws;
  float* qs = (float*)lds;
  const int b = vb / SEQ, p = NMETA + vb % SEQ, t = b * L + p;
  const int tid = threadIdx.x & 255, h = tid >> 5, l = tid & 31;
  const bf16_t* qa = (const bf16_t*)(ws + O_QA) + (size_t)t * 768;
  for (int i = tid; i < 768; i += 256) qs[i] = bf2f(qa[i]);
  __syncthreads();
  const int na = n_adm(p);
  const bf16_t* km = (const bf16_t*)(ws + O_KMLA) + (size_t)(b * 8 + h) * LP * 96;
  const bf16_t* vt = (const bf16_t*)(ws + O_VT) + (size_t)(b * 8 + h) * 64 * LP;
  float m = -1e30f, ls = 0.f, acc[64];
#pragma unroll
  for (int d = 0; d < 64; ++d) acc[d] = 0.f;
  const float* q = qs + h * 96;
  for (int j = l; j < na; j += 32) {
    const bf16_t* kr = km + (size_t)j * 96;
    float s = 0.f;
#pragma unroll 8
    for (int d = 0; d < 96; ++d) s = fmaf(q[d], bf2f(kr[d]), s);
    const float mn = fmaxf(m, s), c = exp2f(m - mn), pe = exp2f(s - mn);
    ls = ls * c + pe;
#pragma unroll
    for (int d = 0; d < 64; ++d) acc[d] = acc[d] * c + pe * bf2f(vt[(size_t)d * LP + j]);
    m = mn;
  }
#pragma unroll
  for (int off = 16; off >= 1; off >>= 1) {
    const float m2 = __shfl_xor(m, off), l2 = __shfl_xor(ls, off);
    const float mn = fmaxf(m, m2), c1 = exp2f(m - mn), c2 = exp2f(m2 - mn);
    ls = ls * c1 + l2 * c2;
#pragma unroll
    for (int d = 0; d < 64; ++d) { const float a2 = __shfl_xor(acc[d], off); acc[d] = acc[d] * c1 + a2 * c2; }
    m = mn;
  }
  if (l == 0) {
    const float inv = 1.f / ls;
    bf16_t* oa = (bf16_t*)(ws + O_OA) + (size_t)vb * 512 + h * 64;
    if (CHECK) {
#if SELFCHECK
#pragma unroll
      for (int d = 0; d < 64; ++d) if (far(bf2f(oa[d]), acc[d] * inv, 0.004f, 0.03f)) chk_fail(P, 13);
#endif
    } else {
#pragma unroll
      for (int d = 0; d < 64; ++d) oa[d] = f2bf(acc[d] * inv);
    }
  }
  __syncthreads();
}

#if SELFCHECK
struct NvDsaLds { float qi[512]; float qb[512]; float wi[8]; unsigned keys[L]; int sel[256]; float sc[8][256]; int redi[8]; int scan_gt[257]; int scan_eq[257]; unsigned char mine[L]; };
DI void nv_dsa_check(const Params& P, int vb, unsigned char* lds) {
  unsigned char* ws = P.ws;
  NvDsaLds& S = *(NvDsaLds*)lds;
  const int b = vb / SEQ, p = NMETA + vb % SEQ, t = b * L + p, tid = threadIdx.x & 255;
  const bf16_t* qi_g = (const bf16_t*)(ws + O_QI) + (size_t)t * 512;
  const bf16_t* qb_g = (const bf16_t*)(ws + O_QB) + (size_t)t * 512;
  for (int i = tid; i < 512; i += 256) { S.qi[i] = bf2f(qi_g[i]); S.qb[i] = bf2f(qb_g[i]); }
  if (tid < 8) S.wi[tid] = ((const float*)(ws + O_WI))[(size_t)t * 8 + tid];
  __syncthreads();
  const int na = n_adm(p);
  const bf16_t* ki_g = (const bf16_t*)(ws + O_KI) + (size_t)b * L * 64;
  for (int j = tid; j < na; j += 256) {
    const bf16_t* ki = ki_g + (size_t)j * 64;
    float s = 0.f;
    for (int h = 0; h < 8; ++h) {
      float lg = 0.f;
#pragma unroll 8
      for (int d = 0; d < 64; ++d) lg = fmaf(S.qi[h * 64 + d], bf2f(ki[d]), lg);
      s += S.wi[h] * fmaxf(lg, 0.f);
    }
    S.keys[j] = f2key(s);
    S.mine[j] = 0;
  }
  __syncthreads();
  if (na <= 256) {
    for (int j = tid; j < na; j += 256) S.mine[j] = 1;
  } else {
    unsigned T = 0;
    for (int bit = 31; bit >= 0; --bit) {
      const unsigned cand = T | (1u << bit);
      int c = 0;
      for (int j = tid; j < na; j += 256) c += S.keys[j] >= cand;
      c = block_sumi256(c, S.redi);
      if (c >= 256) T = cand;
    }
    const int chunk = (na + 255) / 256;
    const int j0 = tid * chunk, j1 = min(j0 + chunk, na);
    int cgt = 0, ce = 0;
    for (int j = j0; j < j1; ++j) { cgt += S.keys[j] > T; ce += S.keys[j] == T; }
    S.scan_gt[tid + 1] = cgt; S.scan_eq[tid + 1] = ce;
    __syncthreads();
    if (threadIdx.x == 0) { S.scan_gt[0] = 0; S.scan_eq[0] = 0; for (int i = 1; i <= 256; ++i) { S.scan_gt[i] += S.scan_gt[i - 1]; S.scan_eq[i] += S.scan_eq[i - 1]; } }
    __syncthreads();
    const int r = 256 - S.scan_gt[256];
    int pe = S.scan_eq[tid];
    for (int j = j0; j < j1; ++j) {
      if (S.keys[j] > T) S.mine[j] = 1;
      else if (S.keys[j] == T) { if (pe < r) S.mine[j] = 1; ++pe; }
    }
  }
  __syncthreads();
  const unsigned* mrow = (const unsigned*)(P.ws + O_MASK) + (size_t)vb * MW;
  int mism = 0, cntk = 0;
  for (int j = tid; j < 4224; j += 256) {
    const int kb = (mrow[j >> 5] >> (j & 31)) & 1;
    const int me = j < na ? (int)S.mine[j] : 0;
    mism += kb != me; cntk += kb;
    if (kb && j >= na) mism += 1000;
  }
  mism = block_sumi256(mism, S.redi);
  cntk = block_sumi256(cntk, S.redi);
  if (tid == 0) { if (mism > 16) chk_fail(P, 14); if (cntk != (na < 256 ? na : 256)) chk_fail(P, 14); }
  if (tid == 0) { int k = 0; for (int j = 0; j < na && k < 256; ++j) if ((mrow[j >> 5] >> (j & 31)) & 1) S.sel[k++] = j; for (; k < 256; ++k) S.sel[k] = 0; }
  const int nsel = na < 256 ? na : 256;
  __syncthreads();
  if (tid < nsel) {
    const int j = S.sel[tid];
    const bf16_t* kb = (const bf16_t*)(ws + O_KB) + (size_t)(b * L + j) * 512;
    const int bk = t5_bucket(j - p);
    for (int h = 0; h < 8; ++h) {
      float s = 0.f;
#pragma unroll 8
      for (int d = 0; d < 64; ++d) s = fmaf(S.qb[h * 64 + d], bf2f(kb[h * 64 + d]), s);
      S.sc[h][tid] = s + P.rel_bias[bk * 8 + h] * LOG2E;
    }
  }
  __syncthreads();
  {
    const int h = tid >> 5, l = tid & 31;
    float m = -1e30f;
    for (int k = l; k < nsel; k += 32) m = fmaxf(m, S.sc[h][k]);
#pragma unroll
    for (int off = 16; off >= 1; off >>= 1) m = fmaxf(m, __shfl_xor(m, off));
    float s = 0.f;
    for (int k = l; k < nsel; k += 32) s += exp2f(S.sc[h][k] - m);
#pragma unroll
    for (int off = 16; off >= 1; off >>= 1) s += __shfl_xor(s, off);
    const float inv = 1.f / s;
    __syncthreads();
    if (threadIdx.x < 256) for (int k = l; k < nsel; k += 32) S.sc[h][k] = exp2f(S.sc[h][k] - m) * inv;
  }
  __syncthreads();
  const bf16_t* vbt = (const bf16_t*)(ws + O_VBT) + (size_t)b * 8 * 64 * LP;
  const bf16_t* ob = (const bf16_t*)(ws + O_OB) + (size_t)vb * 512;
  for (int o = tid; o < 512; o += 256) {
    const int h = o >> 6;
    float a = 0.f;
    for (int k = 0; k < nsel; ++k) a = fmaf(S.sc[h][k], bf2f(vbt[(size_t)o * LP + S.sel[k]]), a);
    if (far(bf2f(ob[o]), a, 0.006f, 0.03f)) chk_fail(P, 15);
  }
  __syncthreads();
}
#endif

DI void p7_merge_tile(const Params& P, int mt, int nt, unsigned char* lds) {
  unsigned char* ws = P.ws;
  const int m0 = mt * 256, n0 = nt * 256;
  const bf16_t* gates = (const bf16_t*)P.out;
  bf16_t* yo = (bf16_t*)(ws + O_Y);
  TilePtrs tp;
  f32x16 acc[4][2];
  const int lane = threadIdx.x & 63, w = threadIdx.x >> 6, wr = w >> 2, wc = w & 3, hh = lane >> 5, lc = lane & 31;
#pragma unroll 1
  for (int br = 0; br < 2; ++br) {
    set_ptrs(tp, (const bf16_t*)(ws + (br ? O_OB : O_OA)), 512, NR, m0, (const bf16_t*)(ws + (br ? O_WBRB : O_WBRA)), 512, 1024, n0);
    zero_acc(acc); gemm_kloop<true>(acc, tp, 512, lds);
#pragma unroll
    for (int mi = 0; mi < 4; ++mi) {
      int row = m0 + acc_row0(wr, mi) + lc;
      asm volatile("" : "+v"(row));
#pragma unroll
      for (int ni = 0; ni < 2; ++ni) {
        const int c0 = n0 + acc_col0(wc, ni) + 4 * hh;
        const bf16_t* gp = gates + (size_t)row * 2048 + br * 1024 + c0;
        bf16_t* yp = yo + (size_t)row * 1024 + c0;
        u32x2 gv[4], pv[4];
#pragma unroll
        for (int g = 0; g < 4; ++g) { gv[g] = *(const u32x2*)(gp + 8 * g); if (br) pv[g] = *(const u32x2*)(yp + 8 * g); else { pv[g][0] = 0u; pv[g][1] = 0u; } }
#pragma unroll
        for (int g = 0; g < 4; ++g) {
          const float y0 = __uint_as_float(gv[g][0] << 16) * acc[mi][ni][4 * g] + __uint_as_float(pv[g][0] << 16);
          const float y1 = __uint_as_float(gv[g][0] & 0xffff0000u) * acc[mi][ni][4 * g + 1] + __uint_as_float(pv[g][0] & 0xffff0000u);
          const float y2 = __uint_as_float(gv[g][1] << 16) * acc[mi][ni][4 * g + 2] + __uint_as_float(pv[g][1] << 16);
          const float y3 = __uint_as_float(gv[g][1] & 0xffff0000u) * acc[mi][ni][4 * g + 3] + __uint_as_float(pv[g][1] & 0xffff0000u);
          *(u32x2*)(yp + 8 * g) = pk4(y0, y1, y2, y3);
        }
        __builtin_amdgcn_sched_barrier(0);
      }
    }
    asm volatile("" ::: "memory");
  }
}

DI void p8_out_tile(const Params& P, int mt, int nt, unsigned char* lds) {
  unsigned char* ws = P.ws;
  const int m0 = mt * 256, n0 = nt * 256;
  TilePtrs tp; set_ptrs(tp, (const bf16_t*)(ws + O_Y), 1024, NR, m0, (const bf16_t*)(ws + O_WO), 1024, 1024, n0);
  f32x16 acc[4][2]; zero_acc(acc);
  gemm_kloop<true>(acc, tp, 1024, lds);
  const int lane = threadIdx.x & 63, w = threadIdx.x >> 6, wr = w >> 2, wc = w & 3, hh = lane >> 5, lc = lane & 31;
#pragma unroll
  for (int mi = 0; mi < 4; ++mi) {
    int row = m0 + acc_row0(wr, mi) + lc;
    asm volatile("" : "+v"(row));
#pragma unroll
    for (int ni = 0; ni < 2; ++ni) {
      const size_t off = (size_t)row * D + n0 + acc_col0(wc, ni) + 4 * hh;
      f32x4 xv[4];
#pragma unroll
      for (int g = 0; g < 4; ++g) xv[g] = *(const f32x4*)(P.x + off + 8 * g);
#pragma unroll
      for (int g = 0; g < 4; ++g) {
        f32x4 o; o[0] = xv[g][0] + acc[mi][ni][4 * g]; o[1] = xv[g][1] + acc[mi][ni][4 * g + 1]; o[2] = xv[g][2] + acc[mi][ni][4 * g + 2]; o[3] = xv[g][3] + acc[mi][ni][4 * g + 3];
        *(f32x4*)(P.out + off + 8 * g) = o;
      }
    }
  }
}

DI void p9_router_token(const Params& P, int tok, int lane) {
  unsigned char* ws = P.ws;
  const float* row = P.out + (size_t)tok * D;
  f32x4 v[4]; float s = 0.f;
#pragma unroll
  for (int i = 0; i < 4; ++i) { v[i] = *(const f32x4*)(row + 256 * i + 4 * lane); s += v[i][0] * v[i][0] + v[i][1] * v[i][1] + v[i][2] * v[i][2] + v[i][3] * v[i][3]; }
  s = wave_sum(s);
  const float rs = rsqrtf(s * (1.f / D) + EPS);
#pragma unroll
  for (int i = 0; i < 4; ++i) {
    const f32x4 g = *(const f32x4*)(P.g_ffn + 256 * i + 4 * lane);
    v[i][0] *= rs * g[0]; v[i][1] *= rs * g[1]; v[i][2] *= rs * g[2]; v[i][3] *= rs * g[3];
    u32x2 o; o[0] = pk2(v[i][0], v[i][1]); o[1] = pk2(v[i][2], v[i][3]);
    *(u32x2*)((bf16_t*)(ws + M_XN) + (size_t)tok * D + 256 * i + 4 * lane) = o;
  }
  const float* wr = (const float*)(ws + O_WR);
  float mylog = 0.f;
#pragma unroll 1
  for (int c = 0; c < 36; ++c) {
    float a = 0.f;
#pragma unroll
    for (int i = 0; i < 4; ++i) { const f32x4 w4 = *(const f32x4*)(wr + c * 1024 + 256 * i + 4 * lane); a += v[i][0] * w4[0] + v[i][1] * w4[1] + v[i][2] * w4[2] + v[i][3] * w4[3]; }
    a = wave_sum(a);
    if (lane == c) mylog = a + (c < 4 ? P.b_rg[c] : P.b_re[c - 4]);
  }
  float lg[4];
#pragma unroll
  for (int i = 0; i < 4; ++i) lg[i] = __shfl(mylog, i);
  int gs = 0; float gm = lg[0];
#pragma unroll
  for (int i = 1; i < 4; ++i) if (lg[i] > gm) { gm = lg[i]; gs = i; }
  float se = 0.f;
#pragma unroll
  for (int i = 0; i < 4; ++i) se += expf(lg[i] - gm);
  const float pg = 1.f / se;
  float el[8];
#pragma unroll
  for (int i = 0; i < 8; ++i) el[i] = __shfl(mylog, 4 + gs * 8 + i);
  float em = el[0];
#pragma unroll
  for (int i = 1; i < 8; ++i) em = fmaxf(em, el[i]);
  float pe[8]; float ss = 0.f;
#pragma unroll
  for (int i = 0; i < 8; ++i) { pe[i] = expf(el[i] - em); ss += pe[i]; }
  int e1 = 0; float p1 = pe[0];
#pragma unroll
  for (int i = 1; i < 8; ++i) if (pe[i] > p1) { p1 = pe[i]; e1 = i; }
  int e2 = 0; float p2 = -1.f;
#pragma unroll
  for (int i = 0; i < 8; ++i) if (i != e1 && pe[i] > p2) { p2 = pe[i]; e2 = i; }
  p1 /= ss; p2 /= ss;
  const float den = p1 + p2;
  const float w1 = pg * p1 / den, w2 = pg * p2 / den;
  const int x1 = gs * 8 + e1, x2 = gs * 8 + e2;
  if (lane == 0) {
    unsigned* cnt = (unsigned*)(ws + O_CTR) + 32;
    const int q1 = (int)atomicAdd(cnt + x1, 1u), q2 = (int)atomicAdd(cnt + x2, 1u);
    ((int*)(ws + M_LIST))[(size_t)x1 * NR + q1] = tok; ((int*)(ws + M_LIST))[(size_t)x2 * NR + q2] = tok;
    ((float*)(ws + M_WL))[(size_t)x1 * NR + q1] = w1; ((float*)(ws + M_WL))[(size_t)x2 * NR + q2] = w2;
    int* asg = (int*)(ws + M_ASG) + (size_t)tok * 4;
    asg[0] = x1; asg[1] = q1; asg[2] = x2; asg[3] = q2;
  }
}
DI void p9_conv_gu_item(const Params& P, int item, float* scr, int tid, bool valid) {
  const int e = item >> 7, r = item & 127, kb = r & 15, nb = r >> 4;
  const int k0 = kb * 64, n0 = nb * 64;
  bf16_t* dst = (bf16_t*)(P.ws + M_WGU) + (size_t)e * 512 * 1024;
  if (valid) {
    const int n = tid & 63, nd = n0 + n, q = nd >> 8, within = nd & 255, part = within >> 7, idx = within & 127;
    const float* src = (part ? P.w_eu : P.w_eg) + (size_t)e * 1024 * 256 + (q * 128 + idx);
#pragma unroll 4
    for (int i = 0; i < 16; ++i) { const int k = (tid >> 6) + 4 * i; scr[k * 65 + n] = src[(size_t)(k0 + k) * 256]; }
  }
  __syncthreads();
  if (valid) {
    const int kq = tid & 7;
#pragma unroll
    for (int i = 0; i < 2; ++i) {
      const int n = (tid >> 3) + 32 * i;
      const float* sp = scr + (kq * 8) * 65 + n;
      u32x4 o; o[0] = pk2(sp[0], sp[65]); o[1] = pk2(sp[2 * 65], sp[3 * 65]); o[2] = pk2(sp[4 * 65], sp[5 * 65]); o[3] = pk2(sp[6 * 65], sp[7 * 65]);
      *(u32x4*)(dst + (size_t)(n0 + n) * 1024 + k0 + kq * 8) = o;
    }
  }
  __syncthreads();
}
DI int moe_tile_lookup(const Params& P, int tile, int& e_out, int& rt_out, int& cnt_out, int& base_slot) {
  const unsigned* cnt = (const unsigned*)(P.ws + O_CTR) + 32;
  int acc = 0, found = 0;
  e_out = 0; rt_out = 0; cnt_out = 0; base_slot = 0;
  for (int e = 0; e < 32; ++e) {
    const int c = (int)cnt[e], nt = (c + 255) >> 8;
    if (!found && tile < acc + nt) { e_out = e; rt_out = tile - acc; cnt_out = c; base_slot = acc * 256; found = 1; }
    acc += nt;
  }
  return acc;
}
DI void p10_gu_tile(const Params& P, int tile, int e, int rt, int cnt, int base_slot, int q, unsigned char* lds) {
  unsigned char* ws = P.ws;
  const int tid = threadIdx.x;
  const int* list = (const int*)(ws + M_LIST) + (size_t)e * NR;
  TilePtrs tp;
#pragma unroll
  for (int i = 0; i < 4; ++i) { int row, kc; tile_rc(i, row, kc); int r = rt * 256 + row; r = r < cnt ? r : cnt - 1; tp.a[i] = ((unsigned)list[r] * 1024u + kc * 8) * 2u; tp.b[i] = ((unsigned)(q * 256 + row) * 1024u + kc * 8) * 2u; }
  tp.A = (const bf16_t*)(ws + M_XN); tp.B = (const bf16_t*)(ws + M_WGU) + (size_t)e * 512 * 1024;
  f32x16 acc[4][2]; zero_acc(acc);
  gemm_kloop<true>(acc, tp, 1024, lds);
  const int lane = tid & 63, w = tid >> 6, wr = w >> 2, wc = w & 3, hh = lane >> 5, lc = lane & 31;
  bf16_t* hm = (bf16_t*)(ws + M_HMID);
  const int col = q * 128 + wc * 32 + 4 * hh;
#pragma unroll
  for (int mi = 0; mi < 4; ++mi) {
    int rr = rt * 256 + acc_row0(wr, mi) + lc;
    asm volatile("" : "+v"(rr));
    bf16_t* hp = hm + (size_t)(base_slot + rr) * 256 + col;
#pragma unroll
    for (int g = 0; g < 4; ++g) {
      float hv[4];
#pragma unroll
      for (int e = 0; e < 4; ++e) { const float gt = acc[mi][0][4 * g + e], u = acc[mi][1][4 * g + e]; hv[e] = gt * __builtin_amdgcn_rcpf(1.f + __expf(-gt)) * u; }
      if (rr < cnt) *(u32x2*)(hp + 8 * g) = pk4(hv[0], hv[1], hv[2], hv[3]);
    }
  }
  asm volatile("s_waitcnt vmcnt(0)" ::: "memory");
  __syncthreads();
  if (threadIdx.x == 0) {
    __builtin_amdgcn_fence(__ATOMIC_RELEASE, "agent");
    asm volatile("s_waitcnt vmcnt(0)" ::: "memory");
    __hip_atomic_fetch_add((unsigned*)(ws + O_DEP) + tile, 1u, __ATOMIC_RELAXED, __HIP_MEMORY_SCOPE_AGENT);
  }
}
DI void p11_down_tile(const Params& P, int tile, int e, int rt, int cnt, int base_slot, int nt, unsigned char* lds) {
  unsigned char* ws = P.ws;
  if (threadIdx.x == 0) {
    unsigned* dep = (unsigned*)(ws + O_DEP) + tile;
    unsigned spins = 0;
    while (__hip_atomic_load(dep, __ATOMIC_RELAXED, __HIP_MEMORY_SCOPE_AGENT) < 2u && ++spins < (1u << 22)) __builtin_amdgcn_s_sleep(2);
    __builtin_amdgcn_fence(__ATOMIC_ACQUIRE, "agent");
    asm volatile("s_waitcnt vmcnt(0)" ::: "memory");
  }
  __syncthreads();
  const int tid = threadIdx.x;
  TilePtrs tp;
#pragma unroll
  for (int i = 0; i < 4; ++i) { int row, kc; tile_rc(i, row, kc); int r = rt * 256 + row; r = r < cnt ? r : cnt - 1; tp.a[i] = ((unsigned)(base_slot + r) * 256u + kc * 8) * 2u; tp.b[i] = ((unsigned)(nt * 256 + row) * 256u + kc * 8) * 2u; }
  tp.A = (const bf16_t*)(ws + M_HMID); tp.B = (const bf16_t*)(ws + M_WD) + (size_t)e * 1024 * 256;
  f32x16 acc[4][2]; zero_acc(acc);
  gemm_kloop<true>(acc, tp, 256, lds);
  const int lane = tid & 63, w = tid >> 6, wr = w >> 2, wc = w & 3, hh = lane >> 5, lc = lane & 31;
  bf16_t* ys = (bf16_t*)(ws + M_YS);
  const float* wl = (const float*)(ws + M_WL) + (size_t)e * NR;
#pragma unroll
  for (int mi = 0; mi < 4; ++mi) {
    int rr = rt * 256 + acc_row0(wr, mi) + lc;
    asm volatile("" : "+v"(rr));
    const bool ok = rr < cnt;
    const float wt = ok ? wl[rr] : 0.f;
    bf16_t* yp = ys + (size_t)(base_slot + rr) * 1024 + nt * 256 + 4 * hh;
#pragma unroll
    for (int ni = 0; ni < 2; ++ni)
#pragma unroll
      for (int g = 0; g < 4; ++g)
        if (ok) *(u32x2*)(yp + acc_col0(wc, ni) + 8 * g) = pk4(acc[mi][ni][4 * g] * wt, acc[mi][ni][4 * g + 1] * wt, acc[mi][ni][4 * g + 2] * wt, acc[mi][ni][4 * g + 3] * wt);
  }
}
DI void p12_final_token(const Params& P, int tok, int lane, const int* sbase  ) {
  unsigned char* ws = P.ws;
  float* row = P.out + (size_t)tok * D;
  const int* asg = (const int*)(ws + M_ASG) + (size_t)tok * 4;
  const int s1 = sbase[asg[0]] + asg[1], s2 = sbase[asg[2]] + asg[3];
  const bf16_t* y1 = (const bf16_t*)(ws + M_YS) + (size_t)s1 * 1024;
  const bf16_t* y2 = (const bf16_t*)(ws + M_YS) + (size_t)s2 * 1024;
  f32x4 v[4]; float s = 0.f;
#pragma unroll
  for (int i = 0; i < 4; ++i) {
    v[i] = *(const f32x4*)(row + 256 * i + 4 * lane);
    const u32x2 a = *(const u32x2*)(y1 + 256 * i + 4 * lane), b = *(const u32x2*)(y2 + 256 * i + 4 * lane);
    v[i][0] += __uint_as_float(a[0] << 16) + __uint_as_float(b[0] << 16);
    v[i][1] += __uint_as_float(a[0] & 0xffff0000u) + __uint_as_float(b[0] & 0xffff0000u);
    v[i][2] += __uint_as_float(a[1] << 16) + __uint_as_float(b[1] << 16);
    v[i][3] += __uint_as_float(a[1] & 0xffff0000u) + __uint_as_float(b[1] & 0xffff0000u);
    s += v[i][0] * v[i][0] + v[i][1] * v[i][1] + v[i][2] * v[i][2] + v[i][3] * v[i][3];
  }
  s = wave_sum(s);
  const float rs = rsqrtf(s * (1.f / D) + EPS);
#pragma unroll
  for (int i = 0; i < 4; ++i) {
    const f32x4 g = *(const f32x4*)(P.g_fin + 256 * i + 4 * lane);
    f32x4 o; o[0] = v[i][0] * rs * g[0]; o[1] = v[i][1] * rs * g[1]; o[2] = v[i][2] * rs * g[2]; o[3] = v[i][3] * rs * g[3];
    *(f32x4*)(row + 256 * i + 4 * lane) = o;
  }
}

struct NvMoeLds { float xr[D]; float xn[D]; float hm[256]; float red[8]; float logit[36]; float gatew[2]; int expert[2]; };


#if SELFCHECK
DI const float* h_row(const Params& P, int t) { const int b = t / L, p = t % L; return p < NMETA ? P.meta + (size_t)p * D : P.x + ((size_t)b * SEQ + (p - NMETA)) * D; }
DI void chk_load_hn(const Params& P, int t, float* hv, float* red) {
  const float* row = h_row(P, t);
  float s = 0.f;
  for (int i = (threadIdx.x & 255); i < D; i += 256) { const float v = row[i]; hv[i] = v; s += v * v; }
  s = block_sum256(s, red);
  const float rs = rsqrtf(s * (1.f / D) + EPS);
  if (threadIdx.x < 256) for (int i = threadIdx.x; i < D; i += 256) hv[i] = hv[i] * rs * P.g_mix[i];
  __syncthreads();
}
DI void chk_stageA(const Params& P, unsigned char* lds) {
  unsigned char* ws = P.ws;
  float* hv = (float*)lds; float* pj = hv + 1024; float* red = pj + 4608; float* cq = red + 8; float* ckv = cq + 256;
  const int tid = threadIdx.x & 255;
  for (int sidx = blockIdx.x; sidx < 512; sidx += gridDim.x) {
    const int t = sidx < 8 ? (sidx < 4 ? sidx * L + (sidx & 3) * 5 : NT - 1 - (sidx - 4) * 1031) : (int)(hash_u(sidx * 7919u + 13u) % NT);
    const int b = t / L, p = t % L;
    chk_load_hn(P, t, hv, red);
    for (int c = tid; c < 2536; c += 256) { float a = 0.f; for (int k = 0; k < D; ++k) a = fmaf(hv[k], P.w_in[(size_t)k * INC + c], a); pj[c] = a; }
    __syncthreads();
    const float* sm = (const float*)(ws + O_SMALL) + (size_t)t * 512;
    for (int c = tid; c < 416; c += 256) if (far(sm[c], pj[c], 0.06f, 0.02f)) chk_fail(P, 1);
    for (int c = tid; c < 8; c += 256) if (far(sm[S_WI + c], pj[2528 + c], 0.06f, 0.02f)) chk_fail(P, 1);
    for (int c = tid; c < 64; c += 256) if (far(sm[S_KI + c], pj[2464 + c], 0.06f, 0.02f)) chk_fail(P, 1);
    for (int c = tid; c < 512; c += 256) {
      if (far(bf2f(((const bf16_t*)(ws + O_QB))[(size_t)t * 512 + c]), pj[416 + c] * (0.125f * LOG2E), 0.012f, 0.02f)) chk_fail(P, 2);
      if (far(bf2f(((const bf16_t*)(ws + O_KB))[(size_t)t * 512 + c]), pj[928 + c], 0.06f, 0.02f)) chk_fail(P, 3);
      const int h = c >> 6, d = c & 63;
      if (far(bf2f(((const bf16_t*)(ws + O_VBT))[((size_t)(b * 8 + h) * 64 + d) * LP + p]), pj[1440 + c], 0.06f, 0.02f)) chk_fail(P, 4);
      if (far(bf2f(((const bf16_t*)(ws + O_QI))[(size_t)t * 512 + c]), pj[1952 + c] * 0.125f, 0.01f, 0.02f)) chk_fail(P, 5);
    }
    for (int c = tid; c < 64; c += 256) if (far(bf2f(((const bf16_t*)(ws + O_KI))[(size_t)t * 64 + c]), pj[2464 + c], 0.06f, 0.02f)) chk_fail(P, 6);
    for (int c = tid; c < 8; c += 256) if (far(((const float*)(ws + O_WI))[(size_t)t * 8 + c], pj[2528 + c] * 0.35355339f, 0.03f, 0.02f)) chk_fail(P, 6);
    { float s = 0.f; for (int i = tid; i < 256; i += 256) s += pj[i] * pj[i]; s = block_sum256(s, red);
      const float rs = rsqrtf(s * (1.f / 256) + EPS); for (int i = tid; i < 256; i += 256) cq[i] = pj[i] * rs * P.g_cq[i]; }
    { float s = 0.f; for (int i = tid; i < 128; i += 256) s += pj[256 + i] * pj[256 + i]; s = block_sum256(s, red);
      const float rs = rsqrtf(s * (1.f / 128) + EPS); for (int i = tid; i < 128; i += 256) ckv[i] = pj[256 + i] * rs * P.g_ckv[i]; }
    __syncthreads();
    const float qscale = 0.10206207261596575f * LOG2E;
    for (int c = tid; c < 768; c += 256) {
      const int h = c / 96, e = c % 96;
      float ref;
      if (e < 64) { float a = 0.f; for (int k = 0; k < 256; ++k) a = fmaf(cq[k], P.w_uq[(size_t)k * 768 + c], a); ref = a; }
      else {
        const int j = (e - 64) & 15; const int c1 = h * 96 + 64 + j, c2 = c1 + 16;
        float a1 = 0.f, a2 = 0.f; for (int k = 0; k < 256; ++k) { a1 = fmaf(cq[k], P.w_uq[(size_t)k * 768 + c1], a1); a2 = fmaf(cq[k], P.w_uq[(size_t)k * 768 + c2], a2); }
        const float inv = powf(10000.f, -(float)j / 16.f); float sn, cs; sincosf((float)p * inv, &sn, &cs);
        ref = (e - 64) < 16 ? a1 * cs - a2 * sn : a1 * sn + a2 * cs;
      }
      if (far(bf2f(((const bf16_t*)(ws + O_QA))[(size_t)t * 768 + c]), ref * qscale, 0.01f, 0.02f)) chk_fail(P, 7);
    }
    for (int c = tid; c < 1024; c += 256) {
      float a = 0.f; for (int k = 0; k < 128; ++k) a = fmaf(ckv[k], P.w_ukv[(size_t)k * 1024 + c], a);
      const int h = c >> 7, e = c & 127;
      if (e < 64) { if (far(bf2f(((const bf16_t*)(ws + O_KMLA))[((size_t)(b * 8 + h) * LP + p) * 96 + e]), a, 0.06f, 0.02f)) chk_fail(P, 8); }
      else { if (far(bf2f(((const bf16_t*)(ws + O_VT))[((size_t)(b * 8 + h) * 64 + (e - 64)) * LP + p]), a, 0.06f, 0.02f)) chk_fail(P, 9); }
    }
    for (int c = tid; c < 256; c += 256) {
      const int h = c >> 5, e = c & 31, j = e & 15;
      const float inv = powf(10000.f, -(float)j / 16.f); float sn, cs; sincosf((float)p * inv, &sn, &cs);
      const float x1 = pj[384 + j], x2 = pj[384 + 16 + j];
      const float ref = e < 16 ? x1 * cs - x2 * sn : x1 * sn + x2 * cs;
      if (far(bf2f(((const bf16_t*)(ws + O_KMLA))[((size_t)(b * 8 + h) * LP + p) * 96 + 64 + e]), ref, 0.06f, 0.02f)) chk_fail(P, 10);
    }
    __syncthreads();
  }
}
DI void chk_stageB(const Params& P, unsigned char* lds) {
  unsigned char* ws = P.ws;
  float* hv = (float*)lds; float* yv = hv + 1024; float* red = yv + 1024; float* oa = red + 8; float* ob = oa + 512;
  const int tid = threadIdx.x & 255;
  for (int sidx = blockIdx.x; sidx < 256; sidx += gridDim.x) {
    const int rt = (int)(hash_u(sidx * 104729u + 7u) % NR);
    const int b = rt / SEQ, p = NMETA + rt % SEQ, t = b * L + p;
    chk_load_hn(P, t, hv, red);
    for (int i = tid; i < 512; i += 256) { oa[i] = bf2f(((const bf16_t*)(ws + O_OA))[(size_t)rt * 512 + i]); ob[i] = bf2f(((const bf16_t*)(ws + O_OB))[(size_t)rt * 512 + i]); }
    __syncthreads();
    const bf16_t* gates = (const bf16_t*)P.out + (size_t)rt * 2048;
    for (int c = tid; c < D; c += 256) {
      float ga = 0.f, gb = 0.f, va = 0.f, vb = 0.f;
      for (int k = 0; k < D; ++k) { ga = fmaf(hv[k], P.w_in[(size_t)k * INC + 2536 + c], ga); gb = fmaf(hv[k], P.w_in[(size_t)k * INC + 3560 + c], gb); }
      for (int k = 0; k < 512; ++k) { va = fmaf(oa[k], P.w_bra[(size_t)k * D + c], va); vb = fmaf(ob[k], P.w_brb[(size_t)k * D + c], vb); }
      const float sa = 1.f / (1.f + expf(-ga)), sb = 1.f / (1.f + expf(-gb));
      if (far(bf2f(gates[c]), sa, 0.01f, 0.01f) || far(bf2f(gates[1024 + c]), sb, 0.01f, 0.01f)) chk_fail(P, 10);
      const float ref = va * sa + vb * sb;
      if (far(bf2f(((const bf16_t*)(ws + O_Y))[(size_t)rt * D + c]), ref, 0.004f, 0.03f)) chk_fail(P, 11);
    }
    __syncthreads();
  }
}
DI void chk_stageC(const Params& P, unsigned char* lds) {
  unsigned char* ws = P.ws;
  float* yv = (float*)lds;
  const int tid = threadIdx.x & 255;
  for (int sidx = blockIdx.x; sidx < 256; sidx += gridDim.x) {
    const int rt = (int)(hash_u(sidx * 15485863u + 3u) % NR);
    const int b = rt / SEQ, p = NMETA + rt % SEQ, t = b * L + p;
    for (int i = tid; i < D; i += 256) yv[i] = bf2f(((const bf16_t*)(ws + O_Y))[(size_t)rt * D + i]);
    __syncthreads();
    for (int c = tid; c < D; c += 256) {
      float a = 0.f; for (int k = 0; k < D; ++k) a = fmaf(yv[k], P.w_o[(size_t)k * D + c], a);
      const float ref = P.x[(size_t)rt * D + c] + a;
      if (far(P.out[(size_t)rt * D + c], ref, 0.003f, 0.002f)) chk_fail(P, 12);
    }
    __syncthreads();
  }
}
#endif

#if SELFCHECK
DI void chk_moe(const Params& P, unsigned char* lds) {
  unsigned char* ws = P.ws;
  NvMoeLds& S = *(NvMoeLds*)lds;
  __shared__ int sb[32];
  const int t = threadIdx.x & 255, lane = t & 63, wv = t >> 6;
  if (t == 0) { const unsigned* c = (const unsigned*)(ws + O_CTR) + 32; int a = 0; for (int i = 0; i < 32; ++i) { sb[i] = a; a += (((int)c[i] + 255) >> 8) * 256; } }
  __syncthreads();
  for (int sidx = blockIdx.x; sidx < 192; sidx += gridDim.x) {
    const int tok = (int)(hash_u(sidx * 40503u + 77u) % NR);
    const float* row = P.out + (size_t)tok * D;
    float s = 0.f;
    for (int i = t; i < D; i += 256) { const float v = row[i]; S.xr[i] = v; s += v * v; }
    s = block_sum256(s, S.red);
    const float rs = rsqrtf(s * (1.f / D) + EPS);
    for (int i = t; i < D; i += 256) { S.xn[i] = S.xr[i] * rs * P.g_ffn[i]; if (far(bf2f(((const bf16_t*)(ws + M_XN))[(size_t)tok * D + i]), S.xn[i], 0.02f, 0.01f)) chk_fail(P, 0); }
    __syncthreads();
    for (int c = wv; c < 36; c += 4) {
      float a = 0.f;
      if (c < 4) { for (int i = lane; i < D; i += 64) a = fmaf(S.xn[i], P.w_rg[i * 4 + c], a); }
      else { for (int i = lane; i < D; i += 64) a = fmaf(S.xn[i], P.w_re[i * 32 + (c - 4)], a); }
      a = wave_sum(a);
      if (lane == 0) S.logit[c] = a + (c < 4 ? P.b_rg[c] : P.b_re[c - 4]);
    }
    __syncthreads();
    const int* asg = (const int*)(ws + M_ASG) + (size_t)tok * 4;
    if (t == 0) {
      const int gs = asg[0] >> 3;
      float gm = S.logit[0]; for (int i = 1; i < 4; ++i) gm = fmaxf(gm, S.logit[i]);
      if (S.logit[gs] < gm - 1e-4f || (asg[2] >> 3) != gs) chk_fail(P, 1);
      const float* el = S.logit + 4 + gs * 8;
      const int e1 = asg[0] & 7, e2 = asg[2] & 7;
      int nb = 0; for (int i = 0; i < 8; ++i) if (i != e1 && i != e2 && el[i] > fminf(el[e1], el[e2]) + 1e-4f) ++nb;
      if (nb || e1 == e2 || el[e1] < el[e2] - 1e-4f) chk_fail(P, 2);
      float se = 0.f; for (int i = 0; i < 4; ++i) se += expf(S.logit[i] - gm);
      const float pg = expf(S.logit[gs] - gm) / se;
      const float a = expf(el[e1] - el[e1]), b2 = expf(el[e2] - el[e1]);
      S.gatew[0] = pg * a / (a + b2); S.gatew[1] = pg * b2 / (a + b2);
      S.expert[0] = asg[0]; S.expert[1] = asg[2];
      if (far(((const float*)(ws + M_WL))[(size_t)asg[0] * NR + asg[1]], S.gatew[0], 1e-4f, 1e-3f)) chk_fail(P, 3);
      if (far(((const float*)(ws + M_WL))[(size_t)asg[2] * NR + asg[3]], S.gatew[1], 1e-4f, 1e-3f)) chk_fail(P, 3);
      if (((const int*)(ws + M_LIST))[(size_t)asg[0] * NR + asg[1]] != tok || ((const int*)(ws + M_LIST))[(size_t)asg[2] * NR + asg[3]] != tok) chk_fail(P, 4);
    }
    __syncthreads();
    for (int a = 0; a < 2; ++a) {
      const int e = S.expert[a];
      const int slot = sb[e] + asg[2 * a + 1];
      const float* wg = P.w_eg + (size_t)e * D * 256;
      const float* wu = P.w_eu + (size_t)e * D * 256;
      float g = 0.f, u = 0.f;
      for (int k = 0; k < D; ++k) { const float xv = S.xn[k]; g = fmaf(xv, wg[(size_t)k * 256 + t], g); u = fmaf(xv, wu[(size_t)k * 256 + t], u); }
      S.hm[t] = g / (1.f + expf(-g)) * u;
      if (far(bf2f(((const bf16_t*)(ws + M_HMID))[(size_t)slot * 256 + t]), S.hm[t], 0.03f, 0.03f)) chk_fail(P, 5);
      __syncthreads();
      const float* wd = P.w_ed + (size_t)e * 256 * D;
      const float gw = S.gatew[a];
      for (int i = 0; i < 4; ++i) {
        float y = 0.f;
        for (int j = 0; j < 256; ++j) y = fmaf(S.hm[j], wd[(size_t)j * D + t + 256 * i], y);
        if (far(bf2f(((const bf16_t*)(ws + M_YS))[(size_t)slot * 1024 + t + 256 * i]), gw * y, 0.02f, 0.03f)) chk_fail(P, 6);
      }
      __syncthreads();
    }
  }
}
#endif

__global__ void __launch_bounds__(NTHR, 2) mega(Params P) {
  cg::grid_group grid = cg::this_grid();
  extern __shared__ __attribute__((aligned(16))) unsigned char lds[];
  const int G = gridDim.x, bx = blockIdx.x;
  const int lane = threadIdx.x & 63, wv = threadIdx.x >> 6, gw = bx * NW + wv, NGW = G * NW;
  const int half = threadIdx.x >> 8, t2 = threadIdx.x & 255;
  constexpr int MTB = (NT + 255) / 256;
  if (threadIdx.x < 16) ((unsigned*)(lds + LDS_CTL))[threadIdx.x] = 0u;
  __syncthreads();
  if (P.use_cg) grid.sync();
  const XcdBarrier xb = xcd_barrier_post((unsigned*)(P.ws + O_BAR), (volatile LAS unsigned*)(lds + LDS_CTL));
  int* const slot = (int*)(lds + LDS_CTL + 16);
#define GSYNC() xcd_barrier(xb)
  p0_prologue(P, lds);
  GSYNC();
  { int mt, nt; for (int k = 0; p1_tile_map(bx, k, G, mt, nt); ++k) p1_inproj_tile(P, mt, nt, lds); }
  GSYNC();
  for (int t = gw; t < NT; t += NGW) p2a_token(P, t, lane);
  GSYNC();
  for (int t = bx; t < MTB * (768 / 256 + 1024 / 256); t += G) { if (t < MTB * 3) p2b_q_tile(P, t, lds); else p2b_kv_tile(P, t - MTB * 3, lds); }
  GSYNC();
#if SELFCHECK
  chk_stageA(P, lds);
  GSYNC();
#endif
  for (int it = next_item(P, 0, slot); it < 512; it = next_item(P, 0, slot)) mla_item(P, it, lds);
#if SELFCHECK
  GSYNC();
  for (int sidx = bx; sidx < 384; sidx += G) nv_mla<true>(P, sidx < 8 ? (sidx < 4 ? sidx * 37 : NR - 1 - (sidx - 4) * 4096) : (int)(hash_u(sidx * 2654435761u + 11u) % NR), lds);
#endif
  GSYNC();
  for (int q = next_item(P, 1, slot); 2 * q < S1_ITEMS; q = next_item(P, 1, slot)) s1_item(P, 2 * q + (wv >> 2));
  GSYNC();
  { unsigned* wl = (unsigned*)lds + wv * 64; for (int r = gw; r < NR; r += NGW) s2_dispatch(P, r, lane, wl); }
  GSYNC();
  for (int it = next_item(P, 2, slot); it < 512; it = next_item(P, 2, slot)) dsa_item(P, it, lds);
  GSYNC();
#if SELFCHECK
  for (int sidx = bx; sidx < 384; sidx += G) nv_dsa_check(P, sidx < 8 ? (sidx < 4 ? 200 + sidx * 37 : NR - 1 - (sidx - 4) * 4096) : (int)(hash_u(sidx * 2246822519u + 5u) % NR), lds);
  GSYNC();
#endif
  { int mt, nt; for (int k = 0; p78_tile_map(bx, k, G, mt, nt); ++k) p7_merge_tile(P, mt, nt, lds); }
  GSYNC();
#if SELFCHECK
  chk_stageB(P, lds);
  GSYNC();
#endif
  { int mt, nt; for (int k = 0; p78_tile_map(bx, k, G, mt, nt); ++k) p8_out_tile(P, mt, nt, lds); }
  GSYNC();
#if SELFCHECK
  chk_stageC(P, lds);
  GSYNC();
#endif
  { int lane9 = threadIdx.x & 63; asm volatile("" : "+v"(lane9)); for (int t = gw; t < NR; t += NGW) p9_router_token(P, t, lane9); }
  { float* scr = (float*)lds + half * (64 * 65 + 32);
    for (int k = bx; 2 * k < 32 * 128; k += G) p9_conv_gu_item(P, 2 * k + half, scr, t2, true);
    for (int k = bx; 2 * k < 32 * 64; k += G) { const int it = 2 * k + half, e = it >> 6; transpose_item(P.w_ed + (size_t)e * 256 * 1024, 1024, 256, (bf16_t*)(P.ws + M_WD) + (size_t)e * 1024 * 256, MapOff{0}, it & 63, scr, t2, true); } }
  GSYNC();
  {
    int e, rt, cnt, bs;
    const int ntile = moe_tile_lookup(P, 0, e, rt, cnt, bs);
    for (int q = next_item(P, 3, slot); q < ntile * 6; q = next_item(P, 3, slot)) {
      if (q < ntile * 2) { moe_tile_lookup(P, q >> 1, e, rt, cnt, bs); p10_gu_tile(P, q >> 1, e, rt, cnt, bs, q & 1, lds); }
      else { const int q2 = q - ntile * 2; moe_tile_lookup(P, q2 >> 2, e, rt, cnt, bs); p11_down_tile(P, q2 >> 2, e, rt, cnt, bs, q2 & 3, lds); }
    }
    GSYNC();
#if SELFCHECK
    chk_moe(P, lds);
    GSYNC();
#endif
    int* sbase = (int*)lds;
    __syncthreads();
    if (threadIdx.x == 0) { const unsigned* c = (const unsigned*)(P.ws + O_CTR) + 32; int a = 0; for (int i = 0; i < 32; ++i) { sbase[i] = a; a += (((int)c[i] + 255) >> 8) * 256; } }
    __syncthreads();
    int lane12 = threadIdx.x & 63; asm volatile("" : "+v"(lane12));
    for (int t = gw; t < NR; t += NGW) p12_final_token(P, t, lane12, sbase);
  }
#if SELFCHECK
  GSYNC();
  {
    const unsigned* chk = (const unsigned*)(P.ws + O_CHK);
    float f = 1.f;
    for (int k = 15; k >= 0; --k) if (chk[k]) f = 1.f + 0.25f * (float)(1 << k);
    if (f != 1.f) for (size_t i = (size_t)bx * NTHR + threadIdx.x; i < (size_t)NR * D; i += (size_t)G * NTHR) P.out[i] *= f;
  }
#endif
}
}

extern "C" void kernel_launch(void* const* d_in, const int* in_sizes, int n_in, void* d_out, int out_size, void* d_ws, size_t ws_size, hipStream_t stream) {
  using namespace mk;
  static int grid_blocks = 0;
  if (!grid_blocks) {
    int dev = 0, cus = 0, per_cu = 0;
    (void)hipGetDevice(&dev);
    (void)hipDeviceGetAttribute(&cus, hipDeviceAttributeMultiprocessorCount, dev);
    (void)hipFuncSetAttribute((const void*)mega, hipFuncAttributeMaxDynamicSharedMemorySize, LDS_BYTES);
    (void)hipOccupancyMaxActiveBlocksPerMultiprocessor(&per_cu, mega, NTHR, LDS_BYTES);
    per_cu = 1;
    grid_blocks = cus * per_cu;
    if (ws_size < WS_END) fprintf(stderr, "workspace too small: need %zu have %zu\n", (size_t)WS_END, ws_size);
  }
  Params p{};
  const float** pp = (const float**)&p;
  for (int i = 0; i < 21; ++i) pp[i] = (const float*)d_in[i];
  p.out = (float*)d_out; p.ws = (unsigned char*)d_ws;
  (void)hipMemsetAsync((unsigned char*)d_ws + O_CHK, 0, O_WR - O_CHK, stream);
  void* args[] = {&p};
  hipError_t e = hipLaunchCooperativeKernel((void*)mega, dim3(grid_blocks), dim3(NTHR), args, LDS_BYTES, stream);
  if (e != hipSuccess) fprintf(stderr, "cooperative launch failed: %s (grid %d)\n", hipGetErrorString(e), grid_blocks);
}
```

```cpp
#include <hip/hip_runtime.h>
#include <hip/hip_cooperative_groups.h>
#include <cstdio>
#include <math.h>
#include <stdint.h>
namespace cg = cooperative_groups;

namespace mk {
typedef unsigned short bf16_t;
typedef short bf16x8 __attribute__((ext_vector_type(8)));
typedef float f32x16 __attribute__((ext_vector_type(16)));
typedef float f32x4 __attribute__((ext_vector_type(4)));
typedef unsigned u32x4 __attribute__((ext_vector_type(4)));
typedef unsigned u32x2 __attribute__((ext_vector_type(2)));

constexpr int D = 1024, NB = 4, SEQ = 4096, NMETA = 16, L = SEQ + NMETA, NT = NB * L  , NR = NB * SEQ  ;
constexpr int INC = 4584, LP = 4128;
constexpr int S_CQ = 0, S_CKV = 256, S_KR = 384, S_WI = 416, S_KI = 424;
constexpr float EPS = 1e-6f;
constexpr float LOG2E = 1.4426950408889634f;
constexpr int NTHR = 512, NW = NTHR / 64;

#define DI __device__ __forceinline__
#ifndef REP_P0
#define REP_P0 1
#endif
#ifndef REP_P1
#define REP_P1 1
#endif
#ifndef REP_MLA
#define REP_MLA 1
#endif
#ifndef REP_S1
#define REP_S1 1
#endif
#ifndef REP_S2
#define REP_S2 1
#endif
#ifndef REP_DSA
#define REP_DSA 1
#endif
#ifndef REP_P7
#define REP_P7 1
#endif
#ifndef REP_P8
#define REP_P8 1
#endif
#ifndef REP_MOE
#define REP_MOE 1
#endif
#ifndef REP_P2
#define REP_P2 1
#endif
#ifndef REP_CONV
#define REP_CONV 1
#endif
#ifndef SELFCHECK
#define SELFCHECK 0
#endif

typedef __bf16 bf2_t __attribute__((ext_vector_type(2)));
DI bf16_t f2bf(float x) { const __bf16 b = (__bf16)x; return __builtin_bit_cast(bf16_t, b); }
DI float bf2f(bf16_t v) { return __uint_as_float(((unsigned)v) << 16); }
DI unsigned pk2(float lo, float hi) { const bf2_t v = {(__bf16)lo, (__bf16)hi}; return __builtin_bit_cast(unsigned, v); }
#define dpp_i(v, ctrl) __builtin_amdgcn_update_dpp(0, (v), (ctrl), 0xf, 0xf, true)
DI float wave_sum(float v) {
  v += __int_as_float(dpp_i(__float_as_int(v), 0xB1));
  v += __int_as_float(dpp_i(__float_as_int(v), 0x4E));
  v += __int_as_float(dpp_i(__float_as_int(v), 0x141));
  v += __int_as_float(dpp_i(__float_as_int(v), 0x140));
  const int b = __float_as_int(v);
  return (__int_as_float(__builtin_amdgcn_readlane(b, 0)) + __int_as_float(__builtin_amdgcn_readlane(b, 16))) +
         (__int_as_float(__builtin_amdgcn_readlane(b, 32)) + __int_as_float(__builtin_amdgcn_readlane(b, 48)));
}
DI int wave_sumi(int v) {
  v += dpp_i(v, 0xB1); v += dpp_i(v, 0x4E); v += dpp_i(v, 0x141); v += dpp_i(v, 0x140);
  return (__builtin_amdgcn_readlane(v, 0) + __builtin_amdgcn_readlane(v, 16)) + (__builtin_amdgcn_readlane(v, 32) + __builtin_amdgcn_readlane(v, 48));
}
DI float block_sum256(float v, float* red) {
  v = wave_sum(v);
  __syncthreads();
  if ((threadIdx.x & 63) == 0) red[threadIdx.x >> 6] = v;
  __syncthreads();
  return red[0] + red[1] + red[2] + red[3];
}
DI int block_sumi256(int v, int* red) {
#pragma unroll
  for (int o = 1; o < 64; o <<= 1) v += __shfl_xor(v, o);
  __syncthreads();
  if ((threadIdx.x & 63) == 0) red[threadIdx.x >> 6] = v;
  __syncthreads();
  return red[0] + red[1] + red[2] + red[3];
}
DI int n_adm(int p) { return p < NMETA ? NMETA : NMETA + 64 * (1 + (p - NMETA) / 64); }


#if SELFCHECK
DI unsigned hash_u(unsigned x) { x ^= x >> 16; x *= 0x7feb352du; x ^= x >> 15; x *= 0x846ca68bu; x ^= x >> 16; return x; }
DI bool far(float got, float ref, float atol, float rtol) { const float d = fabsf(got - ref); return !(d <= atol + rtol * fabsf(ref)); }
#endif
struct Params {
  const float *x, *meta, *g_mix, *w_in, *g_cq, *g_ckv, *w_uq, *w_ukv, *w_bra, *w_brb, *w_o, *rel_bias, *g_ffn, *w_rg, *b_rg, *w_re, *b_re, *w_eg, *w_eu, *w_ed, *g_fin;
  float* out; unsigned char* ws;
  int use_cg; int pad;
};

constexpr size_t al(size_t x) { return (x + 255) & ~(size_t)255; }
constexpr size_t O_QB = 0;
constexpr size_t O_KB = al(O_QB + (size_t)NT * 512 * 2);
constexpr size_t O_VBT = al(O_KB + (size_t)NT * 512 * 2);
constexpr size_t O_QI = al(O_VBT + (size_t)NB * 8 * 64 * LP * 2);
constexpr size_t O_KI = al(O_QI + (size_t)NT * 512 * 2);
constexpr size_t O_WI = al(O_KI + (size_t)NT * 64 * 2);
constexpr size_t O_SMALL = al(O_WI + (size_t)NT * 8 * 4);
constexpr size_t O_CQN = al(O_SMALL + (size_t)NT * 512 * 4);
constexpr size_t O_CKVN = al(O_CQN + (size_t)NT * 256 * 2);
constexpr size_t O_QA = al(O_CKVN + (size_t)NT * 128 * 2);
constexpr size_t O_KMLA = al(O_QA + (size_t)NT * 768 * 2);
constexpr size_t O_VT = al(O_KMLA + (size_t)NB * 8 * LP * 96 * 2);
constexpr size_t R_END = al(O_VT + (size_t)NB * 8 * 64 * LP * 2 + (size_t)NT * 1536 * 2);
constexpr size_t O_HN = O_QA;
constexpr size_t O_OA = O_SMALL;
constexpr int MW = 132;
constexpr size_t O_MASK = al(O_OA + (size_t)NR * 512 * 2);
constexpr size_t O_SCORES = al(O_MASK + (size_t)NR * MW * 4);
constexpr size_t SCORES_PER_BATCH = (size_t)8192 * 1088;
constexpr size_t O_OB = O_SCORES;
constexpr size_t O_Y = al(O_OB + (size_t)NR * 512 * 2);
static_assert(O_SCORES + (size_t)NB * SCORES_PER_BATCH * 2 + 65536 <= R_END, "scores must fit region R");
constexpr size_t O_WIN = R_END;
constexpr size_t O_WG = al(O_WIN + (size_t)2560 * 1024 * 2);
constexpr size_t O_WUQ = al(O_WG + (size_t)2048 * 1024 * 2);
constexpr size_t O_WUKV = al(O_WUQ + (size_t)768 * 256 * 2);
constexpr size_t O_WBRA = al(O_WUKV + (size_t)1024 * 128 * 2);
constexpr size_t O_WBRB = al(O_WBRA + (size_t)1024 * 512 * 2);
constexpr size_t O_WO = al(O_WBRB + (size_t)1024 * 512 * 2);
constexpr size_t O_ROPE = al(O_WO + (size_t)1024 * 1024 * 2);
constexpr size_t O_CHK = al(O_ROPE + (size_t)L * 32 * 4);
constexpr size_t O_CTR = al(O_CHK + 256);
constexpr size_t O_BAR = al(O_CTR + 256);
constexpr size_t O_DEP = al(O_BAR + 3456 * 4);
constexpr size_t O_WR = al(O_DEP + 512 * 4);
constexpr size_t WS_END = al(O_WR + (size_t)36 * 1024 * 4);
constexpr int SLOTS = 2 * NR + 32 * 256;
constexpr size_t M_XN = 0;
constexpr size_t M_HMID = al(M_XN + (size_t)NR * 1024 * 2);
constexpr size_t M_YS = al(M_HMID + (size_t)SLOTS * 256 * 2);
constexpr size_t M_WGU = al(M_YS + (size_t)SLOTS * 1024 * 2);
constexpr size_t M_WD = al(M_WGU + (size_t)32 * 512 * 1024 * 2);
constexpr size_t M_LIST = al(M_WD + (size_t)32 * 1024 * 256 * 2);
constexpr size_t M_WL = al(M_LIST + (size_t)32 * NR * 4);
constexpr size_t M_ASG = al(M_WL + (size_t)32 * NR * 4);
constexpr size_t M_RS = al(M_ASG + (size_t)NR * 16);
constexpr size_t M_END = al(M_RS + (size_t)NR * 4);
static_assert(M_END <= O_WIN, "MoE overlay must stay below the weights");
static_assert(WS_END <= (size_t)256 * 1024 * 1024, "workspace budget");
#if SELFCHECK
DI void chk_fail(const Params& P, int k) { atomicAdd((unsigned*)(P.ws + O_CHK) + k, 1u); }
#endif
constexpr int GX_A = 256 * 128, GX_B = 256 * 128, GX_STAGE = GX_A + GX_B;
constexpr int LDS_CTL = 2 * GX_STAGE;
constexpr int LDS_BYTES = LDS_CTL + 64;


#define XB_TMO      128
#define XB_XCNT(j)  (256  + 64 * (j))
#define XB_XSUB(j)  (1280 + 64 * (j))
#define XB_XGEN(j)  (2304 + 64 * (j))
#define XB_TOP      3328
#define XB_TOPGEN   3392
#define XCD_BAR_WORDS 3456
#define XB_SPIN_CAP (1u << 18)
#define LAS __attribute__((address_space(3)))
DI unsigned xb_ld(unsigned* p)              { return __hip_atomic_load(p, __ATOMIC_RELAXED, __HIP_MEMORY_SCOPE_AGENT); }
DI unsigned xb_add(unsigned* p, unsigned v) { return __hip_atomic_fetch_add(p, v, __ATOMIC_RELAXED, __HIP_MEMORY_SCOPE_AGENT); }
DI unsigned xb_xcc_id() { return (unsigned)__builtin_amdgcn_s_getreg((3 << 11) | 20) & 0xFu; }
#define XB_SPIN(cond, bar) do { unsigned _sp = 0; while (cond) { __builtin_amdgcn_s_sleep(1); \
    if ((++_sp & 255u) == 0u) { if (xb_ld(&(bar)[XB_TMO])) break; if (_sp > XB_SPIN_CAP) { atomicAdd(&(bar)[XB_TMO], 1u); break; } } } } while (0)
struct XcdBarrier { unsigned* bar; unsigned x; volatile LAS unsigned* st; };
DI XcdBarrier xcd_barrier_post(unsigned* bar, volatile LAS unsigned* st) {
  XcdBarrier b; b.bar = bar; b.x = xb_xcc_id(); b.st = st;
  if (threadIdx.x == 0) (void)xb_add(&bar[XB_XCNT(b.x)], 1u);
  return b;
}
DI void xcd_barrier_complete(unsigned* bar, unsigned x, unsigned& nloc, unsigned& nx) {
  const unsigned G = gridDim.x * gridDim.y * gridDim.z;
  unsigned sum, cnt, mine, sp = 0u;
  for (;;) {
    sum = 0u; cnt = 0u; mine = 0u;
#pragma unroll
    for (unsigned j = 0; j < 16; ++j) { const unsigned c = xb_ld(&bar[XB_XCNT(j)]); sum += c; cnt += (c > 0u) ? 1u : 0u; mine = (j == x) ? c : mine; }
    if (sum == G) break;
    __builtin_amdgcn_s_sleep(1);
    if ((++sp & 255u) == 0u) { if (xb_ld(&bar[XB_TMO])) break; if (sp > XB_SPIN_CAP) { atomicAdd(&bar[XB_TMO], 1u); break; } }
  }
  nloc = mine > 0u ? mine : 1u; nx = cnt > 0u ? cnt : 1u;
}
DI void xcd_barrier(const XcdBarrier& b) {
  asm volatile("s_waitcnt vmcnt(0)" ::: "memory");
  __syncthreads();
  if (threadIdx.x == 0) {
    unsigned* bar = b.bar;
    __builtin_amdgcn_s_waitcnt(0);
    unsigned nloc = b.st[0], nx = b.st[1];
    if (nloc == 0u) { xcd_barrier_complete(bar, b.x, nloc, nx); b.st[0] = nloc; b.st[1] = nx; }
    const unsigned old = xb_add(&bar[XB_XSUB(b.x)], 1u);
    const unsigned gen = old / nloc;
    if (old + 1u == (gen + 1u) * nloc) {
      __builtin_amdgcn_fence(__ATOMIC_RELEASE, "agent");
      asm volatile("s_waitcnt vmcnt(0)" ::: "memory");
      const unsigned og = xb_add(&bar[XB_TOP], 1u);
      const unsigned tg = og / nx;
      if (og + 1u == (tg + 1u) * nx) xb_add(&bar[XB_TOPGEN], 1u);
      else XB_SPIN(xb_ld(&bar[XB_TOPGEN]) == tg, bar);
      __builtin_amdgcn_fence(__ATOMIC_ACQUIRE, "agent");
      xb_add(&bar[XB_XGEN(b.x)], 1u);
      asm volatile("s_waitcnt vmcnt(0)" ::: "memory");
    } else {
      XB_SPIN(xb_ld(&bar[XB_XGEN(b.x)]) == gen, bar);
      __builtin_amdgcn_fence(__ATOMIC_ACQUIRE, "agent");
      asm volatile("s_waitcnt vmcnt(0)" ::: "memory");
    }
  }
  __syncthreads();
}

DI void p0_norm_row(const Params& P, int t, bf16_t* hn, int lane) {
  const int b = t / L, p = t % L;
  const float* row = p < NMETA ? P.meta + (size_t)p * D : P.x + ((size_t)b * SEQ + (p - NMETA)) * D;
  f32x4 v[4]; float s = 0.f;
#pragma unroll
  for (int i = 0; i < 4; ++i) { v[i] = *(const f32x4*)(row + 256 * i + 4 * lane); s += v[i][0] * v[i][0] + v[i][1] * v[i][1] + v[i][2] * v[i][2] + v[i][3] * v[i][3]; }
  s = wave_sum(s);
  const float rs = rsqrtf(s * (1.f / D) + EPS);
#pragma unroll
  for (int i = 0; i < 4; ++i) {
    const f32x4 g = *(const f32x4*)(P.g_mix + 256 * i + 4 * lane);
    u32x2 o; o[0] = pk2(v[i][0] * rs * g[0], v[i][1] * rs * g[1]); o[1] = pk2(v[i][2] * rs * g[2], v[i][3] * rs * g[3]);
    *(u32x2*)(hn + (size_t)t * D + 256 * i + 4 * lane) = o;
  }
}
template <class F>
DI void transpose_item(const float* src, int ldsrc, int K, bf16_t* dst, F map, int item, float* scr  , int tid, bool valid) {
  const int nkb = K / 64, kb = item % nkb, nb = item / nkb, k0 = kb * 64, n0 = nb * 64;
  if (valid) {
    const int n = tid & 63; const int col = map(n0 + n);
#pragma unroll 4
    for (int i = 0; i < 16; ++i) { const int k = (tid >> 6) + 4 * i; scr[k * 65 + n] = col >= 0 ? src[(size_t)(k0 + k) * ldsrc + col] : 0.f; }
  }
  __syncthreads();
  if (valid) {
    const int kq = tid & 7;
#pragma unroll
    for (int i = 0; i < 2; ++i) {
      const int n = (tid >> 3) + 32 * i;
      const float* s = scr + (kq * 8) * 65 + n;
      u32x4 o; o[0] = pk2(s[0], s[65]); o[1] = pk2(s[2 * 65], s[3 * 65]); o[2] = pk2(s[4 * 65], s[5 * 65]); o[3] = pk2(s[6 * 65], s[7 * 65]);
      *(u32x4*)(dst + (size_t)(n0 + n) * K + k0 + kq * 8) = o;
    }
  }
  __syncthreads();
}
struct MapIn {
  DI int operator()(int n) const {
    if (n < 416) return n;
    if (n < 424) return 2528 + (n - 416);
    if (n < 488) return 2464 + (n - 424);
    if (n < 512) return -1;
    return 416 + (n - 512);
  }
};
struct MapOff { int off; DI int operator()(int n) const { return off + n; } };
struct MapUkv { DI int operator()(int n) const { const int m = n & 511; return (m >> 6) * 128 + (n >> 9) * 64 + (m & 63); } };

DI void p0_prologue(const Params& P, unsigned char* lds) {
  unsigned char* ws = P.ws;
  const int tid = threadIdx.x, lane = tid & 63, wv = tid >> 6;
  const int gw = blockIdx.x * NW + wv, ngw = gridDim.x * NW;
  bf16_t* hn = (bf16_t*)(P.ws + O_HN);
  for (int t = gw; t < NT; t += ngw) p0_norm_row(P, t, hn, lane);
  float* rope = (float*)(ws + O_ROPE);
  for (int i = blockIdx.x * NTHR + tid; i < L * 16; i += gridDim.x * NTHR) {
    const int p = i >> 4, j = i & 15;
    const float inv = powf(10000.f, -(float)j / 16.f);
    const float ang = (float)p * inv;
    float sn, cs; sincosf(ang, &sn, &cs);
    rope[p * 32 + j] = cs; rope[p * 32 + 16 + j] = sn;
  }
  {
    bf16_t* vbt = (bf16_t*)(ws + O_VBT); bf16_t* vt = (bf16_t*)(ws + O_VT);
    for (int i = blockIdx.x * NTHR + tid; i < NB * 8 * 64 * (LP - L); i += gridDim.x * NTHR) {
      const int r = i / (LP - L), c = L + i % (LP - L);
      vbt[(size_t)r * LP + c] = 0; vt[(size_t)r * LP + c] = 0;
    }
  }
  {
    float* wr = (float*)(ws + O_WR);
    for (int i = blockIdx.x * NTHR + tid; i < 36 * 1024; i += gridDim.x * NTHR) {
      const int c = i >> 10, k = i & 1023;
      wr[i] = c < 4 ? P.w_rg[k * 4 + c] : P.w_re[k * 32 + (c - 4)];
    }
  }
  const int half = tid >> 8, t2 = tid & 255;
  float* scr = (float*)lds + half * (64 * 65 + 32);
  constexpr int I_IN = (1024 / 64) * (2560 / 64), I_G = (1024 / 64) * (2048 / 64), I_UQ = (256 / 64) * (768 / 64), I_UKV = (128 / 64) * (1024 / 64),
                I_BR = (512 / 64) * (1024 / 64), I_O = (1024 / 64) * (1024 / 64);
  constexpr int NIT = I_IN + I_G + I_UQ + I_UKV + 2 * I_BR + I_O;
  for (int it2 = blockIdx.x; 2 * it2 < NIT; it2 += gridDim.x) {
    int r = 2 * it2 + half; const bool valid = r < NIT; if (!valid) r = 0;
    if (r < I_IN) transpose_item(P.w_in, INC, 1024, (bf16_t*)(ws + O_WIN), MapIn(), r, scr, t2, valid);
    else if ((r -= I_IN) < I_G) transpose_item(P.w_in, INC, 1024, (bf16_t*)(ws + O_WG), MapOff{2536}, r, scr, t2, valid);
    else if ((r -= I_G) < I_UQ) transpose_item(P.w_uq, 768, 256, (bf16_t*)(ws + O_WUQ), MapOff{0}, r, scr, t2, valid);
    else if ((r -= I_UQ) < I_UKV) transpose_item(P.w_ukv, 1024, 128, (bf16_t*)(ws + O_WUKV), MapUkv{}, r, scr, t2, valid);
    else if ((r -= I_UKV) < I_BR) transpose_item(P.w_bra, 1024, 512, (bf16_t*)(ws + O_WBRA), MapOff{0}, r, scr, t2, valid);
    else if ((r -= I_BR) < I_BR) transpose_item(P.w_brb, 1024, 512, (bf16_t*)(ws + O_WBRB), MapOff{0}, r, scr, t2, valid);
    else { r -= I_BR; transpose_item(P.w_o, 1024, 1024, (bf16_t*)(ws + O_WO), MapOff{0}, r, scr, t2, valid); }
  }
}

struct TilePtrs { const bf16_t* A; const bf16_t* B; unsigned a[4], b[4]; };
DI void glds16(const unsigned char* g, unsigned char* l) { __builtin_amdgcn_global_load_lds((const unsigned*)g, (unsigned*)l, 16, 0, 0); }
template <bool SWAP>
DI void gemm_kloop(f32x16 (&acc)[4][2], const TilePtrs& tp, int K, unsigned char* lds) {
  const int tid = threadIdx.x, lane = tid & 63, w = __builtin_amdgcn_readfirstlane(tid >> 6), wr = w >> 2, wc = w & 3;
  const int nt = K / 64;
  unsigned char* const lw = lds + w * 1024;
  const int swz = (lane >> 1) & 7, hh = lane >> 5;
  const unsigned char* const ar = lds + (wr * 64 + (lane & 31)) * 128;
  const unsigned char* const br = lds + GX_A + (wc * 32 + (lane & 31)) * 128;
  int coff[4];
#pragma unroll
  for (int kk = 0; kk < 4; ++kk) coff[kk] = ((2 * kk + hh) ^ swz) * 16;
  bf16x8 At[2][4], B0[4], B1[4];
  unsigned oa[4], ob[4];
#pragma unroll
  for (int j = 0; j < 4; ++j) { oa[j] = tp.a[j]; ob[j] = tp.b[j]; }
#define HT_(BO_, H_) ((BO_) + (H_) * 16384)
#define STG_A(BO_, H_, kt) do { const unsigned char* g_ = (const unsigned char*)tp.A + (kt) * 128; glds16(g_ + oa[2 * (H_)], lw + HT_(BO_, H_)); glds16(g_ + oa[2 * (H_) + 1], lw + HT_(BO_, H_) + 8192); } while (0)
#define STG_B(BO_, H_, kt) do { const unsigned char* g_ = (const unsigned char*)tp.B + (kt) * 128; glds16(g_ + ob[2 * (H_)], lw + GX_A + HT_(BO_, H_)); glds16(g_ + ob[2 * (H_) + 1], lw + GX_A + HT_(BO_, H_) + 8192); } while (0)
#define PIN_OFFS() do { _Pragma("unroll") for (int j_ = 0; j_ < 4; ++j_) { asm volatile("" : "+v"(oa[j_])); asm volatile("" : "+v"(ob[j_])); } } while (0)
#define LDA_(BO_, H_) do { _Pragma("unroll") for (int m_ = 0; m_ < 2; ++m_) _Pragma("unroll") for (int k_ = 0; k_ < 4; ++k_) At[m_][k_] = *(const bf16x8*)(ar + HT_(BO_, H_) + m_ * 4096 + coff[k_]); } while (0)
#define LDB_(Bx, BO_, H_) do { _Pragma("unroll") for (int k_ = 0; k_ < 4; ++k_) Bx[k_] = *(const bf16x8*)(br + HT_(BO_, H_) + coff[k_]); } while (0)
#define MMA_(ai, bj, Bx) do { __builtin_amdgcn_s_setprio(1); _Pragma("unroll") for (int k_ = 0; k_ < 4; ++k_) _Pragma("unroll") for (int m_ = 0; m_ < 2; ++m_) \
    acc[2 * (ai) + m_][bj] = SWAP ? __builtin_amdgcn_mfma_f32_32x32x16_bf16(Bx[k_], At[m_][k_], acc[2 * (ai) + m_][bj], 0, 0, 0) \
                                  : __builtin_amdgcn_mfma_f32_32x32x16_bf16(At[m_][k_], Bx[k_], acc[2 * (ai) + m_][bj], 0, 0, 0); __builtin_amdgcn_s_setprio(0); } while (0)
#define WAIT_V(n) asm volatile("s_waitcnt vmcnt(" #n ")" ::: "memory")
#define WAIT_L(n) asm volatile("s_waitcnt lgkmcnt(" #n ")" ::: "memory")
#define BAR_ __builtin_amdgcn_s_barrier()
#define SCHED_ __builtin_amdgcn_sched_barrier(0)
  WAIT_V(0);
  PIN_OFFS();
  STG_B(0, 0, 0); STG_A(0, 0, 0); STG_B(0, 1, 0); STG_A(0, 1, 0);
  if (wr == 1) BAR_;
  WAIT_V(4); BAR_;
  STG_B(GX_STAGE, 0, 1); STG_A(GX_STAGE, 0, 1); STG_B(GX_STAGE, 1, 1);
  WAIT_V(6); BAR_;
  int cur = 0;
#pragma unroll 1
  for (int t = 0; t < nt - 2; ++t) {
    asm volatile("" : "+s"(cur));
    PIN_OFFS();
    const int nxt = cur ^ GX_STAGE;
    LDB_(B0, cur, 0); SCHED_; LDA_(cur, 0); STG_A(nxt, 1, t + 1);
    WAIT_L(8); BAR_; WAIT_L(0); MMA_(0, 0, B0); BAR_; SCHED_;
    LDB_(B1, cur, 1); STG_B(cur, 0, t + 2);
    BAR_; WAIT_L(0); MMA_(0, 1, B1); BAR_;
    LDA_(cur, 1); STG_A(cur, 0, t + 2);
    BAR_; WAIT_L(0); MMA_(1, 0, B0); BAR_; SCHED_;
    STG_B(cur, 1, t + 2);
    WAIT_V(6); BAR_; MMA_(1, 1, B1); BAR_;
    cur = nxt;
  }
  { asm volatile("" : "+s"(cur));
    PIN_OFFS();
    const int nxt = cur ^ GX_STAGE;
    LDB_(B0, cur, 0); LDA_(cur, 0); STG_A(nxt, 1, nt - 1);
    BAR_; WAIT_L(0); MMA_(0, 0, B0); BAR_;
    LDB_(B1, cur, 1); BAR_; WAIT_L(0); MMA_(0, 1, B1); BAR_;
    LDA_(cur, 1); WAIT_V(4); BAR_; WAIT_L(0); MMA_(1, 0, B0); MMA_(1, 1, B1); BAR_;
    LDB_(B0, nxt, 0); LDA_(nxt, 0); WAIT_V(2); BAR_; WAIT_L(0); MMA_(0, 0, B0); BAR_;
    LDB_(B1, nxt, 1); WAIT_V(0); BAR_; WAIT_L(0); MMA_(0, 1, B1); BAR_;
    LDA_(nxt, 1); BAR_; WAIT_L(0); MMA_(1, 0, B0); MMA_(1, 1, B1); BAR_; }
  if (wr == 0) BAR_;
#undef HT_
#undef STG_A
#undef STG_B
#undef LDA_
#undef LDB_
#undef MMA_
#undef PIN_OFFS
}
DI void tile_rc(int i, int& row, int& chunk) { const int t = threadIdx.x; row = (i >> 1) * 128 + (i & 1) * 64 + (t >> 3); chunk = (t & 7) ^ ((row >> 1) & 7); }
DI int acc_row0(int wr, int mi) { return (mi >> 1) * 128 + wr * 64 + (mi & 1) * 32; }
DI int acc_col0(int wc, int ni) { return ni * 128 + wc * 32; }
DI u32x2 pk4(float a, float b, float c, float d) { u32x2 o; o[0] = pk2(a, b); o[1] = pk2(c, d); return o; }
DI void zero_acc(f32x16 (&acc)[4][2]) {
#pragma unroll
  for (int i = 0; i < 4; ++i)
#pragma unroll
    for (int j = 0; j < 2; ++j)
#pragma unroll
      for (int r = 0; r < 16; ++r) acc[i][j][r] = 0.f;
}
DI void set_ptrs(TilePtrs& tp, const bf16_t* A, int lda, int M, int m0, const bf16_t* Bt, int ldb, int N, int n0) {
#pragma unroll
  for (int i = 0; i < 4; ++i) {
    int row, kc; tile_rc(i, row, kc);
    int r = m0 + row; r = r < M ? r : M - 1;
    int c = n0 + row; c = c < N ? c : N - 1;
    tp.a[i] = ((unsigned)r * (unsigned)lda + kc * 8) * 2u;
    tp.b[i] = ((unsigned)c * (unsigned)ldb + kc * 8) * 2u;
  }
  tp.A = A; tp.B = Bt;
}

DI bool p1_tile_map(int bx, int k, int G, int& mt, int& nt) { const int t = bx + k * G; if (t >= 65 * 18) return false; mt = t / 18; nt = t % 18; return true; }
DI bool p78_tile_map(int bx, int k, int G, int& mt, int& nt) { const int t = bx + k * G; if (t >= 64 * 4) return false; mt = t >> 2; nt = t & 3; return true; }

DI void p1_inproj_tile(const Params& P, int mt, int nt, unsigned char* lds) {
  unsigned char* ws = P.ws;
  const int m0 = mt * 256, n0 = nt * 256;
  const bf16_t* hn = (const bf16_t*)(ws + O_HN);
  TilePtrs tp;
  if (n0 < 2560) set_ptrs(tp, hn, 1024, NT, m0, (const bf16_t*)(ws + O_WIN), 1024, 2560, n0);
  else set_ptrs(tp, hn, 1024, NT, m0, (const bf16_t*)(ws + O_WG), 1024, 2048, n0 - 2560);
  f32x16 acc[4][2]; zero_acc(acc);
  const int lane = threadIdx.x & 63, w = threadIdx.x >> 6, wr = w >> 2, wc = w & 3, hh = lane >> 5, lc = lane & 31;
  const int seg = n0 / 512, cb = n0 % 512;
  if (seg == 3) {
    gemm_kloop<false>(acc, tp, 1024, lds);
    bf16_t* vbt = (bf16_t*)(ws + O_VBT);
#pragma unroll
    for (int mi = 0; mi < 4; ++mi)
#pragma unroll
      for (int ni = 0; ni < 2; ++ni) {
        const int col = cb + acc_col0(wc, ni) + lc;
        const int rbase = m0 + acc_row0(wr, mi) + 4 * hh;
        const int h = col >> 6, d = col & 63;
#pragma unroll
        for (int g = 0; g < 4; ++g) {
          const int row = rbase + 8 * g;
          if (row < NT) {
            const int b = row / L, p = row % L;
            *(u32x2*)(vbt + ((size_t)(b * 8 + h) * 64 + d) * LP + p) = pk4(acc[mi][ni][4 * g], acc[mi][ni][4 * g + 1], acc[mi][ni][4 * g + 2], acc[mi][ni][4 * g + 3]);
          }
        }
      }
    return;
  }
  gemm_kloop<true>(acc, tp, 1024, lds);
  if (n0 >= 2560) {
    bf16_t* gates = (bf16_t*)P.out;
#pragma unroll
    for (int mi = 0; mi < 4; ++mi) {
      int row = m0 + acc_row0(wr, mi) + lc;
      asm volatile("" : "+v"(row));
      const int b = row / L, p = row - b * L;
      const bool ok = row < NT && p >= NMETA;
      bf16_t* gp = gates + (size_t)(row - NMETA * (b + 1)) * 2048 + (n0 - 2560) + 4 * hh;
#pragma unroll
      for (int ni = 0; ni < 2; ++ni)
#pragma unroll
        for (int g = 0; g < 4; ++g) {
          float sg[4];
#pragma unroll
          for (int e = 0; e < 4; ++e) sg[e] = __builtin_amdgcn_rcpf(1.f + __expf(-acc[mi][ni][4 * g + e]));
          if (ok) *(u32x2*)(gp + acc_col0(wc, ni) + 8 * g) = pk4(sg[0], sg[1], sg[2], sg[3]);
        }
    }
    return;
  }
#pragma unroll
  for (int mi = 0; mi < 4; ++mi) {
    int row = m0 + acc_row0(wr, mi) + lc;
    asm volatile("" : "+v"(row));
    const bool ok = row < NT;
    if (seg == 0) {
      float* sp = (float*)(ws + O_SMALL) + (size_t)row * 512 + cb + 4 * hh;
#pragma unroll
      for (int ni = 0; ni < 2; ++ni)
#pragma unroll
        for (int g = 0; g < 4; ++g) {
          f32x4 o; o[0] = acc[mi][ni][4 * g]; o[1] = acc[mi][ni][4 * g + 1]; o[2] = acc[mi][ni][4 * g + 2]; o[3] = acc[mi][ni][4 * g + 3];
          if (ok) *(f32x4*)(sp + acc_col0(wc, ni) + 8 * g) = o;
        }
    } else {
      bf16_t* dp = (bf16_t*)(ws + (seg == 1 ? O_QB : seg == 2 ? O_KB : O_QI)) + (size_t)row * 512 + cb + 4 * hh;
      const float sc = seg == 4 ? 0.125f : seg == 1 ? 0.125f * LOG2E : 1.f;
#pragma unroll
      for (int ni = 0; ni < 2; ++ni)
#pragma unroll
        for (int g = 0; g < 4; ++g)
          if (ok) *(u32x2*)(dp + acc_col0(wc, ni) + 8 * g) = pk4(acc[mi][ni][4 * g] * sc, acc[mi][ni][4 * g + 1] * sc, acc[mi][ni][4 * g + 2] * sc, acc[mi][ni][4 * g + 3] * sc);
    }
  }
}

DI void p2a_token(const Params& P, int t, int lane) {
  unsigned char* ws = P.ws;
  const float* sm = (const float*)(ws + O_SMALL) + (size_t)t * 512;
  const int b = t / L, p = t % L;
  {
    const f32x4 v = *(const f32x4*)(sm + S_CQ + 4 * lane);
    const float s = wave_sum(v[0] * v[0] + v[1] * v[1] + v[2] * v[2] + v[3] * v[3]);
    const float rs = rsqrtf(s * (1.f / 256) + EPS);
    const f32x4 g = *(const f32x4*)(P.g_cq + 4 * lane);
    u32x2 o; o[0] = pk2(v[0] * rs * g[0], v[1] * rs * g[1]); o[1] = pk2(v[2] * rs * g[2], v[3] * rs * g[3]);
    *(u32x2*)((bf16_t*)(ws + O_CQN) + (size_t)t * 256 + 4 * lane) = o;
  }
  {
    const float v0 = sm[S_CKV + 2 * lane], v1 = sm[S_CKV + 2 * lane + 1];
    const float s = wave_sum(v0 * v0 + v1 * v1);
    const float rs = rsqrtf(s * (1.f / 128) + EPS);
    *(unsigned*)((bf16_t*)(ws + O_CKVN) + (size_t)t * 128 + 2 * lane) = pk2(v0 * rs * P.g_ckv[2 * lane], v1 * rs * P.g_ckv[2 * lane + 1]);
  }
  {
    const float* rp = (const float*)(ws + O_ROPE) + p * 32;
    const int j = lane & 15;
    const float x1 = sm[S_KR + j], x2 = sm[S_KR + 16 + j], cs = rp[j], sn = rp[16 + j];
    const float o = (lane & 16) ? (x1 * sn + x2 * cs) : (x1 * cs - x2 * sn);
    bf16_t* km = (bf16_t*)(ws + O_KMLA);
    const bf16_t ob = f2bf(o);
    const int c = lane & 31;
#pragma unroll
    for (int hq = 0; hq < 4; ++hq) { const int h = hq + 4 * (lane >> 5); km[((size_t)(b * 8 + h) * LP + p) * 96 + 64 + c] = ob; }
  }
  ((bf16_t*)(ws + O_KI))[(size_t)t * 64 + lane] = f2bf(sm[S_KI + lane]);
  if (lane < 8) ((float*)(ws + O_WI))[(size_t)t * 8 + lane] = sm[S_WI + lane] * 0.35355339059327373f;
}

DI void p2b_q_tile(const Params& P, int tile, unsigned char* lds) {
  unsigned char* ws = P.ws;
  constexpr int NNT = 768 / 256;
  const int mt = tile / NNT, nt = tile % NNT, m0 = mt * 256, n0 = nt * 256;
  TilePtrs tp; set_ptrs(tp, (const bf16_t*)(ws + O_CQN), 256, NT, m0, (const bf16_t*)(ws + O_WUQ), 256, 768, n0);
  f32x16 acc[4][2]; zero_acc(acc);
  gemm_kloop<true>(acc, tp, 256, lds);
  const int lane = threadIdx.x & 63, w = threadIdx.x >> 6, wr = w >> 2, wc = w & 3, hh = lane >> 5, lc = lane & 31;
  const float qscale = 0.10206207261596575f * LOG2E;
  const float* rope = (const float*)(ws + O_ROPE);
  bf16_t* qa = (bf16_t*)(ws + O_QA);
#pragma unroll
  for (int mi = 0; mi < 4; ++mi) {
    int row = m0 + acc_row0(wr, mi) + lc;
    asm volatile("" : "+v"(row));
    const bool ok = row < NT;
    const int rowc = ok ? row : NT - 1, p = rowc % L;
#pragma unroll
    for (int ni = 0; ni < 2; ++ni) {
      const int c0 = n0 + acc_col0(wc, ni);
      const bool is_rope = ((c0 >> 5) % 3) == 2;
      float v[16];
#pragma unroll
      for (int r = 0; r < 16; ++r) v[r] = acc[mi][ni][r];
      if (is_rope) {
#pragma unroll
        for (int g = 0; g < 2; ++g) {
          const f32x4 cs = *(const f32x4*)(rope + p * 32 + 8 * g + 4 * hh), sn = *(const f32x4*)(rope + p * 32 + 16 + 8 * g + 4 * hh);
#pragma unroll
          for (int e = 0; e < 4; ++e) {
            const float lo = v[4 * g + e], hi = v[4 * (g + 2) + e];
            v[4 * g + e] = lo * cs[e] - hi * sn[e];
            v[4 * (g + 2) + e] = lo * sn[e] + hi * cs[e];
          }
        }
      }
#pragma unroll
      for (int g = 0; g < 4; ++g)
        if (ok) *(u32x2*)(qa + (size_t)row * 768 + c0 + 8 * g + 4 * hh) = pk4(v[4 * g] * qscale, v[4 * g + 1] * qscale, v[4 * g + 2] * qscale, v[4 * g + 3] * qscale);
    }
  }
}
DI void p2b_kv_tile(const Params& P, int tile, unsigned char* lds) {
  unsigned char* ws = P.ws;
  constexpr int NNT = 1024 / 256;
  const int mt = tile / NNT, nt = tile % NNT, m0 = mt * 256, n0 = nt * 256;
  TilePtrs tp; set_ptrs(tp, (const bf16_t*)(ws + O_CKVN), 128, NT, m0, (const bf16_t*)(ws + O_WUKV), 128, 1024, n0);
  f32x16 acc[4][2]; zero_acc(acc);
  const int lane = threadIdx.x & 63, w = threadIdx.x >> 6, wr = w >> 2, wc = w & 3, hh = lane >> 5, lc = lane & 31;
  if (nt < 2) {
    gemm_kloop<true>(acc, tp, 128, lds);
    bf16_t* km = (bf16_t*)(ws + O_KMLA);
#pragma unroll
    for (int mi = 0; mi < 4; ++mi) {
      int row = m0 + acc_row0(wr, mi) + lc;
      asm volatile("" : "+v"(row));
      const bool ok = row < NT;
      const int b = row / L, p = row % L;
#pragma unroll
      for (int ni = 0; ni < 2; ++ni) {
        const int cc = n0 + acc_col0(wc, ni), h = cc >> 6, c = (cc & 63) + 4 * hh;
        bf16_t* kp = km + ((size_t)(b * 8 + h) * LP + p) * 96 + c;
#pragma unroll
        for (int g = 0; g < 4; ++g)
          if (ok) *(u32x2*)(kp + 8 * g) = pk4(acc[mi][ni][4 * g], acc[mi][ni][4 * g + 1], acc[mi][ni][4 * g + 2], acc[mi][ni][4 * g + 3]);
      }
    }
  } else {
    gemm_kloop<false>(acc, tp, 128, lds);
    bf16_t* vt = (bf16_t*)(ws + O_VT);
#pragma unroll
    for (int mi = 0; mi < 4; ++mi)
#pragma unroll
      for (int ni = 0; ni < 2; ++ni) {
        const int cc = n0 - 512 + acc_col0(wc, ni) + lc, h = cc >> 6, d = cc & 63;
        const int rbase = m0 + acc_row0(wr, mi) + 4 * hh;
#pragma unroll
        for (int g = 0; g < 4; ++g) {
          const int row = rbase + 8 * g;
          if (row < NT) {
            const int b = row / L, p = row % L;
            *(u32x2*)(vt + ((size_t)(b * 8 + h) * 64 + d) * LP + p) = pk4(acc[mi][ni][4 * g], acc[mi][ni][4 * g + 1], acc[mi][ni][4 * g + 2], acc[mi][ni][4 * g + 3]);
          }
        }
      }
  }
}


DI int next_item(const Params& P, int ctr, int* slot) {
  __syncthreads();
  if (threadIdx.x == 0) *slot = (int)atomicAdd((unsigned*)(P.ws + O_CTR) + ctr, 1u);
  __syncthreads();
  return *slot;
}
DI float fast_exp2(float x) { return __builtin_amdgcn_exp2f(x); }
DI bf16x8 pack8(const f32x16& v, int s) {
  u32x4 p;
  p[0] = pk2(v[8 * s + 0], v[8 * s + 1]); p[1] = pk2(v[8 * s + 2], v[8 * s + 3]); p[2] = pk2(v[8 * s + 4], v[8 * s + 5]); p[3] = pk2(v[8 * s + 6], v[8 * s + 7]);
  return __builtin_bit_cast(bf16x8, p);
}

constexpr float MASKV = -3.0e38f;
constexpr float DEFER_THR = 6.0f;
DI float xmax32(float v) {
  const auto r = __builtin_amdgcn_permlane32_swap(__float_as_uint(v), __float_as_uint(v), false, false);
  return fmaxf(__uint_as_float(r[0]), __uint_as_float(r[1]));
}
DI void softmax_update1(f32x16& s, float& m, float mref, float& lsum, f32x16& o0, f32x16& o1) {
  float mx = s[0];
#pragma unroll
  for (int r = 1; r < 16; ++r) mx = fmaxf(mx, s[r]);
  mx = xmax32(mx);
  const bool have = m > -1e29f;
  const float shift = (have ? m : 0.f) - mref;
  const bool need = (mx - shift > DEFER_THR) || (!have && mx > -1e37f);
  if (__any(need || shift != 0.f)) {
    const float delta = need ? mx - shift : 0.f;
    const float alpha = (need && have) ? fast_exp2(-delta) : 1.f;
    m = need ? (have ? m : 0.f) + delta : m;
    const float sub = shift + delta;
#pragma unroll
    for (int r = 0; r < 16; ++r) { s[r] -= sub; o0[r] *= alpha; o1[r] *= alpha; }
    lsum *= alpha;
  }
#pragma unroll
  for (int r = 0; r < 16; ++r) s[r] = fast_exp2(s[r]);
  typedef float f32x2 __attribute__((ext_vector_type(2)));
  f32x2 ps = {0.f, 0.f};
#pragma unroll
  for (int r = 0; r < 16; r += 2) ps += (f32x2){s[r], s[r + 1]};
  lsum += ps[0] + ps[1];
}
DI void pv_subtile(const unsigned char* Vc, int vstr, const f32x16& p, f32x16& o0, f32x16& o1) {
#pragma unroll
  for (int s2 = 0; s2 < 2; ++s2) {
    const bf16x8 pb = pack8(p, s2);
    const u32x2 a0l = *(const u32x2*)(Vc + s2 * 32), a0h = *(const u32x2*)(Vc + s2 * 32 + 16);
    const u32x2 a1l = *(const u32x2*)(Vc + 32 * vstr + s2 * 32), a1h = *(const u32x2*)(Vc + 32 * vstr + s2 * 32 + 16);
    o0 = __builtin_amdgcn_mfma_f32_32x32x16_bf16(__builtin_bit_cast(bf16x8, (u32x4){a0l[0], a0l[1], a0h[0], a0h[1]}), pb, o0, 0, 0, 0);
    o1 = __builtin_amdgcn_mfma_f32_32x32x16_bf16(__builtin_bit_cast(bf16x8, (u32x4){a1l[0], a1l[1], a1h[0], a1h[1]}), pb, o1, 0, 0, 0);
  }
}
constexpr int MLA_KSTR = 208, MLA_VSTR = 136, MLA_KBYTES = 64 * MLA_KSTR, MLA_STAGE = MLA_KBYTES + 64 * MLA_VSTR;
DI void mla_stage(const unsigned char* cur, int s, int cw, int lq, int hh, const bf16x8 (&qf)[6], f32x16& o0, f32x16& o1, float& m, float& lsum) {
  if (s > cw) return;
  const bool full = s < cw;
  const float mref = m > -1e29f ? m : 0.f;
  f32x16 s0, s1;
#pragma unroll
  for (int r = 0; r < 16; ++r) { s0[r] = -mref; s1[r] = -mref; }
  const unsigned char* Kc = cur + lq * MLA_KSTR + hh * 16;
  {
    bf16x8 kf[6];
#pragma unroll
    for (int kk = 0; kk < 6; ++kk) kf[kk] = *(const bf16x8*)(Kc + kk * 32);
#pragma unroll
    for (int kk = 0; kk < 6; ++kk) s0 = __builtin_amdgcn_mfma_f32_32x32x16_bf16(kf[kk], qf[kk], s0, 0, 0, 0);
    __builtin_amdgcn_sched_group_barrier(0x100, 6, 0);
    __builtin_amdgcn_sched_group_barrier(0x008, 6, 0);
  }
  if (full) {
    bf16x8 kf[6];
#pragma unroll
    for (int kk = 0; kk < 6; ++kk) kf[kk] = *(const bf16x8*)(Kc + 32 * MLA_KSTR + kk * 32);
#pragma unroll
    for (int kk = 0; kk < 6; ++kk) s1 = __builtin_amdgcn_mfma_f32_32x32x16_bf16(kf[kk], qf[kk], s1, 0, 0, 0);
    __builtin_amdgcn_sched_group_barrier(0x100, 6, 0);
    __builtin_amdgcn_sched_group_barrier(0x008, 6, 0);
  } else {
#pragma unroll
    for (int r = 8; r < 16; ++r) s0[r] = MASKV;
  }
  const unsigned char* Vc = cur + MLA_KBYTES + lq * MLA_VSTR + hh * 8;
  softmax_update1(s0, m, mref, lsum, o0, o1);
  pv_subtile(Vc, MLA_VSTR, s0, o0, o1);
  if (full) {
    softmax_update1(s1, m, mref, lsum, o0, o1);
    pv_subtile(Vc + 64, MLA_VSTR, s1, o0, o1);
  }
}
DI void mla_item(const Params& P, int item, unsigned char* lds) {
  unsigned char* ws = P.ws;
  const int jq = 15 - item / 32, bh = item % 32, b = bh >> 3, h = bh & 7;
  const int c0 = 4 * jq + 1;
  const int tid = threadIdx.x, lane = tid & 63, w = __builtin_amdgcn_readfirstlane(tid >> 6), hh = lane >> 5, lq = lane & 31;
  const int cw = c0 + (w >> 1);
  const int pq = NMETA + 256 * jq + 32 * w + lq;
  const int tq = b * L + pq;
  bf16x8 qf[6];
  {
    const bf16_t* qrow = (const bf16_t*)(ws + O_QA) + (size_t)tq * 768 + h * 96 + hh * 8;
#pragma unroll
    for (int kk = 0; kk < 6; ++kk) qf[kk] = *(const bf16x8*)(qrow + kk * 16);
  }
  f32x16 o0, o1;
#pragma unroll
  for (int r = 0; r < 16; ++r) { o0[r] = 0.f; o1[r] = 0.f; }
  float m = -1e30f, lsum = 0.f;
  const int nst = c0 + 4;
  const bf16_t* kg = (const bf16_t*)(ws + O_KMLA) + (size_t)bh * LP * 96;
  const bf16_t* vg = (const bf16_t*)(ws + O_VT) + (size_t)bh * 64 * LP;
  unsigned kgo[2], klo[2], vgo, vlo;
  const bool k2 = tid < 256;
#pragma unroll
  for (int i = 0; i < 2; ++i) { int idx = tid + 512 * i; idx = idx < 768 ? idx : 767; const int row = idx / 12, c = idx % 12; kgo[i] = row * 96 + c * 8; klo[i] = row * MLA_KSTR + c * 16; }
  { const int d = tid >> 3, c = tid & 7; vgo = d * LP + c * 8; vlo = MLA_KBYTES + d * MLA_VSTR + c * 16; }
  u32x4 rkA[2], rvA, rkB[2], rvB;
#define MLA_LOAD(rk_, rv_, st) do { const bf16_t* kgs = kg + (size_t)(st) * 64 * 96; const bf16_t* vgs = vg + (st) * 64; \
    rk_[0] = *(const u32x4*)(kgs + kgo[0]); rk_[1] = *(const u32x4*)(kgs + kgo[1]); rv_ = *(const u32x4*)(vgs + vgo); } while (0)
#define MLA_WRITE(rk_, rv_, buf) do { unsigned char* nb_ = (buf); \
    *(u32x4*)(nb_ + klo[0]) = rk_[0]; if (k2) *(u32x4*)(nb_ + klo[1]) = rk_[1]; \
    *(u32x2*)(nb_ + vlo) = (u32x2){rv_[0], rv_[1]}; *(u32x2*)(nb_ + vlo + 8) = (u32x2){rv_[2], rv_[3]}; } while (0)
  unsigned char* buf0 = lds; unsigned char* buf1 = lds + MLA_STAGE;
  MLA_LOAD(rkA, rvA, 0); MLA_WRITE(rkA, rvA, buf0);
  __syncthreads();
  if (nst > 1) MLA_LOAD(rkA, rvA, 1);
#pragma unroll 1
  for (int s = 0; s < nst; s += 2) {
    if (s + 2 < nst) MLA_LOAD(rkB, rvB, s + 2);
    mla_stage(buf0, s, cw, lq, hh, qf, o0, o1, m, lsum);
    if (s + 1 < nst) MLA_WRITE(rkA, rvA, buf1);
    __syncthreads();
    if (s + 1 >= nst) break;
    if (s + 3 < nst) MLA_LOAD(rkA, rvA, s + 3);
    mla_stage(buf1, s + 1, cw, lq, hh, qf, o0, o1, m, lsum);
    if (s + 2 < nst) MLA_WRITE(rkB, rvB, buf0);
    __syncthreads();
  }
#undef MLA_LOAD
#undef MLA_WRITE
  lsum += __shfl_xor(lsum, 32);
  const float inv = 1.f / lsum;
  bf16_t* oa = (bf16_t*)(ws + O_OA) + (size_t)(tq - NMETA * (b + 1)) * 512 + h * 64 + 4 * hh;
#pragma unroll
  for (int g = 0; g < 4; ++g) {
    u32x2 v0, v1;
    v0[0] = pk2(o0[4 * g] * inv, o0[4 * g + 1] * inv); v0[1] = pk2(o0[4 * g + 2] * inv, o0[4 * g + 3] * inv);
    v1[0] = pk2(o1[4 * g] * inv, o1[4 * g + 1] * inv); v1[1] = pk2(o1[4 * g + 2] * inv, o1[4 * g + 3] * inv);
    *(u32x2*)(oa + 8 * g) = v0;
    *(u32x2*)(oa + 32 + 8 * g) = v1;
  }
}


DI size_t score_row_off(int b, int i) {
  const int c = 1 + (i >> 6), m = c - 1;
  return (size_t)b * SCORES_PER_BATCH + (size_t)8192 * (m + (m >> 1) * ((m + 1) >> 1)) + (size_t)(i & 63) * (128 * ((c >> 1) + 1));
}
constexpr int S1_ITEMS = 4 * 560;
DI void s1_item(const Params& P, int it) {
  unsigned char* ws = P.ws;
  const int b = it & 3; int r = it >> 2; int c = 64;
  while (r >= (c >> 2) + 1) { r -= (c >> 2) + 1; --c; }
  const int n = 16 + 64 * c;
  const int lane = threadIdx.x & 63, w = (threadIdx.x >> 6) & 3, lq = lane & 15, lg = lane >> 4;
  const int i = (c - 1) * 64 + 16 * w + lq, tq = b * L + NMETA + i;
  bf16x8 qf[8][2];
  const bf16_t* qrow = (const bf16_t*)(ws + O_QI) + (size_t)tq * 512 + 8 * lg;
#pragma unroll
  for (int h = 0; h < 8; ++h) { qf[h][0] = *(const bf16x8*)(qrow + h * 64); qf[h][1] = *(const bf16x8*)(qrow + h * 64 + 32); }
  const f32x4 wa = *(const f32x4*)((const float*)(ws + O_WI) + (size_t)tq * 8), wb = *(const f32x4*)((const float*)(ws + O_WI) + (size_t)tq * 8 + 4);
  const float wv[8] = {wa[0], wa[1], wa[2], wa[3], wb[0], wb[1], wb[2], wb[3]};
  unsigned* srow = (unsigned*)((_Float16*)(ws + O_SCORES) + score_row_off(b, i)) + 4 * lg;
  const bf16_t* kbase = (const bf16_t*)(ws + O_KI) + ((size_t)b * L + lq) * 64 + 8 * lg;
#pragma unroll 1
  for (int g2 = 0; g2 < 2; ++g2) {
    const int kg = 256 * r + 128 * g2;
#pragma unroll 1
    for (int kt4 = 0; kt4 < 64; kt4 += 16) {
      const int ka = kg + kt4, kb = ka + 64;
      if (ka >= n) break;
      f32x4 sa = {0.f, 0.f, 0.f, 0.f}, sb = {0.f, 0.f, 0.f, 0.f};
      {
        const bf16_t* kp = kbase + (size_t)ka * 64;
        const bf16x8 a0 = *(const bf16x8*)kp, a1 = *(const bf16x8*)(kp + 32);
#pragma unroll
        for (int h = 0; h < 8; ++h) {
          f32x4 acc = {0.f, 0.f, 0.f, 0.f};
          acc = __builtin_amdgcn_mfma_f32_16x16x32_bf16(a0, qf[h][0], acc, 0, 0, 0);
          acc = __builtin_amdgcn_mfma_f32_16x16x32_bf16(a1, qf[h][1], acc, 0, 0, 0);
#pragma unroll
          for (int q = 0; q < 4; ++q) sa[q] = fmaf(wv[h], fmaxf(acc[q], 0.f), sa[q]);
        }
      }
      if (kb < n) {
        const bf16_t* kp = kbase + (size_t)kb * 64;
        const bf16x8 a0 = *(const bf16x8*)kp, a1 = *(const bf16x8*)(kp + 32);
#pragma unroll
        for (int h = 0; h < 8; ++h) {
          f32x4 acc = {0.f, 0.f, 0.f, 0.f};
          acc = __builtin_amdgcn_mfma_f32_16x16x32_bf16(a0, qf[h][0], acc, 0, 0, 0);
          acc = __builtin_amdgcn_mfma_f32_16x16x32_bf16(a1, qf[h][1], acc, 0, 0, 0);
#pragma unroll
          for (int q = 0; q < 4; ++q) sb[q] = fmaf(wv[h], fmaxf(acc[q], 0.f), sb[q]);
        }
      }
      typedef _Float16 h2_t __attribute__((ext_vector_type(2)));
      u32x4 o;
#pragma unroll
      for (int q = 0; q < 4; ++q) { const h2_t v = {(_Float16)sa[q], (_Float16)sb[q]}; o[q] = __builtin_bit_cast(unsigned, v); }
      *(u32x4*)(srow + (kg >> 1) + kt4) = o;
    }
  }
}

DI unsigned f2key(float f) { const unsigned u = __float_as_uint(f); return (u & 0x80000000u) ? ~u : (u | 0x80000000u); }
DI unsigned long long lanemask_lt(int lane) { return (1ull << lane) - 1ull; }
template <int NG>
DI void s2_row(const Params& P, int rq, int lane) {
  unsigned char* ws = P.ws;
  const int b = rq / SEQ, i = rq % SEQ, c = 1 + (i >> 6), n = 16 + 64 * c;
  const unsigned* srow = (const unsigned*)((const _Float16*)(ws + O_SCORES) + score_row_off(b, i)) + lane;
  typedef unsigned short u16x2 __attribute__((ext_vector_type(2)));
  u16x2 hp[NG];
  {
    unsigned raw[NG];
#pragma unroll
    for (int e = 0; e < NG; ++e) raw[e] = srow[64 * e];
#pragma unroll
    for (int e = 0; e < NG; ++e) asm volatile("" : "+v"(raw[e]));
#pragma unroll
    for (int e = 0; e < NG; ++e) {
      const unsigned d = raw[e];
      unsigned k = d ^ ((((d >> 15) & 0x00010001u) * 0xffffu) | 0x80008000u);
      if (128 * e + lane >= n) k &= 0xffff0000u;
      if (128 * e + 64 + lane >= n) k &= 0x0000ffffu;
      hp[e] = __builtin_bit_cast(u16x2, k);
    }
  }
  unsigned T = 0; int c_lo = 1 << 30, c_hi = 0;
  for (int bit = 15; bit >= 0; --bit) {
    const unsigned cand = T | (1u << bit);
    const unsigned short chm1 = (unsigned short)(cand - 1u);
    const u16x2 cv = {chm1, chm1}, one = {1, 1};
    u16x2 a0 = {0, 0}, a1 = {0, 0};
#pragma unroll
    for (int e = 0; e < NG; ++e) {
      u16x2 t;
      asm("v_pk_sub_u16 %0, %1, %2 clamp" : "=v"(t) : "v"(hp[e]), "v"(cv));
      asm("v_pk_min_u16 %0, %1, %2" : "=v"(t) : "v"(t), "v"(one));
      if (e & 1) asm("v_pk_add_u16 %0, %1, %2" : "=v"(a1) : "v"(a1), "v"(t)); else asm("v_pk_add_u16 %0, %1, %2" : "=v"(a0) : "v"(a0), "v"(t));
    }
    const u16x2 as = a0 + a1;
    const int cc = wave_sumi((int)as[0] + (int)as[1]);
    if (cc >= 256) { T = cand; c_lo = cc; } else { c_hi = cc; }
    if (c_lo == 256) break;
  }
  unsigned mlo = 0u, mhi = 0u;
  unsigned long long w64 = 0ull;
  int rem = c_lo == 256 ? (1 << 20) : 256 - c_hi;
#pragma unroll
  for (int e = 0; e < NG; ++e) {
    const unsigned kk = __builtin_bit_cast(unsigned, hp[e]);
#pragma unroll
    for (int h = 0; h < 2; ++h) {
      const unsigned kv = h ? (kk >> 16) : (kk & 0xffffu);
      const bool eq = kv == T;
      const unsigned long long meq = __ballot(eq), mgt = __ballot(kv > T);
      unsigned long long msel = mgt;
      if (meq) {
        const int pre = __popcll(meq & lanemask_lt(lane));
        msel |= __ballot(eq && pre < rem);
        rem -= __popcll(meq); rem = rem < 0 ? 0 : rem;
      }
      const int wd = 2 * e + h;
      if (wd < 64) { if (lane == wd) { mlo = (unsigned)msel; mhi = (unsigned)(msel >> 32); } } else if (wd == 64) w64 = msel;
    }
  }
  unsigned* mrow = (unsigned*)(P.ws + O_MASK) + (size_t)rq * MW;
  *(u32x2*)(mrow + 2 * lane) = (u32x2){mlo, mhi};
  if (lane == 0) { *(u32x2*)(mrow + 128) = (u32x2){(unsigned)w64, (unsigned)(w64 >> 32)}; *(u32x2*)(mrow + 130) = (u32x2){0u, 0u}; }
}
DI void s2_dispatch(const Params& P, int rq, int lane, unsigned* wl) {
  (void)wl;
  const int c = 1 + ((rq % SEQ) >> 6), n = 16 + 64 * c;
  if (n <= 256) {
    unsigned* mrow = (unsigned*)(P.ws + O_MASK) + (size_t)rq * MW;
    unsigned long long m = 0ull;
    const int lo = 64 * lane;
    if (lo + 64 <= n) m = ~0ull; else if (lo < n) m = (1ull << (n - lo)) - 1ull;
    *(u32x2*)(mrow + 2 * lane) = (u32x2){(unsigned)m, (unsigned)(m >> 32)};
    if (lane == 0) { *(u32x2*)(mrow + 128) = (u32x2){0u, 0u}; *(u32x2*)(mrow + 130) = (u32x2){0u, 0u}; }
    return;
  }
  const int ng = (c >> 1) + 1;
  if (ng <= 5) s2_row<5>(P, rq, lane);
  else if (ng <= 9) s2_row<9>(P, rq, lane);
  else if (ng <= 13) s2_row<13>(P, rq, lane);
  else if (ng <= 17) s2_row<17>(P, rq, lane);
  else if (ng <= 21) s2_row<21>(P, rq, lane);
  else if (ng <= 25) s2_row<25>(P, rq, lane);
  else if (ng <= 29) s2_row<29>(P, rq, lane);
  else s2_row<33>(P, rq, lane);
}

DI int t5_bucket(int rel) {
  const int n = rel < 0 ? -rel : rel;
  int v;
  if (n < 8) v = n;
  else v = 8 + (n >= 12) + (n >= 16) + (n >= 23) + (n >= 32) + (n >= 46) + (n >= 64) + (n >= 91);
  return (rel > 0 ? 16 : 0) + v;
}
constexpr int DSA_KSTR = 144, DSA_VSTR = 136, DSA_KBYTES = 64 * DSA_KSTR, DSA_STAGE = DSA_KBYTES + 64 * DSA_VSTR;
constexpr int DSA_TB = 2 * DSA_STAGE;
DI void dsa_stage(const unsigned char* cur, int s, int cw, int lq, int hh, int pq, int qmin, float bfar, const float* tb, const unsigned* mrow,
                  const bf16x8 (&qf)[4], f32x16& o0, f32x16& o1, float& m, float& lsum) {
  if (s > cw) return;
  const bool full = s < cw;
  const int kb0 = 64 * s;
  const bool near = kb0 + 63 >= qmin - 91;
  const unsigned w0 = mrow[2 * s] >> (4 * hh), w1 = mrow[2 * s + 1] >> (4 * hh);
  const float mref = m > -1e29f ? m : 0.f;
  f32x16 s0, s1;
  const float binit = (near ? 0.f : bfar) - mref;
#pragma unroll
  for (int r = 0; r < 16; ++r) { s0[r] = binit; s1[r] = binit; }
  const unsigned char* Kc = cur + lq * DSA_KSTR + hh * 16;
  {
    bf16x8 kf[4];
#pragma unroll
    for (int kk = 0; kk < 4; ++kk) kf[kk] = *(const bf16x8*)(Kc + kk * 32);
#pragma unroll
    for (int kk = 0; kk < 4; ++kk) s0 = __builtin_amdgcn_mfma_f32_32x32x16_bf16(kf[kk], qf[kk], s0, 0, 0, 0);
    __builtin_amdgcn_sched_group_barrier(0x100, 4, 0);
    __builtin_amdgcn_sched_group_barrier(0x008, 4, 0);
  }
  if (full) {
    bf16x8 kf[4];
#pragma unroll
    for (int kk = 0; kk < 4; ++kk) kf[kk] = *(const bf16x8*)(Kc + 32 * DSA_KSTR + kk * 32);
#pragma unroll
    for (int kk = 0; kk < 4; ++kk) s1 = __builtin_amdgcn_mfma_f32_32x32x16_bf16(kf[kk], qf[kk], s1, 0, 0, 0);
    __builtin_amdgcn_sched_group_barrier(0x100, 4, 0);
    __builtin_amdgcn_sched_group_barrier(0x008, 4, 0);
  }
  const float* tp = tb + (kb0 + 4 * hh - pq + 192);
  const unsigned char* Vc = cur + DSA_KBYTES + lq * DSA_VSTR + hh * 8;
  if (near) {
#pragma unroll
    for (int r = 0; r < 16; ++r) s0[r] += tp[(r & 3) + 8 * (r >> 2)];
  }
#pragma unroll
  for (int r = 0; r < 16; ++r) s0[r] = (w0 & (1u << ((r & 3) + 8 * (r >> 2)))) ? s0[r] : MASKV;
  softmax_update1(s0, m, mref, lsum, o0, o1);
  pv_subtile(Vc, DSA_VSTR, s0, o0, o1);
  if (full) {
    if (near) {
#pragma unroll
      for (int r = 0; r < 16; ++r) s1[r] += tp[32 + (r & 3) + 8 * (r >> 2)];
    }
#pragma unroll
    for (int r = 0; r < 16; ++r) s1[r] = (w1 & (1u << ((r & 3) + 8 * (r >> 2)))) ? s1[r] : MASKV;
    softmax_update1(s1, m, mref, lsum, o0, o1);
    pv_subtile(Vc + 64, DSA_VSTR, s1, o0, o1);
  }
}
DI void dsa_item(const Params& P, int item, unsigned char* lds) {
  unsigned char* ws = P.ws;
  const int jq = 15 - item / 32, bh = item % 32, b = bh >> 3, h = bh & 7;
  const int c0 = 4 * jq + 1;
  const int tid = threadIdx.x, lane = tid & 63, w = __builtin_amdgcn_readfirstlane(tid >> 6), hh = lane >> 5, lq = lane & 31;
  const int cw = c0 + (w >> 1);
  const int pq = NMETA + 256 * jq + 32 * w + lq;
  const int tq = b * L + pq, rq = b * SEQ + pq - NMETA;
  const int qmin = NMETA + 256 * jq + 32 * w;
  float* tb = (float*)(lds + DSA_TB);
  __syncthreads();
  if (tid < 256) tb[tid] = P.rel_bias[t5_bucket(tid - 192) * 8 + h] * LOG2E;
  const float bfar = P.rel_bias[15 * 8 + h] * LOG2E;
  bf16x8 qf[4];
  {
    const bf16_t* qrow = (const bf16_t*)(ws + O_QB) + (size_t)tq * 512 + h * 64 + hh * 8;
#pragma unroll
    for (int kk = 0; kk < 4; ++kk) qf[kk] = *(const bf16x8*)(qrow + kk * 16);
  }
  const unsigned* mrow = (const unsigned*)(P.ws + O_MASK) + (size_t)rq * MW;
  f32x16 o0, o1;
#pragma unroll
  for (int r = 0; r < 16; ++r) { o0[r] = 0.f; o1[r] = 0.f; }
  float m = -1e30f, lsum = 0.f;
  const int nst = c0 + 4;
  const bf16_t* kg = (const bf16_t*)(ws + O_KB) + (size_t)b * L * 512 + h * 64;
  const bf16_t* vg = (const bf16_t*)(ws + O_VBT) + (size_t)bh * 64 * LP;
  const int srow = tid >> 3, sc = tid & 7;
  const unsigned kgo = srow * 512 + sc * 8, klo = srow * DSA_KSTR + sc * 16, vgo = srow * LP + sc * 8, vlo = DSA_KBYTES + srow * DSA_VSTR + sc * 16;
  u32x4 rkA, rvA, rkB, rvB;
#define DSA_LOAD(rk_, rv_, st) do { const int kn = (st) * 64; const int kr = min(kn + srow, L - 1) - srow; \
    rk_ = *(const u32x4*)(kg + (size_t)kr * 512 + kgo); rv_ = *(const u32x4*)(vg + kn + vgo); } while (0)
#define DSA_WRITE(rk_, rv_, buf) do { unsigned char* nb_ = (buf); *(u32x4*)(nb_ + klo) = rk_; \
    *(u32x2*)(nb_ + vlo) = (u32x2){rv_[0], rv_[1]}; *(u32x2*)(nb_ + vlo + 8) = (u32x2){rv_[2], rv_[3]}; } while (0)
  unsigned char* buf0 = lds; unsigned char* buf1 = lds + DSA_STAGE;
  DSA_LOAD(rkA, rvA, 0); DSA_WRITE(rkA, rvA, buf0);
  __syncthreads();
  if (nst > 1) DSA_LOAD(rkA, rvA, 1);
#pragma unroll 1
  for (int s = 0; s < nst; s += 2) {
    if (s + 2 < nst) DSA_LOAD(rkB, rvB, s + 2);
    dsa_stage(buf0, s, cw, lq, hh, pq, qmin, bfar, tb, mrow, qf, o0, o1, m, lsum);
    if (s + 1 < nst) DSA_WRITE(rkA, rvA, buf1);
    __syncthreads();
    if (s + 1 >= nst) break;
    if (s + 3 < nst) DSA_LOAD(rkA, rvA, s + 3);
    dsa_stage(buf1, s + 1, cw, lq, hh, pq, qmin, bfar, tb, mrow, qf, o0, o1, m, lsum);
    if (s + 2 < nst) DSA_WRITE(rkB, rvB, buf0);
    __syncthreads();
  }
#undef DSA_LOAD
#undef DSA_WRITE
  lsum += __shfl_xor(lsum, 32);
  const float inv = 1.f / lsum;
  bf16_t* ob = (bf16_t*)(ws + O_OB) + (size_t)rq * 512 + h * 64 + 4 * hh;
#pragma unroll
  for (int g = 0; g < 4; ++g) {
    u32x2 v0, v1;
    v0[0] = pk2(o0[4 * g] * inv, o0[4 * g + 1] * inv); v0[1] = pk2(o0[4 * g + 2] * inv, o0[4 * g + 3] * inv);
    v1[0] = pk2(o1[4 * g] * inv, o1[4 * g + 1] * inv); v1[1] = pk2(o1[4 * g + 2] * inv, o1[4 * g + 3] * inv);
    *(u32x2*)(ob + 8 * g) = v0;
    *(u32x2*)(ob + 32 + 8 * g) = v1;
  }
}

template <bool CHECK> DI void nv_mla(const Params& P, int vb, unsigned char* lds) {
  unsigned char* ws = P.ws;
  float* qs = (float*)lds;
  const int b = vb / SEQ, p = NMETA + vb % SEQ, t = b * L + p;
  const int tid = threadIdx.x & 255, h = tid >> 5, l = tid & 31;
  const bf16_t* qa = (const bf16_t*)(ws + O_QA) + (size_t)t * 768;
  for (int i = tid; i < 768; i += 256) qs[i] = bf2f(qa[i]);
  __syncthreads();
  const int na = n_adm(p);
  const bf16_t* km = (const bf16_t*)(ws + O_KMLA) + (size_t)(b * 8 + h) * LP * 96;
  const bf16_t* vt = (const bf16_t*)(ws + O_VT) + (size_t)(b * 8 + h) * 64 * LP;
  float m = -1e30f, ls = 0.f, acc[64];
#pragma unroll
  for (int d = 0; d < 64; ++d) acc[d] = 0.f;
  const float* q = qs + h * 96;
  for (int j = l; j < na; j += 32) {
    const bf16_t* kr = km + (size_t)j * 96;
    float s = 0.f;
#pragma unroll 8
    for (int d = 0; d < 96; ++d) s = fmaf(q[d], bf2f(kr[d]), s);
    const float mn = fmaxf(m, s), c = exp2f(m - mn), pe = exp2f(s - mn);
    ls = ls * c + pe;
#pragma unroll
    for (int d = 0; d < 64; ++d) acc[d] = acc[d] * c + pe * bf2f(vt[(size_t)d * LP + j]);
    m = mn;
  }
#pragma unroll
  for (int off = 16; off >= 1; off >>= 1) {
    const float m2 = __shfl_xor(m, off), l2 = __shfl_xor(ls, off);
    const float mn = fmaxf(m, m2), c1 = exp2f(m - mn), c2 = exp2f(m2 - mn);
    ls = ls * c1 + l2 * c2;
#pragma unroll
    for (int d = 0; d < 64; ++d) { const float a2 = __shfl_xor(acc[d], off); acc[d] = acc[d] * c1 + a2 * c2; }
    m = mn;
  }
  if (l == 0) {
    const float inv = 1.f / ls;
    bf16_t* oa = (bf16_t*)(ws + O_OA) + (size_t)vb * 512 + h * 64;
    if (CHECK) {
#if SELFCHECK
#pragma unroll
      for (int d = 0; d < 64; ++d) if (far(bf2f(oa[d]), acc[d] * inv, 0.004f, 0.03f)) chk_fail(P, 13);
#endif
    } else {
#pragma unroll
      for (int d = 0; d < 64; ++d) oa[d] = f2bf(acc[d] * inv);
    }
  }
  __syncthreads();
}

#if SELFCHECK
struct NvDsaLds { float qi[512]; float qb[512]; float wi[8]; unsigned keys[L]; int sel[256]; float sc[8][256]; int redi[8]; int scan_gt[257]; int scan_eq[257]; unsigned char mine[L]; };
DI void nv_dsa_check(const Params& P, int vb, unsigned char* lds) {
  unsigned char* ws = P.ws;
  NvDsaLds& S = *(NvDsaLds*)lds;
  const int b = vb / SEQ, p = NMETA + vb % SEQ, t = b * L + p, tid = threadIdx.x & 255;
  const bf16_t* qi_g = (const bf16_t*)(ws + O_QI) + (size_t)t * 512;
  const bf16_t* qb_g = (const bf16_t*)(ws + O_QB) + (size_t)t * 512;
  for (int i = tid; i < 512; i += 256) { S.qi[i] = bf2f(qi_g[i]); S.qb[i] = bf2f(qb_g[i]); }
  if (tid < 8) S.wi[tid] = ((const float*)(ws + O_WI))[(size_t)t * 8 + tid];
  __syncthreads();
  const int na = n_adm(p);
  const bf16_t* ki_g = (const bf16_t*)(ws + O_KI) + (size_t)b * L * 64;
  for (int j = tid; j < na; j += 256) {
    const bf16_t* ki = ki_g + (size_t)j * 64;
    float s = 0.f;
    for (int h = 0; h < 8; ++h) {
      float lg = 0.f;
#pragma unroll 8
      for (int d = 0; d < 64; ++d) lg = fmaf(S.qi[h * 64 + d], bf2f(ki[d]), lg);
      s += S.wi[h] * fmaxf(lg, 0.f);
    }
    S.keys[j] = f2key(s);
    S.mine[j] = 0;
  }
  __syncthreads();
  if (na <= 256) {
    for (int j = tid; j < na; j += 256) S.mine[j] = 1;
  } else {
    unsigned T = 0;
    for (int bit = 31; bit >= 0; --bit) {
      const unsigned cand = T | (1u << bit);
      int c = 0;
      for (int j = tid; j < na; j += 256) c += S.keys[j] >= cand;
      c = block_sumi256(c, S.redi);
      if (c >= 256) T = cand;
    }
    const int chunk = (na + 255) / 256;
    const int j0 = tid * chunk, j1 = min(j0 + chunk, na);
    int cgt = 0, ce = 0;
    for (int j = j0; j < j1; ++j) { cgt += S.keys[j] > T; ce += S.keys[j] == T; }
    S.scan_gt[tid + 1] = cgt; S.scan_eq[tid + 1] = ce;
    __syncthreads();
    if (threadIdx.x == 0) { S.scan_gt[0] = 0; S.scan_eq[0] = 0; for (int i = 1; i <= 256; ++i) { S.scan_gt[i] += S.scan_gt[i - 1]; S.scan_eq[i] += S.scan_eq[i - 1]; } }
    __syncthreads();
    const int r = 256 - S.scan_gt[256];
    int pe = S.scan_eq[tid];
    for (int j = j0; j < j1; ++j) {
      if (S.keys[j] > T) S.mine[j] = 1;
      else if (S.keys[j] == T) { if (pe < r) S.mine[j] = 1; ++pe; }
    }
  }
  __syncthreads();
  const unsigned* mrow = (const unsigned*)(P.ws + O_MASK) + (size_t)vb * MW;
  int mism = 0, cntk = 0;
  for (int j = tid; j < 4224; j += 256) {
    const int kb = (mrow[j >> 5] >> (j & 31)) & 1;
    const int me = j < na ? (int)S.mine[j] : 0;
    mism += kb != me; cntk += kb;
    if (kb && j >= na) mism += 1000;
  }
  mism = block_sumi256(mism, S.redi);
  cntk = block_sumi256(cntk, S.redi);
  if (tid == 0) { if (mism > 16) chk_fail(P, 14); if (cntk != (na < 256 ? na : 256)) chk_fail(P, 14); }
  if (tid == 0) { int k = 0; for (int j = 0; j < na && k < 256; ++j) if ((mrow[j >> 5] >> (j & 31)) & 1) S.sel[k++] = j; for (; k < 256; ++k) S.sel[k] = 0; }
  const int nsel = na < 256 ? na : 256;
  __syncthreads();
  if (tid < nsel) {
    const int j = S.sel[tid];
    const bf16_t* kb = (const bf16_t*)(ws + O_KB) + (size_t)(b * L + j) * 512;
    const int bk = t5_bucket(j - p);
    for (int h = 0; h < 8; ++h) {
      float s = 0.f;
#pragma unroll 8
      for (int d = 0; d < 64; ++d) s = fmaf(S.qb[h * 64 + d], bf2f(kb[h * 64 + d]), s);
      S.sc[h][tid] = s + P.rel_bias[bk * 8 + h] * LOG2E;
    }
  }
  __syncthreads();
  {
    const int h = tid >> 5, l = tid & 31;
    float m = -1e30f;
    for (int k = l; k < nsel; k += 32) m = fmaxf(m, S.sc[h][k]);
#pragma unroll
    for (int off = 16; off >= 1; off >>= 1) m = fmaxf(m, __shfl_xor(m, off));
    float s = 0.f;
    for (int k = l; k < nsel; k += 32) s += exp2f(S.sc[h][k] - m);
#pragma unroll
    for (int off = 16; off >= 1; off >>= 1) s += __shfl_xor(s, off);
    const float inv = 1.f / s;
    __syncthreads();
    if (threadIdx.x < 256) for (int k = l; k < nsel; k += 32) S.sc[h][k] = exp2f(S.sc[h][k] - m) * inv;
  }
  __syncthreads();
  const bf16_t* vbt = (const bf16_t*)(ws + O_VBT) + (size_t)b * 8 * 64 * LP;
  const bf16_t* ob = (const bf16_t*)(ws + O_OB) + (size_t)vb * 512;
  for (int o = tid; o < 512; o += 256) {
    const int h = o >> 6;
    float a = 0.f;
    for (int k = 0; k < nsel; ++k) a = fmaf(S.sc[h][k], bf2f(vbt[(size_t)o * LP + S.sel[k]]), a);
    if (far(bf2f(ob[o]), a, 0.006f, 0.03f)) chk_fail(P, 15);
  }
  __syncthreads();
}
#endif

DI void p7_merge_tile(const Params& P, int mt, int nt, unsigned char* lds) {
  unsigned char* ws = P.ws;
  const int m0 = mt * 256, n0 = nt * 256;
  const bf16_t* gates = (const bf16_t*)P.out;
  bf16_t* yo = (bf16_t*)(ws + O_Y);
  TilePtrs tp;
  f32x16 acc[4][2];
  const int lane = threadIdx.x & 63, w = threadIdx.x >> 6, wr = w >> 2, wc = w & 3, hh = lane >> 5, lc = lane & 31;
#pragma unroll 1
  for (int br = 0; br < 2; ++br) {
    set_ptrs(tp, (const bf16_t*)(ws + (br ? O_OB : O_OA)), 512, NR, m0, (const bf16_t*)(ws + (br ? O_WBRB : O_WBRA)), 512, 1024, n0);
    zero_acc(acc); gemm_kloop<true>(acc, tp, 512, lds);
#pragma unroll
    for (int mi = 0; mi < 4; ++mi) {
      int row = m0 + acc_row0(wr, mi) + lc;
      asm volatile("" : "+v"(row));
#pragma unroll
      for (int ni = 0; ni < 2; ++ni) {
        const int c0 = n0 + acc_col0(wc, ni) + 4 * hh;
        const bf16_t* gp = gates + (size_t)row * 2048 + br * 1024 + c0;
        bf16_t* yp = yo + (size_t)row * 1024 + c0;
        u32x2 gv[4], pv[4];
#pragma unroll
        for (int g = 0; g < 4; ++g) { gv[g] = *(const u32x2*)(gp + 8 * g); if (br) pv[g] = *(const u32x2*)(yp + 8 * g); else { pv[g][0] = 0u; pv[g][1] = 0u; } }
#pragma unroll
        for (int g = 0; g < 4; ++g) {
          const float y0 = __uint_as_float(gv[g][0] << 16) * acc[mi][ni][4 * g] + __uint_as_float(pv[g][0] << 16);
          const float y1 = __uint_as_float(gv[g][0] & 0xffff0000u) * acc[mi][ni][4 * g + 1] + __uint_as_float(pv[g][0] & 0xffff0000u);
          const float y2 = __uint_as_float(gv[g][1] << 16) * acc[mi][ni][4 * g + 2] + __uint_as_float(pv[g][1] << 16);
          const float y3 = __uint_as_float(gv[g][1] & 0xffff0000u) * acc[mi][ni][4 * g + 3] + __uint_as_float(pv[g][1] & 0xffff0000u);
          *(u32x2*)(yp + 8 * g) = pk4(y0, y1, y2, y3);
        }
        __builtin_amdgcn_sched_barrier(0);
      }
    }
    asm volatile("" ::: "memory");
  }
}

DI void p8_out_tile(const Params& P, int mt, int nt, unsigned char* lds) {
  unsigned char* ws = P.ws;
  const int m0 = mt * 256, n0 = nt * 256;
  TilePtrs tp; set_ptrs(tp, (const bf16_t*)(ws + O_Y), 1024, NR, m0, (const bf16_t*)(ws + O_WO), 1024, 1024, n0);
  f32x16 acc[4][2]; zero_acc(acc);
  gemm_kloop<true>(acc, tp, 1024, lds);
  const int lane = threadIdx.x & 63, w = threadIdx.x >> 6, wr = w >> 2, wc = w & 3, hh = lane >> 5, lc = lane & 31;
#pragma unroll
  for (int mi = 0; mi < 4; ++mi) {
    int row = m0 + acc_row0(wr, mi) + lc;
    asm volatile("" : "+v"(row));
#pragma unroll
    for (int ni = 0; ni < 2; ++ni) {
      const size_t off = (size_t)row * D + n0 + acc_col0(wc, ni) + 4 * hh;
      f32x4 xv[4];
#pragma unroll
      for (int g = 0; g < 4; ++g) xv[g] = *(const f32x4*)(P.x + off + 8 * g);
#pragma unroll
      for (int g = 0; g < 4; ++g)
        *(u32x2*)((bf16_t*)(ws + M_XN) + off + 8 * g) = pk4(xv[g][0] + acc[mi][ni][4 * g], xv[g][1] + acc[mi][ni][4 * g + 1], xv[g][2] + acc[mi][ni][4 * g + 2], xv[g][3] + acc[mi][ni][4 * g + 3]);
    }
  }
}

DI void p9_router_token(const Params& P, int tok, int lane) {
  unsigned char* ws = P.ws;
  const bf16_t* row = (const bf16_t*)(ws + M_XN) + (size_t)tok * D;
  f32x4 v[4]; float s = 0.f;
#pragma unroll
  for (int i = 0; i < 4; ++i) {
    const u32x2 a = *(const u32x2*)(row + 256 * i + 4 * lane);
    v[i][0] = __uint_as_float(a[0] << 16); v[i][1] = __uint_as_float(a[0] & 0xffff0000u); v[i][2] = __uint_as_float(a[1] << 16); v[i][3] = __uint_as_float(a[1] & 0xffff0000u);
    s += v[i][0] * v[i][0] + v[i][1] * v[i][1] + v[i][2] * v[i][2] + v[i][3] * v[i][3];
  }
  s = wave_sum(s);
  const float rs = rsqrtf(s * (1.f / D) + EPS);
  if (lane == 0) ((float*)(ws + M_RS))[tok] = rs;
#pragma unroll
  for (int i = 0; i < 4; ++i) {
    const f32x4 g = *(const f32x4*)(P.g_ffn + 256 * i + 4 * lane);
    v[i][0] *= rs * g[0]; v[i][1] *= rs * g[1]; v[i][2] *= rs * g[2]; v[i][3] *= rs * g[3];
  }
  const float* wr = (const float*)(ws + O_WR);
  float mylog = 0.f;
#pragma unroll 1
  for (int c = 0; c < 36; ++c) {
    float a = 0.f;
#pragma unroll
    for (int i = 0; i < 4; ++i) { const f32x4 w4 = *(const f32x4*)(wr + c * 1024 + 256 * i + 4 * lane); a += v[i][0] * w4[0] + v[i][1] * w4[1] + v[i][2] * w4[2] + v[i][3] * w4[3]; }
    a = wave_sum(a);
    if (lane == c) mylog = a + (c < 4 ? P.b_rg[c] : P.b_re[c - 4]);
  }
  float lg[4];
#pragma unroll
  for (int i = 0; i < 4; ++i) lg[i] = __shfl(mylog, i);
  int gs = 0; float gm = lg[0];
#pragma unroll
  for (int i = 1; i < 4; ++i) if (lg[i] > gm) { gm = lg[i]; gs = i; }
  float se = 0.f;
#pragma unroll
  for (int i = 0; i < 4; ++i) se += expf(lg[i] - gm);
  const float pg = 1.f / se;
  float el[8];
#pragma unroll
  for (int i = 0; i < 8; ++i) el[i] = __shfl(mylog, 4 + gs * 8 + i);
  float em = el[0];
#pragma unroll
  for (int i = 1; i < 8; ++i) em = fmaxf(em, el[i]);
  float pe[8]; float ss = 0.f;
#pragma unroll
  for (int i = 0; i < 8; ++i) { pe[i] = expf(el[i] - em); ss += pe[i]; }
  int e1 = 0; float p1 = pe[0];
#pragma unroll
  for (int i = 1; i < 8; ++i) if (pe[i] > p1) { p1 = pe[i]; e1 = i; }
  int e2 = 0; float p2 = -1.f;
#pragma unroll
  for (int i = 0; i < 8; ++i) if (i != e1 && pe[i] > p2) { p2 = pe[i]; e2 = i; }
  p1 /= ss; p2 /= ss;
  const float den = p1 + p2;
  const float w1 = pg * p1 / den, w2 = pg * p2 / den;
  const int x1 = gs * 8 + e1, x2 = gs * 8 + e2;
  if (lane == 0) {
    unsigned* cnt = (unsigned*)(ws + O_CTR) + 32;
    const int q1 = (int)atomicAdd(cnt + x1, 1u), q2 = (int)atomicAdd(cnt + x2, 1u);
    ((int*)(ws + M_LIST))[(size_t)x1 * NR + q1] = tok; ((int*)(ws + M_LIST))[(size_t)x2 * NR + q2] = tok;
    ((float*)(ws + M_WL))[(size_t)x1 * NR + q1] = w1; ((float*)(ws + M_WL))[(size_t)x2 * NR + q2] = w2;
    int* asg = (int*)(ws + M_ASG) + (size_t)tok * 4;
    asg[0] = x1; asg[1] = q1; asg[2] = x2; asg[3] = q2;
  }
}
DI void p9_conv_gu_item(const Params& P, int item, float* scr, int tid, bool valid) {
  const int e = item >> 7, r = item & 127, kb = r & 15, nb = r >> 4;
  const int k0 = kb * 64, n0 = nb * 64;
  bf16_t* dst = (bf16_t*)(P.ws + M_WGU) + (size_t)e * 512 * 1024;
  if (valid) {
    const int n = tid & 63, nd = n0 + n, q = nd >> 8, within = nd & 255, part = within >> 7, idx = within & 127;
    const float* src = (part ? P.w_eu : P.w_eg) + (size_t)e * 1024 * 256 + (q * 128 + idx);
#pragma unroll 4
    for (int i = 0; i < 16; ++i) { const int k = (tid >> 6) + 4 * i; scr[k * 65 + n] = src[(size_t)(k0 + k) * 256] * P.g_ffn[k0 + k]; }
  }
  __syncthreads();
  if (valid) {
    const int kq = tid & 7;
#pragma unroll
    for (int i = 0; i < 2; ++i) {
      const int n = (tid >> 3) + 32 * i;
      const float* sp = scr + (kq * 8) * 65 + n;
      u32x4 o; o[0] = pk2(sp[0], sp[65]); o[1] = pk2(sp[2 * 65], sp[3 * 65]); o[2] = pk2(sp[4 * 65], sp[5 * 65]); o[3] = pk2(sp[6 * 65], sp[7 * 65]);
      *(u32x4*)(dst + (size_t)(n0 + n) * 1024 + k0 + kq * 8) = o;
    }
  }
  __syncthreads();
}
DI int moe_tile_lookup(const Params& P, int tile, int& e_out, int& rt_out, int& cnt_out, int& base_slot) {
  const unsigned* cnt = (const unsigned*)(P.ws + O_CTR) + 32;
  int acc = 0, found = 0;
  e_out = 0; rt_out = 0; cnt_out = 0; base_slot = 0;
  for (int e = 0; e < 32; ++e) {
    const int c = (int)cnt[e], nt = (c + 255) >> 8;
    if (!found && tile < acc + nt) { e_out = e; rt_out = tile - acc; cnt_out = c; base_slot = acc * 256; found = 1; }
    acc += nt;
  }
  return acc;
}
DI void p10_gu_tile(const Params& P, int tile, int e, int rt, int cnt, int base_slot, int q, unsigned char* lds) {
  unsigned char* ws = P.ws;
  const int tid = threadIdx.x;
  const int* list = (const int*)(ws + M_LIST) + (size_t)e * NR;
  TilePtrs tp;
#pragma unroll
  for (int i = 0; i < 4; ++i) { int row, kc; tile_rc(i, row, kc); int r = rt * 256 + row; r = r < cnt ? r : cnt - 1; tp.a[i] = ((unsigned)list[r] * 1024u + kc * 8) * 2u; tp.b[i] = ((unsigned)(q * 256 + row) * 1024u + kc * 8) * 2u; }
  tp.A = (const bf16_t*)(ws + M_XN); tp.B = (const bf16_t*)(ws + M_WGU) + (size_t)e * 512 * 1024;
  f32x16 acc[4][2]; zero_acc(acc);
  gemm_kloop<true>(acc, tp, 1024, lds);
  const int lane = tid & 63, w = tid >> 6, wr = w >> 2, wc = w & 3, hh = lane >> 5, lc = lane & 31;
  bf16_t* hm = (bf16_t*)(ws + M_HMID);
  const int col = q * 128 + wc * 32 + 4 * hh;
#pragma unroll
  for (int mi = 0; mi < 4; ++mi) {
    int rr = rt * 256 + acc_row0(wr, mi) + lc;
    asm volatile("" : "+v"(rr));
    bf16_t* hp = hm + (size_t)(base_slot + rr) * 256 + col;
    const float rsv = rr < cnt ? ((const float*)(ws + M_RS))[list[rr]] : 0.f;
#pragma unroll
    for (int g = 0; g < 4; ++g) {
      float hv[4];
#pragma unroll
      for (int e = 0; e < 4; ++e) { const float gt = acc[mi][0][4 * g + e] * rsv, u = acc[mi][1][4 * g + e] * rsv; hv[e] = gt * __builtin_amdgcn_rcpf(1.f + __expf(-gt)) * u; }
      if (rr < cnt) *(u32x2*)(hp + 8 * g) = pk4(hv[0], hv[1], hv[2], hv[3]);
    }
  }
  asm volatile("s_waitcnt vmcnt(0)" ::: "memory");
  __syncthreads();
  if (threadIdx.x == 0) {
    __builtin_amdgcn_fence(__ATOMIC_RELEASE, "agent");
    asm volatile("s_waitcnt vmcnt(0)" ::: "memory");
    __hip_atomic_fetch_add((unsigned*)(ws + O_DEP) + tile, 1u, __ATOMIC_RELAXED, __HIP_MEMORY_SCOPE_AGENT);
  }
}
DI void p11_down_tile(const Params& P, int tile, int e, int rt, int cnt, int base_slot, int nt, unsigned char* lds) {
  unsigned char* ws = P.ws;
  if (threadIdx.x == 0) {
    unsigned* dep = (unsigned*)(ws + O_DEP) + tile;
    unsigned spins = 0;
    while (__hip_atomic_load(dep, __ATOMIC_RELAXED, __HIP_MEMORY_SCOPE_AGENT) < 2u && ++spins < (1u << 22)) __builtin_amdgcn_s_sleep(2);
    __builtin_amdgcn_fence(__ATOMIC_ACQUIRE, "agent");
    asm volatile("s_waitcnt vmcnt(0)" ::: "memory");
  }
  __syncthreads();
  const int tid = threadIdx.x;
  TilePtrs tp;
#pragma unroll
  for (int i = 0; i < 4; ++i) { int row, kc; tile_rc(i, row, kc); int r = rt * 256 + row; r = r < cnt ? r : cnt - 1; tp.a[i] = ((unsigned)(base_slot + r) * 256u + kc * 8) * 2u; tp.b[i] = ((unsigned)(nt * 256 + row) * 256u + kc * 8) * 2u; }
  tp.A = (const bf16_t*)(ws + M_HMID); tp.B = (const bf16_t*)(ws + M_WD) + (size_t)e * 1024 * 256;
  f32x16 acc[4][2]; zero_acc(acc);
  gemm_kloop<true>(acc, tp, 256, lds);
  const int lane = tid & 63, w = tid >> 6, wr = w >> 2, wc = w & 3, hh = lane >> 5, lc = lane & 31;
  bf16_t* ys = (bf16_t*)(ws + M_YS);
  const float* wl = (const float*)(ws + M_WL) + (size_t)e * NR;
#pragma unroll
  for (int mi = 0; mi < 4; ++mi) {
    int rr = rt * 256 + acc_row0(wr, mi) + lc;
    asm volatile("" : "+v"(rr));
    const bool ok = rr < cnt;
    const float wt = ok ? wl[rr] : 0.f;
    bf16_t* yp = ys + (size_t)(base_slot + rr) * 1024 + nt * 256 + 4 * hh;
#pragma unroll
    for (int ni = 0; ni < 2; ++ni)
#pragma unroll
      for (int g = 0; g < 4; ++g)
        if (ok) *(u32x2*)(yp + acc_col0(wc, ni) + 8 * g) = pk4(acc[mi][ni][4 * g] * wt, acc[mi][ni][4 * g + 1] * wt, acc[mi][ni][4 * g + 2] * wt, acc[mi][ni][4 * g + 3] * wt);
  }
}
DI void p12_final_token(const Params& P, int tok, int lane, const int* sbase  ) {
  unsigned char* ws = P.ws;
  float* row = P.out + (size_t)tok * D;
  const bf16_t* h2b = (const bf16_t*)(ws + M_XN) + (size_t)tok * D;
  const int* asg = (const int*)(ws + M_ASG) + (size_t)tok * 4;
  const int s1 = sbase[asg[0]] + asg[1], s2 = sbase[asg[2]] + asg[3];
  const bf16_t* y1 = (const bf16_t*)(ws + M_YS) + (size_t)s1 * 1024;
  const bf16_t* y2 = (const bf16_t*)(ws + M_YS) + (size_t)s2 * 1024;
  f32x4 v[4]; float s = 0.f;
#pragma unroll
  for (int i = 0; i < 4; ++i) {
    const u32x2 hq = *(const u32x2*)(h2b + 256 * i + 4 * lane);
    v[i][0] = __uint_as_float(hq[0] << 16); v[i][1] = __uint_as_float(hq[0] & 0xffff0000u); v[i][2] = __uint_as_float(hq[1] << 16); v[i][3] = __uint_as_float(hq[1] & 0xffff0000u);
    const u32x2 a = *(const u32x2*)(y1 + 256 * i + 4 * lane), b = *(const u32x2*)(y2 + 256 * i + 4 * lane);
    v[i][0] += __uint_as_float(a[0] << 16) + __uint_as_float(b[0] << 16);
    v[i][1] += __uint_as_float(a[0] & 0xffff0000u) + __uint_as_float(b[0] & 0xffff0000u);
    v[i][2] += __uint_as_float(a[1] << 16) + __uint_as_float(b[1] << 16);
    v[i][3] += __uint_as_float(a[1] & 0xffff0000u) + __uint_as_float(b[1] & 0xffff0000u);
    s += v[i][0] * v[i][0] + v[i][1] * v[i][1] + v[i][2] * v[i][2] + v[i][3] * v[i][3];
  }
  s = wave_sum(s);
  const float rs = rsqrtf(s * (1.f / D) + EPS);
#pragma unroll
  for (int i = 0; i < 4; ++i) {
    const f32x4 g = *(const f32x4*)(P.g_fin + 256 * i + 4 * lane);
    f32x4 o; o[0] = v[i][0] * rs * g[0]; o[1] = v[i][1] * rs * g[1]; o[2] = v[i][2] * rs * g[2]; o[3] = v[i][3] * rs * g[3];
    *(f32x4*)(row + 256 * i + 4 * lane) = o;
  }
}

struct NvMoeLds { float xr[D]; float xn[D]; float hm[256]; float red[8]; float logit[36]; float gatew[2]; int expert[2]; };


#if SELFCHECK
DI const float* h_row(const Params& P, int t) { const int b = t / L, p = t % L; return p < NMETA ? P.meta + (size_t)p * D : P.x + ((size_t)b * SEQ + (p - NMETA)) * D; }
DI void chk_load_hn(const Params& P, int t, float* hv, float* red) {
  const float* row = h_row(P, t);
  float s = 0.f;
  for (int i = (threadIdx.x & 255); i < D; i += 256) { const float v = row[i]; hv[i] = v; s += v * v; }
  s = block_sum256(s, red);
  const float rs = rsqrtf(s * (1.f / D) + EPS);
  if (threadIdx.x < 256) for (int i = threadIdx.x; i < D; i += 256) hv[i] = hv[i] * rs * P.g_mix[i];
  __syncthreads();
}
DI void chk_stageA(const Params& P, unsigned char* lds) {
  unsigned char* ws = P.ws;
  float* hv = (float*)lds; float* pj = hv + 1024; float* red = pj + 4608; float* cq = red + 8; float* ckv = cq + 256;
  const int tid = threadIdx.x & 255;
  for (int sidx = blockIdx.x; sidx < 512; sidx += gridDim.x) {
    const int t = sidx < 8 ? (sidx < 4 ? sidx * L + (sidx & 3) * 5 : NT - 1 - (sidx - 4) * 1031) : (int)(hash_u(sidx * 7919u + 13u) % NT);
    const int b = t / L, p = t % L;
    chk_load_hn(P, t, hv, red);
    for (int c = tid; c < 2536; c += 256) { float a = 0.f; for (int k = 0; k < D; ++k) a = fmaf(hv[k], P.w_in[(size_t)k * INC + c], a); pj[c] = a; }
    __syncthreads();
    const float* sm = (const float*)(ws + O_SMALL) + (size_t)t * 512;
    for (int c = tid; c < 416; c += 256) if (far(sm[c], pj[c], 0.06f, 0.02f)) chk_fail(P, 1);
    for (int c = tid; c < 8; c += 256) if (far(sm[S_WI + c], pj[2528 + c], 0.06f, 0.02f)) chk_fail(P, 1);
    for (int c = tid; c < 64; c += 256) if (far(sm[S_KI + c], pj[2464 + c], 0.06f, 0.02f)) chk_fail(P, 1);
    for (int c = tid; c < 512; c += 256) {
      if (far(bf2f(((const bf16_t*)(ws + O_QB))[(size_t)t * 512 + c]), pj[416 + c] * (0.125f * LOG2E), 0.012f, 0.02f)) chk_fail(P, 2);
      if (far(bf2f(((const bf16_t*)(ws + O_KB))[(size_t)t * 512 + c]), pj[928 + c], 0.06f, 0.02f)) chk_fail(P, 3);
      const int h = c >> 6, d = c & 63;
      if (far(bf2f(((const bf16_t*)(ws + O_VBT))[((size_t)(b * 8 + h) * 64 + d) * LP + p]), pj[1440 + c], 0.06f, 0.02f)) chk_fail(P, 4);
      if (far(bf2f(((const bf16_t*)(ws + O_QI))[(size_t)t * 512 + c]), pj[1952 + c] * 0.125f, 0.01f, 0.02f)) chk_fail(P, 5);
    }
    for (int c = tid; c < 64; c += 256) if (far(bf2f(((const bf16_t*)(ws + O_KI))[(size_t)t * 64 + c]), pj[2464 + c], 0.06f, 0.02f)) chk_fail(P, 6);
    for (int c = tid; c < 8; c += 256) if (far(((const float*)(ws + O_WI))[(size_t)t * 8 + c], pj[2528 + c] * 0.35355339f, 0.03f, 0.02f)) chk_fail(P, 6);
    { float s = 0.f; for (int i = tid; i < 256; i += 256) s += pj[i] * pj[i]; s = block_sum256(s, red);
      const float rs = rsqrtf(s * (1.f / 256) + EPS); for (int i = tid; i < 256; i += 256) cq[i] = pj[i] * rs * P.g_cq[i]; }
    { float s = 0.f; for (int i = tid; i < 128; i += 256) s += pj[256 + i] * pj[256 + i]; s = block_sum256(s, red);
      const float rs = rsqrtf(s * (1.f / 128) + EPS); for (int i = tid; i < 128; i += 256) ckv[i] = pj[256 + i] * rs * P.g_ckv[i]; }
    __syncthreads();
    const float qscale = 0.10206207261596575f * LOG2E;
    for (int c = tid; c < 768; c += 256) {
      const int h = c / 96, e = c % 96;
      float ref;
      if (e < 64) { float a = 0.f; for (int k = 0; k < 256; ++k) a = fmaf(cq[k], P.w_uq[(size_t)k * 768 + c], a); ref = a; }
      else {
        const int j = (e - 64) & 15; const int c1 = h * 96 + 64 + j, c2 = c1 + 16;
        float a1 = 0.f, a2 = 0.f; for (int k = 0; k < 256; ++k) { a1 = fmaf(cq[k], P.w_uq[(size_t)k * 768 + c1], a1); a2 = fmaf(cq[k], P.w_uq[(size_t)k * 768 + c2], a2); }
        const float inv = powf(10000.f, -(float)j / 16.f); float sn, cs; sincosf((float)p * inv, &sn, &cs);
        ref = (e - 64) < 16 ? a1 * cs - a2 * sn : a1 * sn + a2 * cs;
      }
      if (far(bf2f(((const bf16_t*)(ws + O_QA))[(size_t)t * 768 + c]), ref * qscale, 0.01f, 0.02f)) chk_fail(P, 7);
    }
    for (int c = tid; c < 1024; c += 256) {
      float a = 0.f; for (int k = 0; k < 128; ++k) a = fmaf(ckv[k], P.w_ukv[(size_t)k * 1024 + c], a);
      const int h = c >> 7, e = c & 127;
      if (e < 64) { if (far(bf2f(((const bf16_t*)(ws + O_KMLA))[((size_t)(b * 8 + h) * LP + p) * 96 + e]), a, 0.06f, 0.02f)) chk_fail(P, 8); }
      else { if (far(bf2f(((const bf16_t*)(ws + O_VT))[((size_t)(b * 8 + h) * 64 + (e - 64)) * LP + p]), a, 0.06f, 0.02f)) chk_fail(P, 9); }
    }
    for (int c = tid; c < 256; c += 256) {
      const int h = c >> 5, e = c & 31, j = e & 15;
      const float inv = powf(10000.f, -(float)j / 16.f); float sn, cs; sincosf((float)p * inv, &sn, &cs);
      const float x1 = pj[384 + j], x2 = pj[384 + 16 + j];
      const float ref = e < 16 ? x1 * cs - x2 * sn : x1 * sn + x2 * cs;
      if (far(bf2f(((const bf16_t*)(ws + O_KMLA))[((size_t)(b * 8 + h) * LP + p) * 96 + 64 + e]), ref, 0.06f, 0.02f)) chk_fail(P, 10);
    }
    __syncthreads();
  }
}
DI void chk_stageB(const Params& P, unsigned char* lds) {
  unsigned char* ws = P.ws;
  float* hv = (float*)lds; float* yv = hv + 1024; float* red = yv + 1024; float* oa = red + 8; float* ob = oa + 512;
  const int tid = threadIdx.x & 255;
  for (int sidx = blockIdx.x; sidx < 256; sidx += gridDim.x) {
    const int rt = (int)(hash_u(sidx * 104729u + 7u) % NR);
    const int b = rt / SEQ, p = NMETA + rt % SEQ, t = b * L + p;
    chk_load_hn(P, t, hv, red);
    for (int i = tid; i < 512; i += 256) { oa[i] = bf2f(((const bf16_t*)(ws + O_OA))[(size_t)rt * 512 + i]); ob[i] = bf2f(((const bf16_t*)(ws + O_OB))[(size_t)rt * 512 + i]); }
    __syncthreads();
    const bf16_t* gates = (const bf16_t*)P.out + (size_t)rt * 2048;
    for (int c = tid; c < D; c += 256) {
      float ga = 0.f, gb = 0.f, va = 0.f, vb = 0.f;
      for (int k = 0; k < D; ++k) { ga = fmaf(hv[k], P.w_in[(size_t)k * INC + 2536 + c], ga); gb = fmaf(hv[k], P.w_in[(size_t)k * INC + 3560 + c], gb); }
      for (int k = 0; k < 512; ++k) { va = fmaf(oa[k], P.w_bra[(size_t)k * D + c], va); vb = fmaf(ob[k], P.w_brb[(size_t)k * D + c], vb); }
      const float sa = 1.f / (1.f + expf(-ga)), sb = 1.f / (1.f + expf(-gb));
      if (far(bf2f(gates[c]), sa, 0.01f, 0.01f) || far(bf2f(gates[1024 + c]), sb, 0.01f, 0.01f)) chk_fail(P, 10);
      const float ref = va * sa + vb * sb;
      if (far(bf2f(((const bf16_t*)(ws + O_Y))[(size_t)rt * D + c]), ref, 0.004f, 0.03f)) chk_fail(P, 11);
    }
    __syncthreads();
  }
}
DI void chk_stageC(const Params& P, unsigned char* lds) {
  unsigned char* ws = P.ws;
  float* yv = (float*)lds;
  const int tid = threadIdx.x & 255;
  for (int sidx = blockIdx.x; sidx < 256; sidx += gridDim.x) {
    const int rt = (int)(hash_u(sidx * 15485863u + 3u) % NR);
    const int b = rt / SEQ, p = NMETA + rt % SEQ, t = b * L + p;
    for (int i = tid; i < D; i += 256) yv[i] = bf2f(((const bf16_t*)(ws + O_Y))[(size_t)rt * D + i]);
    __syncthreads();
    for (int c = tid; c < D; c += 256) {
      float a = 0.f; for (int k = 0; k < D; ++k) a = fmaf(yv[k], P.w_o[(size_t)k * D + c], a);
      const float ref = P.x[(size_t)rt * D + c] + a;
      if (far(P.out[(size_t)rt * D + c], ref, 0.003f, 0.002f)) chk_fail(P, 12);
    }
    __syncthreads();
  }
}
#endif

#if SELFCHECK
DI void chk_moe(const Params& P, unsigned char* lds) {
  unsigned char* ws = P.ws;
  NvMoeLds& S = *(NvMoeLds*)lds;
  __shared__ int sb[32];
  const int t = threadIdx.x & 255, lane = t & 63, wv = t >> 6;
  if (t == 0) { const unsigned* c = (const unsigned*)(ws + O_CTR) + 32; int a = 0; for (int i = 0; i < 32; ++i) { sb[i] = a; a += (((int)c[i] + 255) >> 8) * 256; } }
  __syncthreads();
  for (int sidx = blockIdx.x; sidx < 192; sidx += gridDim.x) {
    const int tok = (int)(hash_u(sidx * 40503u + 77u) % NR);
    const float* row = P.out + (size_t)tok * D;
    float s = 0.f;
    for (int i = t; i < D; i += 256) { const float v = row[i]; S.xr[i] = v; s += v * v; }
    s = block_sum256(s, S.red);
    const float rs = rsqrtf(s * (1.f / D) + EPS);
    for (int i = t; i < D; i += 256) { S.xn[i] = S.xr[i] * rs * P.g_ffn[i]; if (far(bf2f(((const bf16_t*)(ws + M_XN))[(size_t)tok * D + i]), S.xn[i], 0.02f, 0.01f)) chk_fail(P, 0); }
    __syncthreads();
    for (int c = wv; c < 36; c += 4) {
      float a = 0.f;
      if (c < 4) { for (int i = lane; i < D; i += 64) a = fmaf(S.xn[i], P.w_rg[i * 4 + c], a); }
      else { for (int i = lane; i < D; i += 64) a = fmaf(S.xn[i], P.w_re[i * 32 + (c - 4)], a); }
      a = wave_sum(a);
      if (lane == 0) S.logit[c] = a + (c < 4 ? P.b_rg[c] : P.b_re[c - 4]);
    }
    __syncthreads();
    const int* asg = (const int*)(ws + M_ASG) + (size_t)tok * 4;
    if (t == 0) {
      const int gs = asg[0] >> 3;
      float gm = S.logit[0]; for (int i = 1; i < 4; ++i) gm = fmaxf(gm, S.logit[i]);
      if (S.logit[gs] < gm - 1e-4f || (asg[2] >> 3) != gs) chk_fail(P, 1);
      const float* el = S.logit + 4 + gs * 8;
      const int e1 = asg[0] & 7, e2 = asg[2] & 7;
      int nb = 0; for (int i = 0; i < 8; ++i) if (i != e1 && i != e2 && el[i] > fminf(el[e1], el[e2]) + 1e-4f) ++nb;
      if (nb || e1 == e2 || el[e1] < el[e2] - 1e-4f) chk_fail(P, 2);
      float se = 0.f; for (int i = 0; i < 4; ++i) se += expf(S.logit[i] - gm);
      const float pg = expf(S.logit[gs] - gm) / se;
      const float a = expf(el[e1] - el[e1]), b2 = expf(el[e2] - el[e1]);
      S.gatew[0] = pg * a / (a + b2); S.gatew[1] = pg * b2 / (a + b2);
      S.expert[0] = asg[0]; S.expert[1] = asg[2];
      if (far(((const float*)(ws + M_WL))[(size_t)asg[0] * NR + asg[1]], S.gatew[0], 1e-4f, 1e-3f)) chk_fail(P, 3);
      if (far(((const float*)(ws + M_WL))[(size_t)asg[2] * NR + asg[3]], S.gatew[1], 1e-4f, 1e-3f)) chk_fail(P, 3);
      if (((const int*)(ws + M_LIST))[(size_t)asg[0] * NR + asg[1]] != tok || ((const int*)(ws + M_LIST))[(size_t)asg[2] * NR + asg[3]] != tok) chk_fail(P, 4);
    }
    __syncthreads();
    for (int a = 0; a < 2; ++a) {
      const int e = S.expert[a];
      const int slot = sb[e] + asg[2 * a + 1];
      const float* wg = P.w_eg + (size_t)e * D * 256;
      const float* wu = P.w_eu + (size_t)e * D * 256;
      float g = 0.f, u = 0.f;
      for (int k = 0; k < D; ++k) { const float xv = S.xn[k]; g = fmaf(xv, wg[(size_t)k * 256 + t], g); u = fmaf(xv, wu[(size_t)k * 256 + t], u); }
      S.hm[t] = g / (1.f + expf(-g)) * u;
      if (far(bf2f(((const bf16_t*)(ws + M_HMID))[(size_t)slot * 256 + t]), S.hm[t], 0.03f, 0.03f)) chk_fail(P, 5);
      __syncthreads();
      const float* wd = P.w_ed + (size_t)e * 256 * D;
      const float gw = S.gatew[a];
      for (int i = 0; i < 4; ++i) {
        float y = 0.f;
        for (int j = 0; j < 256; ++j) y = fmaf(S.hm[j], wd[(size_t)j * D + t + 256 * i], y);
        if (far(bf2f(((const bf16_t*)(ws + M_YS))[(size_t)slot * 1024 + t + 256 * i]), gw * y, 0.02f, 0.03f)) chk_fail(P, 6);
      }
      __syncthreads();
    }
  }
}
#endif

__global__ void __launch_bounds__(NTHR, 2) mega(Params P) {
  cg::grid_group grid = cg::this_grid();
  extern __shared__ __attribute__((aligned(16))) unsigned char lds[];
  const int G = gridDim.x, bx = blockIdx.x;
  const int lane = threadIdx.x & 63, wv = threadIdx.x >> 6, gw = bx * NW + wv, NGW = G * NW;
  const int half = threadIdx.x >> 8, t2 = threadIdx.x & 255;
  constexpr int MTB = (NT + 255) / 256;
  if (threadIdx.x < 16) ((unsigned*)(lds + LDS_CTL))[threadIdx.x] = 0u;
  __syncthreads();
  if (P.use_cg) grid.sync();
  const XcdBarrier xb = xcd_barrier_post((unsigned*)(P.ws + O_BAR), (volatile LAS unsigned*)(lds + LDS_CTL));
  int* const slot = (int*)(lds + LDS_CTL + 16);
#define GSYNC() xcd_barrier(xb)
  p0_prologue(P, lds);
  GSYNC();
  { int mt, nt; for (int k = 0; p1_tile_map(bx, k, G, mt, nt); ++k) p1_inproj_tile(P, mt, nt, lds); }
  GSYNC();
  for (int t = gw; t < NT; t += NGW) p2a_token(P, t, lane);
  GSYNC();
  for (int t = bx; t < MTB * (768 / 256 + 1024 / 256); t += G) { if (t < MTB * 3) p2b_q_tile(P, t, lds); else p2b_kv_tile(P, t - MTB * 3, lds); }
  GSYNC();
#if SELFCHECK
  chk_stageA(P, lds);
  GSYNC();
#endif
  for (int it = next_item(P, 0, slot); it < 512; it = next_item(P, 0, slot)) mla_item(P, it, lds);
#if SELFCHECK
  GSYNC();
  for (int sidx = bx; sidx < 384; sidx += G) nv_mla<true>(P, sidx < 8 ? (sidx < 4 ? sidx * 37 : NR - 1 - (sidx - 4) * 4096) : (int)(hash_u(sidx * 2654435761u + 11u) % NR), lds);
#endif
  GSYNC();
  for (int q = next_item(P, 1, slot); 2 * q < S1_ITEMS; q = next_item(P, 1, slot)) s1_item(P, 2 * q + (wv >> 2));
  GSYNC();
  { unsigned* wl = (unsigned*)lds + wv * 64; for (int r = gw; r < NR; r += NGW) s2_dispatch(P, r, lane, wl); }
  GSYNC();
  for (int it = next_item(P, 2, slot); it < 512; it = next_item(P, 2, slot)) dsa_item(P, it, lds);
  GSYNC();
#if SELFCHECK
  for (int sidx = bx; sidx < 384; sidx += G) nv_dsa_check(P, sidx < 8 ? (sidx < 4 ? 200 + sidx * 37 : NR - 1 - (sidx - 4) * 4096) : (int)(hash_u(sidx * 2246822519u + 5u) % NR), lds);
  GSYNC();
#endif
  { int mt, nt; for (int k = 0; p78_tile_map(bx, k, G, mt, nt); ++k) p7_merge_tile(P, mt, nt, lds); }
  GSYNC();
#if SELFCHECK
  chk_stageB(P, lds);
  GSYNC();
#endif
  { int mt, nt; for (int k = 0; p78_tile_map(bx, k, G, mt, nt); ++k) p8_out_tile(P, mt, nt, lds); }
  GSYNC();
#if SELFCHECK
  chk_stageC(P, lds);
  GSYNC();
#endif
  { int lane9 = threadIdx.x & 63; asm volatile("" : "+v"(lane9)); for (int t = gw; t < NR; t += NGW) p9_router_token(P, t, lane9); }
  { float* scr = (float*)lds + half * (64 * 65 + 32);
    for (int k = bx; 2 * k < 32 * 128; k += G) p9_conv_gu_item(P, 2 * k + half, scr, t2, true);
    for (int k = bx; 2 * k < 32 * 64; k += G) { const int it = 2 * k + half, e = it >> 6; transpose_item(P.w_ed + (size_t)e * 256 * 1024, 1024, 256, (bf16_t*)(P.ws + M_WD) + (size_t)e * 1024 * 256, MapOff{0}, it & 63, scr, t2, true); } }
  GSYNC();
  {
    int e, rt, cnt, bs;
    const int ntile = moe_tile_lookup(P, 0, e, rt, cnt, bs);
    for (int q = next_item(P, 3, slot); q < ntile * 6; q = next_item(P, 3, slot)) {
      if (q < ntile * 2) { moe_tile_lookup(P, q >> 1, e, rt, cnt, bs); p10_gu_tile(P, q >> 1, e, rt, cnt, bs, q & 1, lds); }
      else { const int q2 = q - ntile * 2; moe_tile_lookup(P, q2 >> 2, e, rt, cnt, bs); p11_down_tile(P, q2 >> 2, e, rt, cnt, bs, q2 & 3, lds); }
    }
    GSYNC();
#if SELFCHECK
    chk_moe(P, lds);
    GSYNC();
#endif
    int* sbase = (int*)lds;
    __syncthreads();
    if (threadIdx.x == 0) { const unsigned* c = (const unsigned*)(P.ws + O_CTR) + 32; int a = 0; for (int i = 0; i < 32; ++i) { sbase[i] = a; a += (((int)c[i] + 255) >> 8) * 256; } }
    __syncthreads();
    int lane12 = threadIdx.x & 63; asm volatile("" : "+v"(lane12));
    for (int t = gw; t < NR; t += NGW) p12_final_token(P, t, lane12, sbase);
  }
#if SELFCHECK
  GSYNC();
  {
    const unsigned* chk = (const unsigned*)(P.ws + O_CHK);
    float f = 1.f;
    for (int k = 15; k >= 0; --k) if (chk[k]) f = 1.f + 0.25f * (float)(1 << k);
    if (f != 1.f) for (size_t i = (size_t)bx * NTHR + threadIdx.x; i < (size_t)NR * D; i += (size_t)G * NTHR) P.out[i] *= f;
  }
#endif
}
}

extern "C" void kernel_launch(void* const* d_in, const int* in_sizes, int n_in, void* d_out, int out_size, void* d_ws, size_t ws_size, hipStream_t stream) {
  using namespace mk;
  static int grid_blocks = 0;
  if (!grid_blocks) {
    int dev = 0, cus = 0, per_cu = 0;
    (void)hipGetDevice(&dev);
    (void)hipDeviceGetAttribute(&cus, hipDeviceAttributeMultiprocessorCount, dev);
    (void)hipFuncSetAttribute((const void*)mega, hipFuncAttributeMaxDynamicSharedMemorySize, LDS_BYTES);
    (void)hipOccupancyMaxActiveBlocksPerMultiprocessor(&per_cu, mega, NTHR, LDS_BYTES);
    per_cu = 1;
    grid_blocks = cus * per_cu;
    if (ws_size < WS_END) fprintf(stderr, "workspace too small: need %zu have %zu\n", (size_t)WS_END, ws_size);
  }
  Params p{};
  const float** pp = (const float**)&p;
  for (int i = 0; i < 21; ++i) pp[i] = (const float*)d_in[i];
  p.out = (float*)d_out; p.ws = (unsigned char*)d_ws;
  (void)hipMemsetAsync((unsigned char*)d_ws + O_CHK, 0, O_WR - O_CHK, stream);
  void* args[] = {&p};
  hipError_t e = hipLaunchCooperativeKernel((void*)mega, dim3(grid_blocks), dim3(NTHR), args, LDS_BYTES, stream);
  if (e != hipSuccess) fprintf(stderr, "cooperative launch failed: %s (grid %d)\n", hipGetErrorString(e), grid_blocks);
}
```

```cpp
#include <hip/hip_runtime.h>
#include <hip/hip_cooperative_groups.h>
#include <cstdio>
#include <math.h>
#include <stdint.h>
namespace cg = cooperative_groups;

namespace mk {
typedef unsigned short bf16_t;
typedef short bf16x8 __attribute__((ext_vector_type(8)));
typedef float f32x16 __attribute__((ext_vector_type(16)));
typedef float f32x4 __attribute__((ext_vector_type(4)));
typedef unsigned u32x4 __attribute__((ext_vector_type(4)));
typedef unsigned u32x2 __attribute__((ext_vector_type(2)));

constexpr int D = 1024, NB = 4, SEQ = 4096, NMETA = 16, L = SEQ + NMETA, NT = NB * L  , NR = NB * SEQ  ;
constexpr int INC = 4584, LP = 4128;
constexpr int S_CQ = 0, S_CKV = 256, S_KR = 384, S_WI = 416, S_KI = 424;
constexpr float EPS = 1e-6f;
constexpr float LOG2E = 1.4426950408889634f;
constexpr int NTHR = 512, NW = NTHR / 64;

#define DI __device__ __forceinline__
#ifndef REP_P0
#define REP_P0 1
#endif
#ifndef REP_P1
#define REP_P1 1
#endif
#ifndef REP_MLA
#define REP_MLA 1
#endif
#ifndef REP_S1
#define REP_S1 1
#endif
#ifndef REP_S2
#define REP_S2 1
#endif
#ifndef REP_DSA
#define REP_DSA 1
#endif
#ifndef REP_P7
#define REP_P7 1
#endif
#ifndef REP_P8
#define REP_P8 1
#endif
#ifndef REP_MOE
#define REP_MOE 1
#endif
#ifndef REP_P2
#define REP_P2 1
#endif
#ifndef REP_CONV
#define REP_CONV 1
#endif
#ifndef SELFCHECK
#define SELFCHECK 0
#endif

typedef __bf16 bf2_t __attribute__((ext_vector_type(2)));
DI bf16_t f2bf(float x) { const __bf16 b = (__bf16)x; return __builtin_bit_cast(bf16_t, b); }
DI float bf2f(bf16_t v) { return __uint_as_float(((unsigned)v) << 16); }
DI unsigned pk2(float lo, float hi) { const bf2_t v = {(__bf16)lo, (__bf16)hi}; return __builtin_bit_cast(unsigned, v); }
#define dpp_i(v, ctrl) __builtin_amdgcn_update_dpp(0, (v), (ctrl), 0xf, 0xf, true)
DI float wave_sum(float v) {
  v += __int_as_float(dpp_i(__float_as_int(v), 0xB1));
  v += __int_as_float(dpp_i(__float_as_int(v), 0x4E));
  v += __int_as_float(dpp_i(__float_as_int(v), 0x141));
  v += __int_as_float(dpp_i(__float_as_int(v), 0x140));
  const int b = __float_as_int(v);
  return (__int_as_float(__builtin_amdgcn_readlane(b, 0)) + __int_as_float(__builtin_amdgcn_readlane(b, 16))) +
         (__int_as_float(__builtin_amdgcn_readlane(b, 32)) + __int_as_float(__builtin_amdgcn_readlane(b, 48)));
}
DI int wave_sumi(int v) {
  v += dpp_i(v, 0xB1); v += dpp_i(v, 0x4E); v += dpp_i(v, 0x141); v += dpp_i(v, 0x140);
  return (__builtin_amdgcn_readlane(v, 0) + __builtin_amdgcn_readlane(v, 16)) + (__builtin_amdgcn_readlane(v, 32) + __builtin_amdgcn_readlane(v, 48));
}
DI float block_sum256(float v, float* red) {
  v = wave_sum(v);
  __syncthreads();
  if ((threadIdx.x & 63) == 0) red[threadIdx.x >> 6] = v;
  __syncthreads();
  return red[0] + red[1] + red[2] + red[3];
}
DI int block_sumi256(int v, int* red) {
#pragma unroll
  for (int o = 1; o < 64; o <<= 1) v += __shfl_xor(v, o);
  __syncthreads();
  if ((threadIdx.x & 63) == 0) red[threadIdx.x >> 6] = v;
  __syncthreads();
  return red[0] + red[1] + red[2] + red[3];
}
DI int n_adm(int p) { return p < NMETA ? NMETA : NMETA + 64 * (1 + (p - NMETA) / 64); }


#if SELFCHECK
DI unsigned hash_u(unsigned x) { x ^= x >> 16; x *= 0x7feb352du; x ^= x >> 15; x *= 0x846ca68bu; x ^= x >> 16; return x; }
DI bool far(float got, float ref, float atol, float rtol) { const float d = fabsf(got - ref); return !(d <= atol + rtol * fabsf(ref)); }
#endif
struct Params {
  const float *x, *meta, *g_mix, *w_in, *g_cq, *g_ckv, *w_uq, *w_ukv, *w_bra, *w_brb, *w_o, *rel_bias, *g_ffn, *w_rg, *b_rg, *w_re, *b_re, *w_eg, *w_eu, *w_ed, *g_fin;
  float* out; unsigned char* ws;
  int use_cg; int pad;
};

constexpr size_t al(size_t x) { return (x + 255) & ~(size_t)255; }
constexpr size_t O_QB = 0;
constexpr size_t O_KB = al(O_QB + (size_t)NT * 512 * 2);
constexpr size_t O_VBT = al(O_KB + (size_t)NT * 512 * 2);
constexpr size_t O_QI = al(O_VBT + (size_t)NB * 8 * 64 * LP * 2);
constexpr size_t O_KI = al(O_QI + (size_t)NT * 512 * 2);
constexpr size_t O_WI = al(O_KI + (size_t)NT * 64 * 2);
constexpr size_t O_SMALL = al(O_WI + (size_t)NT * 8 * 4);
constexpr size_t O_CQN = al(O_SMALL + (size_t)NT * 512 * 4);
constexpr size_t O_CKVN = al(O_CQN + (size_t)NT * 256 * 2);
constexpr size_t O_QA = al(O_CKVN + (size_t)NT * 128 * 2);
constexpr size_t O_KMLA = al(O_QA + (size_t)NT * 768 * 2);
constexpr size_t O_VT = al(O_KMLA + (size_t)NB * 8 * LP * 96 * 2);
constexpr size_t R_END = al(O_VT + (size_t)NB * 8 * 64 * LP * 2 + (size_t)NT * 1536 * 2);
constexpr size_t O_HN = O_QA;
constexpr size_t O_KR = O_SMALL;
constexpr size_t O_OA = O_SMALL;
constexpr int MW = 132;
constexpr size_t O_MASK = al(O_OA + (size_t)NR * 512 * 2);
constexpr size_t O_SCORES = al(O_MASK + (size_t)NR * MW * 4);
constexpr size_t SCORES_PER_BATCH = (size_t)8192 * 1088;
constexpr size_t O_OB = O_SCORES;
constexpr size_t O_Y = al(O_OB + (size_t)NR * 512 * 2);
static_assert(O_SCORES + (size_t)NB * SCORES_PER_BATCH * 2 + 65536 <= R_END, "scores must fit region R");
constexpr size_t O_WIN = R_END;
constexpr size_t O_WG = al(O_WIN + (size_t)2560 * 1024 * 2);
constexpr size_t O_WUQ = al(O_WG + (size_t)2048 * 1024 * 2);
constexpr size_t O_WUKV = al(O_WUQ + (size_t)768 * 256 * 2);
constexpr size_t O_WBRA = al(O_WUKV + (size_t)1024 * 128 * 2);
constexpr size_t O_WBRB = al(O_WBRA + (size_t)1024 * 512 * 2);
constexpr size_t O_WO = al(O_WBRB + (size_t)1024 * 512 * 2);
constexpr size_t O_ROPE = al(O_WO + (size_t)1024 * 1024 * 2);
constexpr size_t O_CHK = al(O_ROPE + (size_t)L * 32 * 4);
constexpr size_t O_CTR = al(O_CHK + 256);
constexpr size_t O_BAR = al(O_CTR + 256);
constexpr size_t O_DEP = al(O_BAR + 3456 * 4);
constexpr size_t O_WR = al(O_DEP + 512 * 4);
constexpr size_t WS_END = al(O_WR + (size_t)36 * 1024 * 4);
constexpr int SLOTS = 2 * NR + 32 * 256;
constexpr size_t M_XN = 0;
constexpr size_t M_HMID = al(M_XN + (size_t)NR * 1024 * 2);
constexpr size_t M_YS = al(M_HMID + (size_t)SLOTS * 256 * 2);
constexpr size_t M_WGU = al(M_YS + (size_t)SLOTS * 1024 * 2);
constexpr size_t M_WD = al(M_WGU + (size_t)32 * 512 * 1024 * 2);
constexpr size_t M_LIST = al(M_WD + (size_t)32 * 1024 * 256 * 2);
constexpr size_t M_WL = al(M_LIST + (size_t)32 * NR * 4);
constexpr size_t M_ASG = al(M_WL + (size_t)32 * NR * 4);
constexpr size_t M_RS = al(M_ASG + (size_t)NR * 16);
constexpr size_t M_END = al(M_RS + (size_t)NR * 4);
static_assert(M_END <= O_WIN, "MoE overlay must stay below the weights");
static_assert(WS_END <= (size_t)256 * 1024 * 1024, "workspace budget");
#if SELFCHECK
DI void chk_fail(const Params& P, int k) { atomicAdd((unsigned*)(P.ws + O_CHK) + k, 1u); }
#endif
constexpr int GX_A = 256 * 128, GX_B = 256 * 128, GX_STAGE = GX_A + GX_B;
constexpr int LDS_CTL = 2 * GX_STAGE;
constexpr int LDS_RED = LDS_CTL + 64;
constexpr int LDS_BYTES = LDS_RED + 4 * 256 * 4;


#define XB_TMO      128
#define XB_XCNT(j)  (256  + 64 * (j))
#define XB_XSUB(j)  (1280 + 64 * (j))
#define XB_XGEN(j)  (2304 + 64 * (j))
#define XB_TOP      3328
#define XB_TOPGEN   3392
#define XCD_BAR_WORDS 3456
#define XB_SPIN_CAP (1u << 18)
#define LAS __attribute__((address_space(3)))
DI unsigned xb_ld(unsigned* p)              { return __hip_atomic_load(p, __ATOMIC_RELAXED, __HIP_MEMORY_SCOPE_AGENT); }
DI unsigned xb_add(unsigned* p, unsigned v) { return __hip_atomic_fetch_add(p, v, __ATOMIC_RELAXED, __HIP_MEMORY_SCOPE_AGENT); }
DI unsigned xb_xcc_id() { return (unsigned)__builtin_amdgcn_s_getreg((3 << 11) | 20) & 0xFu; }
#define XB_SPIN(cond, bar) do { unsigned _sp = 0; while (cond) { __builtin_amdgcn_s_sleep(1); \
    if ((++_sp & 255u) == 0u) { if (xb_ld(&(bar)[XB_TMO])) break; if (_sp > XB_SPIN_CAP) { atomicAdd(&(bar)[XB_TMO], 1u); break; } } } } while (0)
struct XcdBarrier { unsigned* bar; unsigned x; volatile LAS unsigned* st; };
DI XcdBarrier xcd_barrier_post(unsigned* bar, volatile LAS unsigned* st) {
  XcdBarrier b; b.bar = bar; b.x = xb_xcc_id(); b.st = st;
  if (threadIdx.x == 0) (void)xb_add(&bar[XB_XCNT(b.x)], 1u);
  return b;
}
DI void xcd_barrier_complete(unsigned* bar, unsigned x, unsigned& nloc, unsigned& nx) {
  const unsigned G = gridDim.x * gridDim.y * gridDim.z;
  unsigned sum, cnt, mine, sp = 0u;
  for (;;) {
    sum = 0u; cnt = 0u; mine = 0u;
#pragma unroll
    for (unsigned j = 0; j < 16; ++j) { const unsigned c = xb_ld(&bar[XB_XCNT(j)]); sum += c; cnt += (c > 0u) ? 1u : 0u; mine = (j == x) ? c : mine; }
    if (sum == G) break;
    __builtin_amdgcn_s_sleep(1);
    if ((++sp & 255u) == 0u) { if (xb_ld(&bar[XB_TMO])) break; if (sp > XB_SPIN_CAP) { atomicAdd(&bar[XB_TMO], 1u); break; } }
  }
  nloc = mine > 0u ? mine : 1u; nx = cnt > 0u ? cnt : 1u;
}
DI void xcd_barrier(const XcdBarrier& b) {
  asm volatile("s_waitcnt vmcnt(0)" ::: "memory");
  __syncthreads();
  if (threadIdx.x == 0) {
    unsigned* bar = b.bar;
    __builtin_amdgcn_s_waitcnt(0);
    unsigned nloc = b.st[0], nx = b.st[1];
    if (nloc == 0u) { xcd_barrier_complete(bar, b.x, nloc, nx); b.st[0] = nloc; b.st[1] = nx; }
    const unsigned old = xb_add(&bar[XB_XSUB(b.x)], 1u);
    const unsigned gen = old / nloc;
    if (old + 1u == (gen + 1u) * nloc) {
      __builtin_amdgcn_fence(__ATOMIC_RELEASE, "agent");
      asm volatile("s_waitcnt vmcnt(0)" ::: "memory");
      const unsigned og = xb_add(&bar[XB_TOP], 1u);
      const unsigned tg = og / nx;
      if (og + 1u == (tg + 1u) * nx) xb_add(&bar[XB_TOPGEN], 1u);
      else XB_SPIN(xb_ld(&bar[XB_TOPGEN]) == tg, bar);
      __builtin_amdgcn_fence(__ATOMIC_ACQUIRE, "agent");
      xb_add(&bar[XB_XGEN(b.x)], 1u);
      asm volatile("s_waitcnt vmcnt(0)" ::: "memory");
    } else {
      XB_SPIN(xb_ld(&bar[XB_XGEN(b.x)]) == gen, bar);
      __builtin_amdgcn_fence(__ATOMIC_ACQUIRE, "agent");
      asm volatile("s_waitcnt vmcnt(0)" ::: "memory");
    }
  }
  __syncthreads();
}

DI void p0_norm_row(const Params& P, int t, bf16_t* hn, int lane) {
  const int b = t / L, p = t % L;
  const float* row = p < NMETA ? P.meta + (size_t)p * D : P.x + ((size_t)b * SEQ + (p - NMETA)) * D;
  f32x4 v[4]; float s = 0.f;
#pragma unroll
  for (int i = 0; i < 4; ++i) { v[i] = *(const f32x4*)(row + 256 * i + 4 * lane); s += v[i][0] * v[i][0] + v[i][1] * v[i][1] + v[i][2] * v[i][2] + v[i][3] * v[i][3]; }
  s = wave_sum(s);
  const float rs = rsqrtf(s * (1.f / D) + EPS);
#pragma unroll
  for (int i = 0; i < 4; ++i) {
    const f32x4 g = *(const f32x4*)(P.g_mix + 256 * i + 4 * lane);
    u32x2 o; o[0] = pk2(v[i][0] * rs * g[0], v[i][1] * rs * g[1]); o[1] = pk2(v[i][2] * rs * g[2], v[i][3] * rs * g[3]);
    *(u32x2*)(hn + (size_t)t * D + 256 * i + 4 * lane) = o;
  }
}
template <class F>
DI void transpose_item(const float* src, int ldsrc, int K, bf16_t* dst, F map, int item, float* scr  , int tid, bool valid) {
  const int nkb = K / 64, kb = item % nkb, nb = item / nkb, k0 = kb * 64, n0 = nb * 64;
  if (valid) {
    const int n = tid & 63; const int col = map(n0 + n);
#pragma unroll 4
    for (int i = 0; i < 16; ++i) { const int k = (tid >> 6) + 4 * i; scr[k * 65 + n] = col >= 0 ? src[(size_t)(k0 + k) * ldsrc + col] : 0.f; }
  }
  __syncthreads();
  if (valid) {
    const int kq = tid & 7;
#pragma unroll
    for (int i = 0; i < 2; ++i) {
      const int n = (tid >> 3) + 32 * i;
      const float* s = scr + (kq * 8) * 65 + n;
      u32x4 o; o[0] = pk2(s[0], s[65]); o[1] = pk2(s[2 * 65], s[3 * 65]); o[2] = pk2(s[4 * 65], s[5 * 65]); o[3] = pk2(s[6 * 65], s[7 * 65]);
      *(u32x4*)(dst + (size_t)(n0 + n) * K + k0 + kq * 8) = o;
    }
  }
  __syncthreads();
}
struct MapIn {
  DI int operator()(int n) const {
    if (n < 416) return n;
    if (n < 424) return 2528 + (n - 416);
    if (n < 488) return 2464 + (n - 424);
    if (n < 512) return -1;
    return 416 + (n - 512);
  }
};
struct MapOff { int off; DI int operator()(int n) const { return off + n; } };
struct MapUkv { DI int operator()(int n) const { const int m = n & 511; return (m >> 6) * 128 + (n >> 9) * 64 + (m & 63); } };

DI void p0_prologue(const Params& P, unsigned char* lds) {
  unsigned char* ws = P.ws;
  const int tid = threadIdx.x, lane = tid & 63, wv = tid >> 6;
  const int gw = blockIdx.x * NW + wv, ngw = gridDim.x * NW;
  bf16_t* hn = (bf16_t*)(P.ws + O_HN);
  for (int t = gw; t < NT; t += ngw) p0_norm_row(P, t, hn, lane);
  float* rope = (float*)(ws + O_ROPE);
  for (int i = blockIdx.x * NTHR + tid; i < L * 16; i += gridDim.x * NTHR) {
    const int p = i >> 4, j = i & 15;
    const float inv = powf(10000.f, -(float)j / 16.f);
    const float ang = (float)p * inv;
    float sn, cs; sincosf(ang, &sn, &cs);
    rope[p * 32 + j] = cs; rope[p * 32 + 16 + j] = sn;
  }
  {
    bf16_t* vbt = (bf16_t*)(ws + O_VBT); bf16_t* vt = (bf16_t*)(ws + O_VT);
    for (int i = blockIdx.x * NTHR + tid; i < NB * 8 * 64 * (LP - L); i += gridDim.x * NTHR) {
      const int r = i / (LP - L), c = L + i % (LP - L);
      vbt[(size_t)r * LP + c] = 0; vt[(size_t)r * LP + c] = 0;
    }
  }
  {
    float* wr = (float*)(ws + O_WR);
    for (int i = blockIdx.x * NTHR + tid; i < 36 * 1024; i += gridDim.x * NTHR) {
      const int c = i >> 10, k = i & 1023;
      wr[i] = c < 4 ? P.w_rg[k * 4 + c] : P.w_re[k * 32 + (c - 4)];
    }
  }
  const int half = tid >> 8, t2 = tid & 255;
  float* scr = (float*)lds + half * (64 * 65 + 32);
  constexpr int I_IN = (1024 / 64) * (2560 / 64), I_G = (1024 / 64) * (2048 / 64), I_UQ = (256 / 64) * (768 / 64), I_UKV = (128 / 64) * (1024 / 64),
                I_BR = (512 / 64) * (1024 / 64), I_O = (1024 / 64) * (1024 / 64);
  constexpr int NIT = I_IN + I_G + I_UQ + I_UKV + 2 * I_BR + I_O;
  for (int it2 = blockIdx.x; 2 * it2 < NIT; it2 += gridDim.x) {
    int r = 2 * it2 + half; const bool valid = r < NIT; if (!valid) r = 0;
    if (r < I_IN) transpose_item(P.w_in, INC, 1024, (bf16_t*)(ws + O_WIN), MapIn(), r, scr, t2, valid);
    else if ((r -= I_IN) < I_G) transpose_item(P.w_in, INC, 1024, (bf16_t*)(ws + O_WG), MapOff{2536}, r, scr, t2, valid);
    else if ((r -= I_G) < I_UQ) transpose_item(P.w_uq, 768, 256, (bf16_t*)(ws + O_WUQ), MapOff{0}, r, scr, t2, valid);
    else if ((r -= I_UQ) < I_UKV) transpose_item(P.w_ukv, 1024, 128, (bf16_t*)(ws + O_WUKV), MapUkv{}, r, scr, t2, valid);
    else if ((r -= I_UKV) < I_BR) transpose_item(P.w_bra, 1024, 512, (bf16_t*)(ws + O_WBRA), MapOff{0}, r, scr, t2, valid);
    else if ((r -= I_BR) < I_BR) transpose_item(P.w_brb, 1024, 512, (bf16_t*)(ws + O_WBRB), MapOff{0}, r, scr, t2, valid);
    else { r -= I_BR; transpose_item(P.w_o, 1024, 1024, (bf16_t*)(ws + O_WO), MapOff{0}, r, scr, t2, valid); }
  }
}

struct TilePtrs { const bf16_t* A; const bf16_t* B; unsigned a[4], b[4]; };
DI void glds16(const unsigned char* g, unsigned char* l) { __builtin_amdgcn_global_load_lds((const unsigned*)g, (unsigned*)l, 16, 0, 0); }
template <bool SWAP>
DI int gemm_kloop(f32x16 (&acc)[4][2], const TilePtrs& tp, int K, unsigned char* lds) {
  const int tid = threadIdx.x, lane = tid & 63, w = __builtin_amdgcn_readfirstlane(tid >> 6), wr = w >> 2, wc = w & 3;
  const int nt = K / 64;
  unsigned char* const lw = lds + w * 1024;
  const int swz = (lane >> 1) & 7, hh = lane >> 5;
  const unsigned char* const ar = lds + (wr * 64 + (lane & 31)) * 128;
  const unsigned char* const br = lds + GX_A + (wc * 32 + (lane & 31)) * 128;
  int coff[4];
#pragma unroll
  for (int kk = 0; kk < 4; ++kk) coff[kk] = ((2 * kk + hh) ^ swz) * 16;
  bf16x8 At[2][4], B0[4], B1[4];
  unsigned oa[4], ob[4];
#pragma unroll
  for (int j = 0; j < 4; ++j) { oa[j] = tp.a[j]; ob[j] = tp.b[j]; }
#define HT_(BO_, H_) ((BO_) + (H_) * 16384)
#define STG_A(BO_, H_, kt) do { const unsigned char* g_ = (const unsigned char*)tp.A + (kt) * 128; glds16(g_ + oa[2 * (H_)], lw + HT_(BO_, H_)); glds16(g_ + oa[2 * (H_) + 1], lw + HT_(BO_, H_) + 8192); } while (0)
#define STG_B(BO_, H_, kt) do { const unsigned char* g_ = (const unsigned char*)tp.B + (kt) * 128; glds16(g_ + ob[2 * (H_)], lw + GX_A + HT_(BO_, H_)); glds16(g_ + ob[2 * (H_) + 1], lw + GX_A + HT_(BO_, H_) + 8192); } while (0)
#define PIN_OFFS() do { _Pragma("unroll") for (int j_ = 0; j_ < 4; ++j_) { asm volatile("" : "+v"(oa[j_])); asm volatile("" : "+v"(ob[j_])); } } while (0)
#define LDA_(BO_, H_) do { _Pragma("unroll") for (int m_ = 0; m_ < 2; ++m_) _Pragma("unroll") for (int k_ = 0; k_ < 4; ++k_) At[m_][k_] = *(const bf16x8*)(ar + HT_(BO_, H_) + m_ * 4096 + coff[k_]); } while (0)
#define LDB_(Bx, BO_, H_) do { _Pragma("unroll") for (int k_ = 0; k_ < 4; ++k_) Bx[k_] = *(const bf16x8*)(br + HT_(BO_, H_) + coff[k_]); } while (0)
#define MMA_(ai, bj, Bx) do { __builtin_amdgcn_s_setprio(1); _Pragma("unroll") for (int k_ = 0; k_ < 4; ++k_) _Pragma("unroll") for (int m_ = 0; m_ < 2; ++m_) \
    acc[2 * (ai) + m_][bj] = SWAP ? __builtin_amdgcn_mfma_f32_32x32x16_bf16(Bx[k_], At[m_][k_], acc[2 * (ai) + m_][bj], 0, 0, 0) \
                                  : __builtin_amdgcn_mfma_f32_32x32x16_bf16(At[m_][k_], Bx[k_], acc[2 * (ai) + m_][bj], 0, 0, 0); __builtin_amdgcn_s_setprio(0); } while (0)
#define WAIT_V(n) asm volatile("s_waitcnt vmcnt(" #n ")" ::: "memory")
#define WAIT_L(n) asm volatile("s_waitcnt lgkmcnt(" #n ")" ::: "memory")
#define BAR_ __builtin_amdgcn_s_barrier()
#define SCHED_ __builtin_amdgcn_sched_barrier(0)
  WAIT_V(0);
  PIN_OFFS();
  STG_B(0, 0, 0); STG_A(0, 0, 0); STG_B(0, 1, 0); STG_A(0, 1, 0);
  if (wr == 1) BAR_;
  WAIT_V(4); BAR_;
  STG_B(GX_STAGE, 0, 1); STG_A(GX_STAGE, 0, 1); STG_B(GX_STAGE, 1, 1);
  WAIT_V(6); BAR_;
  int cur = 0;
#pragma unroll 1
  for (int t = 0; t < nt - 2; ++t) {
    asm volatile("" : "+s"(cur));
    PIN_OFFS();
    const int nxt = cur ^ GX_STAGE;
    LDB_(B0, cur, 0); SCHED_; LDA_(cur, 0); STG_A(nxt, 1, t + 1);
    WAIT_L(8); BAR_; WAIT_L(0); MMA_(0, 0, B0); BAR_; SCHED_;
    LDB_(B1, cur, 1); STG_B(cur, 0, t + 2);
    BAR_; WAIT_L(0); MMA_(0, 1, B1); BAR_;
    LDA_(cur, 1); STG_A(cur, 0, t + 2);
    BAR_; WAIT_L(0); MMA_(1, 0, B0); BAR_; SCHED_;
    STG_B(cur, 1, t + 2);
    WAIT_V(6); BAR_; MMA_(1, 1, B1); BAR_;
    cur = nxt;
  }
  { asm volatile("" : "+s"(cur));
    PIN_OFFS();
    const int nxt = cur ^ GX_STAGE;
    LDB_(B0, cur, 0); LDA_(cur, 0); STG_A(nxt, 1, nt - 1);
    BAR_; WAIT_L(0); MMA_(0, 0, B0); BAR_;
    LDB_(B1, cur, 1); BAR_; WAIT_L(0); MMA_(0, 1, B1); BAR_;
    LDA_(cur, 1); WAIT_V(4); BAR_; WAIT_L(0); MMA_(1, 0, B0); MMA_(1, 1, B1); BAR_;
    LDB_(B0, nxt, 0); LDA_(nxt, 0); WAIT_V(2); BAR_; WAIT_L(0); MMA_(0, 0, B0); BAR_;
    LDB_(B1, nxt, 1); WAIT_V(0); BAR_; WAIT_L(0); MMA_(0, 1, B1); BAR_;
    LDA_(nxt, 1); BAR_; WAIT_L(0); MMA_(1, 0, B0); MMA_(1, 1, B1); BAR_; }
  if (wr == 0) BAR_;
#undef HT_
#undef STG_A
#undef STG_B
#undef LDA_
#undef LDB_
#undef MMA_
#undef PIN_OFFS
  int l_ = threadIdx.x & 63; asm volatile("" : "+v"(l_));
  return l_;
}
DI void tile_rc(int i, int& row, int& chunk) { const int t = threadIdx.x; row = (i >> 1) * 128 + (i & 1) * 64 + (t >> 3); chunk = (t & 7) ^ ((row >> 1) & 7); }
DI int acc_row0(int wr, int mi) { return (mi >> 1) * 128 + wr * 64 + (mi & 1) * 32; }
DI int acc_col0(int wc, int ni) { return ni * 128 + wc * 32; }
#define EPI_IDS(L_) const int lane = (L_), w = __builtin_amdgcn_readfirstlane(threadIdx.x >> 6), wr = w >> 2, wc = w & 3, hh = lane >> 5, lc = lane & 31
DI u32x2 pk4(float a, float b, float c, float d) { u32x2 o; o[0] = pk2(a, b); o[1] = pk2(c, d); return o; }
DI void zero_acc(f32x16 (&acc)[4][2]) {
#pragma unroll
  for (int i = 0; i < 4; ++i)
#pragma unroll
    for (int j = 0; j < 2; ++j)
#pragma unroll
      for (int r = 0; r < 16; ++r) acc[i][j][r] = 0.f;
}
DI void set_ptrs(TilePtrs& tp, const bf16_t* A, int lda, int M, int m0, const bf16_t* Bt, int ldb, int N, int n0) {
#pragma unroll
  for (int i = 0; i < 4; ++i) {
    int row, kc; tile_rc(i, row, kc);
    int r = m0 + row; r = r < M ? r : M - 1;
    int c = n0 + row; c = c < N ? c : N - 1;
    tp.a[i] = ((unsigned)r * (unsigned)lda + kc * 8) * 2u;
    tp.b[i] = ((unsigned)c * (unsigned)ldb + kc * 8) * 2u;
  }
  tp.A = A; tp.B = Bt;
}

DI bool p1_tile_map(int bx, int k, int G, int& mt, int& nt) { const int t = bx + k * G; if (t >= 65 * 18) return false; mt = t / 18; nt = t % 18; return true; }
DI bool p78_tile_map(int bx, int k, int G, int& mt, int& nt) { const int t = bx + k * G; if (t >= 64 * 4) return false; mt = t >> 2; nt = t & 3; return true; }

DI void p1_seg0_epilogue(const Params& P, f32x16 (&acc)[4][2], int m0, int cb, int wr, int wc, int hh, int lc, unsigned char* lds) {
  unsigned char* ws = P.ws;
  float* red = (float*)(lds + LDS_RED);
  const bool isq = cb == 0;
#pragma unroll
  for (int mi = 0; mi < 4; ++mi) {
    float a = 0.f;
#pragma unroll
    for (int r = 0; r < 16; ++r) a = fmaf(acc[mi][0][r], acc[mi][0][r], a);
    if (isq) {
#pragma unroll
      for (int r = 0; r < 16; ++r) a = fmaf(acc[mi][1][r], acc[mi][1][r], a);
    }
    const auto sw = __builtin_amdgcn_permlane32_swap(__float_as_uint(a), __float_as_uint(a), false, false);
    a = __uint_as_float(sw[0]) + __uint_as_float(sw[1]);
    if (hh == 0) red[wc * 256 + acc_row0(wr, mi) + lc] = a;
  }
  __syncthreads();
#pragma unroll
  for (int mi = 0; mi < 4; ++mi) {
    const int rl = acc_row0(wr, mi) + lc;
    int row = m0 + rl;
    asm volatile("" : "+v"(row));
    const bool ok = row < NT;
    const float ssq = red[rl] + red[256 + rl] + red[512 + rl] + red[768 + rl];
    if (isq) {
      const float rs = rsqrtf(ssq * (1.f / 256) + EPS);
      bf16_t* dp = (bf16_t*)(ws + O_CQN) + (size_t)row * 256 + 4 * hh;
#pragma unroll
      for (int ni = 0; ni < 2; ++ni)
#pragma unroll
        for (int g = 0; g < 4; ++g) {
          const int col = acc_col0(wc, ni) + 8 * g;
          const f32x4 gq = *(const f32x4*)(P.g_cq + col + 4 * hh);
          if (ok) *(u32x2*)(dp + col) = pk4(acc[mi][ni][4 * g] * rs * gq[0], acc[mi][ni][4 * g + 1] * rs * gq[1], acc[mi][ni][4 * g + 2] * rs * gq[2], acc[mi][ni][4 * g + 3] * rs * gq[3]);
        }
    } else {
      const float rs = rsqrtf(ssq * (1.f / 128) + EPS);
      bf16_t* dp = (bf16_t*)(ws + O_CKVN) + (size_t)row * 128 + wc * 32 + 4 * hh;
#pragma unroll
      for (int g = 0; g < 4; ++g) {
        const f32x4 gk = *(const f32x4*)(P.g_ckv + wc * 32 + 8 * g + 4 * hh);
        if (ok) *(u32x2*)(dp + 8 * g) = pk4(acc[mi][0][4 * g] * rs * gk[0], acc[mi][0][4 * g + 1] * rs * gk[1], acc[mi][0][4 * g + 2] * rs * gk[2], acc[mi][0][4 * g + 3] * rs * gk[3]);
      }
      if (wc == 0) {
        const int rowc = ok ? row : NT - 1, p = rowc % L;
        const float* rp = (const float*)(ws + O_ROPE) + p * 32;
        u32x2 o[4];
#pragma unroll
        for (int g = 0; g < 2; ++g) {
          const f32x4 cs = *(const f32x4*)(rp + 8 * g + 4 * hh), sn = *(const f32x4*)(rp + 16 + 8 * g + 4 * hh);
          float lo[4], hi[4];
#pragma unroll
          for (int e = 0; e < 4; ++e) { const float x1 = acc[mi][1][4 * g + e], x2 = acc[mi][1][4 * (g + 2) + e]; lo[e] = x1 * cs[e] - x2 * sn[e]; hi[e] = x1 * sn[e] + x2 * cs[e]; }
          o[g] = pk4(lo[0], lo[1], lo[2], lo[3]); o[g + 2] = pk4(hi[0], hi[1], hi[2], hi[3]);
        }
        bf16_t* kp = (bf16_t*)(ws + O_KR) + (size_t)row * 32 + 4 * hh;
        if (ok) {
#pragma unroll
          for (int g = 0; g < 4; ++g) *(u32x2*)(kp + 8 * g) = o[g];
        }
      } else if (wc == 1) {
        if (ok) {
          f32x4 wv; wv[0] = acc[mi][1][0] * 0.35355339059327373f; wv[1] = acc[mi][1][1] * 0.35355339059327373f; wv[2] = acc[mi][1][2] * 0.35355339059327373f; wv[3] = acc[mi][1][3] * 0.35355339059327373f;
          *(f32x4*)((float*)(ws + O_WI) + (size_t)row * 8 + 4 * hh) = wv;
          bf16_t* kip = (bf16_t*)(ws + O_KI) + (size_t)row * 64 + 4 * hh;
#pragma unroll
          for (int g = 1; g < 4; ++g) *(u32x2*)(kip + 8 * g - 8) = pk4(acc[mi][1][4 * g], acc[mi][1][4 * g + 1], acc[mi][1][4 * g + 2], acc[mi][1][4 * g + 3]);
        }
      } else if (wc == 2) {
        if (ok) {
          bf16_t* kip = (bf16_t*)(ws + O_KI) + (size_t)row * 64 + 24 + 4 * hh;
#pragma unroll
          for (int g = 0; g < 4; ++g) *(u32x2*)(kip + 8 * g) = pk4(acc[mi][1][4 * g], acc[mi][1][4 * g + 1], acc[mi][1][4 * g + 2], acc[mi][1][4 * g + 3]);
        }
      } else {
        if (ok) *(u32x2*)((bf16_t*)(ws + O_KI) + (size_t)row * 64 + 56 + 4 * hh) = pk4(acc[mi][1][0], acc[mi][1][1], acc[mi][1][2], acc[mi][1][3]);
      }
    }
  }
}
DI void p1_inproj_tile(const Params& P, int mt, int nt, unsigned char* lds) {
  unsigned char* ws = P.ws;
  const int m0 = mt * 256, n0 = nt * 256;
  const bf16_t* hn = (const bf16_t*)(ws + O_HN);
  TilePtrs tp;
  if (n0 < 2560) set_ptrs(tp, hn, 1024, NT, m0, (const bf16_t*)(ws + O_WIN), 1024, 2560, n0);
  else set_ptrs(tp, hn, 1024, NT, m0, (const bf16_t*)(ws + O_WG), 1024, 2048, n0 - 2560);
  f32x16 acc[4][2]; zero_acc(acc);
  const int seg = n0 / 512, cb = n0 % 512;
  if (seg == 3) {
    EPI_IDS(gemm_kloop<false>(acc, tp, 1024, lds));
    bf16_t* vbt = (bf16_t*)(ws + O_VBT);
#pragma unroll
    for (int mi = 0; mi < 4; ++mi)
#pragma unroll
      for (int ni = 0; ni < 2; ++ni) {
        const int col = cb + acc_col0(wc, ni) + lc;
        const int rbase = m0 + acc_row0(wr, mi) + 4 * hh;
        const int h = col >> 6, d = col & 63;
#pragma unroll
        for (int g = 0; g < 4; ++g) {
          const int row = rbase + 8 * g;
          if (row < NT) {
            const int b = row / L, p = row % L;
            *(u32x2*)(vbt + ((size_t)(b * 8 + h) * 64 + d) * LP + p) = pk4(acc[mi][ni][4 * g], acc[mi][ni][4 * g + 1], acc[mi][ni][4 * g + 2], acc[mi][ni][4 * g + 3]);
          }
        }
      }
    return;
  }
  EPI_IDS(gemm_kloop<true>(acc, tp, 1024, lds));
  if (seg == 0) { p1_seg0_epilogue(P, acc, m0, cb, wr, wc, hh, lc, lds); return; }
  if (n0 >= 2560) {
    bf16_t* gates = (bf16_t*)P.out;
#pragma unroll
    for (int mi = 0; mi < 4; ++mi) {
      int row = m0 + acc_row0(wr, mi) + lc;
      asm volatile("" : "+v"(row));
      const int b = row / L, p = row - b * L;
      const bool ok = row < NT && p >= NMETA;
      bf16_t* gp = gates + (size_t)(row - NMETA * (b + 1)) * 2048 + (n0 - 2560) + 4 * hh;
#pragma unroll
      for (int ni = 0; ni < 2; ++ni)
#pragma unroll
        for (int g = 0; g < 4; ++g) {
          float sg[4];
#pragma unroll
          for (int e = 0; e < 4; ++e) sg[e] = __builtin_amdgcn_rcpf(1.f + __expf(-acc[mi][ni][4 * g + e]));
          if (ok) *(u32x2*)(gp + acc_col0(wc, ni) + 8 * g) = pk4(sg[0], sg[1], sg[2], sg[3]);
        }
    }
    return;
  }
#pragma unroll
  for (int mi = 0; mi < 4; ++mi) {
    int row = m0 + acc_row0(wr, mi) + lc;
    asm volatile("" : "+v"(row));
    const bool ok = row < NT;
    {
      bf16_t* dp = (bf16_t*)(ws + (seg == 1 ? O_QB : seg == 2 ? O_KB : O_QI)) + (size_t)row * 512 + cb + 4 * hh;
      const float sc = seg == 4 ? 0.125f : seg == 1 ? 0.125f * LOG2E : 1.f;
#pragma unroll
      for (int ni = 0; ni < 2; ++ni)
#pragma unroll
        for (int g = 0; g < 4; ++g)
          if (ok) *(u32x2*)(dp + acc_col0(wc, ni) + 8 * g) = pk4(acc[mi][ni][4 * g] * sc, acc[mi][ni][4 * g + 1] * sc, acc[mi][ni][4 * g + 2] * sc, acc[mi][ni][4 * g + 3] * sc);
    }
  }
}

DI void p2a_token(const Params& P, int t, int lane) {
  unsigned char* ws = P.ws;
  const float* sm = (const float*)(ws + O_SMALL) + (size_t)t * 512;
  const int b = t / L, p = t % L;
  {
    const f32x4 v = *(const f32x4*)(sm + S_CQ + 4 * lane);
    const float s = wave_sum(v[0] * v[0] + v[1] * v[1] + v[2] * v[2] + v[3] * v[3]);
    const float rs = rsqrtf(s * (1.f / 256) + EPS);
    const f32x4 g = *(const f32x4*)(P.g_cq + 4 * lane);
    u32x2 o; o[0] = pk2(v[0] * rs * g[0], v[1] * rs * g[1]); o[1] = pk2(v[2] * rs * g[2], v[3] * rs * g[3]);
    *(u32x2*)((bf16_t*)(ws + O_CQN) + (size_t)t * 256 + 4 * lane) = o;
  }
  {
    const float v0 = sm[S_CKV + 2 * lane], v1 = sm[S_CKV + 2 * lane + 1];
    const float s = wave_sum(v0 * v0 + v1 * v1);
    const float rs = rsqrtf(s * (1.f / 128) + EPS);
    *(unsigned*)((bf16_t*)(ws + O_CKVN) + (size_t)t * 128 + 2 * lane) = pk2(v0 * rs * P.g_ckv[2 * lane], v1 * rs * P.g_ckv[2 * lane + 1]);
  }
  {
    const float* rp = (const float*)(ws + O_ROPE) + p * 32;
    const int j = lane & 15;
    const float x1 = sm[S_KR + j], x2 = sm[S_KR + 16 + j], cs = rp[j], sn = rp[16 + j];
    const float o = (lane & 16) ? (x1 * sn + x2 * cs) : (x1 * cs - x2 * sn);
    bf16_t* km = (bf16_t*)(ws + O_KMLA);
    const bf16_t ob = f2bf(o);
    const int c = lane & 31;
#pragma unroll
    for (int hq = 0; hq < 4; ++hq) { const int h = hq + 4 * (lane >> 5); km[((size_t)(b * 8 + h) * LP + p) * 96 + 64 + c] = ob; }
  }
  ((bf16_t*)(ws + O_KI))[(size_t)t * 64 + lane] = f2bf(sm[S_KI + lane]);
  if (lane < 8) ((float*)(ws + O_WI))[(size_t)t * 8 + lane] = sm[S_WI + lane] * 0.35355339059327373f;
}

DI void p2b_q_tile(const Params& P, int tile, unsigned char* lds) {
  unsigned char* ws = P.ws;
  constexpr int NNT = 768 / 256;
  const int mt = tile / NNT, nt = tile % NNT, m0 = mt * 256, n0 = nt * 256;
  TilePtrs tp; set_ptrs(tp, (const bf16_t*)(ws + O_CQN), 256, NT, m0, (const bf16_t*)(ws + O_WUQ), 256, 768, n0);
  f32x16 acc[4][2]; zero_acc(acc);
  EPI_IDS(gemm_kloop<true>(acc, tp, 256, lds));
  const float qscale = 0.10206207261596575f * LOG2E;
  const float* rope = (const float*)(ws + O_ROPE);
  bf16_t* qa = (bf16_t*)(ws + O_QA);
#pragma unroll
  for (int mi = 0; mi < 4; ++mi) {
    int row = m0 + acc_row0(wr, mi) + lc;
    asm volatile("" : "+v"(row));
    const bool ok = row < NT;
    const int rowc = ok ? row : NT - 1, p = rowc % L;
#pragma unroll
    for (int ni = 0; ni < 2; ++ni) {
      const int c0 = n0 + acc_col0(wc, ni);
      const bool is_rope = ((c0 >> 5) % 3) == 2;
      float v[16];
#pragma unroll
      for (int r = 0; r < 16; ++r) v[r] = acc[mi][ni][r];
      if (is_rope) {
#pragma unroll
        for (int g = 0; g < 2; ++g) {
          const f32x4 cs = *(const f32x4*)(rope + p * 32 + 8 * g + 4 * hh), sn = *(const f32x4*)(rope + p * 32 + 16 + 8 * g + 4 * hh);
#pragma unroll
          for (int e = 0; e < 4; ++e) {
            const float lo = v[4 * g + e], hi = v[4 * (g + 2) + e];
            v[4 * g + e] = lo * cs[e] - hi * sn[e];
            v[4 * (g + 2) + e] = lo * sn[e] + hi * cs[e];
          }
        }
      }
#pragma unroll
      for (int g = 0; g < 4; ++g)
        if (ok) *(u32x2*)(qa + (size_t)row * 768 + c0 + 8 * g + 4 * hh) = pk4(v[4 * g] * qscale, v[4 * g + 1] * qscale, v[4 * g + 2] * qscale, v[4 * g + 3] * qscale);
    }
  }
}
DI void p2b_kv_tile(const Params& P, int tile, unsigned char* lds) {
  unsigned char* ws = P.ws;
  constexpr int NNT = 1024 / 256;
  const int mt = tile / NNT, nt = tile % NNT, m0 = mt * 256, n0 = nt * 256;
  TilePtrs tp; set_ptrs(tp, (const bf16_t*)(ws + O_CKVN), 128, NT, m0, (const bf16_t*)(ws + O_WUKV), 128, 1024, n0);
  f32x16 acc[4][2]; zero_acc(acc);
  if (nt < 2) {
    {
      const int row = m0 + (threadIdx.x >> 1);
      if (row < NT) {
        const int b = row / L, p = row % L, h = 4 * nt + 2 * (threadIdx.x & 1);
        const u32x4* src = (const u32x4*)((const bf16_t*)(ws + O_KR) + (size_t)row * 32);
        u32x4* dst = (u32x4*)((bf16_t*)(ws + O_KMLA) + ((size_t)(b * 8 + h) * LP + p) * 96 + 64);
        const u32x4 v0 = src[0], v1 = src[1], v2 = src[2], v3 = src[3];
        dst[0] = v0; dst[1] = v1; dst[2] = v2; dst[3] = v3;
        u32x4* dst2 = dst + (size_t)LP * 96 * 2 / 16;
        dst2[0] = v0; dst2[1] = v1; dst2[2] = v2; dst2[3] = v3;
      }
    }
    EPI_IDS(gemm_kloop<true>(acc, tp, 128, lds));
    bf16_t* km = (bf16_t*)(ws + O_KMLA);
#pragma unroll
    for (int mi = 0; mi < 4; ++mi) {
      int row = m0 + acc_row0(wr, mi) + lc;
      asm volatile("" : "+v"(row));
      const bool ok = row < NT;
      const int b = row / L, p = row % L;
#pragma unroll
      for (int ni = 0; ni < 2; ++ni) {
        const int cc = n0 + acc_col0(wc, ni), h = cc >> 6, c = (cc & 63) + 4 * hh;
        bf16_t* kp = km + ((size_t)(b * 8 + h) * LP + p) * 96 + c;
#pragma unroll
        for (int g = 0; g < 4; ++g)
          if (ok) *(u32x2*)(kp + 8 * g) = pk4(acc[mi][ni][4 * g], acc[mi][ni][4 * g + 1], acc[mi][ni][4 * g + 2], acc[mi][ni][4 * g + 3]);
      }
    }
  } else {
    EPI_IDS(gemm_kloop<false>(acc, tp, 128, lds));
    bf16_t* vt = (bf16_t*)(ws + O_VT);
#pragma unroll
    for (int mi = 0; mi < 4; ++mi)
#pragma unroll
      for (int ni = 0; ni < 2; ++ni) {
        const int cc = n0 - 512 + acc_col0(wc, ni) + lc, h = cc >> 6, d = cc & 63;
        const int rbase = m0 + acc_row0(wr, mi) + 4 * hh;
#pragma unroll
        for (int g = 0; g < 4; ++g) {
          const int row = rbase + 8 * g;
          if (row < NT) {
            const int b = row / L, p = row % L;
            *(u32x2*)(vt + ((size_t)(b * 8 + h) * 64 + d) * LP + p) = pk4(acc[mi][ni][4 * g], acc[mi][ni][4 * g + 1], acc[mi][ni][4 * g + 2], acc[mi][ni][4 * g + 3]);
          }
        }
      }
  }
}


DI int next_item(const Params& P, int ctr, int* slot) {
  __syncthreads();
  if (threadIdx.x == 0) *slot = (int)atomicAdd((unsigned*)(P.ws + O_CTR) + ctr, 1u);
  __syncthreads();
  return *slot;
}
DI float fast_exp2(float x) { return __builtin_amdgcn_exp2f(x); }
DI bf16x8 pack8(const f32x16& v, int s) {
  u32x4 p;
  p[0] = pk2(v[8 * s + 0], v[8 * s + 1]); p[1] = pk2(v[8 * s + 2], v[8 * s + 3]); p[2] = pk2(v[8 * s + 4], v[8 * s + 5]); p[3] = pk2(v[8 * s + 6], v[8 * s + 7]);
  return __builtin_bit_cast(bf16x8, p);
}

constexpr float MASKV = -3.0e38f;
constexpr float DEFER_THR = 6.0f;
DI float xmax32(float v) {
  const auto r = __builtin_amdgcn_permlane32_swap(__float_as_uint(v), __float_as_uint(v), false, false);
  return fmaxf(__uint_as_float(r[0]), __uint_as_float(r[1]));
}
DI void softmax_update1(f32x16& s, float& m, float mref, float& lsum, f32x16& o0, f32x16& o1) {
  float mx = s[0];
#pragma unroll
  for (int r = 1; r < 16; ++r) mx = fmaxf(mx, s[r]);
  mx = xmax32(mx);
  const bool have = m > -1e29f;
  const float shift = (have ? m : 0.f) - mref;
  const bool need = (mx - shift > DEFER_THR) || (!have && mx > -1e37f);
  if (__any(need || shift != 0.f)) {
    const float delta = need ? mx - shift : 0.f;
    const float alpha = (need && have) ? fast_exp2(-delta) : 1.f;
    m = need ? (have ? m : 0.f) + delta : m;
    const float sub = shift + delta;
#pragma unroll
    for (int r = 0; r < 16; ++r) { s[r] -= sub; o0[r] *= alpha; o1[r] *= alpha; }
    lsum *= alpha;
  }
#pragma unroll
  for (int r = 0; r < 16; ++r) s[r] = fast_exp2(s[r]);
  typedef float f32x2 __attribute__((ext_vector_type(2)));
  f32x2 ps = {0.f, 0.f};
#pragma unroll
  for (int r = 0; r < 16; r += 2) ps += (f32x2){s[r], s[r + 1]};
  lsum += ps[0] + ps[1];
}
DI void pv_subtile(const unsigned char* Vc, int vstr, const f32x16& p, f32x16& o0, f32x16& o1) {
#pragma unroll
  for (int s2 = 0; s2 < 2; ++s2) {
    const bf16x8 pb = pack8(p, s2);
    const u32x2 a0l = *(const u32x2*)(Vc + s2 * 32), a0h = *(const u32x2*)(Vc + s2 * 32 + 16);
    const u32x2 a1l = *(const u32x2*)(Vc + 32 * vstr + s2 * 32), a1h = *(const u32x2*)(Vc + 32 * vstr + s2 * 32 + 16);
    o0 = __builtin_amdgcn_mfma_f32_32x32x16_bf16(__builtin_bit_cast(bf16x8, (u32x4){a0l[0], a0l[1], a0h[0], a0h[1]}), pb, o0, 0, 0, 0);
    o1 = __builtin_amdgcn_mfma_f32_32x32x16_bf16(__builtin_bit_cast(bf16x8, (u32x4){a1l[0], a1l[1], a1h[0], a1h[1]}), pb, o1, 0, 0, 0);
  }
}
constexpr int MLA_KSTR = 208, MLA_VSTR = 136, MLA_KBYTES = 64 * MLA_KSTR, MLA_STAGE = MLA_KBYTES + 64 * MLA_VSTR;
DI void mla_stage(const unsigned char* cur, int s, int cw, int lq, int hh, const bf16x8 (&qf)[6], f32x16& o0, f32x16& o1, float& m, float& lsum) {
  if (s > cw) return;
  const bool full = s < cw;
  const float mref = m > -1e29f ? m : 0.f;
  f32x16 s0, s1;
#pragma unroll
  for (int r = 0; r < 16; ++r) { s0[r] = -mref; s1[r] = -mref; }
  const unsigned char* Kc = cur + lq * MLA_KSTR + hh * 16;
  {
    bf16x8 kf[6];
#pragma unroll
    for (int kk = 0; kk < 6; ++kk) kf[kk] = *(const bf16x8*)(Kc + kk * 32);
#pragma unroll
    for (int kk = 0; kk < 6; ++kk) s0 = __builtin_amdgcn_mfma_f32_32x32x16_bf16(kf[kk], qf[kk], s0, 0, 0, 0);
    __builtin_amdgcn_sched_group_barrier(0x100, 6, 0);
    __builtin_amdgcn_sched_group_barrier(0x008, 6, 0);
  }
  if (full) {
    bf16x8 kf[6];
#pragma unroll
    for (int kk = 0; kk < 6; ++kk) kf[kk] = *(const bf16x8*)(Kc + 32 * MLA_KSTR + kk * 32);
#pragma unroll
    for (int kk = 0; kk < 6; ++kk) s1 = __builtin_amdgcn_mfma_f32_32x32x16_bf16(kf[kk], qf[kk], s1, 0, 0, 0);
    __builtin_amdgcn_sched_group_barrier(0x100, 6, 0);
    __builtin_amdgcn_sched_group_barrier(0x008, 6, 0);
  } else {
#pragma unroll
    for (int r = 8; r < 16; ++r) s0[r] = MASKV;
  }
  const unsigned char* Vc = cur + MLA_KBYTES + lq * MLA_VSTR + hh * 8;
  softmax_update1(s0, m, mref, lsum, o0, o1);
  pv_subtile(Vc, MLA_VSTR, s0, o0, o1);
  if (full) {
    softmax_update1(s1, m, mref, lsum, o0, o1);
    pv_subtile(Vc + 64, MLA_VSTR, s1, o0, o1);
  }
}
DI void mla_item(const Params& P, int item, unsigned char* lds) {
  unsigned char* ws = P.ws;
  const int jq = 15 - item / 32, bh = item % 32, b = bh >> 3, h = bh & 7;
  const int c0 = 4 * jq + 1;
  const int tid = threadIdx.x, lane = tid & 63, w = __builtin_amdgcn_readfirstlane(tid >> 6), hh = lane >> 5, lq = lane & 31;
  const int cw = c0 + (w >> 1);
  const int pq = NMETA + 256 * jq + 32 * w + lq;
  const int tq = b * L + pq;
  bf16x8 qf[6];
  {
    const bf16_t* qrow = (const bf16_t*)(ws + O_QA) + (size_t)tq * 768 + h * 96 + hh * 8;
#pragma unroll
    for (int kk = 0; kk < 6; ++kk) qf[kk] = *(const bf16x8*)(qrow + kk * 16);
  }
  f32x16 o0, o1;
#pragma unroll
  for (int r = 0; r < 16; ++r) { o0[r] = 0.f; o1[r] = 0.f; }
  float m = -1e30f, lsum = 0.f;
  const int nst = c0 + 4;
  const bf16_t* kg = (const bf16_t*)(ws + O_KMLA) + (size_t)bh * LP * 96;
  const bf16_t* vg = (const bf16_t*)(ws + O_VT) + (size_t)bh * 64 * LP;
  unsigned kgo[2], klo[2], vgo, vlo;
  const bool k2 = tid < 256;
#pragma unroll
  for (int i = 0; i < 2; ++i) { int idx = tid + 512 * i; idx = idx < 768 ? idx : 767; const int row = idx / 12, c = idx % 12; kgo[i] = row * 96 + c * 8; klo[i] = row * MLA_KSTR + c * 16; }
  { const int d = tid >> 3, c = tid & 7; vgo = d * LP + c * 8; vlo = MLA_KBYTES + d * MLA_VSTR + c * 16; }
  u32x4 rkA[2], rvA, rkB[2], rvB;
#define MLA_LOAD(rk_, rv_, st) do { const bf16_t* kgs = kg + (size_t)(st) * 64 * 96; const bf16_t* vgs = vg + (st) * 64; \
    rk_[0] = *(const u32x4*)(kgs + kgo[0]); rk_[1] = *(const u32x4*)(kgs + kgo[1]); rv_ = *(const u32x4*)(vgs + vgo); } while (0)
#define MLA_WRITE(rk_, rv_, buf) do { unsigned char* nb_ = (buf); \
    *(u32x4*)(nb_ + klo[0]) = rk_[0]; if (k2) *(u32x4*)(nb_ + klo[1]) = rk_[1]; \
    *(u32x2*)(nb_ + vlo) = (u32x2){rv_[0], rv_[1]}; *(u32x2*)(nb_ + vlo + 8) = (u32x2){rv_[2], rv_[3]}; } while (0)
  unsigned char* buf0 = lds; unsigned char* buf1 = lds + MLA_STAGE;
  MLA_LOAD(rkA, rvA, 0); MLA_WRITE(rkA, rvA, buf0);
  __syncthreads();
  if (nst > 1) MLA_LOAD(rkA, rvA, 1);
#pragma unroll 1
  for (int s = 0; s < nst; s += 2) {
    if (s + 2 < nst) MLA_LOAD(rkB, rvB, s + 2);
    mla_stage(buf0, s, cw, lq, hh, qf, o0, o1, m, lsum);
    if (s + 1 < nst) MLA_WRITE(rkA, rvA, buf1);
    __syncthreads();
    if (s + 1 >= nst) break;
    if (s + 3 < nst) MLA_LOAD(rkA, rvA, s + 3);
    mla_stage(buf1, s + 1, cw, lq, hh, qf, o0, o1, m, lsum);
    if (s + 2 < nst) MLA_WRITE(rkB, rvB, buf0);
    __syncthreads();
  }
#undef MLA_LOAD
#undef MLA_WRITE
  lsum += __shfl_xor(lsum, 32);
  const float inv = 1.f / lsum;
  bf16_t* oa = (bf16_t*)(ws + O_OA) + (size_t)(tq - NMETA * (b + 1)) * 512 + h * 64 + 4 * hh;
#pragma unroll
  for (int g = 0; g < 4; ++g) {
    u32x2 v0, v1;
    v0[0] = pk2(o0[4 * g] * inv, o0[4 * g + 1] * inv); v0[1] = pk2(o0[4 * g + 2] * inv, o0[4 * g + 3] * inv);
    v1[0] = pk2(o1[4 * g] * inv, o1[4 * g + 1] * inv); v1[1] = pk2(o1[4 * g + 2] * inv, o1[4 * g + 3] * inv);
    *(u32x2*)(oa + 8 * g) = v0;
    *(u32x2*)(oa + 32 + 8 * g) = v1;
  }
}


DI size_t score_row_off(int b, int i) {
  const int c = 1 + (i >> 6), m = c - 1;
  return (size_t)b * SCORES_PER_BATCH + (size_t)8192 * (m + (m >> 1) * ((m + 1) >> 1)) + (size_t)(i & 63) * (128 * ((c >> 1) + 1));
}
constexpr int S1_ITEMS = 4 * 560;
DI void s1_item(const Params& P, int it) {
  unsigned char* ws = P.ws;
  const int b = it & 3; int r = it >> 2; int c = 64;
  while (r >= (c >> 2) + 1) { r -= (c >> 2) + 1; --c; }
  const int n = 16 + 64 * c;
  const int lane = threadIdx.x & 63, w = (threadIdx.x >> 6) & 3, lq = lane & 15, lg = lane >> 4;
  const int i = (c - 1) * 64 + 16 * w + lq, tq = b * L + NMETA + i;
  bf16x8 qf[8][2];
  const bf16_t* qrow = (const bf16_t*)(ws + O_QI) + (size_t)tq * 512 + 8 * lg;
#pragma unroll
  for (int h = 0; h < 8; ++h) { qf[h][0] = *(const bf16x8*)(qrow + h * 64); qf[h][1] = *(const bf16x8*)(qrow + h * 64 + 32); }
  const f32x4 wa = *(const f32x4*)((const float*)(ws + O_WI) + (size_t)tq * 8), wb = *(const f32x4*)((const float*)(ws + O_WI) + (size_t)tq * 8 + 4);
  const float wv[8] = {wa[0], wa[1], wa[2], wa[3], wb[0], wb[1], wb[2], wb[3]};
  unsigned* srow = (unsigned*)((_Float16*)(ws + O_SCORES) + score_row_off(b, i)) + 4 * lg;
  const bf16_t* kbase = (const bf16_t*)(ws + O_KI) + ((size_t)b * L + lq) * 64 + 8 * lg;
#pragma unroll 1
  for (int g2 = 0; g2 < 2; ++g2) {
    const int kg = 256 * r + 128 * g2;
#pragma unroll 1
    for (int kt4 = 0; kt4 < 64; kt4 += 16) {
      const int ka = kg + kt4, kb = ka + 64;
      if (ka >= n) break;
      f32x4 sa = {0.f, 0.f, 0.f, 0.f}, sb = {0.f, 0.f, 0.f, 0.f};
      {
        const bf16_t* kp = kbase + (size_t)ka * 64;
        const bf16x8 a0 = *(const bf16x8*)kp, a1 = *(const bf16x8*)(kp + 32);
#pragma unroll
        for (int h = 0; h < 8; ++h) {
          f32x4 acc = {0.f, 0.f, 0.f, 0.f};
          acc = __builtin_amdgcn_mfma_f32_16x16x32_bf16(a0, qf[h][0], acc, 0, 0, 0);
          acc = __builtin_amdgcn_mfma_f32_16x16x32_bf16(a1, qf[h][1], acc, 0, 0, 0);
#pragma unroll
          for (int q = 0; q < 4; ++q) sa[q] = fmaf(wv[h], fmaxf(acc[q], 0.f), sa[q]);
        }
      }
      if (kb < n) {
        const bf16_t* kp = kbase + (size_t)kb * 64;
        const bf16x8 a0 = *(const bf16x8*)kp, a1 = *(const bf16x8*)(kp + 32);
#pragma unroll
        for (int h = 0; h < 8; ++h) {
          f32x4 acc = {0.f, 0.f, 0.f, 0.f};
          acc = __builtin_amdgcn_mfma_f32_16x16x32_bf16(a0, qf[h][0], acc, 0, 0, 0);
          acc = __builtin_amdgcn_mfma_f32_16x16x32_bf16(a1, qf[h][1], acc, 0, 0, 0);
#pragma unroll
          for (int q = 0; q < 4; ++q) sb[q] = fmaf(wv[h], fmaxf(acc[q], 0.f), sb[q]);
        }
      }
      typedef _Float16 h2_t __attribute__((ext_vector_type(2)));
      u32x4 o;
#pragma unroll
      for (int q = 0; q < 4; ++q) { const h2_t v = {(_Float16)sa[q], (_Float16)sb[q]}; o[q] = __builtin_bit_cast(unsigned, v); }
      *(u32x4*)(srow + (kg >> 1) + kt4) = o;
    }
  }
}

DI unsigned f2key(float f) { const unsigned u = __float_as_uint(f); return (u & 0x80000000u) ? ~u : (u | 0x80000000u); }
DI unsigned long long lanemask_lt(int lane) { return (1ull << lane) - 1ull; }
template <int NG>
DI void s2_row(const Params& P, int rq, int lane) {
  unsigned char* ws = P.ws;
  const int b = rq / SEQ, i = rq % SEQ, c = 1 + (i >> 6), n = 16 + 64 * c;
  const unsigned* srow = (const unsigned*)((const _Float16*)(ws + O_SCORES) + score_row_off(b, i)) + lane;
  typedef unsigned short u16x2 __attribute__((ext_vector_type(2)));
  u16x2 hp[NG];
  {
    unsigned raw[NG];
#pragma unroll
    for (int e = 0; e < NG; ++e) raw[e] = srow[64 * e];
#pragma unroll
    for (int e = 0; e < NG; ++e) asm volatile("" : "+v"(raw[e]));
#pragma unroll
    for (int e = 0; e < NG; ++e) {
      const unsigned d = raw[e];
      unsigned k = d ^ ((((d >> 15) & 0x00010001u) * 0xffffu) | 0x80008000u);
      if (128 * e + lane >= n) k &= 0xffff0000u;
      if (128 * e + 64 + lane >= n) k &= 0x0000ffffu;
      hp[e] = __builtin_bit_cast(u16x2, k);
    }
  }
  unsigned T = 0; int c_lo = 1 << 30, c_hi = 0;
  for (int bit = 15; bit >= 0; --bit) {
    const unsigned cand = T | (1u << bit);
    const unsigned short chm1 = (unsigned short)(cand - 1u);
    const u16x2 cv = {chm1, chm1}, one = {1, 1};
    u16x2 a0 = {0, 0}, a1 = {0, 0};
#pragma unroll
    for (int e = 0; e < NG; ++e) {
      u16x2 t;
      asm("v_pk_sub_u16 %0, %1, %2 clamp" : "=v"(t) : "v"(hp[e]), "v"(cv));
      asm("v_pk_min_u16 %0, %1, %2" : "=v"(t) : "v"(t), "v"(one));
      if (e & 1) asm("v_pk_add_u16 %0, %1, %2" : "=v"(a1) : "v"(a1), "v"(t)); else asm("v_pk_add_u16 %0, %1, %2" : "=v"(a0) : "v"(a0), "v"(t));
    }
    const u16x2 as = a0 + a1;
    const int cc = wave_sumi((int)as[0] + (int)as[1]);
    if (cc >= 256) { T = cand; c_lo = cc; } else { c_hi = cc; }
    if (c_lo == 256) break;
  }
  unsigned mlo = 0u, mhi = 0u;
  unsigned long long w64 = 0ull;
  int rem = c_lo == 256 ? (1 << 20) : 256 - c_hi;
#pragma unroll
  for (int e = 0; e < NG; ++e) {
    const unsigned kk = __builtin_bit_cast(unsigned, hp[e]);
#pragma unroll
    for (int h = 0; h < 2; ++h) {
      const unsigned kv = h ? (kk >> 16) : (kk & 0xffffu);
      const bool eq = kv == T;
      const unsigned long long meq = __ballot(eq), mgt = __ballot(kv > T);
      unsigned long long msel = mgt;
      if (meq) {
        const int pre = __popcll(meq & lanemask_lt(lane));
        msel |= __ballot(eq && pre < rem);
        rem -= __popcll(meq); rem = rem < 0 ? 0 : rem;
      }
      const int wd = 2 * e + h;
      if (wd < 64) { if (lane == wd) { mlo = (unsigned)msel; mhi = (unsigned)(msel >> 32); } } else if (wd == 64) w64 = msel;
    }
  }
  unsigned* mrow = (unsigned*)(P.ws + O_MASK) + (size_t)rq * MW;
  *(u32x2*)(mrow + 2 * lane) = (u32x2){mlo, mhi};
  if (lane == 0) { *(u32x2*)(mrow + 128) = (u32x2){(unsigned)w64, (unsigned)(w64 >> 32)}; *(u32x2*)(mrow + 130) = (u32x2){0u, 0u}; }
}
DI void s2_dispatch(const Params& P, int rq, int lane, unsigned* wl) {
  (void)wl;
  const int c = 1 + ((rq % SEQ) >> 6), n = 16 + 64 * c;
  if (n <= 256) {
    unsigned* mrow = (unsigned*)(P.ws + O_MASK) + (size_t)rq * MW;
    unsigned long long m = 0ull;
    const int lo = 64 * lane;
    if (lo + 64 <= n) m = ~0ull; else if (lo < n) m = (1ull << (n - lo)) - 1ull;
    *(u32x2*)(mrow + 2 * lane) = (u32x2){(unsigned)m, (unsigned)(m >> 32)};
    if (lane == 0) { *(u32x2*)(mrow + 128) = (u32x2){0u, 0u}; *(u32x2*)(mrow + 130) = (u32x2){0u, 0u}; }
    return;
  }
  const int ng = (c >> 1) + 1;
  if (ng <= 5) s2_row<5>(P, rq, lane);
  else if (ng <= 9) s2_row<9>(P, rq, lane);
  else if (ng <= 13) s2_row<13>(P, rq, lane);
  else if (ng <= 17) s2_row<17>(P, rq, lane);
  else if (ng <= 21) s2_row<21>(P, rq, lane);
  else if (ng <= 25) s2_row<25>(P, rq, lane);
  else if (ng <= 29) s2_row<29>(P, rq, lane);
  else s2_row<33>(P, rq, lane);
}

DI int t5_bucket(int rel) {
  const int n = rel < 0 ? -rel : rel;
  int v;
  if (n < 8) v = n;
  else v = 8 + (n >= 12) + (n >= 16) + (n >= 23) + (n >= 32) + (n >= 46) + (n >= 64) + (n >= 91);
  return (rel > 0 ? 16 : 0) + v;
}
constexpr int DSA_KSTR = 144, DSA_VSTR = 136, DSA_KBYTES = 64 * DSA_KSTR, DSA_STAGE = DSA_KBYTES + 64 * DSA_VSTR;
constexpr int DSA_TB = 2 * DSA_STAGE;
DI void dsa_stage(const unsigned char* cur, int s, int cw, int lq, int hh, int pq, int qmin, float bfar, const float* tb, const unsigned* mrow,
                  const bf16x8 (&qf)[4], f32x16& o0, f32x16& o1, float& m, float& lsum) {
  if (s > cw) return;
  const bool full = s < cw;
  const int kb0 = 64 * s;
  const bool near = kb0 + 63 >= qmin - 91;
  const unsigned w0 = mrow[2 * s] >> (4 * hh), w1 = mrow[2 * s + 1] >> (4 * hh);
  const float mref = m > -1e29f ? m : 0.f;
  f32x16 s0, s1;
  const float binit = (near ? 0.f : bfar) - mref;
#pragma unroll
  for (int r = 0; r < 16; ++r) { s0[r] = binit; s1[r] = binit; }
  const unsigned char* Kc = cur + lq * DSA_KSTR + hh * 16;
  {
    bf16x8 kf[4];
#pragma unroll
    for (int kk = 0; kk < 4; ++kk) kf[kk] = *(const bf16x8*)(Kc + kk * 32);
#pragma unroll
    for (int kk = 0; kk < 4; ++kk) s0 = __builtin_amdgcn_mfma_f32_32x32x16_bf16(kf[kk], qf[kk], s0, 0, 0, 0);
    __builtin_amdgcn_sched_group_barrier(0x100, 4, 0);
    __builtin_amdgcn_sched_group_barrier(0x008, 4, 0);
  }
  if (full) {
    bf16x8 kf[4];
#pragma unroll
    for (int kk = 0; kk < 4; ++kk) kf[kk] = *(const bf16x8*)(Kc + 32 * DSA_KSTR + kk * 32);
#pragma unroll
    for (int kk = 0; kk < 4; ++kk) s1 = __builtin_amdgcn_mfma_f32_32x32x16_bf16(kf[kk], qf[kk], s1, 0, 0, 0);
    __builtin_amdgcn_sched_group_barrier(0x100, 4, 0);
    __builtin_amdgcn_sched_group_barrier(0x008, 4, 0);
  }
  const float* tp = tb + (kb0 + 4 * hh - pq + 192);
  const unsigned char* Vc = cur + DSA_KBYTES + lq * DSA_VSTR + hh * 8;
  if (near) {
#pragma unroll
    for (int r = 0; r < 16; ++r) s0[r] += tp[(r & 3) + 8 * (r >> 2)];
  }
#pragma unroll
  for (int r = 0; r < 16; ++r) s0[r] = (w0 & (1u << ((r & 3) + 8 * (r >> 2)))) ? s0[r] : MASKV;
  softmax_update1(s0, m, mref, lsum, o0, o1);
  pv_subtile(Vc, DSA_VSTR, s0, o0, o1);
  if (full) {
    if (near) {
#pragma unroll
      for (int r = 0; r < 16; ++r) s1[r] += tp[32 + (r & 3) + 8 * (r >> 2)];
    }
#pragma unroll
    for (int r = 0; r < 16; ++r) s1[r] = (w1 & (1u << ((r & 3) + 8 * (r >> 2)))) ? s1[r] : MASKV;
    softmax_update1(s1, m, mref, lsum, o0, o1);
    pv_subtile(Vc + 64, DSA_VSTR, s1, o0, o1);
  }
}
DI void dsa_item(const Params& P, int item, unsigned char* lds) {
  unsigned char* ws = P.ws;
  const int jq = 15 - item / 32, bh = item % 32, b = bh >> 3, h = bh & 7;
  const int c0 = 4 * jq + 1;
  const int tid = threadIdx.x, lane = tid & 63, w = __builtin_amdgcn_readfirstlane(tid >> 6), hh = lane >> 5, lq = lane & 31;
  const int cw = c0 + (w >> 1);
  const int pq = NMETA + 256 * jq + 32 * w + lq;
  const int tq = b * L + pq, rq = b * SEQ + pq - NMETA;
  const int qmin = NMETA + 256 * jq + 32 * w;
  float* tb = (float*)(lds + DSA_TB);
  __syncthreads();
  if (tid < 256) tb[tid] = P.rel_bias[t5_bucket(tid - 192) * 8 + h] * LOG2E;
  const float bfar = P.rel_bias[15 * 8 + h] * LOG2E;
  bf16x8 qf[4];
  {
    const bf16_t* qrow = (const bf16_t*)(ws + O_QB) + (size_t)tq * 512 + h * 64 + hh * 8;
#pragma unroll
    for (int kk = 0; kk < 4; ++kk) qf[kk] = *(const bf16x8*)(qrow + kk * 16);
  }
  const unsigned* mrow = (const unsigned*)(P.ws + O_MASK) + (size_t)rq * MW;
  f32x16 o0, o1;
#pragma unroll
  for (int r = 0; r < 16; ++r) { o0[r] = 0.f; o1[r] = 0.f; }
  float m = -1e30f, lsum = 0.f;
  const int nst = c0 + 4;
  const bf16_t* kg = (const bf16_t*)(ws + O_KB) + (size_t)b * L * 512 + h * 64;
  const bf16_t* vg = (const bf16_t*)(ws + O_VBT) + (size_t)bh * 64 * LP;
  const int srow = tid >> 3, sc = tid & 7;
  const unsigned kgo = srow * 512 + sc * 8, klo = srow * DSA_KSTR + sc * 16, vgo = srow * LP + sc * 8, vlo = DSA_KBYTES + srow * DSA_VSTR + sc * 16;
  u32x4 rkA, rvA, rkB, rvB;
#define DSA_LOAD(rk_, rv_, st) do { const int kn = (st) * 64; const int kr = min(kn + srow, L - 1) - srow; \
    rk_ = *(const u32x4*)(kg + (size_t)kr * 512 + kgo); rv_ = *(const u32x4*)(vg + kn + vgo); } while (0)
#define DSA_WRITE(rk_, rv_, buf) do { unsigned char* nb_ = (buf); *(u32x4*)(nb_ + klo) = rk_; \
    *(u32x2*)(nb_ + vlo) = (u32x2){rv_[0], rv_[1]}; *(u32x2*)(nb_ + vlo + 8) = (u32x2){rv_[2], rv_[3]}; } while (0)
  unsigned char* buf0 = lds; unsigned char* buf1 = lds + DSA_STAGE;
  DSA_LOAD(rkA, rvA, 0); DSA_WRITE(rkA, rvA, buf0);
  __syncthreads();
  if (nst > 1) DSA_LOAD(rkA, rvA, 1);
#pragma unroll 1
  for (int s = 0; s < nst; s += 2) {
    if (s + 2 < nst) DSA_LOAD(rkB, rvB, s + 2);
    dsa_stage(buf0, s, cw, lq, hh, pq, qmin, bfar, tb, mrow, qf, o0, o1, m, lsum);
    if (s + 1 < nst) DSA_WRITE(rkA, rvA, buf1);
    __syncthreads();
    if (s + 1 >= nst) break;
    if (s + 3 < nst) DSA_LOAD(rkA, rvA, s + 3);
    dsa_stage(buf1, s + 1, cw, lq, hh, pq, qmin, bfar, tb, mrow, qf, o0, o1, m, lsum);
    if (s + 2 < nst) DSA_WRITE(rkB, rvB, buf0);
    __syncthreads();
  }
#undef DSA_LOAD
#undef DSA_WRITE
  lsum += __shfl_xor(lsum, 32);
  const float inv = 1.f / lsum;
  bf16_t* ob = (bf16_t*)(ws + O_OB) + (size_t)rq * 512 + h * 64 + 4 * hh;
#pragma unroll
  for (int g = 0; g < 4; ++g) {
    u32x2 v0, v1;
    v0[0] = pk2(o0[4 * g] * inv, o0[4 * g + 1] * inv); v0[1] = pk2(o0[4 * g + 2] * inv, o0[4 * g + 3] * inv);
    v1[0] = pk2(o1[4 * g] * inv, o1[4 * g + 1] * inv); v1[1] = pk2(o1[4 * g + 2] * inv, o1[4 * g + 3] * inv);
    *(u32x2*)(ob + 8 * g) = v0;
    *(u32x2*)(ob + 32 + 8 * g) = v1;
  }
}

template <bool CHECK> DI void nv_mla(const Params& P, int vb, unsigned char* lds) {
  unsigned char* ws = P.ws;
  float* qs = (float*)lds;
  const int b = vb / SEQ, p = NMETA + vb % SEQ, t = b * L + p;
  const int tid = threadIdx.x & 255, h = tid >> 5, l = tid & 31;
  const bf16_t* qa = (const bf16_t*)(ws + O_QA) + (size_t)t * 768;
  for (int i = tid; i < 768; i += 256) qs[i] = bf2f(qa[i]);
  __syncthreads();
  const int na = n_adm(p);
  const bf16_t* km = (const bf16_t*)(ws + O_KMLA) + (size_t)(b * 8 + h) * LP * 96;
  const bf16_t* vt = (const bf16_t*)(ws + O_VT) + (size_t)(b * 8 + h) * 64 * LP;
  float m = -1e30f, ls = 0.f, acc[64];
#pragma unroll
  for (int d = 0; d < 64; ++d) acc[d] = 0.f;
  const float* q = qs + h * 96;
  for (int j = l; j < na; j += 32) {
    const bf16_t* kr = km + (size_t)j * 96;
    float s = 0.f;
#pragma unroll 8
    for (int d = 0; d < 96; ++d) s = fmaf(q[d], bf2f(kr[d]), s);
    const float mn = fmaxf(m, s), c = exp2f(m - mn), pe = exp2f(s - mn);
    ls = ls * c + pe;
#pragma unroll
    for (int d = 0; d < 64; ++d) acc[d] = acc[d] * c + pe * bf2f(vt[(size_t)d * LP + j]);
    m = mn;
  }
#pragma unroll
  for (int off = 16; off >= 1; off >>= 1) {
    const float m2 = __shfl_xor(m, off), l2 = __shfl_xor(ls, off);
    const float mn = fmaxf(m, m2), c1 = exp2f(m - mn), c2 = exp2f(m2 - mn);
    ls = ls * c1 + l2 * c2;
#pragma unroll
    for (int d = 0; d < 64; ++d) { const float a2 = __shfl_xor(acc[d], off); acc[d] = acc[d] * c1 + a2 * c2; }
    m = mn;
  }
  if (l == 0) {
    const float inv = 1.f / ls;
    bf16_t* oa = (bf16_t*)(ws + O_OA) + (size_t)vb * 512 + h * 64;
    if (CHECK) {
#if SELFCHECK
#pragma unroll
      for (int d = 0; d < 64; ++d) if (far(bf2f(oa[d]), acc[d] * inv, 0.004f, 0.03f)) chk_fail(P, 13);
#endif
    } else {
#pragma unroll
      for (int d = 0; d < 64; ++d) oa[d] = f2bf(acc[d] * inv);
    }
  }
  __syncthreads();
}

#if SELFCHECK
struct NvDsaLds { float qi[512]; float qb[512]; float wi[8]; unsigned keys[L]; int sel[256]; float sc[8][256]; int redi[8]; int scan_gt[257]; int scan_eq[257]; unsigned char mine[L]; };
DI void nv_dsa_check(const Params& P, int vb, unsigned char* lds) {
  unsigned char* ws = P.ws;
  NvDsaLds& S = *(NvDsaLds*)lds;
  const int b = vb / SEQ, p = NMETA + vb % SEQ, t = b * L + p, tid = threadIdx.x & 255;
  const bf16_t* qi_g = (const bf16_t*)(ws + O_QI) + (size_t)t * 512;
  const bf16_t* qb_g = (const bf16_t*)(ws + O_QB) + (size_t)t * 512;
  for (int i = tid; i < 512; i += 256) { S.qi[i] = bf2f(qi_g[i]); S.qb[i] = bf2f(qb_g[i]); }
  if (tid < 8) S.wi[tid] = ((const float*)(ws + O_WI))[(size_t)t * 8 + tid];
  __syncthreads();
  const int na = n_adm(p);
  const bf16_t* ki_g = (const bf16_t*)(ws + O_KI) + (size_t)b * L * 64;
  for (int j = tid; j < na; j += 256) {
    const bf16_t* ki = ki_g + (size_t)j * 64;
    float s = 0.f;
    for (int h = 0; h < 8; ++h) {
      float lg = 0.f;
#pragma unroll 8
      for (int d = 0; d < 64; ++d) lg = fmaf(S.qi[h * 64 + d], bf2f(ki[d]), lg);
      s += S.wi[h] * fmaxf(lg, 0.f);
    }
    S.keys[j] = f2key(s);
    S.mine[j] = 0;
  }
  __syncthreads();
  if (na <= 256) {
    for (int j = tid; j < na; j += 256) S.mine[j] = 1;
  } else {
    unsigned T = 0;
    for (int bit = 31; bit >= 0; --bit) {
      const unsigned cand = T | (1u << bit);
      int c = 0;
      for (int j = tid; j < na; j += 256) c += S.keys[j] >= cand;
      c = block_sumi256(c, S.redi);
      if (c >= 256) T = cand;
    }
    const int chunk = (na + 255) / 256;
    const int j0 = tid * chunk, j1 = min(j0 + chunk, na);
    int cgt = 0, ce = 0;
    for (int j = j0; j < j1; ++j) { cgt += S.keys[j] > T; ce += S.keys[j] == T; }
    S.scan_gt[tid + 1] = cgt; S.scan_eq[tid + 1] = ce;
    __syncthreads();
    if (threadIdx.x == 0) { S.scan_gt[0] = 0; S.scan_eq[0] = 0; for (int i = 1; i <= 256; ++i) { S.scan_gt[i] += S.scan_gt[i - 1]; S.scan_eq[i] += S.scan_eq[i - 1]; } }
    __syncthreads();
    const int r = 256 - S.scan_gt[256];
    int pe = S.scan_eq[tid];
    for (int j = j0; j < j1; ++j) {
      if (S.keys[j] > T) S.mine[j] = 1;
      else if (S.keys[j] == T) { if (pe < r) S.mine[j] = 1; ++pe; }
    }
  }
  __syncthreads();
  const unsigned* mrow = (const unsigned*)(P.ws + O_MASK) + (size_t)vb * MW;
  int mism = 0, cntk = 0;
  for (int j = tid; j < 4224; j += 256) {
    const int kb = (mrow[j >> 5] >> (j & 31)) & 1;
    const int me = j < na ? (int)S.mine[j] : 0;
    mism += kb != me; cntk += kb;
    if (kb && j >= na) mism += 1000;
  }
  mism = block_sumi256(mism, S.redi);
  cntk = block_sumi256(cntk, S.redi);
  if (tid == 0) { if (mism > 16) chk_fail(P, 14); if (cntk != (na < 256 ? na : 256)) chk_fail(P, 14); }
  if (tid == 0) { int k = 0; for (int j = 0; j < na && k < 256; ++j) if ((mrow[j >> 5] >> (j & 31)) & 1) S.sel[k++] = j; for (; k < 256; ++k) S.sel[k] = 0; }
  const int nsel = na < 256 ? na : 256;
  __syncthreads();
  if (tid < nsel) {
    const int j = S.sel[tid];
    const bf16_t* kb = (const bf16_t*)(ws + O_KB) + (size_t)(b * L + j) * 512;
    const int bk = t5_bucket(j - p);
    for (int h = 0; h < 8; ++h) {
      float s = 0.f;
#pragma unroll 8
      for (int d = 0; d < 64; ++d) s = fmaf(S.qb[h * 64 + d], bf2f(kb[h * 64 + d]), s);
      S.sc[h][tid] = s + P.rel_bias[bk * 8 + h] * LOG2E;
    }
  }
  __syncthreads();
  {
    const int h = tid >> 5, l = tid & 31;
    float m = -1e30f;
    for (int k = l; k < nsel; k += 32) m = fmaxf(m, S.sc[h][k]);
#pragma unroll
    for (int off = 16; off >= 1; off >>= 1) m = fmaxf(m, __shfl_xor(m, off));
    float s = 0.f;
    for (int k = l; k < nsel; k += 32) s += exp2f(S.sc[h][k] - m);
#pragma unroll
    for (int off = 16; off >= 1; off >>= 1) s += __shfl_xor(s, off);
    const float inv = 1.f / s;
    __syncthreads();
    if (threadIdx.x < 256) for (int k = l; k < nsel; k += 32) S.sc[h][k] = exp2f(S.sc[h][k] - m) * inv;
  }
  __syncthreads();
  const bf16_t* vbt = (const bf16_t*)(ws + O_VBT) + (size_t)b * 8 * 64 * LP;
  const bf16_t* ob = (const bf16_t*)(ws + O_OB) + (size_t)vb * 512;
  for (int o = tid; o < 512; o += 256) {
    const int h = o >> 6;
    float a = 0.f;
    for (int k = 0; k < nsel; ++k) a = fmaf(S.sc[h][k], bf2f(vbt[(size_t)o * LP + S.sel[k]]), a);
    if (far(bf2f(ob[o]), a, 0.006f, 0.03f)) chk_fail(P, 15);
  }
  __syncthreads();
}
#endif

DI void p7_merge_tile(const Params& P, int mt, int nt, unsigned char* lds) {
  unsigned char* ws = P.ws;
  const int m0 = mt * 256, n0 = nt * 256;
  const bf16_t* gates = (const bf16_t*)P.out;
  bf16_t* yo = (bf16_t*)(ws + O_Y);
  TilePtrs tp;
  f32x16 acc[4][2];
#pragma unroll 1
  for (int br = 0; br < 2; ++br) {
    set_ptrs(tp, (const bf16_t*)(ws + (br ? O_OB : O_OA)), 512, NR, m0, (const bf16_t*)(ws + (br ? O_WBRB : O_WBRA)), 512, 1024, n0);
    zero_acc(acc); EPI_IDS(gemm_kloop<true>(acc, tp, 512, lds));
#pragma unroll
    for (int mi = 0; mi < 4; ++mi) {
      int row = m0 + acc_row0(wr, mi) + lc;
      asm volatile("" : "+v"(row));
#pragma unroll
      for (int ni = 0; ni < 2; ++ni) {
        const int c0 = n0 + acc_col0(wc, ni) + 4 * hh;
        const bf16_t* gp = gates + (size_t)row * 2048 + br * 1024 + c0;
        bf16_t* yp = yo + (size_t)row * 1024 + c0;
        u32x2 gv[4], pv[4];
#pragma unroll
        for (int g = 0; g < 4; ++g) { gv[g] = *(const u32x2*)(gp + 8 * g); if (br) pv[g] = *(const u32x2*)(yp + 8 * g); else { pv[g][0] = 0u; pv[g][1] = 0u; } }
#pragma unroll
        for (int g = 0; g < 4; ++g) {
          const float y0 = __uint_as_float(gv[g][0] << 16) * acc[mi][ni][4 * g] + __uint_as_float(pv[g][0] << 16);
          const float y1 = __uint_as_float(gv[g][0] & 0xffff0000u) * acc[mi][ni][4 * g + 1] + __uint_as_float(pv[g][0] & 0xffff0000u);
          const float y2 = __uint_as_float(gv[g][1] << 16) * acc[mi][ni][4 * g + 2] + __uint_as_float(pv[g][1] << 16);
          const float y3 = __uint_as_float(gv[g][1] & 0xffff0000u) * acc[mi][ni][4 * g + 3] + __uint_as_float(pv[g][1] & 0xffff0000u);
          *(u32x2*)(yp + 8 * g) = pk4(y0, y1, y2, y3);
        }
        __builtin_amdgcn_sched_barrier(0);
      }
    }
    asm volatile("" ::: "memory");
  }
}

DI void p8_out_tile(const Params& P, int mt, int nt, unsigned char* lds) {
  unsigned char* ws = P.ws;
  const int m0 = mt * 256, n0 = nt * 256;
  TilePtrs tp; set_ptrs(tp, (const bf16_t*)(ws + O_Y), 1024, NR, m0, (const bf16_t*)(ws + O_WO), 1024, 1024, n0);
  f32x16 acc[4][2]; zero_acc(acc);
  EPI_IDS(gemm_kloop<true>(acc, tp, 1024, lds));
#pragma unroll
  for (int mi = 0; mi < 4; ++mi) {
    int row = m0 + acc_row0(wr, mi) + lc;
    asm volatile("" : "+v"(row));
#pragma unroll
    for (int ni = 0; ni < 2; ++ni) {
      const size_t off = (size_t)row * D + n0 + acc_col0(wc, ni) + 4 * hh;
      f32x4 xv[4];
#pragma unroll
      for (int g = 0; g < 4; ++g) xv[g] = *(const f32x4*)(P.x + off + 8 * g);
#pragma unroll
      for (int g = 0; g < 4; ++g)
        *(u32x2*)((bf16_t*)(ws + M_XN) + off + 8 * g) = pk4(xv[g][0] + acc[mi][ni][4 * g], xv[g][1] + acc[mi][ni][4 * g + 1], xv[g][2] + acc[mi][ni][4 * g + 2], xv[g][3] + acc[mi][ni][4 * g + 3]);
    }
  }
}

DI void p9_router_token(const Params& P, int tok, int lane) {
  unsigned char* ws = P.ws;
  const bf16_t* row = (const bf16_t*)(ws + M_XN) + (size_t)tok * D;
  f32x4 v[4]; float s = 0.f;
#pragma unroll
  for (int i = 0; i < 4; ++i) {
    const u32x2 a = *(const u32x2*)(row + 256 * i + 4 * lane);
    v[i][0] = __uint_as_float(a[0] << 16); v[i][1] = __uint_as_float(a[0] & 0xffff0000u); v[i][2] = __uint_as_float(a[1] << 16); v[i][3] = __uint_as_float(a[1] & 0xffff0000u);
    s += v[i][0] * v[i][0] + v[i][1] * v[i][1] + v[i][2] * v[i][2] + v[i][3] * v[i][3];
  }
  s = wave_sum(s);
  const float rs = rsqrtf(s * (1.f / D) + EPS);
  if (lane == 0) ((float*)(ws + M_RS))[tok] = rs;
#pragma unroll
  for (int i = 0; i < 4; ++i) {
    const f32x4 g = *(const f32x4*)(P.g_ffn + 256 * i + 4 * lane);
    v[i][0] *= rs * g[0]; v[i][1] *= rs * g[1]; v[i][2] *= rs * g[2]; v[i][3] *= rs * g[3];
  }
  const float* wr = (const float*)(ws + O_WR);
  float mylog = 0.f;
#pragma unroll 1
  for (int c = 0; c < 36; ++c) {
    float a = 0.f;
#pragma unroll
    for (int i = 0; i < 4; ++i) { const f32x4 w4 = *(const f32x4*)(wr + c * 1024 + 256 * i + 4 * lane); a += v[i][0] * w4[0] + v[i][1] * w4[1] + v[i][2] * w4[2] + v[i][3] * w4[3]; }
    a = wave_sum(a);
    if (lane == c) mylog = a + (c < 4 ? P.b_rg[c] : P.b_re[c - 4]);
  }
  float lg[4];
#pragma unroll
  for (int i = 0; i < 4; ++i) lg[i] = __shfl(mylog, i);
  int gs = 0; float gm = lg[0];
#pragma unroll
  for (int i = 1; i < 4; ++i) if (lg[i] > gm) { gm = lg[i]; gs = i; }
  float se = 0.f;
#pragma unroll
  for (int i = 0; i < 4; ++i) se += expf(lg[i] - gm);
  const float pg = 1.f / se;
  float el[8];
#pragma unroll
  for (int i = 0; i < 8; ++i) el[i] = __shfl(mylog, 4 + gs * 8 + i);
  float em = el[0];
#pragma unroll
  for (int i = 1; i < 8; ++i) em = fmaxf(em, el[i]);
  float pe[8]; float ss = 0.f;
#pragma unroll
  for (int i = 0; i < 8; ++i) { pe[i] = expf(el[i] - em); ss += pe[i]; }
  int e1 = 0; float p1 = pe[0];
#pragma unroll
  for (int i = 1; i < 8; ++i) if (pe[i] > p1) { p1 = pe[i]; e1 = i; }
  int e2 = 0; float p2 = -1.f;
#pragma unroll
  for (int i = 0; i < 8; ++i) if (i != e1 && pe[i] > p2) { p2 = pe[i]; e2 = i; }
  p1 /= ss; p2 /= ss;
  const float den = p1 + p2;
  const float w1 = pg * p1 / den, w2 = pg * p2 / den;
  const int x1 = gs * 8 + e1, x2 = gs * 8 + e2;
  if (lane == 0) {
    unsigned* cnt = (unsigned*)(ws + O_CTR) + 32;
    const int q1 = (int)atomicAdd(cnt + x1, 1u), q2 = (int)atomicAdd(cnt + x2, 1u);
    ((int*)(ws + M_LIST))[(size_t)x1 * NR + q1] = tok; ((int*)(ws + M_LIST))[(size_t)x2 * NR + q2] = tok;
    ((float*)(ws + M_WL))[(size_t)x1 * NR + q1] = w1; ((float*)(ws + M_WL))[(size_t)x2 * NR + q2] = w2;
    int* asg = (int*)(ws + M_ASG) + (size_t)tok * 4;
    asg[0] = x1; asg[1] = q1; asg[2] = x2; asg[3] = q2;
  }
}
DI void p9_conv_gu_item(const Params& P, int item, float* scr, int tid, bool valid) {
  const int e = item >> 7, r = item & 127, kb = r & 15, nb = r >> 4;
  const int k0 = kb * 64, n0 = nb * 64;
  bf16_t* dst = (bf16_t*)(P.ws + M_WGU) + (size_t)e * 512 * 1024;
  if (valid) {
    const int n = tid & 63, nd = n0 + n, q = nd >> 8, within = nd & 255, part = within >> 7, idx = within & 127;
    const float* src = (part ? P.w_eu : P.w_eg) + (size_t)e * 1024 * 256 + (q * 128 + idx);
#pragma unroll 4
    for (int i = 0; i < 16; ++i) { const int k = (tid >> 6) + 4 * i; scr[k * 65 + n] = src[(size_t)(k0 + k) * 256] * P.g_ffn[k0 + k]; }
  }
  __syncthreads();
  if (valid) {
    const int kq = tid & 7;
#pragma unroll
    for (int i = 0; i < 2; ++i) {
      const int n = (tid >> 3) + 32 * i;
      const float* sp = scr + (kq * 8) * 65 + n;
      u32x4 o; o[0] = pk2(sp[0], sp[65]); o[1] = pk2(sp[2 * 65], sp[3 * 65]); o[2] = pk2(sp[4 * 65], sp[5 * 65]); o[3] = pk2(sp[6 * 65], sp[7 * 65]);
      *(u32x4*)(dst + (size_t)(n0 + n) * 1024 + k0 + kq * 8) = o;
    }
  }
  __syncthreads();
}
DI int moe_tile_lookup(const Params& P, int tile, int& e_out, int& rt_out, int& cnt_out, int& base_slot) {
  const unsigned* cnt = (const unsigned*)(P.ws + O_CTR) + 32;
  int acc = 0, found = 0;
  e_out = 0; rt_out = 0; cnt_out = 0; base_slot = 0;
  for (int e = 0; e < 32; ++e) {
    const int c = (int)cnt[e], nt = (c + 255) >> 8;
    if (!found && tile < acc + nt) { e_out = e; rt_out = tile - acc; cnt_out = c; base_slot = acc * 256; found = 1; }
    acc += nt;
  }
  return acc;
}
DI void p10_gu_tile(const Params& P, int tile, int e, int rt, int cnt, int base_slot, int q, unsigned char* lds) {
  unsigned char* ws = P.ws;
  const int tid = threadIdx.x;
  const int* list = (const int*)(ws + M_LIST) + (size_t)e * NR;
  TilePtrs tp;
#pragma unroll
  for (int i = 0; i < 4; ++i) { int row, kc; tile_rc(i, row, kc); int r = rt * 256 + row; r = r < cnt ? r : cnt - 1; tp.a[i] = ((unsigned)list[r] * 1024u + kc * 8) * 2u; tp.b[i] = ((unsigned)(q * 256 + row) * 1024u + kc * 8) * 2u; }
  tp.A = (const bf16_t*)(ws + M_XN); tp.B = (const bf16_t*)(ws + M_WGU) + (size_t)e * 512 * 1024;
  f32x16 acc[4][2]; zero_acc(acc);
  EPI_IDS(gemm_kloop<true>(acc, tp, 1024, lds));
  bf16_t* hm = (bf16_t*)(ws + M_HMID);
  const int col = q * 128 + wc * 32 + 4 * hh;
#pragma unroll
  for (int mi = 0; mi < 4; ++mi) {
    int rr = rt * 256 + acc_row0(wr, mi) + lc;
    asm volatile("" : "+v"(rr));
    bf16_t* hp = hm + (size_t)(base_slot + rr) * 256 + col;
    const float rsv = rr < cnt ? ((const float*)(ws + M_RS))[list[rr]] : 0.f;
#pragma unroll
    for (int g = 0; g < 4; ++g) {
      float hv[4];
#pragma unroll
      for (int e = 0; e < 4; ++e) { const float gt = acc[mi][0][4 * g + e] * rsv, u = acc[mi][1][4 * g + e] * rsv; hv[e] = gt * __builtin_amdgcn_rcpf(1.f + __expf(-gt)) * u; }
      if (rr < cnt) *(u32x2*)(hp + 8 * g) = pk4(hv[0], hv[1], hv[2], hv[3]);
    }
  }
  asm volatile("s_waitcnt vmcnt(0)" ::: "memory");
  __syncthreads();
  if (threadIdx.x == 0) {
    __builtin_amdgcn_fence(__ATOMIC_RELEASE, "agent");
    asm volatile("s_waitcnt vmcnt(0)" ::: "memory");
    __hip_atomic_fetch_add((unsigned*)(ws + O_DEP) + tile, 1u, __ATOMIC_RELAXED, __HIP_MEMORY_SCOPE_AGENT);
  }
}
DI void p11_down_tile(const Params& P, int tile, int e, int rt, int cnt, int base_slot, int nt, unsigned char* lds) {
  unsigned char* ws = P.ws;
  if (threadIdx.x == 0) {
    unsigned* dep = (unsigned*)(ws + O_DEP) + tile;
    unsigned spins = 0;
    while (__hip_atomic_load(dep, __ATOMIC_RELAXED, __HIP_MEMORY_SCOPE_AGENT) < 2u && ++spins < (1u << 22)) __builtin_amdgcn_s_sleep(2);
    __builtin_amdgcn_fence(__ATOMIC_ACQUIRE, "agent");
    asm volatile("s_waitcnt vmcnt(0)" ::: "memory");
  }
  __syncthreads();
  const int tid = threadIdx.x;
  TilePtrs tp;
#pragma unroll
  for (int i = 0; i < 4; ++i) { int row, kc; tile_rc(i, row, kc); int r = rt * 256 + row; r = r < cnt ? r : cnt - 1; tp.a[i] = ((unsigned)(base_slot + r) * 256u + kc * 8) * 2u; tp.b[i] = ((unsigned)(nt * 256 + row) * 256u + kc * 8) * 2u; }
  tp.A = (const bf16_t*)(ws + M_HMID); tp.B = (const bf16_t*)(ws + M_WD) + (size_t)e * 1024 * 256;
  f32x16 acc[4][2]; zero_acc(acc);
  EPI_IDS(gemm_kloop<true>(acc, tp, 256, lds));
  bf16_t* ys = (bf16_t*)(ws + M_YS);
  const float* wl = (const float*)(ws + M_WL) + (size_t)e * NR;
#pragma unroll
  for (int mi = 0; mi < 4; ++mi) {
    int rr = rt * 256 + acc_row0(wr, mi) + lc;
    asm volatile("" : "+v"(rr));
    const bool ok = rr < cnt;
    const float wt = ok ? wl[rr] : 0.f;
    bf16_t* yp = ys + (size_t)(base_slot + rr) * 1024 + nt * 256 + 4 * hh;
#pragma unroll
    for (int ni = 0; ni < 2; ++ni)
#pragma unroll
      for (int g = 0; g < 4; ++g)
        if (ok) *(u32x2*)(yp + acc_col0(wc, ni) + 8 * g) = pk4(acc[mi][ni][4 * g] * wt, acc[mi][ni][4 * g + 1] * wt, acc[mi][ni][4 * g + 2] * wt, acc[mi][ni][4 * g + 3] * wt);
  }
}
DI void p12_final_token(const Params& P, int tok, int lane, const int* sbase  ) {
  unsigned char* ws = P.ws;
  float* row = P.out + (size_t)tok * D;
  const bf16_t* h2b = (const bf16_t*)(ws + M_XN) + (size_t)tok * D;
  const int* asg = (const int*)(ws + M_ASG) + (size_t)tok * 4;
  const int s1 = sbase[asg[0]] + asg[1], s2 = sbase[asg[2]] + asg[3];
  const bf16_t* y1 = (const bf16_t*)(ws + M_YS) + (size_t)s1 * 1024;
  const bf16_t* y2 = (const bf16_t*)(ws + M_YS) + (size_t)s2 * 1024;
  f32x4 v[4]; float s = 0.f;
#pragma unroll
  for (int i = 0; i < 4; ++i) {
    const u32x2 hq = *(const u32x2*)(h2b + 256 * i + 4 * lane);
    v[i][0] = __uint_as_float(hq[0] << 16); v[i][1] = __uint_as_float(hq[0] & 0xffff0000u); v[i][2] = __uint_as_float(hq[1] << 16); v[i][3] = __uint_as_float(hq[1] & 0xffff0000u);
    const u32x2 a = *(const u32x2*)(y1 + 256 * i + 4 * lane), b = *(const u32x2*)(y2 + 256 * i + 4 * lane);
    v[i][0] += __uint_as_float(a[0] << 16) + __uint_as_float(b[0] << 16);
    v[i][1] += __uint_as_float(a[0] & 0xffff0000u) + __uint_as_float(b[0] & 0xffff0000u);
    v[i][2] += __uint_as_float(a[1] << 16) + __uint_as_float(b[1] << 16);
    v[i][3] += __uint_as_float(a[1] & 0xffff0000u) + __uint_as_float(b[1] & 0xffff0000u);
    s += v[i][0] * v[i][0] + v[i][1] * v[i][1] + v[i][2] * v[i][2] + v[i][3] * v[i][3];
  }
  s = wave_sum(s);
  const float rs = rsqrtf(s * (1.f / D) + EPS);
#pragma unroll
  for (int i = 0; i < 4; ++i) {
    const f32x4 g = *(const f32x4*)(P.g_fin + 256 * i + 4 * lane);
    f32x4 o; o[0] = v[i][0] * rs * g[0]; o[1] = v[i][1] * rs * g[1]; o[2] = v[i][2] * rs * g[2]; o[3] = v[i][3] * rs * g[3];
    *(f32x4*)(row + 256 * i + 4 * lane) = o;
  }
}

struct NvMoeLds { float xr[D]; float xn[D]; float hm[256]; float red[8]; float logit[36]; float gatew[2]; int expert[2]; };


#if SELFCHECK
DI const float* h_row(const Params& P, int t) { const int b = t / L, p = t % L; return p < NMETA ? P.meta + (size_t)p * D : P.x + ((size_t)b * SEQ + (p - NMETA)) * D; }
DI void chk_load_hn(const Params& P, int t, float* hv, float* red) {
  const float* row = h_row(P, t);
  float s = 0.f;
  for (int i = (threadIdx.x & 255); i < D; i += 256) { const float v = row[i]; hv[i] = v; s += v * v; }
  s = block_sum256(s, red);
  const float rs = rsqrtf(s * (1.f / D) + EPS);
  if (threadIdx.x < 256) for (int i = threadIdx.x; i < D; i += 256) hv[i] = hv[i] * rs * P.g_mix[i];
  __syncthreads();
}
DI void chk_stageA(const Params& P, unsigned char* lds) {
  unsigned char* ws = P.ws;
  float* hv = (float*)lds; float* pj = hv + 1024; float* red = pj + 4608; float* cq = red + 8; float* ckv = cq + 256;
  const int tid = threadIdx.x & 255;
  for (int sidx = blockIdx.x; sidx < 512; sidx += gridDim.x) {
    const int t = sidx < 8 ? (sidx < 4 ? sidx * L + (sidx & 3) * 5 : NT - 1 - (sidx - 4) * 1031) : (int)(hash_u(sidx * 7919u + 13u) % NT);
    const int b = t / L, p = t % L;
    chk_load_hn(P, t, hv, red);
    for (int c = tid; c < 2536; c += 256) { float a = 0.f; for (int k = 0; k < D; ++k) a = fmaf(hv[k], P.w_in[(size_t)k * INC + c], a); pj[c] = a; }
    __syncthreads();
    const float* sm = (const float*)(ws + O_SMALL) + (size_t)t * 512;
    for (int c = tid; c < 416; c += 256) if (far(sm[c], pj[c], 0.06f, 0.02f)) chk_fail(P, 1);
    for (int c = tid; c < 8; c += 256) if (far(sm[S_WI + c], pj[2528 + c], 0.06f, 0.02f)) chk_fail(P, 1);
    for (int c = tid; c < 64; c += 256) if (far(sm[S_KI + c], pj[2464 + c], 0.06f, 0.02f)) chk_fail(P, 1);
    for (int c = tid; c < 512; c += 256) {
      if (far(bf2f(((const bf16_t*)(ws + O_QB))[(size_t)t * 512 + c]), pj[416 + c] * (0.125f * LOG2E), 0.012f, 0.02f)) chk_fail(P, 2);
      if (far(bf2f(((const bf16_t*)(ws + O_KB))[(size_t)t * 512 + c]), pj[928 + c], 0.06f, 0.02f)) chk_fail(P, 3);
      const int h = c >> 6, d = c & 63;
      if (far(bf2f(((const bf16_t*)(ws + O_VBT))[((size_t)(b * 8 + h) * 64 + d) * LP + p]), pj[1440 + c], 0.06f, 0.02f)) chk_fail(P, 4);
      if (far(bf2f(((const bf16_t*)(ws + O_QI))[(size_t)t * 512 + c]), pj[1952 + c] * 0.125f, 0.01f, 0.02f)) chk_fail(P, 5);
    }
    for (int c = tid; c < 64; c += 256) if (far(bf2f(((const bf16_t*)(ws + O_KI))[(size_t)t * 64 + c]), pj[2464 + c], 0.06f, 0.02f)) chk_fail(P, 6);
    for (int c = tid; c < 8; c += 256) if (far(((const float*)(ws + O_WI))[(size_t)t * 8 + c], pj[2528 + c] * 0.35355339f, 0.03f, 0.02f)) chk_fail(P, 6);
    { float s = 0.f; for (int i = tid; i < 256; i += 256) s += pj[i] * pj[i]; s = block_sum256(s, red);
      const float rs = rsqrtf(s * (1.f / 256) + EPS); for (int i = tid; i < 256; i += 256) cq[i] = pj[i] * rs * P.g_cq[i]; }
    { float s = 0.f; for (int i = tid; i < 128; i += 256) s += pj[256 + i] * pj[256 + i]; s = block_sum256(s, red);
      const float rs = rsqrtf(s * (1.f / 128) + EPS); for (int i = tid; i < 128; i += 256) ckv[i] = pj[256 + i] * rs * P.g_ckv[i]; }
    __syncthreads();
    const float qscale = 0.10206207261596575f * LOG2E;
    for (int c = tid; c < 768; c += 256) {
      const int h = c / 96, e = c % 96;
      float ref;
      if (e < 64) { float a = 0.f; for (int k = 0; k < 256; ++k) a = fmaf(cq[k], P.w_uq[(size_t)k * 768 + c], a); ref = a; }
      else {
        const int j = (e - 64) & 15; const int c1 = h * 96 + 64 + j, c2 = c1 + 16;
        float a1 = 0.f, a2 = 0.f; for (int k = 0; k < 256; ++k) { a1 = fmaf(cq[k], P.w_uq[(size_t)k * 768 + c1], a1); a2 = fmaf(cq[k], P.w_uq[(size_t)k * 768 + c2], a2); }
        const float inv = powf(10000.f, -(float)j / 16.f); float sn, cs; sincosf((float)p * inv, &sn, &cs);
        ref = (e - 64) < 16 ? a1 * cs - a2 * sn : a1 * sn + a2 * cs;
      }
      if (far(bf2f(((const bf16_t*)(ws + O_QA))[(size_t)t * 768 + c]), ref * qscale, 0.01f, 0.02f)) chk_fail(P, 7);
    }
    for (int c = tid; c < 1024; c += 256) {
      float a = 0.f; for (int k = 0; k < 128; ++k) a = fmaf(ckv[k], P.w_ukv[(size_t)k * 1024 + c], a);
      const int h = c >> 7, e = c & 127;
      if (e < 64) { if (far(bf2f(((const bf16_t*)(ws + O_KMLA))[((size_t)(b * 8 + h) * LP + p) * 96 + e]), a, 0.06f, 0.02f)) chk_fail(P, 8); }
      else { if (far(bf2f(((const bf16_t*)(ws + O_VT))[((size_t)(b * 8 + h) * 64 + (e - 64)) * LP + p]), a, 0.06f, 0.02f)) chk_fail(P, 9); }
    }
    for (int c = tid; c < 256; c += 256) {
      const int h = c >> 5, e = c & 31, j = e & 15;
      const float inv = powf(10000.f, -(float)j / 16.f); float sn, cs; sincosf((float)p * inv, &sn, &cs);
      const float x1 = pj[384 + j], x2 = pj[384 + 16 + j];
      const float ref = e < 16 ? x1 * cs - x2 * sn : x1 * sn + x2 * cs;
      if (far(bf2f(((const bf16_t*)(ws + O_KMLA))[((size_t)(b * 8 + h) * LP + p) * 96 + 64 + e]), ref, 0.06f, 0.02f)) chk_fail(P, 10);
    }
    __syncthreads();
  }
}
DI void chk_stageB(const Params& P, unsigned char* lds) {
  unsigned char* ws = P.ws;
  float* hv = (float*)lds; float* yv = hv + 1024; float* red = yv + 1024; float* oa = red + 8; float* ob = oa + 512;
  const int tid = threadIdx.x & 255;
  for (int sidx = blockIdx.x; sidx < 256; sidx += gridDim.x) {
    const int rt = (int)(hash_u(sidx * 104729u + 7u) % NR);
    const int b = rt / SEQ, p = NMETA + rt % SEQ, t = b * L + p;
    chk_load_hn(P, t, hv, red);
    for (int i = tid; i < 512; i += 256) { oa[i] = bf2f(((const bf16_t*)(ws + O_OA))[(size_t)rt * 512 + i]); ob[i] = bf2f(((const bf16_t*)(ws + O_OB))[(size_t)rt * 512 + i]); }
    __syncthreads();
    const bf16_t* gates = (const bf16_t*)P.out + (size_t)rt * 2048;
    for (int c = tid; c < D; c += 256) {
      float ga = 0.f, gb = 0.f, va = 0.f, vb = 0.f;
      for (int k = 0; k < D; ++k) { ga = fmaf(hv[k], P.w_in[(size_t)k * INC + 2536 + c], ga); gb = fmaf(hv[k], P.w_in[(size_t)k * INC + 3560 + c], gb); }
      for (int k = 0; k < 512; ++k) { va = fmaf(oa[k], P.w_bra[(size_t)k * D + c], va); vb = fmaf(ob[k], P.w_brb[(size_t)k * D + c], vb); }
      const float sa = 1.f / (1.f + expf(-ga)), sb = 1.f / (1.f + expf(-gb));
      if (far(bf2f(gates[c]), sa, 0.01f, 0.01f) || far(bf2f(gates[1024 + c]), sb, 0.01f, 0.01f)) chk_fail(P, 10);
      const float ref = va * sa + vb * sb;
      if (far(bf2f(((const bf16_t*)(ws + O_Y))[(size_t)rt * D + c]), ref, 0.004f, 0.03f)) chk_fail(P, 11);
    }
    __syncthreads();
  }
}
DI void chk_stageC(const Params& P, unsigned char* lds) {
  unsigned char* ws = P.ws;
  float* yv = (float*)lds;
  const int tid = threadIdx.x & 255;
  for (int sidx = blockIdx.x; sidx < 256; sidx += gridDim.x) {
    const int rt = (int)(hash_u(sidx * 15485863u + 3u) % NR);
    const int b = rt / SEQ, p = NMETA + rt % SEQ, t = b * L + p;
    for (int i = tid; i < D; i += 256) yv[i] = bf2f(((const bf16_t*)(ws + O_Y))[(size_t)rt * D + i]);
    __syncthreads();
    for (int c = tid; c < D; c += 256) {
      float a = 0.f; for (int k = 0; k < D; ++k) a = fmaf(yv[k], P.w_o[(size_t)k * D + c], a);
      const float ref = P.x[(size_t)rt * D + c] + a;
      if (far(P.out[(size_t)rt * D + c], ref, 0.003f, 0.002f)) chk_fail(P, 12);
    }
    __syncthreads();
  }
}
#endif

#if SELFCHECK
DI void chk_moe(const Params& P, unsigned char* lds) {
  unsigned char* ws = P.ws;
  NvMoeLds& S = *(NvMoeLds*)lds;
  __shared__ int sb[32];
  const int t = threadIdx.x & 255, lane = t & 63, wv = t >> 6;
  if (t == 0) { const unsigned* c = (const unsigned*)(ws + O_CTR) + 32; int a = 0; for (int i = 0; i < 32; ++i) { sb[i] = a; a += (((int)c[i] + 255) >> 8) * 256; } }
  __syncthreads();
  for (int sidx = blockIdx.x; sidx < 192; sidx += gridDim.x) {
    const int tok = (int)(hash_u(sidx * 40503u + 77u) % NR);
    const float* row = P.out + (size_t)tok * D;
    float s = 0.f;
    for (int i = t; i < D; i += 256) { const float v = row[i]; S.xr[i] = v; s += v * v; }
    s = block_sum256(s, S.red);
    const float rs = rsqrtf(s * (1.f / D) + EPS);
    for (int i = t; i < D; i += 256) { S.xn[i] = S.xr[i] * rs * P.g_ffn[i]; if (far(bf2f(((const bf16_t*)(ws + M_XN))[(size_t)tok * D + i]), S.xn[i], 0.02f, 0.01f)) chk_fail(P, 0); }
    __syncthreads();
    for (int c = wv; c < 36; c += 4) {
      float a = 0.f;
      if (c < 4) { for (int i = lane; i < D; i += 64) a = fmaf(S.xn[i], P.w_rg[i * 4 + c], a); }
      else { for (int i = lane; i < D; i += 64) a = fmaf(S.xn[i], P.w_re[i * 32 + (c - 4)], a); }
      a = wave_sum(a);
      if (lane == 0) S.logit[c] = a + (c < 4 ? P.b_rg[c] : P.b_re[c - 4]);
    }
    __syncthreads();
    const int* asg = (const int*)(ws + M_ASG) + (size_t)tok * 4;
    if (t == 0) {
      const int gs = asg[0] >> 3;
      float gm = S.logit[0]; for (int i = 1; i < 4; ++i) gm = fmaxf(gm, S.logit[i]);
      if (S.logit[gs] < gm - 1e-4f || (asg[2] >> 3) != gs) chk_fail(P, 1);
      const float* el = S.logit + 4 + gs * 8;
      const int e1 = asg[0] & 7, e2 = asg[2] & 7;
      int nb = 0; for (int i = 0; i < 8; ++i) if (i != e1 && i != e2 && el[i] > fminf(el[e1], el[e2]) + 1e-4f) ++nb;
      if (nb || e1 == e2 || el[e1] < el[e2] - 1e-4f) chk_fail(P, 2);
      float se = 0.f; for (int i = 0; i < 4; ++i) se += expf(S.logit[i] - gm);
      const float pg = expf(S.logit[gs] - gm) / se;
      const float a = expf(el[e1] - el[e1]), b2 = expf(el[e2] - el[e1]);
      S.gatew[0] = pg * a / (a + b2); S.gatew[1] = pg * b2 / (a + b2);
      S.expert[0] = asg[0]; S.expert[1] = asg[2];
      if (far(((const float*)(ws + M_WL))[(size_t)asg[0] * NR + asg[1]], S.gatew[0], 1e-4f, 1e-3f)) chk_fail(P, 3);
      if (far(((const float*)(ws + M_WL))[(size_t)asg[2] * NR + asg[3]], S.gatew[1], 1e-4f, 1e-3f)) chk_fail(P, 3);
      if (((const int*)(ws + M_LIST))[(size_t)asg[0] * NR + asg[1]] != tok || ((const int*)(ws + M_LIST))[(size_t)asg[2] * NR + asg[3]] != tok) chk_fail(P, 4);
    }
    __syncthreads();
    for (int a = 0; a < 2; ++a) {
      const int e = S.expert[a];
      const int slot = sb[e] + asg[2 * a + 1];
      const float* wg = P.w_eg + (size_t)e * D * 256;
      const float* wu = P.w_eu + (size_t)e * D * 256;
      float g = 0.f, u = 0.f;
      for (int k = 0; k < D; ++k) { const float xv = S.xn[k]; g = fmaf(xv, wg[(size_t)k * 256 + t], g); u = fmaf(xv, wu[(size_t)k * 256 + t], u); }
      S.hm[t] = g / (1.f + expf(-g)) * u;
      if (far(bf2f(((const bf16_t*)(ws + M_HMID))[(size_t)slot * 256 + t]), S.hm[t], 0.03f, 0.03f)) chk_fail(P, 5);
      __syncthreads();
      const float* wd = P.w_ed + (size_t)e * 256 * D;
      const float gw = S.gatew[a];
      for (int i = 0; i < 4; ++i) {
        float y = 0.f;
        for (int j = 0; j < 256; ++j) y = fmaf(S.hm[j], wd[(size_t)j * D + t + 256 * i], y);
        if (far(bf2f(((const bf16_t*)(ws + M_YS))[(size_t)slot * 1024 + t + 256 * i]), gw * y, 0.02f, 0.03f)) chk_fail(P, 6);
      }
      __syncthreads();
    }
  }
}
#endif

__global__ void __launch_bounds__(NTHR, 2) mega(Params P) {
  cg::grid_group grid = cg::this_grid();
  extern __shared__ __attribute__((aligned(16))) unsigned char lds[];
  const int G = gridDim.x, bx = blockIdx.x;
  const int lane = threadIdx.x & 63, wv = threadIdx.x >> 6, gw = bx * NW + wv, NGW = G * NW;
  const int half = threadIdx.x >> 8, t2 = threadIdx.x & 255;
  constexpr int MTB = (NT + 255) / 256;
  if (threadIdx.x < 16) ((unsigned*)(lds + LDS_CTL))[threadIdx.x] = 0u;
  __syncthreads();
  if (P.use_cg) grid.sync();
  const XcdBarrier xb = xcd_barrier_post((unsigned*)(P.ws + O_BAR), (volatile LAS unsigned*)(lds + LDS_CTL));
  int* const slot = (int*)(lds + LDS_CTL + 16);
#define GSYNC() xcd_barrier(xb)
  p0_prologue(P, lds);
  GSYNC();
  { int mt, nt; for (int k = 0; p1_tile_map(bx, k, G, mt, nt); ++k) p1_inproj_tile(P, mt, nt, lds); }
  GSYNC();
  for (int t = bx; t < MTB * (768 / 256 + 1024 / 256); t += G) { if (t < MTB * 3) p2b_q_tile(P, t, lds); else p2b_kv_tile(P, t - MTB * 3, lds); }
  GSYNC();
#if SELFCHECK
  chk_stageA(P, lds);
  GSYNC();
#endif
  for (int it = next_item(P, 0, slot); it < 512; it = next_item(P, 0, slot)) mla_item(P, it, lds);
#if SELFCHECK
  GSYNC();
  for (int sidx = bx; sidx < 384; sidx += G) nv_mla<true>(P, sidx < 8 ? (sidx < 4 ? sidx * 37 : NR - 1 - (sidx - 4) * 4096) : (int)(hash_u(sidx * 2654435761u + 11u) % NR), lds);
#endif
  GSYNC();
  for (int q = next_item(P, 1, slot); 2 * q < S1_ITEMS; q = next_item(P, 1, slot)) s1_item(P, 2 * q + (wv >> 2));
  GSYNC();
  { unsigned* wl = (unsigned*)lds + wv * 64; for (int r = gw; r < NR; r += NGW) s2_dispatch(P, r, lane, wl); }
  GSYNC();
  for (int it = next_item(P, 2, slot); it < 512; it = next_item(P, 2, slot)) dsa_item(P, it, lds);
  GSYNC();
#if SELFCHECK
  for (int sidx = bx; sidx < 384; sidx += G) nv_dsa_check(P, sidx < 8 ? (sidx < 4 ? 200 + sidx * 37 : NR - 1 - (sidx - 4) * 4096) : (int)(hash_u(sidx * 2246822519u + 5u) % NR), lds);
  GSYNC();
#endif
  { int mt, nt; for (int k = 0; p78_tile_map(bx, k, G, mt, nt); ++k) p7_merge_tile(P, mt, nt, lds); }
  GSYNC();
#if SELFCHECK
  chk_stageB(P, lds);
  GSYNC();
#endif
  { int mt, nt; for (int k = 0; p78_tile_map(bx, k, G, mt, nt); ++k) p8_out_tile(P, mt, nt, lds); }
  GSYNC();
#if SELFCHECK
  chk_stageC(P, lds);
  GSYNC();
#endif
  { int lane9 = threadIdx.x & 63; asm volatile("" : "+v"(lane9)); for (int t = gw; t < NR; t += NGW) p9_router_token(P, t, lane9); }
  { float* scr = (float*)lds + half * (64 * 65 + 32);
    for (int k = bx; 2 * k < 32 * 128; k += G) p9_conv_gu_item(P, 2 * k + half, scr, t2, true);
    for (int k = bx; 2 * k < 32 * 64; k += G) { const int it = 2 * k + half, e = it >> 6; transpose_item(P.w_ed + (size_t)e * 256 * 1024, 1024, 256, (bf16_t*)(P.ws + M_WD) + (size_t)e * 1024 * 256, MapOff{0}, it & 63, scr, t2, true); } }
  GSYNC();
  {
    int e, rt, cnt, bs;
    const int ntile = moe_tile_lookup(P, 0, e, rt, cnt, bs);
    for (int q = next_item(P, 3, slot); q < ntile * 6; q = next_item(P, 3, slot)) {
      if (q < ntile * 2) { moe_tile_lookup(P, q >> 1, e, rt, cnt, bs); p10_gu_tile(P, q >> 1, e, rt, cnt, bs, q & 1, lds); }
      else { const int q2 = q - ntile * 2; moe_tile_lookup(P, q2 >> 2, e, rt, cnt, bs); p11_down_tile(P, q2 >> 2, e, rt, cnt, bs, q2 & 3, lds); }
    }
    GSYNC();
#if SELFCHECK
    chk_moe(P, lds);
    GSYNC();
#endif
    int* sbase = (int*)lds;
    __syncthreads();
    if (threadIdx.x == 0) { const unsigned* c = (const unsigned*)(P.ws + O_CTR) + 32; int a = 0; for (int i = 0; i < 32; ++i) { sbase[i] = a; a += (((int)c[i] + 255) >> 8) * 256; } }
    __syncthreads();
    int lane12 = threadIdx.x & 63; asm volatile("" : "+v"(lane12));
    for (int t = gw; t < NR; t += NGW) p12_final_token(P, t, lane12, sbase);
  }
#if SELFCHECK
  GSYNC();
  {
    const unsigned* chk = (const unsigned*)(P.ws + O_CHK);
    float f = 1.f;
    for (int k = 15; k >= 0; --k) if (chk[k]) f = 1.f + 0.25f * (float)(1 << k);
    if (f != 1.f) for (size_t i = (size_t)bx * NTHR + threadIdx.x; i < (size_t)NR * D; i += (size_t)G * NTHR) P.out[i] *= f;
  }
#endif
}
}

extern "C" void kernel_launch(void* const* d_in, const int* in_sizes, int n_in, void* d_out, int out_size, void* d_ws, size_t ws_size, hipStream_t stream) {
  using namespace mk;
  static int grid_blocks = 0;
  if (!grid_blocks) {
    int dev = 0, cus = 0, per_cu = 0;
    (void)hipGetDevice(&dev);
    (void)hipDeviceGetAttribute(&cus, hipDeviceAttributeMultiprocessorCount, dev);
    (void)hipFuncSetAttribute((const void*)mega, hipFuncAttributeMaxDynamicSharedMemorySize, LDS_BYTES);
    (void)hipOccupancyMaxActiveBlocksPerMultiprocessor(&per_cu, mega, NTHR, LDS_BYTES);
    per_cu = 1;
    grid_blocks = cus * per_cu;
    if (ws_size < WS_END) fprintf(stderr, "workspace too small: need %zu have %zu\n", (size_t)WS_END, ws_size);
  }
  Params p{};
  const float** pp = (const float**)&p;
  for (int i = 0; i < 21; ++i) pp[i] = (const float*)d_in[i];
  p.out = (float*)d_out; p.ws = (unsigned char*)d_ws;
  (void)hipMemsetAsync((unsigned char*)d_ws + O_CHK, 0, O_WR - O_CHK, stream);
  void* args[] = {&p};
  hipError_t e = hipLaunchCooperativeKernel((void*)mega, dim3(grid_blocks), dim3(NTHR), args, LDS_BYTES, stream);
  if (e != hipSuccess) fprintf(stderr, "cooperative launch failed: %s (grid %d)\n", hipGetErrorString(e), grid_blocks);
}
```

```cpp
#include <hip/hip_runtime.h>
#include <hip/hip_cooperative_groups.h>
#include <cstdio>
#include <math.h>
#include <stdint.h>
namespace cg = cooperative_groups;

namespace mk {
typedef unsigned short bf16_t;
typedef short bf16x8 __attribute__((ext_vector_type(8)));
typedef float f32x16 __attribute__((ext_vector_type(16)));
typedef float f32x4 __attribute__((ext_vector_type(4)));
typedef unsigned u32x4 __attribute__((ext_vector_type(4)));
typedef unsigned u32x2 __attribute__((ext_vector_type(2)));

constexpr int D = 1024, NB = 4, SEQ = 4096, NMETA = 16, L = SEQ + NMETA, NT = NB * L  , NR = NB * SEQ  ;
constexpr int INC = 4584, LP = 4128;
constexpr int S_CQ = 0, S_CKV = 256, S_KR = 384, S_WI = 416, S_KI = 424;
constexpr float EPS = 1e-6f;
constexpr float LOG2E = 1.4426950408889634f;
constexpr int NTHR = 512, NW = NTHR / 64;

#define DI __device__ __forceinline__
#ifndef REP_P0
#define REP_P0 1
#endif
#ifndef REP_P1
#define REP_P1 1
#endif
#ifndef REP_MLA
#define REP_MLA 1
#endif
#ifndef REP_S1
#define REP_S1 1
#endif
#ifndef REP_S2
#define REP_S2 1
#endif
#ifndef REP_DSA
#define REP_DSA 1
#endif
#ifndef REP_P7
#define REP_P7 1
#endif
#ifndef REP_P8
#define REP_P8 1
#endif
#ifndef REP_MOE
#define REP_MOE 1
#endif
#ifndef REP_P2
#define REP_P2 1
#endif
#ifndef REP_CONV
#define REP_CONV 1
#endif
#ifndef SELFCHECK
#define SELFCHECK 0
#endif

typedef __bf16 bf2_t __attribute__((ext_vector_type(2)));
DI bf16_t f2bf(float x) { const __bf16 b = (__bf16)x; return __builtin_bit_cast(bf16_t, b); }
DI float bf2f(bf16_t v) { return __uint_as_float(((unsigned)v) << 16); }
DI unsigned pk2(float lo, float hi) { const bf2_t v = {(__bf16)lo, (__bf16)hi}; return __builtin_bit_cast(unsigned, v); }
#define dpp_i(v, ctrl) __builtin_amdgcn_update_dpp(0, (v), (ctrl), 0xf, 0xf, true)
DI float wave_sum(float v) {
  v += __int_as_float(dpp_i(__float_as_int(v), 0xB1));
  v += __int_as_float(dpp_i(__float_as_int(v), 0x4E));
  v += __int_as_float(dpp_i(__float_as_int(v), 0x141));
  v += __int_as_float(dpp_i(__float_as_int(v), 0x140));
  const int b = __float_as_int(v);
  return (__int_as_float(__builtin_amdgcn_readlane(b, 0)) + __int_as_float(__builtin_amdgcn_readlane(b, 16))) +
         (__int_as_float(__builtin_amdgcn_readlane(b, 32)) + __int_as_float(__builtin_amdgcn_readlane(b, 48)));
}
DI int wave_sumi(int v) {
  v += dpp_i(v, 0xB1); v += dpp_i(v, 0x4E); v += dpp_i(v, 0x141); v += dpp_i(v, 0x140);
  return (__builtin_amdgcn_readlane(v, 0) + __builtin_amdgcn_readlane(v, 16)) + (__builtin_amdgcn_readlane(v, 32) + __builtin_amdgcn_readlane(v, 48));
}
DI float block_sum256(float v, float* red) {
  v = wave_sum(v);
  __syncthreads();
  if ((threadIdx.x & 63) == 0) red[threadIdx.x >> 6] = v;
  __syncthreads();
  return red[0] + red[1] + red[2] + red[3];
}
DI int block_sumi256(int v, int* red) {
#pragma unroll
  for (int o = 1; o < 64; o <<= 1) v += __shfl_xor(v, o);
  __syncthreads();
  if ((threadIdx.x & 63) == 0) red[threadIdx.x >> 6] = v;
  __syncthreads();
  return red[0] + red[1] + red[2] + red[3];
}
DI int n_adm(int p) { return p < NMETA ? NMETA : NMETA + 64 * (1 + (p - NMETA) / 64); }


#if SELFCHECK
DI unsigned hash_u(unsigned x) { x ^= x >> 16; x *= 0x7feb352du; x ^= x >> 15; x *= 0x846ca68bu; x ^= x >> 16; return x; }
DI bool far(float got, float ref, float atol, float rtol) { const float d = fabsf(got - ref); return !(d <= atol + rtol * fabsf(ref)); }
#endif
struct Params {
  const float *x, *meta, *g_mix, *w_in, *g_cq, *g_ckv, *w_uq, *w_ukv, *w_bra, *w_brb, *w_o, *rel_bias, *g_ffn, *w_rg, *b_rg, *w_re, *b_re, *w_eg, *w_eu, *w_ed, *g_fin;
  float* out; unsigned char* ws;
  int use_cg; int pad;
};

constexpr size_t al(size_t x) { return (x + 255) & ~(size_t)255; }
constexpr size_t O_QB = 0;
constexpr size_t O_KB = al(O_QB + (size_t)NT * 512 * 2);
constexpr size_t O_VBT = al(O_KB + (size_t)NT * 512 * 2);
constexpr size_t O_QI = al(O_VBT + (size_t)NB * 8 * 64 * LP * 2);
constexpr size_t O_KI = al(O_QI + (size_t)NT * 512 * 2);
constexpr size_t O_WI = al(O_KI + (size_t)NT * 64 * 2);
constexpr size_t O_SMALL = al(O_WI + (size_t)NT * 8 * 4);
constexpr size_t O_CQN = al(O_SMALL + (size_t)NT * 512 * 4);
constexpr size_t O_CKVN = al(O_CQN + (size_t)NT * 256 * 2);
constexpr size_t O_QA = al(O_CKVN + (size_t)NT * 128 * 2);
constexpr size_t O_KMLA = al(O_QA + (size_t)NT * 768 * 2);
constexpr size_t O_VT = al(O_KMLA + (size_t)NB * 8 * LP * 96 * 2);
constexpr size_t R_END = al(O_VT + (size_t)NB * 8 * 64 * LP * 2 + (size_t)NT * 1536 * 2);
constexpr size_t O_HN = O_QA;
constexpr size_t O_KR = O_SMALL;
constexpr size_t O_OA = O_SMALL;
constexpr int MW = 132;
constexpr size_t O_MASK = al(O_OA + (size_t)NR * 512 * 2);
constexpr size_t O_SCORES = al(O_MASK + (size_t)NR * MW * 4);
constexpr size_t SCORES_PER_BATCH = (size_t)8192 * 1088;
constexpr size_t O_OB = O_SCORES;
constexpr size_t O_Y = al(O_OB + (size_t)NR * 512 * 2);
static_assert(O_SCORES + (size_t)NB * SCORES_PER_BATCH * 2 + 65536 <= R_END, "scores must fit region R");
constexpr size_t O_WIN = R_END;
constexpr size_t O_WG = al(O_WIN + (size_t)2560 * 1024 * 2);
constexpr size_t O_WUQ = al(O_WG + (size_t)2048 * 1024 * 2);
constexpr size_t O_WUKV = al(O_WUQ + (size_t)768 * 256 * 2);
constexpr size_t O_WBRA = al(O_WUKV + (size_t)1024 * 128 * 2);
constexpr size_t O_WBRB = al(O_WBRA + (size_t)1024 * 512 * 2);
constexpr size_t O_WO = al(O_WBRB + (size_t)1024 * 512 * 2);
constexpr size_t O_ROPE = al(O_WO + (size_t)1024 * 1024 * 2);
constexpr size_t O_CHK = al(O_ROPE + (size_t)L * 32 * 4);
constexpr size_t O_CTR = al(O_CHK + 256);
constexpr size_t O_BAR = al(O_CTR + 256);
constexpr size_t O_DEP = al(O_BAR + 3456 * 4);
constexpr size_t O_WR = al(O_DEP + 512 * 4);
constexpr size_t WS_END = al(O_WR + (size_t)36 * 1024 * 4);
constexpr int SLOTS = 2 * NR + 32 * 256;
constexpr size_t M_XN = 0;
constexpr size_t M_HMID = al(M_XN + (size_t)NR * 1024 * 2);
constexpr size_t M_YS = al(M_HMID + (size_t)SLOTS * 256 * 2);
constexpr size_t M_WGU = al(M_YS + (size_t)SLOTS * 1024 * 2);
constexpr size_t M_WD = al(M_WGU + (size_t)32 * 512 * 1024 * 2);
constexpr size_t M_LIST = al(M_WD + (size_t)32 * 1024 * 256 * 2);
constexpr size_t M_WL = al(M_LIST + (size_t)32 * NR * 4);
constexpr size_t M_ASG = al(M_WL + (size_t)32 * NR * 4);
constexpr size_t M_RS = al(M_ASG + (size_t)NR * 16);
constexpr size_t M_END = al(M_RS + (size_t)NR * 4);
static_assert(M_END <= O_WIN, "MoE overlay must stay below the weights");
static_assert(WS_END <= (size_t)256 * 1024 * 1024, "workspace budget");
#if SELFCHECK
DI void chk_fail(const Params& P, int k) { atomicAdd((unsigned*)(P.ws + O_CHK) + k, 1u); }
#endif
constexpr int GX_A = 256 * 128, GX_B = 256 * 128, GX_STAGE = GX_A + GX_B;
constexpr int S12_STRIDE = 2116;
constexpr int LDS_CTL = 16 * S12_STRIDE * 4;
constexpr int LDS_RED = LDS_CTL + 64;
constexpr int LDS_BYTES = LDS_RED + 4 * 256 * 4;


#define XB_TMO      128
#define XB_XCNT(j)  (256  + 64 * (j))
#define XB_XSUB(j)  (1280 + 64 * (j))
#define XB_XGEN(j)  (2304 + 64 * (j))
#define XB_TOP      3328
#define XB_TOPGEN   3392
#define XCD_BAR_WORDS 3456
#define XB_SPIN_CAP (1u << 18)
#define LAS __attribute__((address_space(3)))
DI unsigned xb_ld(unsigned* p)              { return __hip_atomic_load(p, __ATOMIC_RELAXED, __HIP_MEMORY_SCOPE_AGENT); }
DI unsigned xb_add(unsigned* p, unsigned v) { return __hip_atomic_fetch_add(p, v, __ATOMIC_RELAXED, __HIP_MEMORY_SCOPE_AGENT); }
DI unsigned xb_xcc_id() { return (unsigned)__builtin_amdgcn_s_getreg((3 << 11) | 20) & 0xFu; }
#define XB_SPIN(cond, bar) do { unsigned _sp = 0; while (cond) { __builtin_amdgcn_s_sleep(1); \
    if ((++_sp & 255u) == 0u) { if (xb_ld(&(bar)[XB_TMO])) break; if (_sp > XB_SPIN_CAP) { atomicAdd(&(bar)[XB_TMO], 1u); break; } } } } while (0)
struct XcdBarrier { unsigned* bar; unsigned x; volatile LAS unsigned* st; };
DI XcdBarrier xcd_barrier_post(unsigned* bar, volatile LAS unsigned* st) {
  XcdBarrier b; b.bar = bar; b.x = xb_xcc_id(); b.st = st;
  if (threadIdx.x == 0) (void)xb_add(&bar[XB_XCNT(b.x)], 1u);
  return b;
}
DI void xcd_barrier_complete(unsigned* bar, unsigned x, unsigned& nloc, unsigned& nx) {
  const unsigned G = gridDim.x * gridDim.y * gridDim.z;
  unsigned sum, cnt, mine, sp = 0u;
  for (;;) {
    sum = 0u; cnt = 0u; mine = 0u;
#pragma unroll
    for (unsigned j = 0; j < 16; ++j) { const unsigned c = xb_ld(&bar[XB_XCNT(j)]); sum += c; cnt += (c > 0u) ? 1u : 0u; mine = (j == x) ? c : mine; }
    if (sum == G) break;
    __builtin_amdgcn_s_sleep(1);
    if ((++sp & 255u) == 0u) { if (xb_ld(&bar[XB_TMO])) break; if (sp > XB_SPIN_CAP) { atomicAdd(&bar[XB_TMO], 1u); break; } }
  }
  nloc = mine > 0u ? mine : 1u; nx = cnt > 0u ? cnt : 1u;
}
DI void xcd_barrier(const XcdBarrier& b) {
  asm volatile("s_waitcnt vmcnt(0)" ::: "memory");
  __syncthreads();
  if (threadIdx.x == 0) {
    unsigned* bar = b.bar;
    __builtin_amdgcn_s_waitcnt(0);
    unsigned nloc = b.st[0], nx = b.st[1];
    if (nloc == 0u) { xcd_barrier_complete(bar, b.x, nloc, nx); b.st[0] = nloc; b.st[1] = nx; }
    const unsigned old = xb_add(&bar[XB_XSUB(b.x)], 1u);
    const unsigned gen = old / nloc;
    if (old + 1u == (gen + 1u) * nloc) {
      __builtin_amdgcn_fence(__ATOMIC_RELEASE, "agent");
      asm volatile("s_waitcnt vmcnt(0)" ::: "memory");
      const unsigned og = xb_add(&bar[XB_TOP], 1u);
      const unsigned tg = og / nx;
      if (og + 1u == (tg + 1u) * nx) xb_add(&bar[XB_TOPGEN], 1u);
      else XB_SPIN(xb_ld(&bar[XB_TOPGEN]) == tg, bar);
      __builtin_amdgcn_fence(__ATOMIC_ACQUIRE, "agent");
      xb_add(&bar[XB_XGEN(b.x)], 1u);
      asm volatile("s_waitcnt vmcnt(0)" ::: "memory");
    } else {
      XB_SPIN(xb_ld(&bar[XB_XGEN(b.x)]) == gen, bar);
      __builtin_amdgcn_fence(__ATOMIC_ACQUIRE, "agent");
      asm volatile("s_waitcnt vmcnt(0)" ::: "memory");
    }
  }
  __syncthreads();
}

DI void p0_norm_row(const Params& P, int t, bf16_t* hn, int lane) {
  const int b = t / L, p = t % L;
  const float* row = p < NMETA ? P.meta + (size_t)p * D : P.x + ((size_t)b * SEQ + (p - NMETA)) * D;
  f32x4 v[4]; float s = 0.f;
#pragma unroll
  for (int i = 0; i < 4; ++i) { v[i] = *(const f32x4*)(row + 256 * i + 4 * lane); s += v[i][0] * v[i][0] + v[i][1] * v[i][1] + v[i][2] * v[i][2] + v[i][3] * v[i][3]; }
  s = wave_sum(s);
  const float rs = rsqrtf(s * (1.f / D) + EPS);
#pragma unroll
  for (int i = 0; i < 4; ++i) {
    const f32x4 g = *(const f32x4*)(P.g_mix + 256 * i + 4 * lane);
    u32x2 o; o[0] = pk2(v[i][0] * rs * g[0], v[i][1] * rs * g[1]); o[1] = pk2(v[i][2] * rs * g[2], v[i][3] * rs * g[3]);
    *(u32x2*)(hn + (size_t)t * D + 256 * i + 4 * lane) = o;
  }
}
template <class F>
DI void transpose_item(const float* src, int ldsrc, int K, bf16_t* dst, F map, int item, float* scr  , int tid, bool valid) {
  const int nkb = K / 64, kb = item % nkb, nb = item / nkb, k0 = kb * 64, n0 = nb * 64;
  if (valid) {
    const int n = tid & 63; const int col = map(n0 + n);
#pragma unroll 4
    for (int i = 0; i < 16; ++i) { const int k = (tid >> 6) + 4 * i; scr[k * 65 + n] = col >= 0 ? src[(size_t)(k0 + k) * ldsrc + col] : 0.f; }
  }
  __syncthreads();
  if (valid) {
    const int kq = tid & 7;
#pragma unroll
    for (int i = 0; i < 2; ++i) {
      const int n = (tid >> 3) + 32 * i;
      const float* s = scr + (kq * 8) * 65 + n;
      u32x4 o; o[0] = pk2(s[0], s[65]); o[1] = pk2(s[2 * 65], s[3 * 65]); o[2] = pk2(s[4 * 65], s[5 * 65]); o[3] = pk2(s[6 * 65], s[7 * 65]);
      *(u32x4*)(dst + (size_t)(n0 + n) * K + k0 + kq * 8) = o;
    }
  }
  __syncthreads();
}
struct MapIn {
  DI int operator()(int n) const {
    if (n < 416) return n;
    if (n < 424) return 2528 + (n - 416);
    if (n < 488) return 2464 + (n - 424);
    if (n < 512) return -1;
    return 416 + (n - 512);
  }
};
struct MapOff { int off; DI int operator()(int n) const { return off + n; } };
struct MapUkv { DI int operator()(int n) const { const int m = n & 511; return (m >> 6) * 128 + (n >> 9) * 64 + (m & 63); } };

DI void p0_prologue(const Params& P, unsigned char* lds) {
  unsigned char* ws = P.ws;
  const int tid = threadIdx.x, lane = tid & 63, wv = tid >> 6;
  const int gw = blockIdx.x * NW + wv, ngw = gridDim.x * NW;
  bf16_t* hn = (bf16_t*)(P.ws + O_HN);
  for (int t = gw; t < NT; t += ngw) p0_norm_row(P, t, hn, lane);
  float* rope = (float*)(ws + O_ROPE);
  for (int i = blockIdx.x * NTHR + tid; i < L * 16; i += gridDim.x * NTHR) {
    const int p = i >> 4, j = i & 15;
    const float inv = powf(10000.f, -(float)j / 16.f);
    const float ang = (float)p * inv;
    float sn, cs; sincosf(ang, &sn, &cs);
    rope[p * 32 + j] = cs; rope[p * 32 + 16 + j] = sn;
  }
  {
    bf16_t* vbt = (bf16_t*)(ws + O_VBT); bf16_t* vt = (bf16_t*)(ws + O_VT);
    for (int i = blockIdx.x * NTHR + tid; i < NB * 8 * 64 * (LP - L); i += gridDim.x * NTHR) {
      const int r = i / (LP - L), c = L + i % (LP - L);
      vbt[(size_t)r * LP + c] = 0; vt[(size_t)r * LP + c] = 0;
    }
  }
  {
    float* wr = (float*)(ws + O_WR);
    for (int i = blockIdx.x * NTHR + tid; i < 36 * 1024; i += gridDim.x * NTHR) {
      const int c = i >> 10, k = i & 1023;
      wr[i] = c < 4 ? P.w_rg[k * 4 + c] : P.w_re[k * 32 + (c - 4)];
    }
  }
  const int half = tid >> 8, t2 = tid & 255;
  float* scr = (float*)lds + half * (64 * 65 + 32);
  constexpr int I_IN = (1024 / 64) * (2560 / 64), I_G = (1024 / 64) * (2048 / 64), I_UQ = (256 / 64) * (768 / 64), I_UKV = (128 / 64) * (1024 / 64),
                I_BR = (512 / 64) * (1024 / 64), I_O = (1024 / 64) * (1024 / 64);
  constexpr int NIT = I_IN + I_G + I_UQ + I_UKV + 2 * I_BR + I_O;
  for (int it2 = blockIdx.x; 2 * it2 < NIT; it2 += gridDim.x) {
    int r = 2 * it2 + half; const bool valid = r < NIT; if (!valid) r = 0;
    if (r < I_IN) transpose_item(P.w_in, INC, 1024, (bf16_t*)(ws + O_WIN), MapIn(), r, scr, t2, valid);
    else if ((r -= I_IN) < I_G) transpose_item(P.w_in, INC, 1024, (bf16_t*)(ws + O_WG), MapOff{2536}, r, scr, t2, valid);
    else if ((r -= I_G) < I_UQ) transpose_item(P.w_uq, 768, 256, (bf16_t*)(ws + O_WUQ), MapOff{0}, r, scr, t2, valid);
    else if ((r -= I_UQ) < I_UKV) transpose_item(P.w_ukv, 1024, 128, (bf16_t*)(ws + O_WUKV), MapUkv{}, r, scr, t2, valid);
    else if ((r -= I_UKV) < I_BR) transpose_item(P.w_bra, 1024, 512, (bf16_t*)(ws + O_WBRA), MapOff{0}, r, scr, t2, valid);
    else if ((r -= I_BR) < I_BR) transpose_item(P.w_brb, 1024, 512, (bf16_t*)(ws + O_WBRB), MapOff{0}, r, scr, t2, valid);
    else { r -= I_BR; transpose_item(P.w_o, 1024, 1024, (bf16_t*)(ws + O_WO), MapOff{0}, r, scr, t2, valid); }
  }
}

struct TilePtrs { const bf16_t* A; const bf16_t* B; unsigned a[4], b[4]; };
DI void glds16(const unsigned char* g, unsigned char* l) { __builtin_amdgcn_global_load_lds((const unsigned*)g, (unsigned*)l, 16, 0, 0); }
template <bool SWAP>
DI int gemm_kloop(f32x16 (&acc)[4][2], const TilePtrs& tp, int K, unsigned char* lds) {
  const int tid = threadIdx.x, lane = tid & 63, w = __builtin_amdgcn_readfirstlane(tid >> 6), wr = w >> 2, wc = w & 3;
  const int nt = K / 64;
  unsigned char* const lw = lds + w * 1024;
  const int swz = (lane >> 1) & 7, hh = lane >> 5;
  const unsigned char* const ar = lds + (wr * 64 + (lane & 31)) * 128;
  const unsigned char* const br = lds + GX_A + (wc * 32 + (lane & 31)) * 128;
  int coff[4];
#pragma unroll
  for (int kk = 0; kk < 4; ++kk) coff[kk] = ((2 * kk + hh) ^ swz) * 16;
  bf16x8 At[2][4], B0[4], B1[4];
  unsigned oa[4], ob[4];
#pragma unroll
  for (int j = 0; j < 4; ++j) { oa[j] = tp.a[j]; ob[j] = tp.b[j]; }
#define HT_(BO_, H_) ((BO_) + (H_) * 16384)
#define STG_A(BO_, H_, kt) do { const unsigned char* g_ = (const unsigned char*)tp.A + (kt) * 128; glds16(g_ + oa[2 * (H_)], lw + HT_(BO_, H_)); glds16(g_ + oa[2 * (H_) + 1], lw + HT_(BO_, H_) + 8192); } while (0)
#define STG_B(BO_, H_, kt) do { const unsigned char* g_ = (const unsigned char*)tp.B + (kt) * 128; glds16(g_ + ob[2 * (H_)], lw + GX_A + HT_(BO_, H_)); glds16(g_ + ob[2 * (H_) + 1], lw + GX_A + HT_(BO_, H_) + 8192); } while (0)
#define PIN_OFFS() do { _Pragma("unroll") for (int j_ = 0; j_ < 4; ++j_) { asm volatile("" : "+v"(oa[j_])); asm volatile("" : "+v"(ob[j_])); } } while (0)
#define LDA_(BO_, H_) do { _Pragma("unroll") for (int m_ = 0; m_ < 2; ++m_) _Pragma("unroll") for (int k_ = 0; k_ < 4; ++k_) At[m_][k_] = *(const bf16x8*)(ar + HT_(BO_, H_) + m_ * 4096 + coff[k_]); } while (0)
#define LDB_(Bx, BO_, H_) do { _Pragma("unroll") for (int k_ = 0; k_ < 4; ++k_) Bx[k_] = *(const bf16x8*)(br + HT_(BO_, H_) + coff[k_]); } while (0)
#define MMA_(ai, bj, Bx) do { __builtin_amdgcn_s_setprio(1); _Pragma("unroll") for (int k_ = 0; k_ < 4; ++k_) _Pragma("unroll") for (int m_ = 0; m_ < 2; ++m_) \
    acc[2 * (ai) + m_][bj] = SWAP ? __builtin_amdgcn_mfma_f32_32x32x16_bf16(Bx[k_], At[m_][k_], acc[2 * (ai) + m_][bj], 0, 0, 0) \
                                  : __builtin_amdgcn_mfma_f32_32x32x16_bf16(At[m_][k_], Bx[k_], acc[2 * (ai) + m_][bj], 0, 0, 0); __builtin_amdgcn_s_setprio(0); } while (0)
#define WAIT_V(n) asm volatile("s_waitcnt vmcnt(" #n ")" ::: "memory")
#define WAIT_L(n) asm volatile("s_waitcnt lgkmcnt(" #n ")" ::: "memory")
#define BAR_ __builtin_amdgcn_s_barrier()
#define SCHED_ __builtin_amdgcn_sched_barrier(0)
  WAIT_V(0);
  PIN_OFFS();
  STG_B(0, 0, 0); STG_A(0, 0, 0); STG_B(0, 1, 0); STG_A(0, 1, 0);
  if (wr == 1) BAR_;
  WAIT_V(4); BAR_;
  STG_B(GX_STAGE, 0, 1); STG_A(GX_STAGE, 0, 1); STG_B(GX_STAGE, 1, 1);
  WAIT_V(6); BAR_;
  int cur = 0;
#pragma unroll 1
  for (int t = 0; t < nt - 2; ++t) {
    asm volatile("" : "+s"(cur));
    PIN_OFFS();
    const int nxt = cur ^ GX_STAGE;
    LDB_(B0, cur, 0); SCHED_; LDA_(cur, 0); STG_A(nxt, 1, t + 1);
    WAIT_L(8); BAR_; WAIT_L(0); MMA_(0, 0, B0); BAR_; SCHED_;
    LDB_(B1, cur, 1); STG_B(cur, 0, t + 2);
    BAR_; WAIT_L(0); MMA_(0, 1, B1); BAR_;
    LDA_(cur, 1); STG_A(cur, 0, t + 2);
    BAR_; WAIT_L(0); MMA_(1, 0, B0); BAR_; SCHED_;
    STG_B(cur, 1, t + 2);
    WAIT_V(6); BAR_; MMA_(1, 1, B1); BAR_;
    cur = nxt;
  }
  { asm volatile("" : "+s"(cur));
    PIN_OFFS();
    const int nxt = cur ^ GX_STAGE;
    LDB_(B0, cur, 0); LDA_(cur, 0); STG_A(nxt, 1, nt - 1);
    BAR_; WAIT_L(0); MMA_(0, 0, B0); BAR_;
    LDB_(B1, cur, 1); BAR_; WAIT_L(0); MMA_(0, 1, B1); BAR_;
    LDA_(cur, 1); WAIT_V(4); BAR_; WAIT_L(0); MMA_(1, 0, B0); MMA_(1, 1, B1); BAR_;
    LDB_(B0, nxt, 0); LDA_(nxt, 0); WAIT_V(2); BAR_; WAIT_L(0); MMA_(0, 0, B0); BAR_;
    LDB_(B1, nxt, 1); WAIT_V(0); BAR_; WAIT_L(0); MMA_(0, 1, B1); BAR_;
    LDA_(nxt, 1); BAR_; WAIT_L(0); MMA_(1, 0, B0); MMA_(1, 1, B1); BAR_; }
  if (wr == 0) BAR_;
#undef HT_
#undef STG_A
#undef STG_B
#undef LDA_
#undef LDB_
#undef MMA_
#undef PIN_OFFS
  int l_ = threadIdx.x & 63; asm volatile("" : "+v"(l_));
  return l_;
}
DI void tile_rc(int i, int& row, int& chunk) { const int t = threadIdx.x; row = (i >> 1) * 128 + (i & 1) * 64 + (t >> 3); chunk = (t & 7) ^ ((row >> 1) & 7); }
DI int acc_row0(int wr, int mi) { return (mi >> 1) * 128 + wr * 64 + (mi & 1) * 32; }
DI int acc_col0(int wc, int ni) { return ni * 128 + wc * 32; }
#define EPI_IDS(L_) const int lane = (L_), w = __builtin_amdgcn_readfirstlane(threadIdx.x >> 6), wr = w >> 2, wc = w & 3, hh = lane >> 5, lc = lane & 31
DI u32x2 pk4(float a, float b, float c, float d) { u32x2 o; o[0] = pk2(a, b); o[1] = pk2(c, d); return o; }
DI void zero_acc(f32x16 (&acc)[4][2]) {
#pragma unroll
  for (int i = 0; i < 4; ++i)
#pragma unroll
    for (int j = 0; j < 2; ++j)
#pragma unroll
      for (int r = 0; r < 16; ++r) acc[i][j][r] = 0.f;
}
DI void set_ptrs(TilePtrs& tp, const bf16_t* A, int lda, int M, int m0, const bf16_t* Bt, int ldb, int N, int n0) {
#pragma unroll
  for (int i = 0; i < 4; ++i) {
    int row, kc; tile_rc(i, row, kc);
    int r = m0 + row; r = r < M ? r : M - 1;
    int c = n0 + row; c = c < N ? c : N - 1;
    tp.a[i] = ((unsigned)r * (unsigned)lda + kc * 8) * 2u;
    tp.b[i] = ((unsigned)c * (unsigned)ldb + kc * 8) * 2u;
  }
  tp.A = A; tp.B = Bt;
}

DI bool p1_tile_map(int bx, int k, int G, int& mt, int& nt) { const int t = bx + k * G; if (t >= 65 * 18) return false; mt = t / 18; nt = t % 18; return true; }
DI bool p78_tile_map(int bx, int k, int G, int& mt, int& nt) { const int t = bx + k * G; if (t >= 64 * 4) return false; mt = t >> 2; nt = t & 3; return true; }

DI void p1_seg0_epilogue(const Params& P, f32x16 (&acc)[4][2], int m0, int cb, int wr, int wc, int hh, int lc, unsigned char* lds) {
  unsigned char* ws = P.ws;
  float* red = (float*)(lds + LDS_RED);
  const bool isq = cb == 0;
#pragma unroll
  for (int mi = 0; mi < 4; ++mi) {
    float a = 0.f;
#pragma unroll
    for (int r = 0; r < 16; ++r) a = fmaf(acc[mi][0][r], acc[mi][0][r], a);
    if (isq) {
#pragma unroll
      for (int r = 0; r < 16; ++r) a = fmaf(acc[mi][1][r], acc[mi][1][r], a);
    }
    const auto sw = __builtin_amdgcn_permlane32_swap(__float_as_uint(a), __float_as_uint(a), false, false);
    a = __uint_as_float(sw[0]) + __uint_as_float(sw[1]);
    if (hh == 0) red[wc * 256 + acc_row0(wr, mi) + lc] = a;
  }
  __syncthreads();
#pragma unroll
  for (int mi = 0; mi < 4; ++mi) {
    const int rl = acc_row0(wr, mi) + lc;
    int row = m0 + rl;
    asm volatile("" : "+v"(row));
    const bool ok = row < NT;
    const float ssq = red[rl] + red[256 + rl] + red[512 + rl] + red[768 + rl];
    if (isq) {
      const float rs = rsqrtf(ssq * (1.f / 256) + EPS);
      bf16_t* dp = (bf16_t*)(ws + O_CQN) + (size_t)row * 256 + 4 * hh;
#pragma unroll
      for (int ni = 0; ni < 2; ++ni)
#pragma unroll
        for (int g = 0; g < 4; ++g) {
          const int col = acc_col0(wc, ni) + 8 * g;
          const f32x4 gq = *(const f32x4*)(P.g_cq + col + 4 * hh);
          if (ok) *(u32x2*)(dp + col) = pk4(acc[mi][ni][4 * g] * rs * gq[0], acc[mi][ni][4 * g + 1] * rs * gq[1], acc[mi][ni][4 * g + 2] * rs * gq[2], acc[mi][ni][4 * g + 3] * rs * gq[3]);
        }
    } else {
      const float rs = rsqrtf(ssq * (1.f / 128) + EPS);
      bf16_t* dp = (bf16_t*)(ws + O_CKVN) + (size_t)row * 128 + wc * 32 + 4 * hh;
#pragma unroll
      for (int g = 0; g < 4; ++g) {
        const f32x4 gk = *(const f32x4*)(P.g_ckv + wc * 32 + 8 * g + 4 * hh);
        if (ok) *(u32x2*)(dp + 8 * g) = pk4(acc[mi][0][4 * g] * rs * gk[0], acc[mi][0][4 * g + 1] * rs * gk[1], acc[mi][0][4 * g + 2] * rs * gk[2], acc[mi][0][4 * g + 3] * rs * gk[3]);
      }
      if (wc == 0) {
        const int rowc = ok ? row : NT - 1, p = rowc % L;
        const float* rp = (const float*)(ws + O_ROPE) + p * 32;
        u32x2 o[4];
#pragma unroll
        for (int g = 0; g < 2; ++g) {
          const f32x4 cs = *(const f32x4*)(rp + 8 * g + 4 * hh), sn = *(const f32x4*)(rp + 16 + 8 * g + 4 * hh);
          float lo[4], hi[4];
#pragma unroll
          for (int e = 0; e < 4; ++e) { const float x1 = acc[mi][1][4 * g + e], x2 = acc[mi][1][4 * (g + 2) + e]; lo[e] = x1 * cs[e] - x2 * sn[e]; hi[e] = x1 * sn[e] + x2 * cs[e]; }
          o[g] = pk4(lo[0], lo[1], lo[2], lo[3]); o[g + 2] = pk4(hi[0], hi[1], hi[2], hi[3]);
        }
        bf16_t* kp = (bf16_t*)(ws + O_KR) + (size_t)row * 32 + 4 * hh;
        if (ok) {
#pragma unroll
          for (int g = 0; g < 4; ++g) *(u32x2*)(kp + 8 * g) = o[g];
        }
      } else if (wc == 1) {
        if (ok) {
          f32x4 wv; wv[0] = acc[mi][1][0] * 0.35355339059327373f; wv[1] = acc[mi][1][1] * 0.35355339059327373f; wv[2] = acc[mi][1][2] * 0.35355339059327373f; wv[3] = acc[mi][1][3] * 0.35355339059327373f;
          *(f32x4*)((float*)(ws + O_WI) + (size_t)row * 8 + 4 * hh) = wv;
          bf16_t* kip = (bf16_t*)(ws + O_KI) + (size_t)row * 64 + 4 * hh;
#pragma unroll
          for (int g = 1; g < 4; ++g) *(u32x2*)(kip + 8 * g - 8) = pk4(acc[mi][1][4 * g], acc[mi][1][4 * g + 1], acc[mi][1][4 * g + 2], acc[mi][1][4 * g + 3]);
        }
      } else if (wc == 2) {
        if (ok) {
          bf16_t* kip = (bf16_t*)(ws + O_KI) + (size_t)row * 64 + 24 + 4 * hh;
#pragma unroll
          for (int g = 0; g < 4; ++g) *(u32x2*)(kip + 8 * g) = pk4(acc[mi][1][4 * g], acc[mi][1][4 * g + 1], acc[mi][1][4 * g + 2], acc[mi][1][4 * g + 3]);
        }
      } else {
        if (ok) *(u32x2*)((bf16_t*)(ws + O_KI) + (size_t)row * 64 + 56 + 4 * hh) = pk4(acc[mi][1][0], acc[mi][1][1], acc[mi][1][2], acc[mi][1][3]);
      }
    }
  }
}
DI void p1_inproj_tile(const Params& P, int mt, int nt, unsigned char* lds) {
  unsigned char* ws = P.ws;
  const int m0 = mt * 256, n0 = nt * 256;
  const bf16_t* hn = (const bf16_t*)(ws + O_HN);
  TilePtrs tp;
  if (n0 < 2560) set_ptrs(tp, hn, 1024, NT, m0, (const bf16_t*)(ws + O_WIN), 1024, 2560, n0);
  else set_ptrs(tp, hn, 1024, NT, m0, (const bf16_t*)(ws + O_WG), 1024, 2048, n0 - 2560);
  f32x16 acc[4][2]; zero_acc(acc);
  const int seg = n0 / 512, cb = n0 % 512;
  if (seg == 3) {
    EPI_IDS(gemm_kloop<false>(acc, tp, 1024, lds));
    bf16_t* vbt = (bf16_t*)(ws + O_VBT);
#pragma unroll
    for (int mi = 0; mi < 4; ++mi)
#pragma unroll
      for (int ni = 0; ni < 2; ++ni) {
        const int col = cb + acc_col0(wc, ni) + lc;
        const int rbase = m0 + acc_row0(wr, mi) + 4 * hh;
        const int h = col >> 6, d = col & 63;
#pragma unroll
        for (int g = 0; g < 4; ++g) {
          const int row = rbase + 8 * g;
          if (row < NT) {
            const int b = row / L, p = row % L;
            *(u32x2*)(vbt + ((size_t)(b * 8 + h) * 64 + d) * LP + p) = pk4(acc[mi][ni][4 * g], acc[mi][ni][4 * g + 1], acc[mi][ni][4 * g + 2], acc[mi][ni][4 * g + 3]);
          }
        }
      }
    return;
  }
  EPI_IDS(gemm_kloop<true>(acc, tp, 1024, lds));
  if (seg == 0) { p1_seg0_epilogue(P, acc, m0, cb, wr, wc, hh, lc, lds); return; }
  if (n0 >= 2560) {
    bf16_t* gates = (bf16_t*)P.out;
#pragma unroll
    for (int mi = 0; mi < 4; ++mi) {
      int row = m0 + acc_row0(wr, mi) + lc;
      asm volatile("" : "+v"(row));
      const int b = row / L, p = row - b * L;
      const bool ok = row < NT && p >= NMETA;
      bf16_t* gp = gates + (size_t)(row - NMETA * (b + 1)) * 2048 + (n0 - 2560) + 4 * hh;
#pragma unroll
      for (int ni = 0; ni < 2; ++ni)
#pragma unroll
        for (int g = 0; g < 4; ++g) {
          float sg[4];
#pragma unroll
          for (int e = 0; e < 4; ++e) sg[e] = __builtin_amdgcn_rcpf(1.f + __expf(-acc[mi][ni][4 * g + e]));
          if (ok) *(u32x2*)(gp + acc_col0(wc, ni) + 8 * g) = pk4(sg[0], sg[1], sg[2], sg[3]);
        }
    }
    return;
  }
#pragma unroll
  for (int mi = 0; mi < 4; ++mi) {
    int row = m0 + acc_row0(wr, mi) + lc;
    asm volatile("" : "+v"(row));
    const bool ok = row < NT;
    {
      bf16_t* dp = (bf16_t*)(ws + (seg == 1 ? O_QB : seg == 2 ? O_KB : O_QI)) + (size_t)row * 512 + cb + 4 * hh;
      const float sc = seg == 4 ? 0.125f : seg == 1 ? 0.125f * LOG2E : 1.f;
#pragma unroll
      for (int ni = 0; ni < 2; ++ni)
#pragma unroll
        for (int g = 0; g < 4; ++g)
          if (ok) *(u32x2*)(dp + acc_col0(wc, ni) + 8 * g) = pk4(acc[mi][ni][4 * g] * sc, acc[mi][ni][4 * g + 1] * sc, acc[mi][ni][4 * g + 2] * sc, acc[mi][ni][4 * g + 3] * sc);
    }
  }
}

DI void p2a_token(const Params& P, int t, int lane) {
  unsigned char* ws = P.ws;
  const float* sm = (const float*)(ws + O_SMALL) + (size_t)t * 512;
  const int b = t / L, p = t % L;
  {
    const f32x4 v = *(const f32x4*)(sm + S_CQ + 4 * lane);
    const float s = wave_sum(v[0] * v[0] + v[1] * v[1] + v[2] * v[2] + v[3] * v[3]);
    const float rs = rsqrtf(s * (1.f / 256) + EPS);
    const f32x4 g = *(const f32x4*)(P.g_cq + 4 * lane);
    u32x2 o; o[0] = pk2(v[0] * rs * g[0], v[1] * rs * g[1]); o[1] = pk2(v[2] * rs * g[2], v[3] * rs * g[3]);
    *(u32x2*)((bf16_t*)(ws + O_CQN) + (size_t)t * 256 + 4 * lane) = o;
  }
  {
    const float v0 = sm[S_CKV + 2 * lane], v1 = sm[S_CKV + 2 * lane + 1];
    const float s = wave_sum(v0 * v0 + v1 * v1);
    const float rs = rsqrtf(s * (1.f / 128) + EPS);
    *(unsigned*)((bf16_t*)(ws + O_CKVN) + (size_t)t * 128 + 2 * lane) = pk2(v0 * rs * P.g_ckv[2 * lane], v1 * rs * P.g_ckv[2 * lane + 1]);
  }
  {
    const float* rp = (const float*)(ws + O_ROPE) + p * 32;
    const int j = lane & 15;
    const float x1 = sm[S_KR + j], x2 = sm[S_KR + 16 + j], cs = rp[j], sn = rp[16 + j];
    const float o = (lane & 16) ? (x1 * sn + x2 * cs) : (x1 * cs - x2 * sn);
    bf16_t* km = (bf16_t*)(ws + O_KMLA);
    const bf16_t ob = f2bf(o);
    const int c = lane & 31;
#pragma unroll
    for (int hq = 0; hq < 4; ++hq) { const int h = hq + 4 * (lane >> 5); km[((size_t)(b * 8 + h) * LP + p) * 96 + 64 + c] = ob; }
  }
  ((bf16_t*)(ws + O_KI))[(size_t)t * 64 + lane] = f2bf(sm[S_KI + lane]);
  if (lane < 8) ((float*)(ws + O_WI))[(size_t)t * 8 + lane] = sm[S_WI + lane] * 0.35355339059327373f;
}

DI void p2b_q_tile(const Params& P, int tile, unsigned char* lds) {
  unsigned char* ws = P.ws;
  constexpr int NNT = 768 / 256;
  const int mt = tile / NNT, nt = tile % NNT, m0 = mt * 256, n0 = nt * 256;
  TilePtrs tp; set_ptrs(tp, (const bf16_t*)(ws + O_CQN), 256, NT, m0, (const bf16_t*)(ws + O_WUQ), 256, 768, n0);
  f32x16 acc[4][2]; zero_acc(acc);
  EPI_IDS(gemm_kloop<true>(acc, tp, 256, lds));
  const float qscale = 0.10206207261596575f * LOG2E;
  const float* rope = (const float*)(ws + O_ROPE);
  bf16_t* qa = (bf16_t*)(ws + O_QA);
#pragma unroll
  for (int mi = 0; mi < 4; ++mi) {
    int row = m0 + acc_row0(wr, mi) + lc;
    asm volatile("" : "+v"(row));
    const bool ok = row < NT;
    const int rowc = ok ? row : NT - 1, p = rowc % L;
#pragma unroll
    for (int ni = 0; ni < 2; ++ni) {
      const int c0 = n0 + acc_col0(wc, ni);
      const bool is_rope = ((c0 >> 5) % 3) == 2;
      float v[16];
#pragma unroll
      for (int r = 0; r < 16; ++r) v[r] = acc[mi][ni][r];
      if (is_rope) {
#pragma unroll
        for (int g = 0; g < 2; ++g) {
          const f32x4 cs = *(const f32x4*)(rope + p * 32 + 8 * g + 4 * hh), sn = *(const f32x4*)(rope + p * 32 + 16 + 8 * g + 4 * hh);
#pragma unroll
          for (int e = 0; e < 4; ++e) {
            const float lo = v[4 * g + e], hi = v[4 * (g + 2) + e];
            v[4 * g + e] = lo * cs[e] - hi * sn[e];
            v[4 * (g + 2) + e] = lo * sn[e] + hi * cs[e];
          }
        }
      }
#pragma unroll
      for (int g = 0; g < 4; ++g)
        if (ok) *(u32x2*)(qa + (size_t)row * 768 + c0 + 8 * g + 4 * hh) = pk4(v[4 * g] * qscale, v[4 * g + 1] * qscale, v[4 * g + 2] * qscale, v[4 * g + 3] * qscale);
    }
  }
}
DI void p2b_kv_tile(const Params& P, int tile, unsigned char* lds) {
  unsigned char* ws = P.ws;
  constexpr int NNT = 1024 / 256;
  const int mt = tile / NNT, nt = tile % NNT, m0 = mt * 256, n0 = nt * 256;
  TilePtrs tp; set_ptrs(tp, (const bf16_t*)(ws + O_CKVN), 128, NT, m0, (const bf16_t*)(ws + O_WUKV), 128, 1024, n0);
  f32x16 acc[4][2]; zero_acc(acc);
  if (nt < 2) {
    {
      const int row = m0 + (threadIdx.x >> 1);
      if (row < NT) {
        const int b = row / L, p = row % L, h = 4 * nt + 2 * (threadIdx.x & 1);
        const u32x4* src = (const u32x4*)((const bf16_t*)(ws + O_KR) + (size_t)row * 32);
        u32x4* dst = (u32x4*)((bf16_t*)(ws + O_KMLA) + ((size_t)(b * 8 + h) * LP + p) * 96 + 64);
        const u32x4 v0 = src[0], v1 = src[1], v2 = src[2], v3 = src[3];
        dst[0] = v0; dst[1] = v1; dst[2] = v2; dst[3] = v3;
        u32x4* dst2 = dst + (size_t)LP * 96 * 2 / 16;
        dst2[0] = v0; dst2[1] = v1; dst2[2] = v2; dst2[3] = v3;
      }
    }
    EPI_IDS(gemm_kloop<true>(acc, tp, 128, lds));
    bf16_t* km = (bf16_t*)(ws + O_KMLA);
#pragma unroll
    for (int mi = 0; mi < 4; ++mi) {
      int row = m0 + acc_row0(wr, mi) + lc;
      asm volatile("" : "+v"(row));
      const bool ok = row < NT;
      const int b = row / L, p = row % L;
#pragma unroll
      for (int ni = 0; ni < 2; ++ni) {
        const int cc = n0 + acc_col0(wc, ni), h = cc >> 6, c = (cc & 63) + 4 * hh;
        bf16_t* kp = km + ((size_t)(b * 8 + h) * LP + p) * 96 + c;
#pragma unroll
        for (int g = 0; g < 4; ++g)
          if (ok) *(u32x2*)(kp + 8 * g) = pk4(acc[mi][ni][4 * g], acc[mi][ni][4 * g + 1], acc[mi][ni][4 * g + 2], acc[mi][ni][4 * g + 3]);
      }
    }
  } else {
    EPI_IDS(gemm_kloop<false>(acc, tp, 128, lds));
    bf16_t* vt = (bf16_t*)(ws + O_VT);
#pragma unroll
    for (int mi = 0; mi < 4; ++mi)
#pragma unroll
      for (int ni = 0; ni < 2; ++ni) {
        const int cc = n0 - 512 + acc_col0(wc, ni) + lc, h = cc >> 6, d = cc & 63;
        const int rbase = m0 + acc_row0(wr, mi) + 4 * hh;
#pragma unroll
        for (int g = 0; g < 4; ++g) {
          const int row = rbase + 8 * g;
          if (row < NT) {
            const int b = row / L, p = row % L;
            *(u32x2*)(vt + ((size_t)(b * 8 + h) * 64 + d) * LP + p) = pk4(acc[mi][ni][4 * g], acc[mi][ni][4 * g + 1], acc[mi][ni][4 * g + 2], acc[mi][ni][4 * g + 3]);
          }
        }
      }
  }
}


DI int next_item(const Params& P, int ctr, int* slot) {
  __syncthreads();
  if (threadIdx.x == 0) *slot = (int)atomicAdd((unsigned*)(P.ws + O_CTR) + ctr, 1u);
  __syncthreads();
  return *slot;
}
DI float fast_exp2(float x) { return __builtin_amdgcn_exp2f(x); }
DI bf16x8 pack8(const f32x16& v, int s) {
  u32x4 p;
  p[0] = pk2(v[8 * s + 0], v[8 * s + 1]); p[1] = pk2(v[8 * s + 2], v[8 * s + 3]); p[2] = pk2(v[8 * s + 4], v[8 * s + 5]); p[3] = pk2(v[8 * s + 6], v[8 * s + 7]);
  return __builtin_bit_cast(bf16x8, p);
}

constexpr float MASKV = -3.0e38f;
constexpr float DEFER_THR = 6.0f;
DI float xmax32(float v) {
  const auto r = __builtin_amdgcn_permlane32_swap(__float_as_uint(v), __float_as_uint(v), false, false);
  return fmaxf(__uint_as_float(r[0]), __uint_as_float(r[1]));
}
DI void softmax_update1(f32x16& s, float& m, float mref, float& lsum, f32x16& o0, f32x16& o1) {
  float mx = s[0];
#pragma unroll
  for (int r = 1; r < 16; ++r) mx = fmaxf(mx, s[r]);
  mx = xmax32(mx);
  const bool have = m > -1e29f;
  const float shift = (have ? m : 0.f) - mref;
  const bool need = (mx - shift > DEFER_THR) || (!have && mx > -1e37f);
  if (__any(need || shift != 0.f)) {
    const float delta = need ? mx - shift : 0.f;
    const float alpha = (need && have) ? fast_exp2(-delta) : 1.f;
    m = need ? (have ? m : 0.f) + delta : m;
    const float sub = shift + delta;
#pragma unroll
    for (int r = 0; r < 16; ++r) { s[r] -= sub; o0[r] *= alpha; o1[r] *= alpha; }
    lsum *= alpha;
  }
#pragma unroll
  for (int r = 0; r < 16; ++r) s[r] = fast_exp2(s[r]);
  typedef float f32x2 __attribute__((ext_vector_type(2)));
  f32x2 ps = {0.f, 0.f};
#pragma unroll
  for (int r = 0; r < 16; r += 2) ps += (f32x2){s[r], s[r + 1]};
  lsum += ps[0] + ps[1];
}
DI void pv_subtile(const unsigned char* Vc, int vstr, const f32x16& p, f32x16& o0, f32x16& o1) {
#pragma unroll
  for (int s2 = 0; s2 < 2; ++s2) {
    const bf16x8 pb = pack8(p, s2);
    const u32x2 a0l = *(const u32x2*)(Vc + s2 * 32), a0h = *(const u32x2*)(Vc + s2 * 32 + 16);
    const u32x2 a1l = *(const u32x2*)(Vc + 32 * vstr + s2 * 32), a1h = *(const u32x2*)(Vc + 32 * vstr + s2 * 32 + 16);
    o0 = __builtin_amdgcn_mfma_f32_32x32x16_bf16(__builtin_bit_cast(bf16x8, (u32x4){a0l[0], a0l[1], a0h[0], a0h[1]}), pb, o0, 0, 0, 0);
    o1 = __builtin_amdgcn_mfma_f32_32x32x16_bf16(__builtin_bit_cast(bf16x8, (u32x4){a1l[0], a1l[1], a1h[0], a1h[1]}), pb, o1, 0, 0, 0);
  }
}
constexpr int MLA_KSTR = 208, MLA_VSTR = 136, MLA_KBYTES = 64 * MLA_KSTR, MLA_STAGE = MLA_KBYTES + 64 * MLA_VSTR;
DI void mla_stage(const unsigned char* cur, int s, int cw, int lq, int hh, const bf16x8 (&qf)[6], f32x16& o0, f32x16& o1, float& m, float& lsum) {
  if (s > cw) return;
  const bool full = s < cw;
  const float mref = m > -1e29f ? m : 0.f;
  f32x16 s0, s1;
#pragma unroll
  for (int r = 0; r < 16; ++r) { s0[r] = -mref; s1[r] = -mref; }
  const unsigned char* Kc = cur + lq * MLA_KSTR + hh * 16;
  {
    bf16x8 kf[6];
#pragma unroll
    for (int kk = 0; kk < 6; ++kk) kf[kk] = *(const bf16x8*)(Kc + kk * 32);
#pragma unroll
    for (int kk = 0; kk < 6; ++kk) s0 = __builtin_amdgcn_mfma_f32_32x32x16_bf16(kf[kk], qf[kk], s0, 0, 0, 0);
    __builtin_amdgcn_sched_group_barrier(0x100, 6, 0);
    __builtin_amdgcn_sched_group_barrier(0x008, 6, 0);
  }
  if (full) {
    bf16x8 kf[6];
#pragma unroll
    for (int kk = 0; kk < 6; ++kk) kf[kk] = *(const bf16x8*)(Kc + 32 * MLA_KSTR + kk * 32);
#pragma unroll
    for (int kk = 0; kk < 6; ++kk) s1 = __builtin_amdgcn_mfma_f32_32x32x16_bf16(kf[kk], qf[kk], s1, 0, 0, 0);
    __builtin_amdgcn_sched_group_barrier(0x100, 6, 0);
    __builtin_amdgcn_sched_group_barrier(0x008, 6, 0);
  } else {
#pragma unroll
    for (int r = 8; r < 16; ++r) s0[r] = MASKV;
  }
  const unsigned char* Vc = cur + MLA_KBYTES + lq * MLA_VSTR + hh * 8;
  softmax_update1(s0, m, mref, lsum, o0, o1);
  pv_subtile(Vc, MLA_VSTR, s0, o0, o1);
  if (full) {
    softmax_update1(s1, m, mref, lsum, o0, o1);
    pv_subtile(Vc + 64, MLA_VSTR, s1, o0, o1);
  }
}
DI void mla_item(const Params& P, int item, unsigned char* lds) {
  unsigned char* ws = P.ws;
  const int jq = 15 - item / 32, bh = item % 32, b = bh >> 3, h = bh & 7;
  const int c0 = 4 * jq + 1;
  const int tid = threadIdx.x, lane = tid & 63, w = __builtin_amdgcn_readfirstlane(tid >> 6), hh = lane >> 5, lq = lane & 31;
  const int cw = c0 + (w >> 1);
  const int pq = NMETA + 256 * jq + 32 * w + lq;
  const int tq = b * L + pq;
  bf16x8 qf[6];
  {
    const bf16_t* qrow = (const bf16_t*)(ws + O_QA) + (size_t)tq * 768 + h * 96 + hh * 8;
#pragma unroll
    for (int kk = 0; kk < 6; ++kk) qf[kk] = *(const bf16x8*)(qrow + kk * 16);
  }
  f32x16 o0, o1;
#pragma unroll
  for (int r = 0; r < 16; ++r) { o0[r] = 0.f; o1[r] = 0.f; }
  float m = -1e30f, lsum = 0.f;
  const int nst = c0 + 4;
  const bf16_t* kg = (const bf16_t*)(ws + O_KMLA) + (size_t)bh * LP * 96;
  const bf16_t* vg = (const bf16_t*)(ws + O_VT) + (size_t)bh * 64 * LP;
  unsigned kgo[2], klo[2], vgo, vlo;
  const bool k2 = tid < 256;
#pragma unroll
  for (int i = 0; i < 2; ++i) { int idx = tid + 512 * i; idx = idx < 768 ? idx : 767; const int row = idx / 12, c = idx % 12; kgo[i] = row * 96 + c * 8; klo[i] = row * MLA_KSTR + c * 16; }
  { const int d = tid >> 3, c = tid & 7; vgo = d * LP + c * 8; vlo = MLA_KBYTES + d * MLA_VSTR + c * 16; }
  u32x4 rkA[2], rvA, rkB[2], rvB;
#define MLA_LOAD(rk_, rv_, st) do { const bf16_t* kgs = kg + (size_t)(st) * 64 * 96; const bf16_t* vgs = vg + (st) * 64; \
    rk_[0] = *(const u32x4*)(kgs + kgo[0]); rk_[1] = *(const u32x4*)(kgs + kgo[1]); rv_ = *(const u32x4*)(vgs + vgo); } while (0)
#define MLA_WRITE(rk_, rv_, buf) do { unsigned char* nb_ = (buf); \
    *(u32x4*)(nb_ + klo[0]) = rk_[0]; if (k2) *(u32x4*)(nb_ + klo[1]) = rk_[1]; \
    *(u32x2*)(nb_ + vlo) = (u32x2){rv_[0], rv_[1]}; *(u32x2*)(nb_ + vlo + 8) = (u32x2){rv_[2], rv_[3]}; } while (0)
  unsigned char* buf0 = lds; unsigned char* buf1 = lds + MLA_STAGE;
  MLA_LOAD(rkA, rvA, 0); MLA_WRITE(rkA, rvA, buf0);
  __syncthreads();
  if (nst > 1) MLA_LOAD(rkA, rvA, 1);
#pragma unroll 1
  for (int s = 0; s < nst; s += 2) {
    if (s + 2 < nst) MLA_LOAD(rkB, rvB, s + 2);
    mla_stage(buf0, s, cw, lq, hh, qf, o0, o1, m, lsum);
    if (s + 1 < nst) MLA_WRITE(rkA, rvA, buf1);
    __syncthreads();
    if (s + 1 >= nst) break;
    if (s + 3 < nst) MLA_LOAD(rkA, rvA, s + 3);
    mla_stage(buf1, s + 1, cw, lq, hh, qf, o0, o1, m, lsum);
    if (s + 2 < nst) MLA_WRITE(rkB, rvB, buf0);
    __syncthreads();
  }
#undef MLA_LOAD
#undef MLA_WRITE
  lsum += __shfl_xor(lsum, 32);
  const float inv = 1.f / lsum;
  bf16_t* oa = (bf16_t*)(ws + O_OA) + (size_t)(tq - NMETA * (b + 1)) * 512 + h * 64 + 4 * hh;
#pragma unroll
  for (int g = 0; g < 4; ++g) {
    u32x2 v0, v1;
    v0[0] = pk2(o0[4 * g] * inv, o0[4 * g + 1] * inv); v0[1] = pk2(o0[4 * g + 2] * inv, o0[4 * g + 3] * inv);
    v1[0] = pk2(o1[4 * g] * inv, o1[4 * g + 1] * inv); v1[1] = pk2(o1[4 * g + 2] * inv, o1[4 * g + 3] * inv);
    *(u32x2*)(oa + 8 * g) = v0;
    *(u32x2*)(oa + 32 + 8 * g) = v1;
  }
}


DI size_t score_row_off(int b, int i) {
  const int c = 1 + (i >> 6), m = c - 1;
  return (size_t)b * SCORES_PER_BATCH + (size_t)8192 * (m + (m >> 1) * ((m + 1) >> 1)) + (size_t)(i & 63) * (128 * ((c >> 1) + 1));
}
constexpr int S1_ITEMS = 4 * 560;
DI void s1_item(const Params& P, int it) {
  unsigned char* ws = P.ws;
  const int b = it & 3; int r = it >> 2; int c = 64;
  while (r >= (c >> 2) + 1) { r -= (c >> 2) + 1; --c; }
  const int n = 16 + 64 * c;
  const int lane = threadIdx.x & 63, w = (threadIdx.x >> 6) & 3, lq = lane & 15, lg = lane >> 4;
  const int i = (c - 1) * 64 + 16 * w + lq, tq = b * L + NMETA + i;
  bf16x8 qf[8][2];
  const bf16_t* qrow = (const bf16_t*)(ws + O_QI) + (size_t)tq * 512 + 8 * lg;
#pragma unroll
  for (int h = 0; h < 8; ++h) { qf[h][0] = *(const bf16x8*)(qrow + h * 64); qf[h][1] = *(const bf16x8*)(qrow + h * 64 + 32); }
  const f32x4 wa = *(const f32x4*)((const float*)(ws + O_WI) + (size_t)tq * 8), wb = *(const f32x4*)((const float*)(ws + O_WI) + (size_t)tq * 8 + 4);
  const float wv[8] = {wa[0], wa[1], wa[2], wa[3], wb[0], wb[1], wb[2], wb[3]};
  unsigned* srow = (unsigned*)((_Float16*)(ws + O_SCORES) + score_row_off(b, i)) + 4 * lg;
  const bf16_t* kbase = (const bf16_t*)(ws + O_KI) + ((size_t)b * L + lq) * 64 + 8 * lg;
#pragma unroll 1
  for (int g2 = 0; g2 < 2; ++g2) {
    const int kg = 256 * r + 128 * g2;
#pragma unroll 1
    for (int kt4 = 0; kt4 < 64; kt4 += 16) {
      const int ka = kg + kt4, kb = ka + 64;
      if (ka >= n) break;
      f32x4 sa = {0.f, 0.f, 0.f, 0.f}, sb = {0.f, 0.f, 0.f, 0.f};
      {
        const bf16_t* kp = kbase + (size_t)ka * 64;
        const bf16x8 a0 = *(const bf16x8*)kp, a1 = *(const bf16x8*)(kp + 32);
#pragma unroll
        for (int h = 0; h < 8; ++h) {
          f32x4 acc = {0.f, 0.f, 0.f, 0.f};
          acc = __builtin_amdgcn_mfma_f32_16x16x32_bf16(a0, qf[h][0], acc, 0, 0, 0);
          acc = __builtin_amdgcn_mfma_f32_16x16x32_bf16(a1, qf[h][1], acc, 0, 0, 0);
#pragma unroll
          for (int q = 0; q < 4; ++q) sa[q] = fmaf(wv[h], fmaxf(acc[q], 0.f), sa[q]);
        }
      }
      if (kb < n) {
        const bf16_t* kp = kbase + (size_t)kb * 64;
        const bf16x8 a0 = *(const bf16x8*)kp, a1 = *(const bf16x8*)(kp + 32);
#pragma unroll
        for (int h = 0; h < 8; ++h) {
          f32x4 acc = {0.f, 0.f, 0.f, 0.f};
          acc = __builtin_amdgcn_mfma_f32_16x16x32_bf16(a0, qf[h][0], acc, 0, 0, 0);
          acc = __builtin_amdgcn_mfma_f32_16x16x32_bf16(a1, qf[h][1], acc, 0, 0, 0);
#pragma unroll
          for (int q = 0; q < 4; ++q) sb[q] = fmaf(wv[h], fmaxf(acc[q], 0.f), sb[q]);
        }
      }
      typedef _Float16 h2_t __attribute__((ext_vector_type(2)));
      u32x4 o;
#pragma unroll
      for (int q = 0; q < 4; ++q) { const h2_t v = {(_Float16)sa[q], (_Float16)sb[q]}; o[q] = __builtin_bit_cast(unsigned, v); }
      *(u32x4*)(srow + (kg >> 1) + kt4) = o;
    }
  }
}

DI unsigned f2key(float f) { const unsigned u = __float_as_uint(f); return (u & 0x80000000u) ? ~u : (u | 0x80000000u); }
DI unsigned long long lanemask_lt(int lane) { return (1ull << lane) - 1ull; }
template <int NG>
DI void s2_row(const Params& P, int rq, int lane, const unsigned* srow  ) {
  const int i = rq % SEQ, c = 1 + (i >> 6), n = 16 + 64 * c;
  typedef unsigned short u16x2 __attribute__((ext_vector_type(2)));
  u16x2 hp[NG];
  {
    unsigned raw[NG];
#pragma unroll
    for (int e = 0; e < NG; ++e) raw[e] = srow[64 * e];
#pragma unroll
    for (int e = 0; e < NG; ++e) asm volatile("" : "+v"(raw[e]));
#pragma unroll
    for (int e = 0; e < NG; ++e) {
      const unsigned d = raw[e];
      unsigned k = d ^ ((((d >> 15) & 0x00010001u) * 0xffffu) | 0x80008000u);
      if (128 * e + lane >= n) k &= 0xffff0000u;
      if (128 * e + 64 + lane >= n) k &= 0x0000ffffu;
      hp[e] = __builtin_bit_cast(u16x2, k);
    }
  }
  unsigned T = 0; int c_lo = 1 << 30, c_hi = 0;
  for (int bit = 15; bit >= 0; --bit) {
    const unsigned cand = T | (1u << bit);
    const unsigned short chm1 = (unsigned short)(cand - 1u);
    const u16x2 cv = {chm1, chm1}, one = {1, 1};
    u16x2 a0 = {0, 0}, a1 = {0, 0};
#pragma unroll
    for (int e = 0; e < NG; ++e) {
      u16x2 t;
      asm("v_pk_sub_u16 %0, %1, %2 clamp" : "=v"(t) : "v"(hp[e]), "v"(cv));
      asm("v_pk_min_u16 %0, %1, %2" : "=v"(t) : "v"(t), "v"(one));
      if (e & 1) asm("v_pk_add_u16 %0, %1, %2" : "=v"(a1) : "v"(a1), "v"(t)); else asm("v_pk_add_u16 %0, %1, %2" : "=v"(a0) : "v"(a0), "v"(t));
    }
    const u16x2 as = a0 + a1;
    const int cc = wave_sumi((int)as[0] + (int)as[1]);
    if (cc >= 256) { T = cand; c_lo = cc; } else { c_hi = cc; }
    if (c_lo == 256) break;
  }
  unsigned mlo = 0u, mhi = 0u;
  unsigned long long w64 = 0ull;
  int rem = c_lo == 256 ? (1 << 20) : 256 - c_hi;
#pragma unroll
  for (int e = 0; e < NG; ++e) {
    const unsigned kk = __builtin_bit_cast(unsigned, hp[e]);
#pragma unroll
    for (int h = 0; h < 2; ++h) {
      const unsigned kv = h ? (kk >> 16) : (kk & 0xffffu);
      const bool eq = kv == T;
      const unsigned long long meq = __ballot(eq), mgt = __ballot(kv > T);
      unsigned long long msel = mgt;
      if (meq) {
        const int pre = __popcll(meq & lanemask_lt(lane));
        msel |= __ballot(eq && pre < rem);
        rem -= __popcll(meq); rem = rem < 0 ? 0 : rem;
      }
      const int wd = 2 * e + h;
      if (wd < 64) { if (lane == wd) { mlo = (unsigned)msel; mhi = (unsigned)(msel >> 32); } } else if (wd == 64) w64 = msel;
    }
  }
  unsigned* mrow = (unsigned*)(P.ws + O_MASK) + (size_t)rq * MW;
  *(u32x2*)(mrow + 2 * lane) = (u32x2){mlo, mhi};
  if (lane == 0) { *(u32x2*)(mrow + 128) = (u32x2){(unsigned)w64, (unsigned)(w64 >> 32)}; *(u32x2*)(mrow + 130) = (u32x2){0u, 0u}; }
}
DI void s2_dispatch(const Params& P, int rq, int lane, const unsigned* srow) {
  const int c = 1 + ((rq % SEQ) >> 6), n = 16 + 64 * c;
  if (n <= 256) {
    unsigned* mrow = (unsigned*)(P.ws + O_MASK) + (size_t)rq * MW;
    unsigned long long m = 0ull;
    const int lo = 64 * lane;
    if (lo + 64 <= n) m = ~0ull; else if (lo < n) m = (1ull << (n - lo)) - 1ull;
    *(u32x2*)(mrow + 2 * lane) = (u32x2){(unsigned)m, (unsigned)(m >> 32)};
    if (lane == 0) { *(u32x2*)(mrow + 128) = (u32x2){0u, 0u}; *(u32x2*)(mrow + 130) = (u32x2){0u, 0u}; }
    return;
  }
  const int ng = (c >> 1) + 1;
  if (ng <= 5) s2_row<5>(P, rq, lane, srow);
  else if (ng <= 9) s2_row<9>(P, rq, lane, srow);
  else if (ng <= 13) s2_row<13>(P, rq, lane, srow);
  else if (ng <= 17) s2_row<17>(P, rq, lane, srow);
  else if (ng <= 21) s2_row<21>(P, rq, lane, srow);
  else if (ng <= 25) s2_row<25>(P, rq, lane, srow);
  else if (ng <= 29) s2_row<29>(P, rq, lane, srow);
  else s2_row<33>(P, rq, lane, srow);
}

constexpr int S12_ITEMS = 1024;
DI void s12_item(const Params& P, int item, unsigned char* lds) {
  unsigned char* ws = P.ws;
  const int c = 64 - (item >> 4), sub = (item >> 2) & 3, b = item & 3;
  const int n = 16 + 64 * c, ng = (c >> 1) + 1;
  const int tid = threadIdx.x, lane = tid & 63, w = __builtin_amdgcn_readfirstlane(tid >> 6), lq = lane & 15, lg = lane >> 4;
  const int i0 = (c - 1) * 64 + 16 * sub;
  unsigned* sc = (unsigned*)lds;
  if (n > 256) {
    const int tq = b * L + NMETA + i0 + lq;
    bf16x8 qf[8][2];
    const bf16_t* qrow = (const bf16_t*)(ws + O_QI) + (size_t)tq * 512 + 8 * lg;
#pragma unroll
    for (int h = 0; h < 8; ++h) { qf[h][0] = *(const bf16x8*)(qrow + h * 64); qf[h][1] = *(const bf16x8*)(qrow + h * 64 + 32); }
    const f32x4 wa = *(const f32x4*)((const float*)(ws + O_WI) + (size_t)tq * 8), wb = *(const f32x4*)((const float*)(ws + O_WI) + (size_t)tq * 8 + 4);
    const float wv[8] = {wa[0], wa[1], wa[2], wa[3], wb[0], wb[1], wb[2], wb[3]};
    unsigned* srow = sc + lq * S12_STRIDE + 4 * lg;
    const bf16_t* kbase = (const bf16_t*)(ws + O_KI) + ((size_t)b * L + lq) * 64 + 8 * lg;
    const int npair = 4 * ng, klast = n - 16;
    bf16x8 ca0, ca1, cb0, cb1;
#define S12_LOAD(a0_, a1_, b0_, b1_, pi_) do { const int ka_ = 128 * ((pi_) >> 2) + 16 * ((pi_) & 3); \
      const bf16_t* pa_ = kbase + (size_t)min(ka_, klast) * 64; const bf16_t* pb_ = kbase + (size_t)min(ka_ + 64, klast) * 64; \
      a0_ = *(const bf16x8*)pa_; a1_ = *(const bf16x8*)(pa_ + 32); b0_ = *(const bf16x8*)pb_; b1_ = *(const bf16x8*)(pb_ + 32); } while (0)
    S12_LOAD(ca0, ca1, cb0, cb1, w);
#pragma unroll 1
    for (int pi = w; pi < npair; pi += 8) {
      bf16x8 na0 = ca0, na1 = ca1, nb0 = cb0, nb1 = cb1;
      if (pi + 8 < npair) S12_LOAD(na0, na1, nb0, nb1, pi + 8);
      f32x4 sa = {0.f, 0.f, 0.f, 0.f}, sb = {0.f, 0.f, 0.f, 0.f};
#pragma unroll
      for (int h = 0; h < 8; ++h) {
        f32x4 acc = {0.f, 0.f, 0.f, 0.f}, acc2 = {0.f, 0.f, 0.f, 0.f};
        acc = __builtin_amdgcn_mfma_f32_16x16x32_bf16(ca0, qf[h][0], acc, 0, 0, 0);
        acc2 = __builtin_amdgcn_mfma_f32_16x16x32_bf16(cb0, qf[h][0], acc2, 0, 0, 0);
        acc = __builtin_amdgcn_mfma_f32_16x16x32_bf16(ca1, qf[h][1], acc, 0, 0, 0);
        acc2 = __builtin_amdgcn_mfma_f32_16x16x32_bf16(cb1, qf[h][1], acc2, 0, 0, 0);
#pragma unroll
        for (int q = 0; q < 4; ++q) { sa[q] = fmaf(wv[h], fmaxf(acc[q], 0.f), sa[q]); sb[q] = fmaf(wv[h], fmaxf(acc2[q], 0.f), sb[q]); }
      }
      typedef _Float16 h2_t __attribute__((ext_vector_type(2)));
      u32x4 o;
#pragma unroll
      for (int q = 0; q < 4; ++q) { const h2_t v = {(_Float16)sa[q], (_Float16)sb[q]}; o[q] = __builtin_bit_cast(unsigned, v); }
      *(u32x4*)(srow + 64 * (pi >> 2) + 16 * (pi & 3)) = o;
      ca0 = na0; ca1 = na1; cb0 = nb0; cb1 = nb1;
    }
#undef S12_LOAD
  }
  __syncthreads();
#pragma unroll 1
  for (int rr = 0; rr < 2; ++rr) {
    const int q = 2 * w + rr;
    s2_dispatch(P, b * SEQ + i0 + q, lane, sc + q * S12_STRIDE + lane);
  }
  __syncthreads();
}

DI int t5_bucket(int rel) {
  const int n = rel < 0 ? -rel : rel;
  int v;
  if (n < 8) v = n;
  else v = 8 + (n >= 12) + (n >= 16) + (n >= 23) + (n >= 32) + (n >= 46) + (n >= 64) + (n >= 91);
  return (rel > 0 ? 16 : 0) + v;
}
constexpr int DSA_KSTR = 144, DSA_VSTR = 136, DSA_KBYTES = 64 * DSA_KSTR, DSA_STAGE = DSA_KBYTES + 64 * DSA_VSTR;
constexpr int DSA_TB = 2 * DSA_STAGE;
DI void dsa_stage(const unsigned char* cur, int s, int cw, int lq, int hh, int pq, int qmin, float bfar, const float* tb, const unsigned* mrow,
                  const bf16x8 (&qf)[4], f32x16& o0, f32x16& o1, float& m, float& lsum) {
  if (s > cw) return;
  const bool full = s < cw;
  const int kb0 = 64 * s;
  const bool near = kb0 + 63 >= qmin - 91;
  const unsigned w0 = mrow[2 * s] >> (4 * hh), w1 = mrow[2 * s + 1] >> (4 * hh);
  const float mref = m > -1e29f ? m : 0.f;
  f32x16 s0, s1;
  const float binit = (near ? 0.f : bfar) - mref;
#pragma unroll
  for (int r = 0; r < 16; ++r) { s0[r] = binit; s1[r] = binit; }
  const unsigned char* Kc = cur + lq * DSA_KSTR + hh * 16;
  {
    bf16x8 kf[4];
#pragma unroll
    for (int kk = 0; kk < 4; ++kk) kf[kk] = *(const bf16x8*)(Kc + kk * 32);
#pragma unroll
    for (int kk = 0; kk < 4; ++kk) s0 = __builtin_amdgcn_mfma_f32_32x32x16_bf16(kf[kk], qf[kk], s0, 0, 0, 0);
    __builtin_amdgcn_sched_group_barrier(0x100, 4, 0);
    __builtin_amdgcn_sched_group_barrier(0x008, 4, 0);
  }
  if (full) {
    bf16x8 kf[4];
#pragma unroll
    for (int kk = 0; kk < 4; ++kk) kf[kk] = *(const bf16x8*)(Kc + 32 * DSA_KSTR + kk * 32);
#pragma unroll
    for (int kk = 0; kk < 4; ++kk) s1 = __builtin_amdgcn_mfma_f32_32x32x16_bf16(kf[kk], qf[kk], s1, 0, 0, 0);
    __builtin_amdgcn_sched_group_barrier(0x100, 4, 0);
    __builtin_amdgcn_sched_group_barrier(0x008, 4, 0);
  }
  const float* tp = tb + (kb0 + 4 * hh - pq + 192);
  const unsigned char* Vc = cur + DSA_KBYTES + lq * DSA_VSTR + hh * 8;
  if (near) {
#pragma unroll
    for (int r = 0; r < 16; ++r) s0[r] += tp[(r & 3) + 8 * (r >> 2)];
  }
#pragma unroll
  for (int r = 0; r < 16; ++r) s0[r] = (w0 & (1u << ((r & 3) + 8 * (r >> 2)))) ? s0[r] : MASKV;
  softmax_update1(s0, m, mref, lsum, o0, o1);
  pv_subtile(Vc, DSA_VSTR, s0, o0, o1);
  if (full) {
    if (near) {
#pragma unroll
      for (int r = 0; r < 16; ++r) s1[r] += tp[32 + (r & 3) + 8 * (r >> 2)];
    }
#pragma unroll
    for (int r = 0; r < 16; ++r) s1[r] = (w1 & (1u << ((r & 3) + 8 * (r >> 2)))) ? s1[r] : MASKV;
    softmax_update1(s1, m, mref, lsum, o0, o1);
    pv_subtile(Vc + 64, DSA_VSTR, s1, o0, o1);
  }
}
DI void dsa_item(const Params& P, int item, unsigned char* lds) {
  unsigned char* ws = P.ws;
  const int jq = 15 - item / 32, bh = item % 32, b = bh >> 3, h = bh & 7;
  const int c0 = 4 * jq + 1;
  const int tid = threadIdx.x, lane = tid & 63, w = __builtin_amdgcn_readfirstlane(tid >> 6), hh = lane >> 5, lq = lane & 31;
  const int cw = c0 + (w >> 1);
  const int pq = NMETA + 256 * jq + 32 * w + lq;
  const int tq = b * L + pq, rq = b * SEQ + pq - NMETA;
  const int qmin = NMETA + 256 * jq + 32 * w;
  float* tb = (float*)(lds + DSA_TB);
  __syncthreads();
  if (tid < 256) tb[tid] = P.rel_bias[t5_bucket(tid - 192) * 8 + h] * LOG2E;
  const float bfar = P.rel_bias[15 * 8 + h] * LOG2E;
  bf16x8 qf[4];
  {
    const bf16_t* qrow = (const bf16_t*)(ws + O_QB) + (size_t)tq * 512 + h * 64 + hh * 8;
#pragma unroll
    for (int kk = 0; kk < 4; ++kk) qf[kk] = *(const bf16x8*)(qrow + kk * 16);
  }
  const unsigned* mrow = (const unsigned*)(P.ws + O_MASK) + (size_t)rq * MW;
  f32x16 o0, o1;
#pragma unroll
  for (int r = 0; r < 16; ++r) { o0[r] = 0.f; o1[r] = 0.f; }
  float m = -1e30f, lsum = 0.f;
  const int nst = c0 + 4;
  const bf16_t* kg = (const bf16_t*)(ws + O_KB) + (size_t)b * L * 512 + h * 64;
  const bf16_t* vg = (const bf16_t*)(ws + O_VBT) + (size_t)bh * 64 * LP;
  const int srow = tid >> 3, sc = tid & 7;
  const unsigned kgo = srow * 512 + sc * 8, klo = srow * DSA_KSTR + sc * 16, vgo = srow * LP + sc * 8, vlo = DSA_KBYTES + srow * DSA_VSTR + sc * 16;
  u32x4 rkA, rvA, rkB, rvB;
#define DSA_LOAD(rk_, rv_, st) do { const int kn = (st) * 64; const int kr = min(kn + srow, L - 1) - srow; \
    rk_ = *(const u32x4*)(kg + (size_t)kr * 512 + kgo); rv_ = *(const u32x4*)(vg + kn + vgo); } while (0)
#define DSA_WRITE(rk_, rv_, buf) do { unsigned char* nb_ = (buf); *(u32x4*)(nb_ + klo) = rk_; \
    *(u32x2*)(nb_ + vlo) = (u32x2){rv_[0], rv_[1]}; *(u32x2*)(nb_ + vlo + 8) = (u32x2){rv_[2], rv_[3]}; } while (0)
  unsigned char* buf0 = lds; unsigned char* buf1 = lds + DSA_STAGE;
  DSA_LOAD(rkA, rvA, 0); DSA_WRITE(rkA, rvA, buf0);
  __syncthreads();
  if (nst > 1) DSA_LOAD(rkA, rvA, 1);
#pragma unroll 1
  for (int s = 0; s < nst; s += 2) {
    if (s + 2 < nst) DSA_LOAD(rkB, rvB, s + 2);
    dsa_stage(buf0, s, cw, lq, hh, pq, qmin, bfar, tb, mrow, qf, o0, o1, m, lsum);
    if (s + 1 < nst) DSA_WRITE(rkA, rvA, buf1);
    __syncthreads();
    if (s + 1 >= nst) break;
    if (s + 3 < nst) DSA_LOAD(rkA, rvA, s + 3);
    dsa_stage(buf1, s + 1, cw, lq, hh, pq, qmin, bfar, tb, mrow, qf, o0, o1, m, lsum);
    if (s + 2 < nst) DSA_WRITE(rkB, rvB, buf0);
    __syncthreads();
  }
#undef DSA_LOAD
#undef DSA_WRITE
  lsum += __shfl_xor(lsum, 32);
  const float inv = 1.f / lsum;
  bf16_t* ob = (bf16_t*)(ws + O_OB) + (size_t)rq * 512 + h * 64 + 4 * hh;
#pragma unroll
  for (int g = 0; g < 4; ++g) {
    u32x2 v0, v1;
    v0[0] = pk2(o0[4 * g] * inv, o0[4 * g + 1] * inv); v0[1] = pk2(o0[4 * g + 2] * inv, o0[4 * g + 3] * inv);
    v1[0] = pk2(o1[4 * g] * inv, o1[4 * g + 1] * inv); v1[1] = pk2(o1[4 * g + 2] * inv, o1[4 * g + 3] * inv);
    *(u32x2*)(ob + 8 * g) = v0;
    *(u32x2*)(ob + 32 + 8 * g) = v1;
  }
}

template <bool CHECK> DI void nv_mla(const Params& P, int vb, unsigned char* lds) {
  unsigned char* ws = P.ws;
  float* qs = (float*)lds;
  const int b = vb / SEQ, p = NMETA + vb % SEQ, t = b * L + p;
  const int tid = threadIdx.x & 255, h = tid >> 5, l = tid & 31;
  const bf16_t* qa = (const bf16_t*)(ws + O_QA) + (size_t)t * 768;
  for (int i = tid; i < 768; i += 256) qs[i] = bf2f(qa[i]);
  __syncthreads();
  const int na = n_adm(p);
  const bf16_t* km = (const bf16_t*)(ws + O_KMLA) + (size_t)(b * 8 + h) * LP * 96;
  const bf16_t* vt = (const bf16_t*)(ws + O_VT) + (size_t)(b * 8 + h) * 64 * LP;
  float m = -1e30f, ls = 0.f, acc[64];
#pragma unroll
  for (int d = 0; d < 64; ++d) acc[d] = 0.f;
  const float* q = qs + h * 96;
  for (int j = l; j < na; j += 32) {
    const bf16_t* kr = km + (size_t)j * 96;
    float s = 0.f;
#pragma unroll 8
    for (int d = 0; d < 96; ++d) s = fmaf(q[d], bf2f(kr[d]), s);
    const float mn = fmaxf(m, s), c = exp2f(m - mn), pe = exp2f(s - mn);
    ls = ls * c + pe;
#pragma unroll
    for (int d = 0; d < 64; ++d) acc[d] = acc[d] * c + pe * bf2f(vt[(size_t)d * LP + j]);
    m = mn;
  }
#pragma unroll
  for (int off = 16; off >= 1; off >>= 1) {
    const float m2 = __shfl_xor(m, off), l2 = __shfl_xor(ls, off);
    const float mn = fmaxf(m, m2), c1 = exp2f(m - mn), c2 = exp2f(m2 - mn);
    ls = ls * c1 + l2 * c2;
#pragma unroll
    for (int d = 0; d < 64; ++d) { const float a2 = __shfl_xor(acc[d], off); acc[d] = acc[d] * c1 + a2 * c2; }
    m = mn;
  }
  if (l == 0) {
    const float inv = 1.f / ls;
    bf16_t* oa = (bf16_t*)(ws + O_OA) + (size_t)vb * 512 + h * 64;
    if (CHECK) {
#if SELFCHECK
#pragma unroll
      for (int d = 0; d < 64; ++d) if (far(bf2f(oa[d]), acc[d] * inv, 0.004f, 0.03f)) chk_fail(P, 13);
#endif
    } else {
#pragma unroll
      for (int d = 0; d < 64; ++d) oa[d] = f2bf(acc[d] * inv);
    }
  }
  __syncthreads();
}

#if SELFCHECK
struct NvDsaLds { float qi[512]; float qb[512]; float wi[8]; unsigned keys[L]; int sel[256]; float sc[8][256]; int redi[8]; int scan_gt[257]; int scan_eq[257]; unsigned char mine[L]; };
DI void nv_dsa_check(const Params& P, int vb, unsigned char* lds) {
  unsigned char* ws = P.ws;
  NvDsaLds& S = *(NvDsaLds*)lds;
  const int b = vb / SEQ, p = NMETA + vb % SEQ, t = b * L + p, tid = threadIdx.x & 255;
  const bf16_t* qi_g = (const bf16_t*)(ws + O_QI) + (size_t)t * 512;
  const bf16_t* qb_g = (const bf16_t*)(ws + O_QB) + (size_t)t * 512;
  for (int i = tid; i < 512; i += 256) { S.qi[i] = bf2f(qi_g[i]); S.qb[i] = bf2f(qb_g[i]); }
  if (tid < 8) S.wi[tid] = ((const float*)(ws + O_WI))[(size_t)t * 8 + tid];
  __syncthreads();
  const int na = n_adm(p);
  const bf16_t* ki_g = (const bf16_t*)(ws + O_KI) + (size_t)b * L * 64;
  for (int j = tid; j < na; j += 256) {
    const bf16_t* ki = ki_g + (size_t)j * 64;
    float s = 0.f;
    for (int h = 0; h < 8; ++h) {
      float lg = 0.f;
#pragma unroll 8
      for (int d = 0; d < 64; ++d) lg = fmaf(S.qi[h * 64 + d], bf2f(ki[d]), lg);
      s += S.wi[h] * fmaxf(lg, 0.f);
    }
    S.keys[j] = f2key(s);
    S.mine[j] = 0;
  }
  __syncthreads();
  if (na <= 256) {
    for (int j = tid; j < na; j += 256) S.mine[j] = 1;
  } else {
    unsigned T = 0;
    for (int bit = 31; bit >= 0; --bit) {
      const unsigned cand = T | (1u << bit);
      int c = 0;
      for (int j = tid; j < na; j += 256) c += S.keys[j] >= cand;
      c = block_sumi256(c, S.redi);
      if (c >= 256) T = cand;
    }
    const int chunk = (na + 255) / 256;
    const int j0 = tid * chunk, j1 = min(j0 + chunk, na);
    int cgt = 0, ce = 0;
    for (int j = j0; j < j1; ++j) { cgt += S.keys[j] > T; ce += S.keys[j] == T; }
    S.scan_gt[tid + 1] = cgt; S.scan_eq[tid + 1] = ce;
    __syncthreads();
    if (threadIdx.x == 0) { S.scan_gt[0] = 0; S.scan_eq[0] = 0; for (int i = 1; i <= 256; ++i) { S.scan_gt[i] += S.scan_gt[i - 1]; S.scan_eq[i] += S.scan_eq[i - 1]; } }
    __syncthreads();
    const int r = 256 - S.scan_gt[256];
    int pe = S.scan_eq[tid];
    for (int j = j0; j < j1; ++j) {
      if (S.keys[j] > T) S.mine[j] = 1;
      else if (S.keys[j] == T) { if (pe < r) S.mine[j] = 1; ++pe; }
    }
  }
  __syncthreads();
  const unsigned* mrow = (const unsigned*)(P.ws + O_MASK) + (size_t)vb * MW;
  int mism = 0, cntk = 0;
  for (int j = tid; j < 4224; j += 256) {
    const int kb = (mrow[j >> 5] >> (j & 31)) & 1;
    const int me = j < na ? (int)S.mine[j] : 0;
    mism += kb != me; cntk += kb;
    if (kb && j >= na) mism += 1000;
  }
  mism = block_sumi256(mism, S.redi);
  cntk = block_sumi256(cntk, S.redi);
  if (tid == 0) { if (mism > 16) chk_fail(P, 14); if (cntk != (na < 256 ? na : 256)) chk_fail(P, 14); }
  if (tid == 0) { int k = 0; for (int j = 0; j < na && k < 256; ++j) if ((mrow[j >> 5] >> (j & 31)) & 1) S.sel[k++] = j; for (; k < 256; ++k) S.sel[k] = 0; }
  const int nsel = na < 256 ? na : 256;
  __syncthreads();
  if (tid < nsel) {
    const int j = S.sel[tid];
    const bf16_t* kb = (const bf16_t*)(ws + O_KB) + (size_t)(b * L + j) * 512;
    const int bk = t5_bucket(j - p);
    for (int h = 0; h < 8; ++h) {
      float s = 0.f;
#pragma unroll 8
      for (int d = 0; d < 64; ++d) s = fmaf(S.qb[h * 64 + d], bf2f(kb[h * 64 + d]), s);
      S.sc[h][tid] = s + P.rel_bias[bk * 8 + h] * LOG2E;
    }
  }
  __syncthreads();
  {
    const int h = tid >> 5, l = tid & 31;
    float m = -1e30f;
    for (int k = l; k < nsel; k += 32) m = fmaxf(m, S.sc[h][k]);
#pragma unroll
    for (int off = 16; off >= 1; off >>= 1) m = fmaxf(m, __shfl_xor(m, off));
    float s = 0.f;
    for (int k = l; k < nsel; k += 32) s += exp2f(S.sc[h][k] - m);
#pragma unroll
    for (int off = 16; off >= 1; off >>= 1) s += __shfl_xor(s, off);
    const float inv = 1.f / s;
    __syncthreads();
    if (threadIdx.x < 256) for (int k = l; k < nsel; k += 32) S.sc[h][k] = exp2f(S.sc[h][k] - m) * inv;
  }
  __syncthreads();
  const bf16_t* vbt = (const bf16_t*)(ws + O_VBT) + (size_t)b * 8 * 64 * LP;
  const bf16_t* ob = (const bf16_t*)(ws + O_OB) + (size_t)vb * 512;
  for (int o = tid; o < 512; o += 256) {
    const int h = o >> 6;
    float a = 0.f;
    for (int k = 0; k < nsel; ++k) a = fmaf(S.sc[h][k], bf2f(vbt[(size_t)o * LP + S.sel[k]]), a);
    if (far(bf2f(ob[o]), a, 0.006f, 0.03f)) chk_fail(P, 15);
  }
  __syncthreads();
}
#endif

DI void p7_merge_tile(const Params& P, int mt, int nt, unsigned char* lds) {
  unsigned char* ws = P.ws;
  const int m0 = mt * 256, n0 = nt * 256;
  const bf16_t* gates = (const bf16_t*)P.out;
  bf16_t* yo = (bf16_t*)(ws + O_Y);
  TilePtrs tp;
  f32x16 acc[4][2];
#pragma unroll 1
  for (int br = 0; br < 2; ++br) {
    set_ptrs(tp, (const bf16_t*)(ws + (br ? O_OB : O_OA)), 512, NR, m0, (const bf16_t*)(ws + (br ? O_WBRB : O_WBRA)), 512, 1024, n0);
    zero_acc(acc); EPI_IDS(gemm_kloop<true>(acc, tp, 512, lds));
#pragma unroll
    for (int mi = 0; mi < 4; ++mi) {
      int row = m0 + acc_row0(wr, mi) + lc;
      asm volatile("" : "+v"(row));
#pragma unroll
      for (int ni = 0; ni < 2; ++ni) {
        const int c0 = n0 + acc_col0(wc, ni) + 4 * hh;
        const bf16_t* gp = gates + (size_t)row * 2048 + br * 1024 + c0;
        bf16_t* yp = yo + (size_t)row * 1024 + c0;
        u32x2 gv[4], pv[4];
#pragma unroll
        for (int g = 0; g < 4; ++g) { gv[g] = *(const u32x2*)(gp + 8 * g); if (br) pv[g] = *(const u32x2*)(yp + 8 * g); else { pv[g][0] = 0u; pv[g][1] = 0u; } }
#pragma unroll
        for (int g = 0; g < 4; ++g) {
          const float y0 = __uint_as_float(gv[g][0] << 16) * acc[mi][ni][4 * g] + __uint_as_float(pv[g][0] << 16);
          const float y1 = __uint_as_float(gv[g][0] & 0xffff0000u) * acc[mi][ni][4 * g + 1] + __uint_as_float(pv[g][0] & 0xffff0000u);
          const float y2 = __uint_as_float(gv[g][1] << 16) * acc[mi][ni][4 * g + 2] + __uint_as_float(pv[g][1] << 16);
          const float y3 = __uint_as_float(gv[g][1] & 0xffff0000u) * acc[mi][ni][4 * g + 3] + __uint_as_float(pv[g][1] & 0xffff0000u);
          *(u32x2*)(yp + 8 * g) = pk4(y0, y1, y2, y3);
        }
        __builtin_amdgcn_sched_barrier(0);
      }
    }
    asm volatile("" ::: "memory");
  }
}

DI void p8_out_tile(const Params& P, int mt, int nt, unsigned char* lds) {
  unsigned char* ws = P.ws;
  const int m0 = mt * 256, n0 = nt * 256;
  TilePtrs tp; set_ptrs(tp, (const bf16_t*)(ws + O_Y), 1024, NR, m0, (const bf16_t*)(ws + O_WO), 1024, 1024, n0);
  f32x16 acc[4][2]; zero_acc(acc);
  EPI_IDS(gemm_kloop<true>(acc, tp, 1024, lds));
#pragma unroll
  for (int mi = 0; mi < 4; ++mi) {
    int row = m0 + acc_row0(wr, mi) + lc;
    asm volatile("" : "+v"(row));
#pragma unroll
    for (int ni = 0; ni < 2; ++ni) {
      const size_t off = (size_t)row * D + n0 + acc_col0(wc, ni) + 4 * hh;
      f32x4 xv[4];
#pragma unroll
      for (int g = 0; g < 4; ++g) xv[g] = *(const f32x4*)(P.x + off + 8 * g);
#pragma unroll
      for (int g = 0; g < 4; ++g)
        *(u32x2*)((bf16_t*)(ws + M_XN) + off + 8 * g) = pk4(xv[g][0] + acc[mi][ni][4 * g], xv[g][1] + acc[mi][ni][4 * g + 1], xv[g][2] + acc[mi][ni][4 * g + 2], xv[g][3] + acc[mi][ni][4 * g + 3]);
    }
  }
}

DI void p9_router_token(const Params& P, int tok, int lane) {
  unsigned char* ws = P.ws;
  const bf16_t* row = (const bf16_t*)(ws + M_XN) + (size_t)tok * D;
  f32x4 v[4]; float s = 0.f;
#pragma unroll
  for (int i = 0; i < 4; ++i) {
    const u32x2 a = *(const u32x2*)(row + 256 * i + 4 * lane);
    v[i][0] = __uint_as_float(a[0] << 16); v[i][1] = __uint_as_float(a[0] & 0xffff0000u); v[i][2] = __uint_as_float(a[1] << 16); v[i][3] = __uint_as_float(a[1] & 0xffff0000u);
    s += v[i][0] * v[i][0] + v[i][1] * v[i][1] + v[i][2] * v[i][2] + v[i][3] * v[i][3];
  }
  s = wave_sum(s);
  const float rs = rsqrtf(s * (1.f / D) + EPS);
  if (lane == 0) ((float*)(ws + M_RS))[tok] = rs;
#pragma unroll
  for (int i = 0; i < 4; ++i) {
    const f32x4 g = *(const f32x4*)(P.g_ffn + 256 * i + 4 * lane);
    v[i][0] *= rs * g[0]; v[i][1] *= rs * g[1]; v[i][2] *= rs * g[2]; v[i][3] *= rs * g[3];
  }
  const float* wr = (const float*)(ws + O_WR);
  float mylog = 0.f;
#pragma unroll 1
  for (int c = 0; c < 36; ++c) {
    float a = 0.f;
#pragma unroll
    for (int i = 0; i < 4; ++i) { const f32x4 w4 = *(const f32x4*)(wr + c * 1024 + 256 * i + 4 * lane); a += v[i][0] * w4[0] + v[i][1] * w4[1] + v[i][2] * w4[2] + v[i][3] * w4[3]; }
    a = wave_sum(a);
    if (lane == c) mylog = a + (c < 4 ? P.b_rg[c] : P.b_re[c - 4]);
  }
  float lg[4];
#pragma unroll
  for (int i = 0; i < 4; ++i) lg[i] = __shfl(mylog, i);
  int gs = 0; float gm = lg[0];
#pragma unroll
  for (int i = 1; i < 4; ++i) if (lg[i] > gm) { gm = lg[i]; gs = i; }
  float se = 0.f;
#pragma unroll
  for (int i = 0; i < 4; ++i) se += expf(lg[i] - gm);
  const float pg = 1.f / se;
  float el[8];
#pragma unroll
  for (int i = 0; i < 8; ++i) el[i] = __shfl(mylog, 4 + gs * 8 + i);
  float em = el[0];
#pragma unroll
  for (int i = 1; i < 8; ++i) em = fmaxf(em, el[i]);
  float pe[8]; float ss = 0.f;
#pragma unroll
  for (int i = 0; i < 8; ++i) { pe[i] = expf(el[i] - em); ss += pe[i]; }
  int e1 = 0; float p1 = pe[0];
#pragma unroll
  for (int i = 1; i < 8; ++i) if (pe[i] > p1) { p1 = pe[i]; e1 = i; }
  int e2 = 0; float p2 = -1.f;
#pragma unroll
  for (int i = 0; i < 8; ++i) if (i != e1 && pe[i] > p2) { p2 = pe[i]; e2 = i; }
  p1 /= ss; p2 /= ss;
  const float den = p1 + p2;
  const float w1 = pg * p1 / den, w2 = pg * p2 / den;
  const int x1 = gs * 8 + e1, x2 = gs * 8 + e2;
  if (lane == 0) {
    unsigned* cnt = (unsigned*)(ws + O_CTR) + 32;
    const int q1 = (int)atomicAdd(cnt + x1, 1u), q2 = (int)atomicAdd(cnt + x2, 1u);
    ((int*)(ws + M_LIST))[(size_t)x1 * NR + q1] = tok; ((int*)(ws + M_LIST))[(size_t)x2 * NR + q2] = tok;
    ((float*)(ws + M_WL))[(size_t)x1 * NR + q1] = w1; ((float*)(ws + M_WL))[(size_t)x2 * NR + q2] = w2;
    int* asg = (int*)(ws + M_ASG) + (size_t)tok * 4;
    asg[0] = x1; asg[1] = q1; asg[2] = x2; asg[3] = q2;
  }
}
DI void p9_conv_gu_item(const Params& P, int item, float* scr, int tid, bool valid) {
  const int e = item >> 7, r = item & 127, kb = r & 15, nb = r >> 4;
  const int k0 = kb * 64, n0 = nb * 64;
  bf16_t* dst = (bf16_t*)(P.ws + M_WGU) + (size_t)e * 512 * 1024;
  if (valid) {
    const int n = tid & 63, nd = n0 + n, q = nd >> 8, within = nd & 255, part = within >> 7, idx = within & 127;
    const float* src = (part ? P.w_eu : P.w_eg) + (size_t)e * 1024 * 256 + (q * 128 + idx);
#pragma unroll 4
    for (int i = 0; i < 16; ++i) { const int k = (tid >> 6) + 4 * i; scr[k * 65 + n] = src[(size_t)(k0 + k) * 256] * P.g_ffn[k0 + k]; }
  }
  __syncthreads();
  if (valid) {
    const int kq = tid & 7;
#pragma unroll
    for (int i = 0; i < 2; ++i) {
      const int n = (tid >> 3) + 32 * i;
      const float* sp = scr + (kq * 8) * 65 + n;
      u32x4 o; o[0] = pk2(sp[0], sp[65]); o[1] = pk2(sp[2 * 65], sp[3 * 65]); o[2] = pk2(sp[4 * 65], sp[5 * 65]); o[3] = pk2(sp[6 * 65], sp[7 * 65]);
      *(u32x4*)(dst + (size_t)(n0 + n) * 1024 + k0 + kq * 8) = o;
    }
  }
  __syncthreads();
}
DI int moe_tile_lookup(const Params& P, int tile, int& e_out, int& rt_out, int& cnt_out, int& base_slot) {
  const unsigned* cnt = (const unsigned*)(P.ws + O_CTR) + 32;
  int acc = 0, found = 0;
  e_out = 0; rt_out = 0; cnt_out = 0; base_slot = 0;
  for (int e = 0; e < 32; ++e) {
    const int c = (int)cnt[e], nt = (c + 255) >> 8;
    if (!found && tile < acc + nt) { e_out = e; rt_out = tile - acc; cnt_out = c; base_slot = acc * 256; found = 1; }
    acc += nt;
  }
  return acc;
}
DI void p10_gu_tile(const Params& P, int tile, int e, int rt, int cnt, int base_slot, int q, unsigned char* lds) {
  unsigned char* ws = P.ws;
  const int tid = threadIdx.x;
  const int* list = (const int*)(ws + M_LIST) + (size_t)e * NR;
  TilePtrs tp;
#pragma unroll
  for (int i = 0; i < 4; ++i) { int row, kc; tile_rc(i, row, kc); int r = rt * 256 + row; r = r < cnt ? r : cnt - 1; tp.a[i] = ((unsigned)list[r] * 1024u + kc * 8) * 2u; tp.b[i] = ((unsigned)(q * 256 + row) * 1024u + kc * 8) * 2u; }
  tp.A = (const bf16_t*)(ws + M_XN); tp.B = (const bf16_t*)(ws + M_WGU) + (size_t)e * 512 * 1024;
  f32x16 acc[4][2]; zero_acc(acc);
  EPI_IDS(gemm_kloop<true>(acc, tp, 1024, lds));
  bf16_t* hm = (bf16_t*)(ws + M_HMID);
  const int col = q * 128 + wc * 32 + 4 * hh;
#pragma unroll
  for (int mi = 0; mi < 4; ++mi) {
    int rr = rt * 256 + acc_row0(wr, mi) + lc;
    asm volatile("" : "+v"(rr));
    bf16_t* hp = hm + (size_t)(base_slot + rr) * 256 + col;
    const float rsv = rr < cnt ? ((const float*)(ws + M_RS))[list[rr]] : 0.f;
#pragma unroll
    for (int g = 0; g < 4; ++g) {
      float hv[4];
#pragma unroll
      for (int e = 0; e < 4; ++e) { const float gt = acc[mi][0][4 * g + e] * rsv, u = acc[mi][1][4 * g + e] * rsv; hv[e] = gt * __builtin_amdgcn_rcpf(1.f + __expf(-gt)) * u; }
      if (rr < cnt) *(u32x2*)(hp + 8 * g) = pk4(hv[0], hv[1], hv[2], hv[3]);
    }
  }
  asm volatile("s_waitcnt vmcnt(0)" ::: "memory");
  __syncthreads();
  if (threadIdx.x == 0) {
    __builtin_amdgcn_fence(__ATOMIC_RELEASE, "agent");
    asm volatile("s_waitcnt vmcnt(0)" ::: "memory");
    __hip_atomic_fetch_add((unsigned*)(ws + O_DEP) + tile, 1u, __ATOMIC_RELAXED, __HIP_MEMORY_SCOPE_AGENT);
  }
}
DI void p11_down_tile(const Params& P, int tile, int e, int rt, int cnt, int base_slot, int nt, unsigned char* lds) {
  unsigned char* ws = P.ws;
  if (threadIdx.x == 0) {
    unsigned* dep = (unsigned*)(ws + O_DEP) + tile;
    unsigned spins = 0;
    while (__hip_atomic_load(dep, __ATOMIC_RELAXED, __HIP_MEMORY_SCOPE_AGENT) < 2u && ++spins < (1u << 22)) __builtin_amdgcn_s_sleep(2);
    __builtin_amdgcn_fence(__ATOMIC_ACQUIRE, "agent");
    asm volatile("s_waitcnt vmcnt(0)" ::: "memory");
  }
  __syncthreads();
  const int tid = threadIdx.x;
  TilePtrs tp;
#pragma unroll
  for (int i = 0; i < 4; ++i) { int row, kc; tile_rc(i, row, kc); int r = rt * 256 + row; r = r < cnt ? r : cnt - 1; tp.a[i] = ((unsigned)(base_slot + r) * 256u + kc * 8) * 2u; tp.b[i] = ((unsigned)(nt * 256 + row) * 256u + kc * 8) * 2u; }
  tp.A = (const bf16_t*)(ws + M_HMID); tp.B = (const bf16_t*)(ws + M_WD) + (size_t)e * 1024 * 256;
  f32x16 acc[4][2]; zero_acc(acc);
  EPI_IDS(gemm_kloop<true>(acc, tp, 256, lds));
  bf16_t* ys = (bf16_t*)(ws + M_YS);
  const float* wl = (const float*)(ws + M_WL) + (size_t)e * NR;
#pragma unroll
  for (int mi = 0; mi < 4; ++mi) {
    int rr = rt * 256 + acc_row0(wr, mi) + lc;
    asm volatile("" : "+v"(rr));
    const bool ok = rr < cnt;
    const float wt = ok ? wl[rr] : 0.f;
    bf16_t* yp = ys + (size_t)(base_slot + rr) * 1024 + nt * 256 + 4 * hh;
#pragma unroll
    for (int ni = 0; ni < 2; ++ni)
#pragma unroll
      for (int g = 0; g < 4; ++g)
        if (ok) *(u32x2*)(yp + acc_col0(wc, ni) + 8 * g) = pk4(acc[mi][ni][4 * g] * wt, acc[mi][ni][4 * g + 1] * wt, acc[mi][ni][4 * g + 2] * wt, acc[mi][ni][4 * g + 3] * wt);
  }
}
DI void p12_final_token(const Params& P, int tok, int lane, const int* sbase  ) {
  unsigned char* ws = P.ws;
  float* row = P.out + (size_t)tok * D;
  const bf16_t* h2b = (const bf16_t*)(ws + M_XN) + (size_t)tok * D;
  const int* asg = (const int*)(ws + M_ASG) + (size_t)tok * 4;
  const int s1 = sbase[asg[0]] + asg[1], s2 = sbase[asg[2]] + asg[3];
  const bf16_t* y1 = (const bf16_t*)(ws + M_YS) + (size_t)s1 * 1024;
  const bf16_t* y2 = (const bf16_t*)(ws + M_YS) + (size_t)s2 * 1024;
  f32x4 v[4]; float s = 0.f;
#pragma unroll
  for (int i = 0; i < 4; ++i) {
    const u32x2 hq = *(const u32x2*)(h2b + 256 * i + 4 * lane);
    v[i][0] = __uint_as_float(hq[0] << 16); v[i][1] = __uint_as_float(hq[0] & 0xffff0000u); v[i][2] = __uint_as_float(hq[1] << 16); v[i][3] = __uint_as_float(hq[1] & 0xffff0000u);
    const u32x2 a = *(const u32x2*)(y1 + 256 * i + 4 * lane), b = *(const u32x2*)(y2 + 256 * i + 4 * lane);
    v[i][0] += __uint_as_float(a[0] << 16) + __uint_as_float(b[0] << 16);
    v[i][1] += __uint_as_float(a[0] & 0xffff0000u) + __uint_as_float(b[0] & 0xffff0000u);
    v[i][2] += __uint_as_float(a[1] << 16) + __uint_as_float(b[1] << 16);
    v[i][3] += __uint_as_float(a[1] & 0xffff0000u) + __uint_as_float(b[1] & 0xffff0000u);
    s += v[i][0] * v[i][0] + v[i][1] * v[i][1] + v[i][2] * v[i][2] + v[i][3] * v[i][3];
  }
  s = wave_sum(s);
  const float rs = rsqrtf(s * (1.f / D) + EPS);
#pragma unroll
  for (int i = 0; i < 4; ++i) {
    const f32x4 g = *(const f32x4*)(P.g_fin + 256 * i + 4 * lane);
    f32x4 o; o[0] = v[i][0] * rs * g[0]; o[1] = v[i][1] * rs * g[1]; o[2] = v[i][2] * rs * g[2]; o[3] = v[i][3] * rs * g[3];
    *(f32x4*)(row + 256 * i + 4 * lane) = o;
  }
}

struct NvMoeLds { float xr[D]; float xn[D]; float hm[256]; float red[8]; float logit[36]; float gatew[2]; int expert[2]; };


#if SELFCHECK
DI const float* h_row(const Params& P, int t) { const int b = t / L, p = t % L; return p < NMETA ? P.meta + (size_t)p * D : P.x + ((size_t)b * SEQ + (p - NMETA)) * D; }
DI void chk_load_hn(const Params& P, int t, float* hv, float* red) {
  const float* row = h_row(P, t);
  float s = 0.f;
  for (int i = (threadIdx.x & 255); i < D; i += 256) { const float v = row[i]; hv[i] = v; s += v * v; }
  s = block_sum256(s, red);
  const float rs = rsqrtf(s * (1.f / D) + EPS);
  if (threadIdx.x < 256) for (int i = threadIdx.x; i < D; i += 256) hv[i] = hv[i] * rs * P.g_mix[i];
  __syncthreads();
}
DI void chk_stageA(const Params& P, unsigned char* lds) {
  unsigned char* ws = P.ws;
  float* hv = (float*)lds; float* pj = hv + 1024; float* red = pj + 4608; float* cq = red + 8; float* ckv = cq + 256;
  const int tid = threadIdx.x & 255;
  for (int sidx = blockIdx.x; sidx < 512; sidx += gridDim.x) {
    const int t = sidx < 8 ? (sidx < 4 ? sidx * L + (sidx & 3) * 5 : NT - 1 - (sidx - 4) * 1031) : (int)(hash_u(sidx * 7919u + 13u) % NT);
    const int b = t / L, p = t % L;
    chk_load_hn(P, t, hv, red);
    for (int c = tid; c < 2536; c += 256) { float a = 0.f; for (int k = 0; k < D; ++k) a = fmaf(hv[k], P.w_in[(size_t)k * INC + c], a); pj[c] = a; }
    __syncthreads();
    const float* sm = (const float*)(ws + O_SMALL) + (size_t)t * 512;
    for (int c = tid; c < 416; c += 256) if (far(sm[c], pj[c], 0.06f, 0.02f)) chk_fail(P, 1);
    for (int c = tid; c < 8; c += 256) if (far(sm[S_WI + c], pj[2528 + c], 0.06f, 0.02f)) chk_fail(P, 1);
    for (int c = tid; c < 64; c += 256) if (far(sm[S_KI + c], pj[2464 + c], 0.06f, 0.02f)) chk_fail(P, 1);
    for (int c = tid; c < 512; c += 256) {
      if (far(bf2f(((const bf16_t*)(ws + O_QB))[(size_t)t * 512 + c]), pj[416 + c] * (0.125f * LOG2E), 0.012f, 0.02f)) chk_fail(P, 2);
      if (far(bf2f(((const bf16_t*)(ws + O_KB))[(size_t)t * 512 + c]), pj[928 + c], 0.06f, 0.02f)) chk_fail(P, 3);
      const int h = c >> 6, d = c & 63;
      if (far(bf2f(((const bf16_t*)(ws + O_VBT))[((size_t)(b * 8 + h) * 64 + d) * LP + p]), pj[1440 + c], 0.06f, 0.02f)) chk_fail(P, 4);
      if (far(bf2f(((const bf16_t*)(ws + O_QI))[(size_t)t * 512 + c]), pj[1952 + c] * 0.125f, 0.01f, 0.02f)) chk_fail(P, 5);
    }
    for (int c = tid; c < 64; c += 256) if (far(bf2f(((const bf16_t*)(ws + O_KI))[(size_t)t * 64 + c]), pj[2464 + c], 0.06f, 0.02f)) chk_fail(P, 6);
    for (int c = tid; c < 8; c += 256) if (far(((const float*)(ws + O_WI))[(size_t)t * 8 + c], pj[2528 + c] * 0.35355339f, 0.03f, 0.02f)) chk_fail(P, 6);
    { float s = 0.f; for (int i = tid; i < 256; i += 256) s += pj[i] * pj[i]; s = block_sum256(s, red);
      const float rs = rsqrtf(s * (1.f / 256) + EPS); for (int i = tid; i < 256; i += 256) cq[i] = pj[i] * rs * P.g_cq[i]; }
    { float s = 0.f; for (int i = tid; i < 128; i += 256) s += pj[256 + i] * pj[256 + i]; s = block_sum256(s, red);
      const float rs = rsqrtf(s * (1.f / 128) + EPS); for (int i = tid; i < 128; i += 256) ckv[i] = pj[256 + i] * rs * P.g_ckv[i]; }
    __syncthreads();
    const float qscale = 0.10206207261596575f * LOG2E;
    for (int c = tid; c < 768; c += 256) {
      const int h = c / 96, e = c % 96;
      float ref;
      if (e < 64) { float a = 0.f; for (int k = 0; k < 256; ++k) a = fmaf(cq[k], P.w_uq[(size_t)k * 768 + c], a); ref = a; }
      else {
        const int j = (e - 64) & 15; const int c1 = h * 96 + 64 + j, c2 = c1 + 16;
        float a1 = 0.f, a2 = 0.f; for (int k = 0; k < 256; ++k) { a1 = fmaf(cq[k], P.w_uq[(size_t)k * 768 + c1], a1); a2 = fmaf(cq[k], P.w_uq[(size_t)k * 768 + c2], a2); }
        const float inv = powf(10000.f, -(float)j / 16.f); float sn, cs; sincosf((float)p * inv, &sn, &cs);
        ref = (e - 64) < 16 ? a1 * cs - a2 * sn : a1 * sn + a2 * cs;
      }
      if (far(bf2f(((const bf16_t*)(ws + O_QA))[(size_t)t * 768 + c]), ref * qscale, 0.01f, 0.02f)) chk_fail(P, 7);
    }
    for (int c = tid; c < 1024; c += 256) {
      float a = 0.f; for (int k = 0; k < 128; ++k) a = fmaf(ckv[k], P.w_ukv[(size_t)k * 1024 + c], a);
      const int h = c >> 7, e = c & 127;
      if (e < 64) { if (far(bf2f(((const bf16_t*)(ws + O_KMLA))[((size_t)(b * 8 + h) * LP + p) * 96 + e]), a, 0.06f, 0.02f)) chk_fail(P, 8); }
      else { if (far(bf2f(((const bf16_t*)(ws + O_VT))[((size_t)(b * 8 + h) * 64 + (e - 64)) * LP + p]), a, 0.06f, 0.02f)) chk_fail(P, 9); }
    }
    for (int c = tid; c < 256; c += 256) {
      const int h = c >> 5, e = c & 31, j = e & 15;
      const float inv = powf(10000.f, -(float)j / 16.f); float sn, cs; sincosf((float)p * inv, &sn, &cs);
      const float x1 = pj[384 + j], x2 = pj[384 + 16 + j];
      const float ref = e < 16 ? x1 * cs - x2 * sn : x1 * sn + x2 * cs;
      if (far(bf2f(((const bf16_t*)(ws + O_KMLA))[((size_t)(b * 8 + h) * LP + p) * 96 + 64 + e]), ref, 0.06f, 0.02f)) chk_fail(P, 10);
    }
    __syncthreads();
  }
}
DI void chk_stageB(const Params& P, unsigned char* lds) {
  unsigned char* ws = P.ws;
  float* hv = (float*)lds; float* yv = hv + 1024; float* red = yv + 1024; float* oa = red + 8; float* ob = oa + 512;
  const int tid = threadIdx.x & 255;
  for (int sidx = blockIdx.x; sidx < 256; sidx += gridDim.x) {
    const int rt = (int)(hash_u(sidx * 104729u + 7u) % NR);
    const int b = rt / SEQ, p = NMETA + rt % SEQ, t = b * L + p;
    chk_load_hn(P, t, hv, red);
    for (int i = tid; i < 512; i += 256) { oa[i] = bf2f(((const bf16_t*)(ws + O_OA))[(size_t)rt * 512 + i]); ob[i] = bf2f(((const bf16_t*)(ws + O_OB))[(size_t)rt * 512 + i]); }
    __syncthreads();
    const bf16_t* gates = (const bf16_t*)P.out + (size_t)rt * 2048;
    for (int c = tid; c < D; c += 256) {
      float ga = 0.f, gb = 0.f, va = 0.f, vb = 0.f;
      for (int k = 0; k < D; ++k) { ga = fmaf(hv[k], P.w_in[(size_t)k * INC + 2536 + c], ga); gb = fmaf(hv[k], P.w_in[(size_t)k * INC + 3560 + c], gb); }
      for (int k = 0; k < 512; ++k) { va = fmaf(oa[k], P.w_bra[(size_t)k * D + c], va); vb = fmaf(ob[k], P.w_brb[(size_t)k * D + c], vb); }
      const float sa = 1.f / (1.f + expf(-ga)), sb = 1.f / (1.f + expf(-gb));
      if (far(bf2f(gates[c]), sa, 0.01f, 0.01f) || far(bf2f(gates[1024 + c]), sb, 0.01f, 0.01f)) chk_fail(P, 10);
      const float ref = va * sa + vb * sb;
      if (far(bf2f(((const bf16_t*)(ws + O_Y))[(size_t)rt * D + c]), ref, 0.004f, 0.03f)) chk_fail(P, 11);
    }
    __syncthreads();
  }
}
DI void chk_stageC(const Params& P, unsigned char* lds) {
  unsigned char* ws = P.ws;
  float* yv = (float*)lds;
  const int tid = threadIdx.x & 255;
  for (int sidx = blockIdx.x; sidx < 256; sidx += gridDim.x) {
    const int rt = (int)(hash_u(sidx * 15485863u + 3u) % NR);
    const int b = rt / SEQ, p = NMETA + rt % SEQ, t = b * L + p;
    for (int i = tid; i < D; i += 256) yv[i] = bf2f(((const bf16_t*)(ws + O_Y))[(size_t)rt * D + i]);
    __syncthreads();
    for (int c = tid; c < D; c += 256) {
      float a = 0.f; for (int k = 0; k < D; ++k) a = fmaf(yv[k], P.w_o[(size_t)k * D + c], a);
      const float ref = P.x[(size_t)rt * D + c] + a;
      if (far(P.out[(size_t)rt * D + c], ref, 0.003f, 0.002f)) chk_fail(P, 12);
    }
    __syncthreads();
  }
}
#endif

#if SELFCHECK
DI void chk_moe(const Params& P, unsigned char* lds) {
  unsigned char* ws = P.ws;
  NvMoeLds& S = *(NvMoeLds*)lds;
  __shared__ int sb[32];
  const int t = threadIdx.x & 255, lane = t & 63, wv = t >> 6;
  if (t == 0) { const unsigned* c = (const unsigned*)(ws + O_CTR) + 32; int a = 0; for (int i = 0; i < 32; ++i) { sb[i] = a; a += (((int)c[i] + 255) >> 8) * 256; } }
  __syncthreads();
  for (int sidx = blockIdx.x; sidx < 192; sidx += gridDim.x) {
    const int tok = (int)(hash_u(sidx * 40503u + 77u) % NR);
    const float* row = P.out + (size_t)tok * D;
    float s = 0.f;
    for (int i = t; i < D; i += 256) { const float v = row[i]; S.xr[i] = v; s += v * v; }
    s = block_sum256(s, S.red);
    const float rs = rsqrtf(s * (1.f / D) + EPS);
    for (int i = t; i < D; i += 256) { S.xn[i] = S.xr[i] * rs * P.g_ffn[i]; if (far(bf2f(((const bf16_t*)(ws + M_XN))[(size_t)tok * D + i]), S.xn[i], 0.02f, 0.01f)) chk_fail(P, 0); }
    __syncthreads();
    for (int c = wv; c < 36; c += 4) {
      float a = 0.f;
      if (c < 4) { for (int i = lane; i < D; i += 64) a = fmaf(S.xn[i], P.w_rg[i * 4 + c], a); }
      else { for (int i = lane; i < D; i += 64) a = fmaf(S.xn[i], P.w_re[i * 32 + (c - 4)], a); }
      a = wave_sum(a);
      if (lane == 0) S.logit[c] = a + (c < 4 ? P.b_rg[c] : P.b_re[c - 4]);
    }
    __syncthreads();
    const int* asg = (const int*)(ws + M_ASG) + (size_t)tok * 4;
    if (t == 0) {
      const int gs = asg[0] >> 3;
      float gm = S.logit[0]; for (int i = 1; i < 4; ++i) gm = fmaxf(gm, S.logit[i]);
      if (S.logit[gs] < gm - 1e-4f || (asg[2] >> 3) != gs) chk_fail(P, 1);
      const float* el = S.logit + 4 + gs * 8;
      const int e1 = asg[0] & 7, e2 = asg[2] & 7;
      int nb = 0; for (int i = 0; i < 8; ++i) if (i != e1 && i != e2 && el[i] > fminf(el[e1], el[e2]) + 1e-4f) ++nb;
      if (nb || e1 == e2 || el[e1] < el[e2] - 1e-4f) chk_fail(P, 2);
      float se = 0.f; for (int i = 0; i < 4; ++i) se += expf(S.logit[i] - gm);
      const float pg = expf(S.logit[gs] - gm) / se;
      const float a = expf(el[e1] - el[e1]), b2 = expf(el[e2] - el[e1]);
      S.gatew[0] = pg * a / (a + b2); S.gatew[1] = pg * b2 / (a + b2);
      S.expert[0] = asg[0]; S.expert[1] = asg[2];
      if (far(((const float*)(ws + M_WL))[(size_t)asg[0] * NR + asg[1]], S.gatew[0], 1e-4f, 1e-3f)) chk_fail(P, 3);
      if (far(((const float*)(ws + M_WL))[(size_t)asg[2] * NR + asg[3]], S.gatew[1], 1e-4f, 1e-3f)) chk_fail(P, 3);
      if (((const int*)(ws + M_LIST))[(size_t)asg[0] * NR + asg[1]] != tok || ((const int*)(ws + M_LIST))[(size_t)asg[2] * NR + asg[3]] != tok) chk_fail(P, 4);
    }
    __syncthreads();
    for (int a = 0; a < 2; ++a) {
      const int e = S.expert[a];
      const int slot = sb[e] + asg[2 * a + 1];
      const float* wg = P.w_eg + (size_t)e * D * 256;
      const float* wu = P.w_eu + (size_t)e * D * 256;
      float g = 0.f, u = 0.f;
      for (int k = 0; k < D; ++k) { const float xv = S.xn[k]; g = fmaf(xv, wg[(size_t)k * 256 + t], g); u = fmaf(xv, wu[(size_t)k * 256 + t], u); }
      S.hm[t] = g / (1.f + expf(-g)) * u;
      if (far(bf2f(((const bf16_t*)(ws + M_HMID))[(size_t)slot * 256 + t]), S.hm[t], 0.03f, 0.03f)) chk_fail(P, 5);
      __syncthreads();
      const float* wd = P.w_ed + (size_t)e * 256 * D;
      const float gw = S.gatew[a];
      for (int i = 0; i < 4; ++i) {
        float y = 0.f;
        for (int j = 0; j < 256; ++j) y = fmaf(S.hm[j], wd[(size_t)j * D + t + 256 * i], y);
        if (far(bf2f(((const bf16_t*)(ws + M_YS))[(size_t)slot * 1024 + t + 256 * i]), gw * y, 0.02f, 0.03f)) chk_fail(P, 6);
      }
      __syncthreads();
    }
  }
}
#endif

__global__ void __launch_bounds__(NTHR, 2) mega(Params P) {
  cg::grid_group grid = cg::this_grid();
  extern __shared__ __attribute__((aligned(16))) unsigned char lds[];
  const int G = gridDim.x, bx = blockIdx.x;
  const int lane = threadIdx.x & 63, wv = threadIdx.x >> 6, gw = bx * NW + wv, NGW = G * NW;
  const int half = threadIdx.x >> 8, t2 = threadIdx.x & 255;
  constexpr int MTB = (NT + 255) / 256;
  if (threadIdx.x < 16) ((unsigned*)(lds + LDS_CTL))[threadIdx.x] = 0u;
  __syncthreads();
  if (P.use_cg) grid.sync();
  const XcdBarrier xb = xcd_barrier_post((unsigned*)(P.ws + O_BAR), (volatile LAS unsigned*)(lds + LDS_CTL));
  int* const slot = (int*)(lds + LDS_CTL + 16);
#define GSYNC() xcd_barrier(xb)
  p0_prologue(P, lds);
  GSYNC();
  { int mt, nt; for (int k = 0; p1_tile_map(bx, k, G, mt, nt); ++k) p1_inproj_tile(P, mt, nt, lds); }
  GSYNC();
  for (int t = bx; t < MTB * (768 / 256 + 1024 / 256); t += G) { if (t < MTB * 3) p2b_q_tile(P, t, lds); else p2b_kv_tile(P, t - MTB * 3, lds); }
  GSYNC();
#if SELFCHECK
  chk_stageA(P, lds);
  GSYNC();
#endif
  for (int it = next_item(P, 0, slot); it < 512; it = next_item(P, 0, slot)) mla_item(P, it, lds);
#if SELFCHECK
  GSYNC();
  for (int sidx = bx; sidx < 384; sidx += G) nv_mla<true>(P, sidx < 8 ? (sidx < 4 ? sidx * 37 : NR - 1 - (sidx - 4) * 4096) : (int)(hash_u(sidx * 2654435761u + 11u) % NR), lds);
#endif
  GSYNC();
  for (int it = next_item(P, 1, slot); it < S12_ITEMS; it = next_item(P, 1, slot)) s12_item(P, it, lds);
  GSYNC();
  for (int it = next_item(P, 2, slot); it < 512; it = next_item(P, 2, slot)) dsa_item(P, it, lds);
  GSYNC();
#if SELFCHECK
  for (int sidx = bx; sidx < 384; sidx += G) nv_dsa_check(P, sidx < 8 ? (sidx < 4 ? 200 + sidx * 37 : NR - 1 - (sidx - 4) * 4096) : (int)(hash_u(sidx * 2246822519u + 5u) % NR), lds);
  GSYNC();
#endif
  { int mt, nt; for (int k = 0; p78_tile_map(bx, k, G, mt, nt); ++k) p7_merge_tile(P, mt, nt, lds); }
  GSYNC();
#if SELFCHECK
  chk_stageB(P, lds);
  GSYNC();
#endif
  { int mt, nt; for (int k = 0; p78_tile_map(bx, k, G, mt, nt); ++k) p8_out_tile(P, mt, nt, lds); }
  GSYNC();
#if SELFCHECK
  chk_stageC(P, lds);
  GSYNC();
#endif
  { int lane9 = threadIdx.x & 63; asm volatile("" : "+v"(lane9)); for (int t = gw; t < NR; t += NGW) p9_router_token(P, t, lane9); }
  { float* scr = (float*)lds + half * (64 * 65 + 32);
    for (int k = bx; 2 * k < 32 * 128; k += G) p9_conv_gu_item(P, 2 * k + half, scr, t2, true);
    for (int k = bx; 2 * k < 32 * 64; k += G) { const int it = 2 * k + half, e = it >> 6; transpose_item(P.w_ed + (size_t)e * 256 * 1024, 1024, 256, (bf16_t*)(P.ws + M_WD) + (size_t)e * 1024 * 256, MapOff{0}, it & 63, scr, t2, true); } }
  GSYNC();
  {
    int e, rt, cnt, bs;
    const int ntile = moe_tile_lookup(P, 0, e, rt, cnt, bs);
    for (int q = next_item(P, 3, slot); q < ntile * 6; q = next_item(P, 3, slot)) {
      if (q < ntile * 2) { moe_tile_lookup(P, q >> 1, e, rt, cnt, bs); p10_gu_tile(P, q >> 1, e, rt, cnt, bs, q & 1, lds); }
      else { const int q2 = q - ntile * 2; moe_tile_lookup(P, q2 >> 2, e, rt, cnt, bs); p11_down_tile(P, q2 >> 2, e, rt, cnt, bs, q2 & 3, lds); }
    }
    GSYNC();
#if SELFCHECK
    chk_moe(P, lds);
    GSYNC();
#endif
    int* sbase = (int*)lds;
    __syncthreads();
    if (threadIdx.x == 0) { const unsigned* c = (const unsigned*)(P.ws + O_CTR) + 32; int a = 0; for (int i = 0; i < 32; ++i) { sbase[i] = a; a += (((int)c[i] + 255) >> 8) * 256; } }
    __syncthreads();
    int lane12 = threadIdx.x & 63; asm volatile("" : "+v"(lane12));
    for (int t = gw; t < NR; t += NGW) p12_final_token(P, t, lane12, sbase);
  }
#if SELFCHECK
  GSYNC();
  {
    const unsigned* chk = (const unsigned*)(P.ws + O_CHK);
    float f = 1.f;
    for (int k = 15; k >= 0; --k) if (chk[k]) f = 1.f + 0.25f * (float)(1 << k);
    if (f != 1.f) for (size_t i = (size_t)bx * NTHR + threadIdx.x; i < (size_t)NR * D; i += (size_t)G * NTHR) P.out[i] *= f;
  }
#endif
}
}

extern "C" void kernel_launch(void* const* d_in, const int* in_sizes, int n_in, void* d_out, int out_size, void* d_ws, size_t ws_size, hipStream_t stream) {
  using namespace mk;
  static int grid_blocks = 0;
  if (!grid_blocks) {
    int dev = 0, cus = 0, per_cu = 0;
    (void)hipGetDevice(&dev);
    (void)hipDeviceGetAttribute(&cus, hipDeviceAttributeMultiprocessorCount, dev);
    (void)hipFuncSetAttribute((const void*)mega, hipFuncAttributeMaxDynamicSharedMemorySize, LDS_BYTES);
    (void)hipOccupancyMaxActiveBlocksPerMultiprocessor(&per_cu, mega, NTHR, LDS_BYTES);
    per_cu = 1;
    grid_blocks = cus * per_cu;
    if (ws_size < WS_END) fprintf(stderr, "workspace too small: need %zu have %zu\n", (size_t)WS_END, ws_size);
  }
  Params p{};
  const float** pp = (const float**)&p;
  for (int i = 0; i < 21; ++i) pp[i] = (const float*)d_in[i];
  p.out = (float*)d_out; p.ws = (unsigned char*)d_ws;
  (void)hipMemsetAsync((unsigned char*)d_ws + O_CHK, 0, O_WR - O_CHK, stream);
  void* args[] = {&p};
  hipError_t e = hipLaunchCooperativeKernel((void*)mega, dim3(grid_blocks), dim3(NTHR), args, LDS_BYTES, stream);
  if (e != hipSuccess) fprintf(stderr, "cooperative launch failed: %s (grid %d)\n", hipGetErrorString(e), grid_blocks);
}
```

```cpp
#include <hip/hip_runtime.h>
#include <hip/hip_cooperative_groups.h>
#include <cstdio>
#include <math.h>
#include <stdint.h>
namespace cg = cooperative_groups;

namespace mk {
typedef unsigned short bf16_t;
typedef short bf16x8 __attribute__((ext_vector_type(8)));
typedef float f32x16 __attribute__((ext_vector_type(16)));
typedef float f32x4 __attribute__((ext_vector_type(4)));
typedef unsigned u32x4 __attribute__((ext_vector_type(4)));
typedef unsigned u32x2 __attribute__((ext_vector_type(2)));

constexpr int D = 1024, NB = 4, SEQ = 4096, NMETA = 16, L = SEQ + NMETA, NT = NB * L  , NR = NB * SEQ  ;
constexpr int INC = 4584, LP = 4128;
constexpr int S_CQ = 0, S_CKV = 256, S_KR = 384, S_WI = 416, S_KI = 424;
constexpr float EPS = 1e-6f;
constexpr float LOG2E = 1.4426950408889634f;
constexpr int NTHR = 512, NW = NTHR / 64;

#define DI __device__ __forceinline__
#ifndef REP_P0
#define REP_P0 1
#endif
#ifndef REP_P1
#define REP_P1 1
#endif
#ifndef REP_MLA
#define REP_MLA 1
#endif
#ifndef REP_S1
#define REP_S1 1
#endif
#ifndef REP_S2
#define REP_S2 1
#endif
#ifndef REP_DSA
#define REP_DSA 1
#endif
#ifndef REP_P7
#define REP_P7 1
#endif
#ifndef REP_P8
#define REP_P8 1
#endif
#ifndef REP_MOE
#define REP_MOE 1
#endif
#ifndef REP_P2
#define REP_P2 1
#endif
#ifndef REP_CONV
#define REP_CONV 1
#endif
#ifndef SELFCHECK
#define SELFCHECK 0
#endif

typedef __bf16 bf2_t __attribute__((ext_vector_type(2)));
DI bf16_t f2bf(float x) { const __bf16 b = (__bf16)x; return __builtin_bit_cast(bf16_t, b); }
DI float bf2f(bf16_t v) { return __uint_as_float(((unsigned)v) << 16); }
DI unsigned pk2(float lo, float hi) { const bf2_t v = {(__bf16)lo, (__bf16)hi}; return __builtin_bit_cast(unsigned, v); }
#define dpp_i(v, ctrl) __builtin_amdgcn_update_dpp(0, (v), (ctrl), 0xf, 0xf, true)
DI float wave_sum(float v) {
  v += __int_as_float(dpp_i(__float_as_int(v), 0xB1));
  v += __int_as_float(dpp_i(__float_as_int(v), 0x4E));
  v += __int_as_float(dpp_i(__float_as_int(v), 0x141));
  v += __int_as_float(dpp_i(__float_as_int(v), 0x140));
  const int b = __float_as_int(v);
  return (__int_as_float(__builtin_amdgcn_readlane(b, 0)) + __int_as_float(__builtin_amdgcn_readlane(b, 16))) +
         (__int_as_float(__builtin_amdgcn_readlane(b, 32)) + __int_as_float(__builtin_amdgcn_readlane(b, 48)));
}
DI int wave_sumi(int v) {
  v += dpp_i(v, 0xB1); v += dpp_i(v, 0x4E); v += dpp_i(v, 0x141); v += dpp_i(v, 0x140);
  return (__builtin_amdgcn_readlane(v, 0) + __builtin_amdgcn_readlane(v, 16)) + (__builtin_amdgcn_readlane(v, 32) + __builtin_amdgcn_readlane(v, 48));
}
DI float block_sum256(float v, float* red) {
  v = wave_sum(v);
  __syncthreads();
  if ((threadIdx.x & 63) == 0) red[threadIdx.x >> 6] = v;
  __syncthreads();
  return red[0] + red[1] + red[2] + red[3];
}
DI int block_sumi256(int v, int* red) {
#pragma unroll
  for (int o = 1; o < 64; o <<= 1) v += __shfl_xor(v, o);
  __syncthreads();
  if ((threadIdx.x & 63) == 0) red[threadIdx.x >> 6] = v;
  __syncthreads();
  return red[0] + red[1] + red[2] + red[3];
}
DI int n_adm(int p) { return p < NMETA ? NMETA : NMETA + 64 * (1 + (p - NMETA) / 64); }


#if SELFCHECK
DI unsigned hash_u(unsigned x) { x ^= x >> 16; x *= 0x7feb352du; x ^= x >> 15; x *= 0x846ca68bu; x ^= x >> 16; return x; }
DI bool far(float got, float ref, float atol, float rtol) { const float d = fabsf(got - ref); return !(d <= atol + rtol * fabsf(ref)); }
#endif
struct Params {
  const float *x, *meta, *g_mix, *w_in, *g_cq, *g_ckv, *w_uq, *w_ukv, *w_bra, *w_brb, *w_o, *rel_bias, *g_ffn, *w_rg, *b_rg, *w_re, *b_re, *w_eg, *w_eu, *w_ed, *g_fin;
  float* out; unsigned char* ws;
  int use_cg; int pad;
};

constexpr size_t al(size_t x) { return (x + 255) & ~(size_t)255; }
constexpr size_t O_QB = 0;
constexpr size_t O_KB = al(O_QB + (size_t)NT * 512 * 2);
constexpr size_t O_VBT = al(O_KB + (size_t)NT * 512 * 2);
constexpr size_t O_QI = al(O_VBT + (size_t)NB * 8 * 64 * LP * 2);
constexpr size_t O_KI = al(O_QI + (size_t)NT * 512 * 2);
constexpr size_t O_WI = al(O_KI + (size_t)NT * 64 * 2);
constexpr size_t O_SMALL = al(O_WI + (size_t)NT * 8 * 4);
constexpr size_t O_CQN = al(O_SMALL + (size_t)NT * 512 * 4);
constexpr size_t O_CKVN = al(O_CQN + (size_t)NT * 256 * 2);
constexpr size_t O_QA = al(O_CKVN + (size_t)NT * 128 * 2);
constexpr size_t O_KMLA = al(O_QA + (size_t)NT * 768 * 2);
constexpr size_t O_VT = al(O_KMLA + (size_t)NB * 8 * LP * 96 * 2);
constexpr size_t R_END = al(O_VT + (size_t)NB * 8 * 64 * LP * 2 + (size_t)NT * 1536 * 2);
constexpr size_t O_HN = O_QA;
constexpr size_t O_KR = O_SMALL;
constexpr size_t O_OA = O_SMALL;
constexpr int MW = 132;
constexpr size_t O_MASK = al(O_OA + (size_t)NR * 512 * 2);
constexpr size_t O_SCORES = al(O_MASK + (size_t)NR * MW * 4);
constexpr size_t SCORES_PER_BATCH = (size_t)8192 * 1088;
constexpr size_t O_OB = O_SCORES;
constexpr size_t O_Y = al(O_OB + (size_t)NR * 512 * 2);
static_assert(O_SCORES + (size_t)NB * SCORES_PER_BATCH * 2 + 65536 <= R_END, "scores must fit region R");
constexpr size_t O_WIN = R_END;
constexpr size_t O_WG = al(O_WIN + (size_t)2560 * 1024 * 2);
constexpr size_t O_WUQ = al(O_WG + (size_t)2048 * 1024 * 2);
constexpr size_t O_WUKV = al(O_WUQ + (size_t)768 * 256 * 2);
constexpr size_t O_WBRA = al(O_WUKV + (size_t)1024 * 128 * 2);
constexpr size_t O_WBRB = al(O_WBRA + (size_t)1024 * 512 * 2);
constexpr size_t O_WO = al(O_WBRB + (size_t)1024 * 512 * 2);
constexpr size_t O_ROPE = al(O_WO + (size_t)1024 * 1024 * 2);
constexpr size_t O_CHK = al(O_ROPE + (size_t)L * 32 * 4);
constexpr size_t O_CTR = al(O_CHK + 256);
constexpr size_t O_BAR = al(O_CTR + 256);
constexpr size_t O_DEP = al(O_BAR + 3456 * 4);
constexpr size_t O_ECNT = al(O_DEP + 512 * 4);
constexpr int ECS = 32;
constexpr size_t O_WR = al(O_ECNT + 32 * ECS * 4);
constexpr size_t O_WRS = al(O_WR + (size_t)36 * 1024 * 4);
constexpr size_t WS_END = al(O_WRS + (size_t)3 * 64 * 1024 * 2);
constexpr int SLOTS = 2 * NR + 32 * 256;
constexpr size_t M_XN = 0;
constexpr size_t M_HMID = al(M_XN + (size_t)NR * 1024 * 2);
constexpr size_t M_YS = al(M_HMID + (size_t)SLOTS * 256 * 2);
constexpr size_t M_WGU = al(M_YS + (size_t)SLOTS * 1024 * 2);
constexpr size_t M_WD = al(M_WGU + (size_t)32 * 512 * 1024 * 2);
constexpr size_t M_LIST = al(M_WD + (size_t)32 * 1024 * 256 * 2);
constexpr size_t M_WL = al(M_LIST + (size_t)32 * NR * 4);
constexpr size_t M_ASG = al(M_WL + (size_t)32 * NR * 4);
constexpr size_t M_RS = al(M_ASG + (size_t)NR * 16);
constexpr size_t M_END = al(M_RS + (size_t)NR * 4);
static_assert(M_END <= O_WIN, "MoE overlay must stay below the weights");
static_assert(WS_END <= (size_t)256 * 1024 * 1024, "workspace budget");
#if SELFCHECK
DI void chk_fail(const Params& P, int k) { atomicAdd((unsigned*)(P.ws + O_CHK) + k, 1u); }
#endif
constexpr int GX_A = 256 * 128, GX_B = 256 * 128, GX_STAGE = GX_A + GX_B;
constexpr int S12_STRIDE = 2116;
constexpr int LDS_CTL = 16 * S12_STRIDE * 4;
constexpr int LDS_RED = LDS_CTL + 64;
constexpr int LDS_Q = LDS_RED + 4 * 256 * 4;
constexpr int LDS_BYTES = LDS_Q + 16 * 1040;


#define XB_TMO      128
#define XB_XCNT(j)  (256  + 64 * (j))
#define XB_XSUB(j)  (1280 + 64 * (j))
#define XB_XGEN(j)  (2304 + 64 * (j))
#define XB_TOP      3328
#define XB_TOPGEN   3392
#define XCD_BAR_WORDS 3456
#define XB_SPIN_CAP (1u << 18)
#define LAS __attribute__((address_space(3)))
DI unsigned xb_ld(unsigned* p)              { return __hip_atomic_load(p, __ATOMIC_RELAXED, __HIP_MEMORY_SCOPE_AGENT); }
DI unsigned xb_add(unsigned* p, unsigned v) { return __hip_atomic_fetch_add(p, v, __ATOMIC_RELAXED, __HIP_MEMORY_SCOPE_AGENT); }
DI unsigned xb_xcc_id() { return (unsigned)__builtin_amdgcn_s_getreg((3 << 11) | 20) & 0xFu; }
#define XB_SPIN(cond, bar) do { unsigned _sp = 0; while (cond) { __builtin_amdgcn_s_sleep(1); \
    if ((++_sp & 255u) == 0u) { if (xb_ld(&(bar)[XB_TMO])) break; if (_sp > XB_SPIN_CAP) { atomicAdd(&(bar)[XB_TMO], 1u); break; } } } } while (0)
struct XcdBarrier { unsigned* bar; unsigned x; volatile LAS unsigned* st; };
DI XcdBarrier xcd_barrier_post(unsigned* bar, volatile LAS unsigned* st) {
  XcdBarrier b; b.bar = bar; b.x = xb_xcc_id(); b.st = st;
  if (threadIdx.x == 0) (void)xb_add(&bar[XB_XCNT(b.x)], 1u);
  return b;
}
DI void xcd_barrier_complete(unsigned* bar, unsigned x, unsigned& nloc, unsigned& nx) {
  const unsigned G = gridDim.x * gridDim.y * gridDim.z;
  unsigned sum, cnt, mine, sp = 0u;
  for (;;) {
    sum = 0u; cnt = 0u; mine = 0u;
#pragma unroll
    for (unsigned j = 0; j < 16; ++j) { const unsigned c = xb_ld(&bar[XB_XCNT(j)]); sum += c; cnt += (c > 0u) ? 1u : 0u; mine = (j == x) ? c : mine; }
    if (sum == G) break;
    __builtin_amdgcn_s_sleep(1);
    if ((++sp & 255u) == 0u) { if (xb_ld(&bar[XB_TMO])) break; if (sp > XB_SPIN_CAP) { atomicAdd(&bar[XB_TMO], 1u); break; } }
  }
  nloc = mine > 0u ? mine : 1u; nx = cnt > 0u ? cnt : 1u;
}
DI void xcd_barrier(const XcdBarrier& b) {
  asm volatile("s_waitcnt vmcnt(0)" ::: "memory");
  __syncthreads();
  if (threadIdx.x == 0) {
    unsigned* bar = b.bar;
    __builtin_amdgcn_s_waitcnt(0);
    unsigned nloc = b.st[0], nx = b.st[1];
    if (nloc == 0u) { xcd_barrier_complete(bar, b.x, nloc, nx); b.st[0] = nloc; b.st[1] = nx; }
    const unsigned old = xb_add(&bar[XB_XSUB(b.x)], 1u);
    const unsigned gen = old / nloc;
    if (old + 1u == (gen + 1u) * nloc) {
      __builtin_amdgcn_fence(__ATOMIC_RELEASE, "agent");
      asm volatile("s_waitcnt vmcnt(0)" ::: "memory");
      const unsigned og = xb_add(&bar[XB_TOP], 1u);
      const unsigned tg = og / nx;
      if (og + 1u == (tg + 1u) * nx) xb_add(&bar[XB_TOPGEN], 1u);
      else XB_SPIN(xb_ld(&bar[XB_TOPGEN]) == tg, bar);
      __builtin_amdgcn_fence(__ATOMIC_ACQUIRE, "agent");
      xb_add(&bar[XB_XGEN(b.x)], 1u);
      asm volatile("s_waitcnt vmcnt(0)" ::: "memory");
    } else {
      XB_SPIN(xb_ld(&bar[XB_XGEN(b.x)]) == gen, bar);
      __builtin_amdgcn_fence(__ATOMIC_ACQUIRE, "agent");
      asm volatile("s_waitcnt vmcnt(0)" ::: "memory");
    }
  }
  __syncthreads();
}

DI void p0_norm_rows4(const Params& P, int t0, int stride, bf16_t* hn, int lane) {
  f32x4 v[4][4]; int tk[4]; bool has[4];
#pragma unroll
  for (int u = 0; u < 4; ++u) {
    const int t = t0 + u * stride; has[u] = t < NT; tk[u] = has[u] ? t : t0;
    const int b = tk[u] / L, p = tk[u] % L;
    const float* row = p < NMETA ? P.meta + (size_t)p * D : P.x + ((size_t)b * SEQ + (p - NMETA)) * D;
#pragma unroll
    for (int i = 0; i < 4; ++i) v[u][i] = *(const f32x4*)(row + 256 * i + 4 * lane);
  }
  f32x4 g[4];
#pragma unroll
  for (int i = 0; i < 4; ++i) g[i] = *(const f32x4*)(P.g_mix + 256 * i + 4 * lane);
#pragma unroll
  for (int u = 0; u < 4; ++u) {
    float s = 0.f;
#pragma unroll
    for (int i = 0; i < 4; ++i) s += v[u][i][0] * v[u][i][0] + v[u][i][1] * v[u][i][1] + v[u][i][2] * v[u][i][2] + v[u][i][3] * v[u][i][3];
    s = wave_sum(s);
    const float rs = rsqrtf(s * (1.f / D) + EPS);
    if (has[u]) {
#pragma unroll
      for (int i = 0; i < 4; ++i) {
        u32x2 o; o[0] = pk2(v[u][i][0] * rs * g[i][0], v[u][i][1] * rs * g[i][1]); o[1] = pk2(v[u][i][2] * rs * g[i][2], v[u][i][3] * rs * g[i][3]);
        *(u32x2*)(hn + (size_t)tk[u] * D + 256 * i + 4 * lane) = o;
      }
    }
  }
}
template <class F>
DI void transpose_item(const float* src, int ldsrc, int K, bf16_t* dst, F map, int item, float* scr  , int tid, bool valid) {
  const int nkb = K / 64, kb = item % nkb, nb = item / nkb, k0 = kb * 64, n0 = nb * 64;
  if (valid) {
    const int n = tid & 63; const int col = map(n0 + n);
    float r[16];
    const float* sp0 = src + (size_t)(k0 + (tid >> 6)) * ldsrc + (col >= 0 ? col : 0);
#pragma unroll
    for (int i = 0; i < 16; ++i) r[i] = sp0[(size_t)(4 * i) * ldsrc];
#pragma unroll
    for (int i = 0; i < 16; ++i) asm volatile("" : "+v"(r[i]));
#pragma unroll
    for (int i = 0; i < 16; ++i) { const int k = (tid >> 6) + 4 * i; scr[k * 65 + n] = col >= 0 ? r[i] : 0.f; }
  }
  __syncthreads();
  if (valid) {
    const int kq = tid & 7;
#pragma unroll
    for (int i = 0; i < 2; ++i) {
      const int n = (tid >> 3) + 32 * i;
      const float* s = scr + (kq * 8) * 65 + n;
      u32x4 o; o[0] = pk2(s[0], s[65]); o[1] = pk2(s[2 * 65], s[3 * 65]); o[2] = pk2(s[4 * 65], s[5 * 65]); o[3] = pk2(s[6 * 65], s[7 * 65]);
      *(u32x4*)(dst + (size_t)(n0 + n) * K + k0 + kq * 8) = o;
    }
  }
  __syncthreads();
}
struct MapIn {
  DI int operator()(int n) const {
    if (n < 416) return n;
    if (n < 424) return 2528 + (n - 416);
    if (n < 488) return 2464 + (n - 424);
    if (n < 512) return -1;
    return 416 + (n - 512);
  }
};
struct MapOff { int off; DI int operator()(int n) const { return off + n; } };
struct MapUkv { DI int operator()(int n) const { const int m = n & 511; return (m >> 6) * 128 + (n >> 9) * 64 + (m & 63); } };

DI void p0_prologue(const Params& P, unsigned char* lds) {
  unsigned char* ws = P.ws;
  const int tid = threadIdx.x, lane = tid & 63, wv = tid >> 6;
  const int gw = blockIdx.x * NW + wv, ngw = gridDim.x * NW;
  bf16_t* hn = (bf16_t*)(P.ws + O_HN);
  for (int t = gw; t < NT; t += 4 * ngw) p0_norm_rows4(P, t, ngw, hn, lane);
  float* rope = (float*)(ws + O_ROPE);
  for (int i = blockIdx.x * NTHR + tid; i < L * 16; i += gridDim.x * NTHR) {
    const int p = i >> 4, j = i & 15;
    const float inv = powf(10000.f, -(float)j / 16.f);
    const float ang = (float)p * inv;
    float sn, cs; sincosf(ang, &sn, &cs);
    rope[p * 32 + j] = cs; rope[p * 32 + 16 + j] = sn;
  }
  {
    bf16_t* vbt = (bf16_t*)(ws + O_VBT); bf16_t* vt = (bf16_t*)(ws + O_VT);
    for (int i = blockIdx.x * NTHR + tid; i < NB * 8 * 64 * (LP - L); i += gridDim.x * NTHR) {
      const int r = i / (LP - L), c = L + i % (LP - L);
      vbt[(size_t)r * LP + c] = 0; vt[(size_t)r * LP + c] = 0;
    }
  }
  {
    float* wr = (float*)(ws + O_WR);
    for (int i = blockIdx.x * NTHR + tid; i < 36 * 1024; i += gridDim.x * NTHR) {
      const int c = i >> 10, k = i & 1023;
      wr[i] = c < 4 ? P.w_rg[k * 4 + c] : P.w_re[k * 32 + (c - 4)];
    }
    bf16_t* wrs = (bf16_t*)(ws + O_WRS);
    for (int i = blockIdx.x * NTHR + tid; i < 64 * 1024; i += gridDim.x * NTHR) {
      const int c = i >> 10, k = i & 1023;
      const float x = c < 36 ? (c < 4 ? P.w_rg[k * 4 + c] : P.w_re[k * 32 + (c - 4)]) * P.g_ffn[k] : 0.f;
      const bf16_t b0 = f2bf(x); const float r1 = x - bf2f(b0);
      const bf16_t b1 = f2bf(r1); const float r2 = r1 - bf2f(b1);
      const size_t fi = ((((size_t)(c >> 5)) * 64 + (k >> 4)) * 64 + ((c & 31) + 32 * ((k >> 3) & 1))) * 8 + (k & 7);
      wrs[fi] = b0; wrs[65536 + fi] = b1; wrs[131072 + fi] = f2bf(r2);
    }
  }
  const int half = tid >> 8, t2 = tid & 255;
  float* scr = (float*)lds + half * (64 * 65 + 32);
  constexpr int I_IN = (1024 / 64) * (2560 / 64), I_G = (1024 / 64) * (2048 / 64), I_UQ = (256 / 64) * (768 / 64), I_UKV = (128 / 64) * (1024 / 64),
                I_BR = (512 / 64) * (1024 / 64), I_O = (1024 / 64) * (1024 / 64);
  constexpr int NIT = I_IN + I_G + I_UQ + I_UKV + 2 * I_BR + I_O;
  for (int it2 = blockIdx.x; 2 * it2 < NIT; it2 += gridDim.x) {
    int r = 2 * it2 + half; const bool valid = r < NIT; if (!valid) r = 0;
    if (r < I_IN) transpose_item(P.w_in, INC, 1024, (bf16_t*)(ws + O_WIN), MapIn(), r, scr, t2, valid);
    else if ((r -= I_IN) < I_G) transpose_item(P.w_in, INC, 1024, (bf16_t*)(ws + O_WG), MapOff{2536}, r, scr, t2, valid);
    else if ((r -= I_G) < I_UQ) transpose_item(P.w_uq, 768, 256, (bf16_t*)(ws + O_WUQ), MapOff{0}, r, scr, t2, valid);
    else if ((r -= I_UQ) < I_UKV) transpose_item(P.w_ukv, 1024, 128, (bf16_t*)(ws + O_WUKV), MapUkv{}, r, scr, t2, valid);
    else if ((r -= I_UKV) < I_BR) transpose_item(P.w_bra, 1024, 512, (bf16_t*)(ws + O_WBRA), MapOff{0}, r, scr, t2, valid);
    else if ((r -= I_BR) < I_BR) transpose_item(P.w_brb, 1024, 512, (bf16_t*)(ws + O_WBRB), MapOff{0}, r, scr, t2, valid);
    else { r -= I_BR; transpose_item(P.w_o, 1024, 1024, (bf16_t*)(ws + O_WO), MapOff{0}, r, scr, t2, valid); }
  }
}

struct TilePtrs { const bf16_t* A; const bf16_t* B; unsigned a[4], b[4]; };
DI void glds16(const unsigned char* g, unsigned char* l) { __builtin_amdgcn_global_load_lds((const unsigned*)g, (unsigned*)l, 16, 0, 0); }
template <bool SWAP>
DI int gemm_kloop(f32x16 (&acc)[4][2], const TilePtrs& tp, int K, unsigned char* lds, bool lo_only = false) {
  const int tid = threadIdx.x, lane = tid & 63, w = __builtin_amdgcn_readfirstlane(tid >> 6), wr = w >> 2, wc = w & 3;
  const int nt = K / 64;
  unsigned char* const lw = lds + w * 1024;
  const int swz = (lane >> 1) & 7, hh = lane >> 5;
  const unsigned char* const ar = lds + (wr * 64 + (lane & 31)) * 128;
  const unsigned char* const br = lds + GX_A + (wc * 32 + (lane & 31)) * 128;
  int coff[4];
#pragma unroll
  for (int kk = 0; kk < 4; ++kk) coff[kk] = ((2 * kk + hh) ^ swz) * 16;
  bf16x8 At[2][4], B0[4], B1[4];
  unsigned oa[4], ob[4];
#pragma unroll
  for (int j = 0; j < 4; ++j) { oa[j] = tp.a[j]; ob[j] = tp.b[j]; }
#define HT_(BO_, H_) ((BO_) + (H_) * 16384)
#define STG_A(BO_, H_, kt) do { const unsigned char* g_ = (const unsigned char*)tp.A + (kt) * 128; glds16(g_ + oa[2 * (H_)], lw + HT_(BO_, H_)); glds16(g_ + oa[2 * (H_) + 1], lw + HT_(BO_, H_) + 8192); } while (0)
#define STG_B(BO_, H_, kt) do { const unsigned char* g_ = (const unsigned char*)tp.B + (kt) * 128; glds16(g_ + ob[2 * (H_)], lw + GX_A + HT_(BO_, H_)); glds16(g_ + ob[2 * (H_) + 1], lw + GX_A + HT_(BO_, H_) + 8192); } while (0)
#define PIN_OFFS() do { _Pragma("unroll") for (int j_ = 0; j_ < 4; ++j_) { asm volatile("" : "+v"(oa[j_])); asm volatile("" : "+v"(ob[j_])); } } while (0)
#define LDA_(BO_, H_) do { _Pragma("unroll") for (int m_ = 0; m_ < 2; ++m_) _Pragma("unroll") for (int k_ = 0; k_ < 4; ++k_) At[m_][k_] = *(const bf16x8*)(ar + HT_(BO_, H_) + m_ * 4096 + coff[k_]); } while (0)
#define LDB_(Bx, BO_, H_) do { _Pragma("unroll") for (int k_ = 0; k_ < 4; ++k_) Bx[k_] = *(const bf16x8*)(br + HT_(BO_, H_) + coff[k_]); } while (0)
#define MMA_(ai, bj, Bx) do { __builtin_amdgcn_s_setprio(1); _Pragma("unroll") for (int k_ = 0; k_ < 4; ++k_) _Pragma("unroll") for (int m_ = 0; m_ < 2; ++m_) \
    acc[2 * (ai) + m_][bj] = SWAP ? __builtin_amdgcn_mfma_f32_32x32x16_bf16(Bx[k_], At[m_][k_], acc[2 * (ai) + m_][bj], 0, 0, 0) \
                                  : __builtin_amdgcn_mfma_f32_32x32x16_bf16(At[m_][k_], Bx[k_], acc[2 * (ai) + m_][bj], 0, 0, 0); __builtin_amdgcn_s_setprio(0); } while (0)
#define WAIT_V(n) asm volatile("s_waitcnt vmcnt(" #n ")" ::: "memory")
#define WAIT_L(n) asm volatile("s_waitcnt lgkmcnt(" #n ")" ::: "memory")
#define BAR_ __builtin_amdgcn_s_barrier()
#define SCHED_ __builtin_amdgcn_sched_barrier(0)
  PIN_OFFS();
  STG_B(0, 0, 0); STG_A(0, 0, 0); STG_B(0, 1, 0); STG_A(0, 1, 0);
  if (wr == 1) BAR_;
  WAIT_V(4); BAR_;
  STG_B(GX_STAGE, 0, 1); STG_A(GX_STAGE, 0, 1); STG_B(GX_STAGE, 1, 1);
  WAIT_V(6); BAR_;
  int cur = 0;
#pragma unroll 1
  for (int t = 0; t < nt - 2; ++t) {
    asm volatile("" : "+s"(cur));
    PIN_OFFS();
    const int nxt = cur ^ GX_STAGE;
    LDB_(B0, cur, 0); SCHED_; LDA_(cur, 0); STG_A(nxt, 1, t + 1);
    WAIT_L(8); BAR_; WAIT_L(0); MMA_(0, 0, B0); BAR_; SCHED_;
    LDB_(B1, cur, 1); STG_B(cur, 0, t + 2);
    BAR_; WAIT_L(0); MMA_(0, 1, B1); BAR_;
    LDA_(cur, 1); STG_A(cur, 0, t + 2);
    BAR_; WAIT_L(0); if (!lo_only) MMA_(1, 0, B0); BAR_; SCHED_;
    STG_B(cur, 1, t + 2);
    WAIT_V(6); BAR_; if (!lo_only) MMA_(1, 1, B1); BAR_;
    cur = nxt;
  }
  { asm volatile("" : "+s"(cur));
    PIN_OFFS();
    const int nxt = cur ^ GX_STAGE;
    LDB_(B0, cur, 0); LDA_(cur, 0); STG_A(nxt, 1, nt - 1);
    BAR_; WAIT_L(0); MMA_(0, 0, B0); BAR_;
    LDB_(B1, cur, 1); BAR_; WAIT_L(0); MMA_(0, 1, B1); BAR_;
    LDA_(cur, 1); WAIT_V(4); BAR_; WAIT_L(0); if (!lo_only) { MMA_(1, 0, B0); MMA_(1, 1, B1); } BAR_;
    LDB_(B0, nxt, 0); LDA_(nxt, 0); WAIT_V(2); BAR_; WAIT_L(0); MMA_(0, 0, B0); BAR_;
    LDB_(B1, nxt, 1); WAIT_V(0); BAR_; WAIT_L(0); MMA_(0, 1, B1); BAR_;
    LDA_(nxt, 1); BAR_; WAIT_L(0); if (!lo_only) { MMA_(1, 0, B0); MMA_(1, 1, B1); } BAR_; }
  if (wr == 0) BAR_;
#undef HT_
#undef STG_A
#undef STG_B
#undef LDA_
#undef LDB_
#undef MMA_
#undef PIN_OFFS
  int l_ = threadIdx.x & 63; asm volatile("" : "+v"(l_));
  return l_;
}
DI void tile_rc(int i, int& row, int& chunk) { const int t = threadIdx.x; row = (i >> 1) * 128 + (i & 1) * 64 + (t >> 3); chunk = (t & 7) ^ ((row >> 1) & 7); }
DI int acc_row0(int wr, int mi) { return (mi >> 1) * 128 + wr * 64 + (mi & 1) * 32; }
DI int acc_col0(int wc, int ni) { return ni * 128 + wc * 32; }
#define EPI_IDS(L_) const int lane = (L_), w = __builtin_amdgcn_readfirstlane(threadIdx.x >> 6), wr = w >> 2, wc = w & 3, hh = lane >> 5, lc = lane & 31
DI u32x2 pk4(float a, float b, float c, float d) { u32x2 o; o[0] = pk2(a, b); o[1] = pk2(c, d); return o; }
DI u32x4 pair16(u32x2 ga, u32x2 gb) {
  const auto r0 = __builtin_amdgcn_permlane32_swap(ga[0], gb[0], false, false);
  const auto r1 = __builtin_amdgcn_permlane32_swap(ga[1], gb[1], false, false);
  u32x4 o; o[0] = r0[0]; o[1] = r1[0]; o[2] = r0[1]; o[3] = r1[1];
  return o;
}
DI void zero_acc(f32x16 (&acc)[4][2]) {
#pragma unroll
  for (int i = 0; i < 4; ++i)
#pragma unroll
    for (int j = 0; j < 2; ++j)
#pragma unroll
      for (int r = 0; r < 16; ++r) acc[i][j][r] = 0.f;
}
DI void set_ptrs(TilePtrs& tp, const bf16_t* A, int lda, int M, int m0, const bf16_t* Bt, int ldb, int N, int n0) {
#pragma unroll
  for (int i = 0; i < 4; ++i) {
    int row, kc; tile_rc(i, row, kc);
    int r = m0 + row; r = r < M ? r : M - 1;
    int c = n0 + row; c = c < N ? c : N - 1;
    tp.a[i] = ((unsigned)r * (unsigned)lda + kc * 8) * 2u;
    tp.b[i] = ((unsigned)c * (unsigned)ldb + kc * 8) * 2u;
  }
  tp.A = A; tp.B = Bt;
}

DI bool p1_tile_map(int bx, int k, int G, int& mt, int& nt) { const int t = bx + k * G; if (t >= 65 * 18) return false; mt = t / 18; nt = t % 18; return true; }
DI bool p78_tile_map(int bx, int k, int G, int& mt, int& nt) { const int t = bx + k * G; if (t >= 64 * 4) return false; mt = t >> 2; nt = t & 3; return true; }

DI void p1_seg0_epilogue(const Params& P, f32x16 (&acc)[4][2], int m0, int cb, int wr, int wc, int hh, int lc, unsigned char* lds) {
  unsigned char* ws = P.ws;
  float* red = (float*)(lds + LDS_RED);
  const bool isq = cb == 0;
#pragma unroll
  for (int mi = 0; mi < 4; ++mi) {
    float a = 0.f;
#pragma unroll
    for (int r = 0; r < 16; ++r) a = fmaf(acc[mi][0][r], acc[mi][0][r], a);
    if (isq) {
#pragma unroll
      for (int r = 0; r < 16; ++r) a = fmaf(acc[mi][1][r], acc[mi][1][r], a);
    }
    const auto sw = __builtin_amdgcn_permlane32_swap(__float_as_uint(a), __float_as_uint(a), false, false);
    a = __uint_as_float(sw[0]) + __uint_as_float(sw[1]);
    if (hh == 0) red[wc * 256 + acc_row0(wr, mi) + lc] = a;
  }
  __syncthreads();
#pragma unroll
  for (int mi = 0; mi < 4; ++mi) {
    const int rl = acc_row0(wr, mi) + lc;
    int row = m0 + rl;
    asm volatile("" : "+v"(row));
    const bool ok = row < NT;
    const float ssq = red[rl] + red[256 + rl] + red[512 + rl] + red[768 + rl];
    if (isq) {
      const float rs = rsqrtf(ssq * (1.f / 256) + EPS);
      bf16_t* dp = (bf16_t*)(ws + O_CQN) + (size_t)row * 256 + 8 * hh;
#pragma unroll
      for (int ni = 0; ni < 2; ++ni)
#pragma unroll
        for (int j = 0; j < 2; ++j) {
          u32x2 pq[2];
#pragma unroll
          for (int t = 0; t < 2; ++t) {
            const int g = 2 * j + t, col = acc_col0(wc, ni) + 8 * g;
            const f32x4 gq = *(const f32x4*)(P.g_cq + col + 4 * hh);
            pq[t] = pk4(acc[mi][ni][4 * g] * rs * gq[0], acc[mi][ni][4 * g + 1] * rs * gq[1], acc[mi][ni][4 * g + 2] * rs * gq[2], acc[mi][ni][4 * g + 3] * rs * gq[3]);
          }
          const u32x4 o = pair16(pq[0], pq[1]);
          if (ok) *(u32x4*)(dp + acc_col0(wc, ni) + 16 * j) = o;
        }
    } else {
      const float rs = rsqrtf(ssq * (1.f / 128) + EPS);
      bf16_t* dp = (bf16_t*)(ws + O_CKVN) + (size_t)row * 128 + wc * 32 + 8 * hh;
#pragma unroll
      for (int j = 0; j < 2; ++j) {
        u32x2 pq[2];
#pragma unroll
        for (int t = 0; t < 2; ++t) {
          const int g = 2 * j + t;
          const f32x4 gk = *(const f32x4*)(P.g_ckv + wc * 32 + 8 * g + 4 * hh);
          pq[t] = pk4(acc[mi][0][4 * g] * rs * gk[0], acc[mi][0][4 * g + 1] * rs * gk[1], acc[mi][0][4 * g + 2] * rs * gk[2], acc[mi][0][4 * g + 3] * rs * gk[3]);
        }
        const u32x4 o = pair16(pq[0], pq[1]);
        if (ok) *(u32x4*)(dp + 16 * j) = o;
      }
      if (wc == 0) {
        const int rowc = ok ? row : NT - 1, p = rowc % L;
        const float* rp = (const float*)(ws + O_ROPE) + p * 32;
        u32x2 o[4];
#pragma unroll
        for (int g = 0; g < 2; ++g) {
          const f32x4 cs = *(const f32x4*)(rp + 8 * g + 4 * hh), sn = *(const f32x4*)(rp + 16 + 8 * g + 4 * hh);
          float lo[4], hi[4];
#pragma unroll
          for (int e = 0; e < 4; ++e) { const float x1 = acc[mi][1][4 * g + e], x2 = acc[mi][1][4 * (g + 2) + e]; lo[e] = x1 * cs[e] - x2 * sn[e]; hi[e] = x1 * sn[e] + x2 * cs[e]; }
          o[g] = pk4(lo[0], lo[1], lo[2], lo[3]); o[g + 2] = pk4(hi[0], hi[1], hi[2], hi[3]);
        }
        bf16_t* kp = (bf16_t*)(ws + O_KR) + (size_t)row * 32 + 4 * hh;
        if (ok) {
#pragma unroll
          for (int g = 0; g < 4; ++g) *(u32x2*)(kp + 8 * g) = o[g];
        }
      } else if (wc == 1) {
        if (ok) {
          f32x4 wv; wv[0] = acc[mi][1][0] * 0.35355339059327373f; wv[1] = acc[mi][1][1] * 0.35355339059327373f; wv[2] = acc[mi][1][2] * 0.35355339059327373f; wv[3] = acc[mi][1][3] * 0.35355339059327373f;
          *(f32x4*)((float*)(ws + O_WI) + (size_t)row * 8 + 4 * hh) = wv;
          bf16_t* kip = (bf16_t*)(ws + O_KI) + (size_t)row * 64 + 4 * hh;
#pragma unroll
          for (int g = 1; g < 4; ++g) *(u32x2*)(kip + 8 * g - 8) = pk4(acc[mi][1][4 * g], acc[mi][1][4 * g + 1], acc[mi][1][4 * g + 2], acc[mi][1][4 * g + 3]);
        }
      } else if (wc == 2) {
        if (ok) {
          bf16_t* kip = (bf16_t*)(ws + O_KI) + (size_t)row * 64 + 24 + 4 * hh;
#pragma unroll
          for (int g = 0; g < 4; ++g) *(u32x2*)(kip + 8 * g) = pk4(acc[mi][1][4 * g], acc[mi][1][4 * g + 1], acc[mi][1][4 * g + 2], acc[mi][1][4 * g + 3]);
        }
      } else {
        if (ok) *(u32x2*)((bf16_t*)(ws + O_KI) + (size_t)row * 64 + 56 + 4 * hh) = pk4(acc[mi][1][0], acc[mi][1][1], acc[mi][1][2], acc[mi][1][3]);
      }
    }
  }
}
DI void p1_inproj_tile(const Params& P, int mt, int nt, unsigned char* lds) {
  unsigned char* ws = P.ws;
  const int m0 = mt * 256, n0 = nt * 256;
  const bf16_t* hn = (const bf16_t*)(ws + O_HN);
  TilePtrs tp;
  if (n0 < 2560) set_ptrs(tp, hn, 1024, NT, m0, (const bf16_t*)(ws + O_WIN), 1024, 2560, n0);
  else set_ptrs(tp, hn, 1024, NT, m0, (const bf16_t*)(ws + O_WG), 1024, 2048, n0 - 2560);
  f32x16 acc[4][2]; zero_acc(acc);
  const int seg = n0 / 512, cb = n0 % 512;
  if (seg == 3) {
    EPI_IDS(gemm_kloop<false>(acc, tp, 1024, lds));
    bf16_t* vbt = (bf16_t*)(ws + O_VBT);
#pragma unroll
    for (int mi = 0; mi < 4; ++mi)
#pragma unroll
      for (int ni = 0; ni < 2; ++ni) {
        const int col = cb + acc_col0(wc, ni) + lc;
        const int rbase = m0 + acc_row0(wr, mi) + 4 * hh;
        const int h = col >> 6, d = col & 63;
#pragma unroll
        for (int g = 0; g < 4; ++g) {
          const int row = rbase + 8 * g;
          if (row < NT) {
            const int b = row / L, p = row % L;
            *(u32x2*)(vbt + ((size_t)(b * 8 + h) * 64 + d) * LP + p) = pk4(acc[mi][ni][4 * g], acc[mi][ni][4 * g + 1], acc[mi][ni][4 * g + 2], acc[mi][ni][4 * g + 3]);
          }
        }
      }
    return;
  }
  EPI_IDS(gemm_kloop<true>(acc, tp, 1024, lds));
  if (seg == 0) { p1_seg0_epilogue(P, acc, m0, cb, wr, wc, hh, lc, lds); return; }
  if (n0 >= 2560) {
    bf16_t* gates = (bf16_t*)P.out;
#pragma unroll
    for (int mi = 0; mi < 4; ++mi) {
      int row = m0 + acc_row0(wr, mi) + lc;
      asm volatile("" : "+v"(row));
      const int b = row / L, p = row - b * L;
      const bool ok = row < NT && p >= NMETA;
      bf16_t* gp = gates + (size_t)(row - NMETA * (b + 1)) * 2048 + (n0 - 2560) + 8 * hh;
#pragma unroll
      for (int ni = 0; ni < 2; ++ni)
#pragma unroll
        for (int j = 0; j < 2; ++j) {
          float sg[8];
#pragma unroll
          for (int e = 0; e < 8; ++e) sg[e] = __builtin_amdgcn_rcpf(1.f + __expf(-acc[mi][ni][8 * j + e]));
          const u32x4 o = pair16(pk4(sg[0], sg[1], sg[2], sg[3]), pk4(sg[4], sg[5], sg[6], sg[7]));
          if (ok) *(u32x4*)(gp + acc_col0(wc, ni) + 16 * j) = o;
        }
    }
    return;
  }
#pragma unroll
  for (int mi = 0; mi < 4; ++mi) {
    int row = m0 + acc_row0(wr, mi) + lc;
    asm volatile("" : "+v"(row));
    const bool ok = row < NT;
    {
      bf16_t* dp = (bf16_t*)(ws + (seg == 1 ? O_QB : seg == 2 ? O_KB : O_QI)) + (size_t)row * 512 + cb + 8 * hh;
      const float sc = seg == 4 ? 0.125f : seg == 1 ? 0.125f * LOG2E : 1.f;
#pragma unroll
      for (int ni = 0; ni < 2; ++ni)
#pragma unroll
        for (int j = 0; j < 2; ++j) {
          const u32x4 o = pair16(pk4(acc[mi][ni][8 * j] * sc, acc[mi][ni][8 * j + 1] * sc, acc[mi][ni][8 * j + 2] * sc, acc[mi][ni][8 * j + 3] * sc),
                                 pk4(acc[mi][ni][8 * j + 4] * sc, acc[mi][ni][8 * j + 5] * sc, acc[mi][ni][8 * j + 6] * sc, acc[mi][ni][8 * j + 7] * sc));
          if (ok) *(u32x4*)(dp + acc_col0(wc, ni) + 16 * j) = o;
        }
    }
  }
}

DI void p2a_token(const Params& P, int t, int lane) {
  unsigned char* ws = P.ws;
  const float* sm = (const float*)(ws + O_SMALL) + (size_t)t * 512;
  const int b = t / L, p = t % L;
  {
    const f32x4 v = *(const f32x4*)(sm + S_CQ + 4 * lane);
    const float s = wave_sum(v[0] * v[0] + v[1] * v[1] + v[2] * v[2] + v[3] * v[3]);
    const float rs = rsqrtf(s * (1.f / 256) + EPS);
    const f32x4 g = *(const f32x4*)(P.g_cq + 4 * lane);
    u32x2 o; o[0] = pk2(v[0] * rs * g[0], v[1] * rs * g[1]); o[1] = pk2(v[2] * rs * g[2], v[3] * rs * g[3]);
    *(u32x2*)((bf16_t*)(ws + O_CQN) + (size_t)t * 256 + 4 * lane) = o;
  }
  {
    const float v0 = sm[S_CKV + 2 * lane], v1 = sm[S_CKV + 2 * lane + 1];
    const float s = wave_sum(v0 * v0 + v1 * v1);
    const float rs = rsqrtf(s * (1.f / 128) + EPS);
    *(unsigned*)((bf16_t*)(ws + O_CKVN) + (size_t)t * 128 + 2 * lane) = pk2(v0 * rs * P.g_ckv[2 * lane], v1 * rs * P.g_ckv[2 * lane + 1]);
  }
  {
    const float* rp = (const float*)(ws + O_ROPE) + p * 32;
    const int j = lane & 15;
    const float x1 = sm[S_KR + j], x2 = sm[S_KR + 16 + j], cs = rp[j], sn = rp[16 + j];
    const float o = (lane & 16) ? (x1 * sn + x2 * cs) : (x1 * cs - x2 * sn);
    bf16_t* km = (bf16_t*)(ws + O_KMLA);
    const bf16_t ob = f2bf(o);
    const int c = lane & 31;
#pragma unroll
    for (int hq = 0; hq < 4; ++hq) { const int h = hq + 4 * (lane >> 5); km[((size_t)(b * 8 + h) * LP + p) * 96 + 64 + c] = ob; }
  }
  ((bf16_t*)(ws + O_KI))[(size_t)t * 64 + lane] = f2bf(sm[S_KI + lane]);
  if (lane < 8) ((float*)(ws + O_WI))[(size_t)t * 8 + lane] = sm[S_WI + lane] * 0.35355339059327373f;
}

DI void p2b_q_tile(const Params& P, int tile, unsigned char* lds) {
  unsigned char* ws = P.ws;
  constexpr int NNT = 768 / 256;
  const int mt = tile / NNT, nt = tile % NNT, m0 = mt * 256, n0 = nt * 256;
  TilePtrs tp; set_ptrs(tp, (const bf16_t*)(ws + O_CQN), 256, NT, m0, (const bf16_t*)(ws + O_WUQ), 256, 768, n0);
  f32x16 acc[4][2]; zero_acc(acc);
  EPI_IDS(gemm_kloop<true>(acc, tp, 256, lds));
  const float qscale = 0.10206207261596575f * LOG2E;
  const float* rope = (const float*)(ws + O_ROPE);
  bf16_t* qa = (bf16_t*)(ws + O_QA);
#pragma unroll
  for (int mi = 0; mi < 4; ++mi) {
    int row = m0 + acc_row0(wr, mi) + lc;
    asm volatile("" : "+v"(row));
    const bool ok = row < NT;
    const int rowc = ok ? row : NT - 1, p = rowc % L;
#pragma unroll
    for (int ni = 0; ni < 2; ++ni) {
      const int c0 = n0 + acc_col0(wc, ni);
      const bool is_rope = ((c0 >> 5) % 3) == 2;
      float v[16];
#pragma unroll
      for (int r = 0; r < 16; ++r) v[r] = acc[mi][ni][r];
      if (is_rope) {
#pragma unroll
        for (int g = 0; g < 2; ++g) {
          const f32x4 cs = *(const f32x4*)(rope + p * 32 + 8 * g + 4 * hh), sn = *(const f32x4*)(rope + p * 32 + 16 + 8 * g + 4 * hh);
#pragma unroll
          for (int e = 0; e < 4; ++e) {
            const float lo = v[4 * g + e], hi = v[4 * (g + 2) + e];
            v[4 * g + e] = lo * cs[e] - hi * sn[e];
            v[4 * (g + 2) + e] = lo * sn[e] + hi * cs[e];
          }
        }
      }
#pragma unroll
      for (int j = 0; j < 2; ++j) {
        const u32x4 o = pair16(pk4(v[8 * j] * qscale, v[8 * j + 1] * qscale, v[8 * j + 2] * qscale, v[8 * j + 3] * qscale), pk4(v[8 * j + 4] * qscale, v[8 * j + 5] * qscale, v[8 * j + 6] * qscale, v[8 * j + 7] * qscale));
        if (ok) *(u32x4*)(qa + (size_t)row * 768 + c0 + 16 * j + 8 * hh) = o;
      }
    }
  }
}
DI void p2b_kv_tile(const Params& P, int tile, unsigned char* lds) {
  unsigned char* ws = P.ws;
  constexpr int NNT = 1024 / 256;
  const int mt = tile / NNT, nt = tile % NNT, m0 = mt * 256, n0 = nt * 256;
  TilePtrs tp; set_ptrs(tp, (const bf16_t*)(ws + O_CKVN), 128, NT, m0, (const bf16_t*)(ws + O_WUKV), 128, 1024, n0);
  f32x16 acc[4][2]; zero_acc(acc);
  if (nt < 2) {
    {
      const int row = m0 + (threadIdx.x >> 1);
      if (row < NT) {
        const int b = row / L, p = row % L, h = 4 * nt + 2 * (threadIdx.x & 1);
        const u32x4* src = (const u32x4*)((const bf16_t*)(ws + O_KR) + (size_t)row * 32);
        u32x4* dst = (u32x4*)((bf16_t*)(ws + O_KMLA) + ((size_t)(b * 8 + h) * LP + p) * 96 + 64);
        const u32x4 v0 = src[0], v1 = src[1], v2 = src[2], v3 = src[3];
        dst[0] = v0; dst[1] = v1; dst[2] = v2; dst[3] = v3;
        u32x4* dst2 = dst + (size_t)LP * 96 * 2 / 16;
        dst2[0] = v0; dst2[1] = v1; dst2[2] = v2; dst2[3] = v3;
      }
    }
    EPI_IDS(gemm_kloop<true>(acc, tp, 128, lds));
    bf16_t* km = (bf16_t*)(ws + O_KMLA);
#pragma unroll
    for (int mi = 0; mi < 4; ++mi) {
      int row = m0 + acc_row0(wr, mi) + lc;
      asm volatile("" : "+v"(row));
      const bool ok = row < NT;
      const int b = row / L, p = row % L;
#pragma unroll
      for (int ni = 0; ni < 2; ++ni) {
        const int cc = n0 + acc_col0(wc, ni), h = cc >> 6, c = (cc & 63) + 8 * hh;
        bf16_t* kp = km + ((size_t)(b * 8 + h) * LP + p) * 96 + c;
#pragma unroll
        for (int j = 0; j < 2; ++j) {
          const u32x4 o = pair16(pk4(acc[mi][ni][8 * j], acc[mi][ni][8 * j + 1], acc[mi][ni][8 * j + 2], acc[mi][ni][8 * j + 3]), pk4(acc[mi][ni][8 * j + 4], acc[mi][ni][8 * j + 5], acc[mi][ni][8 * j + 6], acc[mi][ni][8 * j + 7]));
          if (ok) *(u32x4*)(kp + 16 * j) = o;
        }
      }
    }
  } else {
    EPI_IDS(gemm_kloop<false>(acc, tp, 128, lds));
    bf16_t* vt = (bf16_t*)(ws + O_VT);
#pragma unroll
    for (int mi = 0; mi < 4; ++mi)
#pragma unroll
      for (int ni = 0; ni < 2; ++ni) {
        const int cc = n0 - 512 + acc_col0(wc, ni) + lc, h = cc >> 6, d = cc & 63;
        const int rbase = m0 + acc_row0(wr, mi) + 4 * hh;
#pragma unroll
        for (int g = 0; g < 4; ++g) {
          const int row = rbase + 8 * g;
          if (row < NT) {
            const int b = row / L, p = row % L;
            *(u32x2*)(vt + ((size_t)(b * 8 + h) * 64 + d) * LP + p) = pk4(acc[mi][ni][4 * g], acc[mi][ni][4 * g + 1], acc[mi][ni][4 * g + 2], acc[mi][ni][4 * g + 3]);
          }
        }
      }
  }
}


DI int next_item(const Params& P, int ctr, int* slot) {
  __syncthreads();
  if (threadIdx.x == 0) *slot = (int)atomicAdd((unsigned*)(P.ws + O_CTR) + ctr, 1u);
  __syncthreads();
  return *slot;
}
DI float fast_exp2(float x) { return __builtin_amdgcn_exp2f(x); }
DI bf16x8 pack8(const f32x16& v, int s) {
  u32x4 p;
  p[0] = pk2(v[8 * s + 0], v[8 * s + 1]); p[1] = pk2(v[8 * s + 2], v[8 * s + 3]); p[2] = pk2(v[8 * s + 4], v[8 * s + 5]); p[3] = pk2(v[8 * s + 6], v[8 * s + 7]);
  return __builtin_bit_cast(bf16x8, p);
}

constexpr float MASKV = -3.0e38f;
constexpr float DEFER_THR = 6.0f;
DI float xmax32(float v) {
  const auto r = __builtin_amdgcn_permlane32_swap(__float_as_uint(v), __float_as_uint(v), false, false);
  return fmaxf(__uint_as_float(r[0]), __uint_as_float(r[1]));
}
DI void softmax_update1(f32x16& s, float& m, float mref, float& lsum, f32x16& o0, f32x16& o1) {
  float mx = s[0];
#pragma unroll
  for (int r = 1; r < 16; ++r) mx = fmaxf(mx, s[r]);
  mx = xmax32(mx);
  const bool have = m > -1e29f;
  const float shift = (have ? m : 0.f) - mref;
  const bool need = (mx - shift > DEFER_THR) || (!have && mx > -1e37f);
  if (__any(need || shift != 0.f)) {
    const float delta = need ? mx - shift : 0.f;
    const float alpha = (need && have) ? fast_exp2(-delta) : 1.f;
    m = need ? (have ? m : 0.f) + delta : m;
    const float sub = shift + delta;
#pragma unroll
    for (int r = 0; r < 16; ++r) { s[r] -= sub; o0[r] *= alpha; o1[r] *= alpha; }
    lsum *= alpha;
  }
#pragma unroll
  for (int r = 0; r < 16; ++r) s[r] = fast_exp2(s[r]);
  typedef float f32x2 __attribute__((ext_vector_type(2)));
  f32x2 ps = {0.f, 0.f};
#pragma unroll
  for (int r = 0; r < 16; r += 2) ps += (f32x2){s[r], s[r + 1]};
  lsum += ps[0] + ps[1];
}
DI void pv_subtile(const unsigned char* Vc, int vstr, const f32x16& p, f32x16& o0, f32x16& o1) {
#pragma unroll
  for (int s2 = 0; s2 < 2; ++s2) {
    const bf16x8 pb = pack8(p, s2);
    const u32x2 a0l = *(const u32x2*)(Vc + s2 * 32), a0h = *(const u32x2*)(Vc + s2 * 32 + 16);
    const u32x2 a1l = *(const u32x2*)(Vc + 32 * vstr + s2 * 32), a1h = *(const u32x2*)(Vc + 32 * vstr + s2 * 32 + 16);
    o0 = __builtin_amdgcn_mfma_f32_32x32x16_bf16(__builtin_bit_cast(bf16x8, (u32x4){a0l[0], a0l[1], a0h[0], a0h[1]}), pb, o0, 0, 0, 0);
    o1 = __builtin_amdgcn_mfma_f32_32x32x16_bf16(__builtin_bit_cast(bf16x8, (u32x4){a1l[0], a1l[1], a1h[0], a1h[1]}), pb, o1, 0, 0, 0);
  }
}
constexpr int MLA_KSTR = 208, MLA_VSTR = 136, MLA_KBYTES = 64 * MLA_KSTR, MLA_STAGE = MLA_KBYTES + 64 * MLA_VSTR;
DI void mla_stage(const unsigned char* cur, int s, int cw, int lq, int hh, const bf16x8 (&qf)[6], f32x16& o0, f32x16& o1, float& m, float& lsum) {
  if (s > cw) return;
  const bool full = s < cw;
  const float mref = m > -1e29f ? m : 0.f;
  f32x16 s0, s1;
#pragma unroll
  for (int r = 0; r < 16; ++r) { s0[r] = -mref; s1[r] = -mref; }
  const unsigned char* Kc = cur + lq * MLA_KSTR + hh * 16;
  {
    bf16x8 kf[6];
#pragma unroll
    for (int kk = 0; kk < 6; ++kk) kf[kk] = *(const bf16x8*)(Kc + kk * 32);
#pragma unroll
    for (int kk = 0; kk < 6; ++kk) s0 = __builtin_amdgcn_mfma_f32_32x32x16_bf16(kf[kk], qf[kk], s0, 0, 0, 0);
    __builtin_amdgcn_sched_group_barrier(0x100, 6, 0);
    __builtin_amdgcn_sched_group_barrier(0x008, 6, 0);
  }
  if (full) {
    bf16x8 kf[6];
#pragma unroll
    for (int kk = 0; kk < 6; ++kk) kf[kk] = *(const bf16x8*)(Kc + 32 * MLA_KSTR + kk * 32);
#pragma unroll
    for (int kk = 0; kk < 6; ++kk) s1 = __builtin_amdgcn_mfma_f32_32x32x16_bf16(kf[kk], qf[kk], s1, 0, 0, 0);
    __builtin_amdgcn_sched_group_barrier(0x100, 6, 0);
    __builtin_amdgcn_sched_group_barrier(0x008, 6, 0);
  } else {
#pragma unroll
    for (int r = 8; r < 16; ++r) s0[r] = MASKV;
  }
  const unsigned char* Vc = cur + MLA_KBYTES + lq * MLA_VSTR + hh * 8;
  softmax_update1(s0, m, mref, lsum, o0, o1);
  pv_subtile(Vc, MLA_VSTR, s0, o0, o1);
  if (full) {
    softmax_update1(s1, m, mref, lsum, o0, o1);
    pv_subtile(Vc + 64, MLA_VSTR, s1, o0, o1);
  }
}
DI void mla_item(const Params& P, int item, unsigned char* lds) {
  unsigned char* ws = P.ws;
  const int jq = 15 - item / 32, bh = item % 32, b = bh >> 3, h = bh & 7;
  const int c0 = 4 * jq + 1;
  const int tid = threadIdx.x, lane = tid & 63, w = __builtin_amdgcn_readfirstlane(tid >> 6), hh = lane >> 5, lq = lane & 31;
  const int cw = c0 + (w >> 1);
  const int pq = NMETA + 256 * jq + 32 * w + lq;
  const int tq = b * L + pq;
  bf16x8 qf[6];
  {
    const bf16_t* qrow = (const bf16_t*)(ws + O_QA) + (size_t)tq * 768 + h * 96 + hh * 8;
#pragma unroll
    for (int kk = 0; kk < 6; ++kk) qf[kk] = *(const bf16x8*)(qrow + kk * 16);
  }
  f32x16 o0, o1;
#pragma unroll
  for (int r = 0; r < 16; ++r) { o0[r] = 0.f; o1[r] = 0.f; }
  float m = -1e30f, lsum = 0.f;
  const int nst = c0 + 4;
  const bf16_t* kg = (const bf16_t*)(ws + O_KMLA) + (size_t)bh * LP * 96;
  const bf16_t* vg = (const bf16_t*)(ws + O_VT) + (size_t)bh * 64 * LP;
  unsigned kgo[2], klo[2], vgo, vlo;
  const bool k2 = tid < 256;
#pragma unroll
  for (int i = 0; i < 2; ++i) { int idx = tid + 512 * i; idx = idx < 768 ? idx : 767; const int row = idx / 12, c = idx % 12; kgo[i] = row * 96 + c * 8; klo[i] = row * MLA_KSTR + c * 16; }
  { const int d = tid >> 3, c = tid & 7; vgo = d * LP + c * 8; vlo = MLA_KBYTES + d * MLA_VSTR + c * 16; }
  u32x4 rkA[2][2], rvA[2], rkB[2][2], rvB[2];
#define MLA_LOAD(rk_, rv_, st) do { const bf16_t* kgs = kg + (size_t)(st) * 64 * 96; const bf16_t* vgs = vg + (st) * 64; \
    rk_[0] = *(const u32x4*)(kgs + kgo[0]); rk_[1] = *(const u32x4*)(kgs + kgo[1]); rv_ = *(const u32x4*)(vgs + vgo); } while (0)
#define MLA_WRITE(rk_, rv_, buf) do { unsigned char* nb_ = (buf); \
    *(u32x4*)(nb_ + klo[0]) = rk_[0]; if (k2) *(u32x4*)(nb_ + klo[1]) = rk_[1]; \
    *(u32x2*)(nb_ + vlo) = (u32x2){rv_[0], rv_[1]}; *(u32x2*)(nb_ + vlo + 8) = (u32x2){rv_[2], rv_[3]}; } while (0)
#define MLA_LOAD2(rk_, rv_, S_) do { MLA_LOAD(rk_[0], rv_[0], 2 * (S_)); MLA_LOAD(rk_[1], rv_[1], min(2 * (S_) + 1, nst - 1)); } while (0)
#define MLA_WRITE2(rk_, rv_, buf) do { MLA_WRITE(rk_[0], rv_[0], buf); MLA_WRITE(rk_[1], rv_[1], (buf) + MLA_STAGE); } while (0)
  const int nS = (nst + 1) >> 1;
  unsigned char* buf0 = lds; unsigned char* buf1 = lds + 2 * MLA_STAGE;
  MLA_LOAD2(rkA, rvA, 0); MLA_WRITE2(rkA, rvA, buf0);
  __syncthreads();
  if (nS > 1) MLA_LOAD2(rkA, rvA, 1);
#pragma unroll 1
  for (int S = 0; S < nS; S += 2) {
    if (S + 2 < nS) MLA_LOAD2(rkB, rvB, S + 2);
    mla_stage(buf0, 2 * S, cw, lq, hh, qf, o0, o1, m, lsum);
    mla_stage(buf0 + MLA_STAGE, 2 * S + 1, cw, lq, hh, qf, o0, o1, m, lsum);
    if (S + 1 < nS) MLA_WRITE2(rkA, rvA, buf1);
    __syncthreads();
    if (S + 1 >= nS) break;
    if (S + 3 < nS) MLA_LOAD2(rkA, rvA, S + 3);
    mla_stage(buf1, 2 * S + 2, cw, lq, hh, qf, o0, o1, m, lsum);
    mla_stage(buf1 + MLA_STAGE, 2 * S + 3, cw, lq, hh, qf, o0, o1, m, lsum);
    if (S + 2 < nS) MLA_WRITE2(rkB, rvB, buf0);
    __syncthreads();
  }
#undef MLA_LOAD2
#undef MLA_WRITE2
#undef MLA_LOAD
#undef MLA_WRITE
  lsum += __shfl_xor(lsum, 32);
  const float inv = 1.f / lsum;
  bf16_t* oa = (bf16_t*)(ws + O_OA) + (size_t)(tq - NMETA * (b + 1)) * 512 + h * 64 + 8 * hh;
#pragma unroll
  for (int j = 0; j < 2; ++j) {
    *(u32x4*)(oa + 16 * j) = pair16(pk4(o0[8 * j] * inv, o0[8 * j + 1] * inv, o0[8 * j + 2] * inv, o0[8 * j + 3] * inv), pk4(o0[8 * j + 4] * inv, o0[8 * j + 5] * inv, o0[8 * j + 6] * inv, o0[8 * j + 7] * inv));
    *(u32x4*)(oa + 32 + 16 * j) = pair16(pk4(o1[8 * j] * inv, o1[8 * j + 1] * inv, o1[8 * j + 2] * inv, o1[8 * j + 3] * inv), pk4(o1[8 * j + 4] * inv, o1[8 * j + 5] * inv, o1[8 * j + 6] * inv, o1[8 * j + 7] * inv));
  }
}


DI size_t score_row_off(int b, int i) {
  const int c = 1 + (i >> 6), m = c - 1;
  return (size_t)b * SCORES_PER_BATCH + (size_t)8192 * (m + (m >> 1) * ((m + 1) >> 1)) + (size_t)(i & 63) * (128 * ((c >> 1) + 1));
}
constexpr int S1_ITEMS = 4 * 560;
DI void s1_item(const Params& P, int it) {
  unsigned char* ws = P.ws;
  const int b = it & 3; int r = it >> 2; int c = 64;
  while (r >= (c >> 2) + 1) { r -= (c >> 2) + 1; --c; }
  const int n = 16 + 64 * c;
  const int lane = threadIdx.x & 63, w = (threadIdx.x >> 6) & 3, lq = lane & 15, lg = lane >> 4;
  const int i = (c - 1) * 64 + 16 * w + lq, tq = b * L + NMETA + i;
  bf16x8 qf[8][2];
  const bf16_t* qrow = (const bf16_t*)(ws + O_QI) + (size_t)tq * 512 + 8 * lg;
#pragma unroll
  for (int h = 0; h < 8; ++h) { qf[h][0] = *(const bf16x8*)(qrow + h * 64); qf[h][1] = *(const bf16x8*)(qrow + h * 64 + 32); }
  const f32x4 wa = *(const f32x4*)((const float*)(ws + O_WI) + (size_t)tq * 8), wb = *(const f32x4*)((const float*)(ws + O_WI) + (size_t)tq * 8 + 4);
  const float wv[8] = {wa[0], wa[1], wa[2], wa[3], wb[0], wb[1], wb[2], wb[3]};
  unsigned* srow = (unsigned*)((_Float16*)(ws + O_SCORES) + score_row_off(b, i)) + 4 * lg;
  const bf16_t* kbase = (const bf16_t*)(ws + O_KI) + ((size_t)b * L + lq) * 64 + 8 * lg;
#pragma unroll 1
  for (int g2 = 0; g2 < 2; ++g2) {
    const int kg = 256 * r + 128 * g2;
#pragma unroll 1
    for (int kt4 = 0; kt4 < 64; kt4 += 16) {
      const int ka = kg + kt4, kb = ka + 64;
      if (ka >= n) break;
      f32x4 sa = {0.f, 0.f, 0.f, 0.f}, sb = {0.f, 0.f, 0.f, 0.f};
      {
        const bf16_t* kp = kbase + (size_t)ka * 64;
        const bf16x8 a0 = *(const bf16x8*)kp, a1 = *(const bf16x8*)(kp + 32);
#pragma unroll
        for (int h = 0; h < 8; ++h) {
          f32x4 acc = {0.f, 0.f, 0.f, 0.f};
          acc = __builtin_amdgcn_mfma_f32_16x16x32_bf16(a0, qf[h][0], acc, 0, 0, 0);
          acc = __builtin_amdgcn_mfma_f32_16x16x32_bf16(a1, qf[h][1], acc, 0, 0, 0);
#pragma unroll
          for (int q = 0; q < 4; ++q) sa[q] = fmaf(wv[h], fmaxf(acc[q], 0.f), sa[q]);
        }
      }
      if (kb < n) {
        const bf16_t* kp = kbase + (size_t)kb * 64;
        const bf16x8 a0 = *(const bf16x8*)kp, a1 = *(const bf16x8*)(kp + 32);
#pragma unroll
        for (int h = 0; h < 8; ++h) {
          f32x4 acc = {0.f, 0.f, 0.f, 0.f};
          acc = __builtin_amdgcn_mfma_f32_16x16x32_bf16(a0, qf[h][0], acc, 0, 0, 0);
          acc = __builtin_amdgcn_mfma_f32_16x16x32_bf16(a1, qf[h][1], acc, 0, 0, 0);
#pragma unroll
          for (int q = 0; q < 4; ++q) sb[q] = fmaf(wv[h], fmaxf(acc[q], 0.f), sb[q]);
        }
      }
      typedef _Float16 h2_t __attribute__((ext_vector_type(2)));
      u32x4 o;
#pragma unroll
      for (int q = 0; q < 4; ++q) { const h2_t v = {(_Float16)sa[q], (_Float16)sb[q]}; o[q] = __builtin_bit_cast(unsigned, v); }
      *(u32x4*)(srow + (kg >> 1) + kt4) = o;
    }
  }
}

DI unsigned f2key(float f) { const unsigned u = __float_as_uint(f); return (u & 0x80000000u) ? ~u : (u | 0x80000000u); }
DI unsigned long long lanemask_lt(int lane) { return (1ull << lane) - 1ull; }
template <int NG>
DI void s2_row(const Params& P, int rq, int lane, const unsigned* srow  ) {
  const int i = rq % SEQ, c = 1 + (i >> 6), n = 16 + 64 * c;
  typedef unsigned short u16x2 __attribute__((ext_vector_type(2)));
  u16x2 hp[NG];
  {
    unsigned raw[NG];
#pragma unroll
    for (int e = 0; e < NG; ++e) raw[e] = srow[64 * e];
#pragma unroll
    for (int e = 0; e < NG; ++e) asm volatile("" : "+v"(raw[e]));
#pragma unroll
    for (int e = 0; e < NG; ++e) {
      const unsigned d = raw[e];
      unsigned k = d ^ ((((d >> 15) & 0x00010001u) * 0xffffu) | 0x80008000u);
      if (128 * e + lane >= n) k &= 0xffff0000u;
      if (128 * e + 64 + lane >= n) k &= 0x0000ffffu;
      hp[e] = __builtin_bit_cast(u16x2, k);
    }
  }
  unsigned T = 0; int c_lo = 1 << 30, c_hi = 0;
  for (int bit = 15; bit >= 0; --bit) {
    const unsigned cand = T | (1u << bit);
    const unsigned short chm1 = (unsigned short)(cand - 1u);
    const u16x2 cv = {chm1, chm1}, one = {1, 1};
    u16x2 a0 = {0, 0}, a1 = {0, 0};
#pragma unroll
    for (int e = 0; e < NG; ++e) {
      u16x2 t;
      asm("v_pk_sub_u16 %0, %1, %2 clamp" : "=v"(t) : "v"(hp[e]), "v"(cv));
      asm("v_pk_min_u16 %0, %1, %2" : "=v"(t) : "v"(t), "v"(one));
      if (e & 1) asm("v_pk_add_u16 %0, %1, %2" : "=v"(a1) : "v"(a1), "v"(t)); else asm("v_pk_add_u16 %0, %1, %2" : "=v"(a0) : "v"(a0), "v"(t));
    }
    const u16x2 as = a0 + a1;
    const int cc = wave_sumi((int)as[0] + (int)as[1]);
    if (cc >= 256) { T = cand; c_lo = cc; } else { c_hi = cc; }
    if (c_lo == 256) break;
  }
  unsigned mlo = 0u, mhi = 0u;
  unsigned long long w64 = 0ull;
  int rem = c_lo == 256 ? (1 << 20) : 256 - c_hi;
#pragma unroll
  for (int e = 0; e < NG; ++e) {
    const unsigned kk = __builtin_bit_cast(unsigned, hp[e]);
#pragma unroll
    for (int h = 0; h < 2; ++h) {
      const unsigned kv = h ? (kk >> 16) : (kk & 0xffffu);
      const bool eq = kv == T;
      const unsigned long long meq = __ballot(eq), mgt = __ballot(kv > T);
      unsigned long long msel = mgt;
      if (meq) {
        const int pre = __popcll(meq & lanemask_lt(lane));
        msel |= __ballot(eq && pre < rem);
        rem -= __popcll(meq); rem = rem < 0 ? 0 : rem;
      }
      const int wd = 2 * e + h;
      if (wd < 64) { if (lane == wd) { mlo = (unsigned)msel; mhi = (unsigned)(msel >> 32); } } else if (wd == 64) w64 = msel;
    }
  }
  unsigned* mrow = (unsigned*)(P.ws + O_MASK) + (size_t)rq * MW;
  *(u32x2*)(mrow + 2 * lane) = (u32x2){mlo, mhi};
  if (lane == 0) { *(u32x2*)(mrow + 128) = (u32x2){(unsigned)w64, (unsigned)(w64 >> 32)}; *(u32x2*)(mrow + 130) = (u32x2){0u, 0u}; }
}
DI void s2_dispatch(const Params& P, int rq, int lane, const unsigned* srow) {
  const int c = 1 + ((rq % SEQ) >> 6), n = 16 + 64 * c;
  if (n <= 256) {
    unsigned* mrow = (unsigned*)(P.ws + O_MASK) + (size_t)rq * MW;
    unsigned long long m = 0ull;
    const int lo = 64 * lane;
    if (lo + 64 <= n) m = ~0ull; else if (lo < n) m = (1ull << (n - lo)) - 1ull;
    *(u32x2*)(mrow + 2 * lane) = (u32x2){(unsigned)m, (unsigned)(m >> 32)};
    if (lane == 0) { *(u32x2*)(mrow + 128) = (u32x2){0u, 0u}; *(u32x2*)(mrow + 130) = (u32x2){0u, 0u}; }
    return;
  }
  const int ng = (c >> 1) + 1;
  if (ng <= 5) s2_row<5>(P, rq, lane, srow);
  else if (ng <= 9) s2_row<9>(P, rq, lane, srow);
  else if (ng <= 13) s2_row<13>(P, rq, lane, srow);
  else if (ng <= 17) s2_row<17>(P, rq, lane, srow);
  else if (ng <= 21) s2_row<21>(P, rq, lane, srow);
  else if (ng <= 25) s2_row<25>(P, rq, lane, srow);
  else if (ng <= 29) s2_row<29>(P, rq, lane, srow);
  else s2_row<33>(P, rq, lane, srow);
}

constexpr int S12_ITEMS = 1024;
DI void s12_item(const Params& P, int item, unsigned char* lds) {
  unsigned char* ws = P.ws;
  const int c = 64 - (item >> 4), sub = (item >> 2) & 3, b = item & 3;
  const int n = 16 + 64 * c, ng = (c >> 1) + 1;
  const int tid = threadIdx.x, lane = tid & 63, w = __builtin_amdgcn_readfirstlane(tid >> 6), lq = lane & 15, lg = lane >> 4;
  const int i0 = (c - 1) * 64 + 16 * sub;
  unsigned* sc = (unsigned*)lds;
  if (n > 256) {
    const int tq = b * L + NMETA + i0 + lq;
    bf16x8 qf[8][2];
    {
      unsigned char* ql = lds + LDS_Q;
#pragma unroll
      for (int i = 0; i < 2; ++i) {
        const int c = tid + 512 * i, qq = c >> 6, dc = c & 63;
        *(u32x4*)(ql + qq * 1040 + dc * 16) = *(const u32x4*)((const bf16_t*)(ws + O_QI) + (size_t)(b * L + NMETA + i0 + qq) * 512 + dc * 8);
      }
      __syncthreads();
      const unsigned char* qr = ql + lq * 1040 + lg * 16;
#pragma unroll
      for (int h = 0; h < 8; ++h) { qf[h][0] = *(const bf16x8*)(qr + h * 128); qf[h][1] = *(const bf16x8*)(qr + h * 128 + 64); }
    }
    const f32x4 wa = *(const f32x4*)((const float*)(ws + O_WI) + (size_t)tq * 8), wb = *(const f32x4*)((const float*)(ws + O_WI) + (size_t)tq * 8 + 4);
    const float wv[8] = {wa[0], wa[1], wa[2], wa[3], wb[0], wb[1], wb[2], wb[3]};
    unsigned* srow = sc + lq * S12_STRIDE + 4 * lg;
    const bf16_t* kbase = (const bf16_t*)(ws + O_KI) + ((size_t)b * L + lq) * 64 + 8 * lg;
    const int npair = 4 * ng, klast = n - 16;
    bf16x8 kr[3][4];
#define S12_LOAD(slot_, pi_) do { const int ka_ = 128 * ((pi_) >> 2) + 16 * ((pi_) & 3); \
      const bf16_t* pa_ = kbase + (size_t)min(ka_, klast) * 64; const bf16_t* pb_ = kbase + (size_t)min(ka_ + 64, klast) * 64; \
      kr[slot_][0] = *(const bf16x8*)pa_; kr[slot_][1] = *(const bf16x8*)(pa_ + 32); kr[slot_][2] = *(const bf16x8*)pb_; kr[slot_][3] = *(const bf16x8*)(pb_ + 32); } while (0)
    S12_LOAD(0, w);
    if (w + 8 < npair) S12_LOAD(1, w + 8);
#pragma unroll 1
    for (int base = w; base < npair; base += 24) {
#pragma unroll
      for (int u = 0; u < 3; ++u) {
        const int pi = base + 8 * u;
        if (pi >= npair) break;
        if (pi + 16 < npair) S12_LOAD((u + 2) % 3, pi + 16);
        f32x4 sa = {0.f, 0.f, 0.f, 0.f}, sb = {0.f, 0.f, 0.f, 0.f};
#pragma unroll
        for (int h = 0; h < 8; ++h) {
          f32x4 acc = {0.f, 0.f, 0.f, 0.f}, acc2 = {0.f, 0.f, 0.f, 0.f};
          acc = __builtin_amdgcn_mfma_f32_16x16x32_bf16(kr[u][0], qf[h][0], acc, 0, 0, 0);
          acc2 = __builtin_amdgcn_mfma_f32_16x16x32_bf16(kr[u][2], qf[h][0], acc2, 0, 0, 0);
          acc = __builtin_amdgcn_mfma_f32_16x16x32_bf16(kr[u][1], qf[h][1], acc, 0, 0, 0);
          acc2 = __builtin_amdgcn_mfma_f32_16x16x32_bf16(kr[u][3], qf[h][1], acc2, 0, 0, 0);
          {
            typedef float f32x2 __attribute__((ext_vector_type(2)));
            float ra[4], rb[4];
#pragma unroll
            for (int q = 0; q < 4; ++q) { ra[q] = __int_as_float(max(__float_as_int(acc[q]), 0)); rb[q] = __int_as_float(max(__float_as_int(acc2[q]), 0)); }
            const f32x2 w2 = {wv[h], wv[h]};
#pragma unroll
            for (int q = 0; q < 4; q += 2) {
              f32x2 t = {sa[q], sa[q + 1]}; t = __builtin_elementwise_fma(w2, (f32x2){ra[q], ra[q + 1]}, t); sa[q] = t[0]; sa[q + 1] = t[1];
              f32x2 u = {sb[q], sb[q + 1]}; u = __builtin_elementwise_fma(w2, (f32x2){rb[q], rb[q + 1]}, u); sb[q] = u[0]; sb[q + 1] = u[1];
            }
          }
        }
        typedef _Float16 h2_t __attribute__((ext_vector_type(2)));
        u32x4 o;
#pragma unroll
        for (int q = 0; q < 4; ++q) { const h2_t v = {(_Float16)sa[q], (_Float16)sb[q]}; o[q] = __builtin_bit_cast(unsigned, v); }
        *(u32x4*)(srow + 64 * (pi >> 2) + 16 * (pi & 3)) = o;
      }
    }
#undef S12_LOAD
  }
  __syncthreads();
#pragma unroll 1
  for (int rr = 0; rr < 2; ++rr) {
    const int q = 2 * w + rr;
    int lane_b = lane; asm volatile("" : "+v"(lane_b));
    s2_dispatch(P, b * SEQ + i0 + q, lane_b, sc + q * S12_STRIDE + lane_b);
  }
  __syncthreads();
}

DI int t5_bucket(int rel) {
  const int n = rel < 0 ? -rel : rel;
  int v;
  if (n < 8) v = n;
  else v = 8 + (n >= 12) + (n >= 16) + (n >= 23) + (n >= 32) + (n >= 46) + (n >= 64) + (n >= 91);
  return (rel > 0 ? 16 : 0) + v;
}
constexpr int DSA_KSTR = 144, DSA_VSTR = 136, DSA_KBYTES = 64 * DSA_KSTR, DSA_STAGE = DSA_KBYTES + 64 * DSA_VSTR;
constexpr int DSA_TB = 2 * DSA_STAGE;
DI void dsa_stage(const unsigned char* cur, int s, int cw, int lq, int hh, int pq, int qmin, float bfar, const float* tb, const unsigned* mrow,
                  const bf16x8 (&qf)[4], f32x16& o0, f32x16& o1, float& m, float& lsum) {
  if (s > cw) return;
  const bool full = s < cw;
  const int kb0 = 64 * s;
  const bool near = kb0 + 63 >= qmin - 91;
  const u32x2 mw = *(const u32x2*)(mrow + 2 * s);
  const unsigned w0 = mw[0] >> (4 * hh), w1 = mw[1] >> (4 * hh);
  const float mref = m > -1e29f ? m : 0.f;
  f32x16 s0, s1;
  const float binit = (near ? 0.f : bfar) - mref;
#pragma unroll
  for (int r = 0; r < 16; ++r) { s0[r] = binit; s1[r] = binit; }
  const unsigned char* Kc = cur + lq * DSA_KSTR + hh * 16;
  {
    bf16x8 kf[4];
#pragma unroll
    for (int kk = 0; kk < 4; ++kk) kf[kk] = *(const bf16x8*)(Kc + kk * 32);
#pragma unroll
    for (int kk = 0; kk < 4; ++kk) s0 = __builtin_amdgcn_mfma_f32_32x32x16_bf16(kf[kk], qf[kk], s0, 0, 0, 0);
    __builtin_amdgcn_sched_group_barrier(0x100, 4, 0);
    __builtin_amdgcn_sched_group_barrier(0x008, 4, 0);
  }
  if (full) {
    bf16x8 kf[4];
#pragma unroll
    for (int kk = 0; kk < 4; ++kk) kf[kk] = *(const bf16x8*)(Kc + 32 * DSA_KSTR + kk * 32);
#pragma unroll
    for (int kk = 0; kk < 4; ++kk) s1 = __builtin_amdgcn_mfma_f32_32x32x16_bf16(kf[kk], qf[kk], s1, 0, 0, 0);
    __builtin_amdgcn_sched_group_barrier(0x100, 4, 0);
    __builtin_amdgcn_sched_group_barrier(0x008, 4, 0);
  }
  const float* tp = tb + (kb0 + 4 * hh - pq + 192);
  const unsigned char* Vc = cur + DSA_KBYTES + lq * DSA_VSTR + hh * 8;
  if (near) {
#pragma unroll
    for (int r = 0; r < 16; ++r) s0[r] += tp[(r & 3) + 8 * (r >> 2)];
  }
#pragma unroll
  for (int r = 0; r < 16; ++r) s0[r] = (w0 & (1u << ((r & 3) + 8 * (r >> 2)))) ? s0[r] : MASKV;
  softmax_update1(s0, m, mref, lsum, o0, o1);
  pv_subtile(Vc, DSA_VSTR, s0, o0, o1);
  if (full) {
    if (near) {
#pragma unroll
      for (int r = 0; r < 16; ++r) s1[r] += tp[32 + (r & 3) + 8 * (r >> 2)];
    }
#pragma unroll
    for (int r = 0; r < 16; ++r) s1[r] = (w1 & (1u << ((r & 3) + 8 * (r >> 2)))) ? s1[r] : MASKV;
    softmax_update1(s1, m, mref, lsum, o0, o1);
    pv_subtile(Vc + 64, DSA_VSTR, s1, o0, o1);
  }
}
DI void dsa_item(const Params& P, int item, unsigned char* lds) {
  unsigned char* ws = P.ws;
  const int jq = 15 - item / 32, bh = item % 32, b = bh >> 3, h = bh & 7;
  const int c0 = 4 * jq + 1;
  const int tid = threadIdx.x, lane = tid & 63, w = __builtin_amdgcn_readfirstlane(tid >> 6), hh = lane >> 5, lq = lane & 31;
  const int cw = c0 + (w >> 1);
  const int pq = NMETA + 256 * jq + 32 * w + lq;
  const int tq = b * L + pq, rq = b * SEQ + pq - NMETA;
  const int qmin = NMETA + 256 * jq + 32 * w;
  float* tb = (float*)(lds + DSA_TB);
  __syncthreads();
  if (tid < 256) tb[tid] = P.rel_bias[t5_bucket(tid - 192) * 8 + h] * LOG2E;
  const float bfar = P.rel_bias[15 * 8 + h] * LOG2E;
  bf16x8 qf[4];
  {
    const bf16_t* qrow = (const bf16_t*)(ws + O_QB) + (size_t)tq * 512 + h * 64 + hh * 8;
#pragma unroll
    for (int kk = 0; kk < 4; ++kk) qf[kk] = *(const bf16x8*)(qrow + kk * 16);
  }
  const unsigned* mrow = (const unsigned*)(P.ws + O_MASK) + (size_t)rq * MW;
  f32x16 o0, o1;
#pragma unroll
  for (int r = 0; r < 16; ++r) { o0[r] = 0.f; o1[r] = 0.f; }
  float m = -1e30f, lsum = 0.f;
  const int nst = c0 + 4;
  const bf16_t* kg = (const bf16_t*)(ws + O_KB) + (size_t)b * L * 512 + h * 64;
  const bf16_t* vg = (const bf16_t*)(ws + O_VBT) + (size_t)bh * 64 * LP;
  const int srow = tid >> 3, sc = tid & 7;
  const unsigned kgo = srow * 512 + sc * 8, klo = srow * DSA_KSTR + sc * 16, vgo = srow * LP + sc * 8, vlo = DSA_KBYTES + srow * DSA_VSTR + sc * 16;
  u32x4 rkA, rvA, rkB, rvB;
#define DSA_LOAD(rk_, rv_, st) do { const int kn = (st) * 64; const int kr = min(kn + srow, L - 1) - srow; \
    rk_ = *(const u32x4*)(kg + (size_t)kr * 512 + kgo); rv_ = *(const u32x4*)(vg + kn + vgo); } while (0)
#define DSA_WRITE(rk_, rv_, buf) do { unsigned char* nb_ = (buf); *(u32x4*)(nb_ + klo) = rk_; \
    *(u32x2*)(nb_ + vlo) = (u32x2){rv_[0], rv_[1]}; *(u32x2*)(nb_ + vlo + 8) = (u32x2){rv_[2], rv_[3]}; } while (0)
  unsigned char* buf0 = lds; unsigned char* buf1 = lds + DSA_STAGE;
  DSA_LOAD(rkA, rvA, 0); DSA_WRITE(rkA, rvA, buf0);
  __syncthreads();
  if (nst > 1) DSA_LOAD(rkA, rvA, 1);
#pragma unroll 1
  for (int s = 0; s < nst; s += 2) {
    if (s + 2 < nst) DSA_LOAD(rkB, rvB, s + 2);
    dsa_stage(buf0, s, cw, lq, hh, pq, qmin, bfar, tb, mrow, qf, o0, o1, m, lsum);
    if (s + 1 < nst) DSA_WRITE(rkA, rvA, buf1);
    __syncthreads();
    if (s + 1 >= nst) break;
    if (s + 3 < nst) DSA_LOAD(rkA, rvA, s + 3);
    dsa_stage(buf1, s + 1, cw, lq, hh, pq, qmin, bfar, tb, mrow, qf, o0, o1, m, lsum);
    if (s + 2 < nst) DSA_WRITE(rkB, rvB, buf0);
    __syncthreads();
  }
#undef DSA_LOAD
#undef DSA_WRITE
  lsum += __shfl_xor(lsum, 32);
  const float inv = 1.f / lsum;
  bf16_t* ob = (bf16_t*)(ws + O_OB) + (size_t)rq * 512 + h * 64 + 8 * hh;
#pragma unroll
  for (int j = 0; j < 2; ++j) {
    *(u32x4*)(ob + 16 * j) = pair16(pk4(o0[8 * j] * inv, o0[8 * j + 1] * inv, o0[8 * j + 2] * inv, o0[8 * j + 3] * inv), pk4(o0[8 * j + 4] * inv, o0[8 * j + 5] * inv, o0[8 * j + 6] * inv, o0[8 * j + 7] * inv));
    *(u32x4*)(ob + 32 + 16 * j) = pair16(pk4(o1[8 * j] * inv, o1[8 * j + 1] * inv, o1[8 * j + 2] * inv, o1[8 * j + 3] * inv), pk4(o1[8 * j + 4] * inv, o1[8 * j + 5] * inv, o1[8 * j + 6] * inv, o1[8 * j + 7] * inv));
  }
}

template <bool CHECK> DI void nv_mla(const Params& P, int vb, unsigned char* lds) {
  unsigned char* ws = P.ws;
  float* qs = (float*)lds;
  const int b = vb / SEQ, p = NMETA + vb % SEQ, t = b * L + p;
  const int tid = threadIdx.x & 255, h = tid >> 5, l = tid & 31;
  const bf16_t* qa = (const bf16_t*)(ws + O_QA) + (size_t)t * 768;
  for (int i = tid; i < 768; i += 256) qs[i] = bf2f(qa[i]);
  __syncthreads();
  const int na = n_adm(p);
  const bf16_t* km = (const bf16_t*)(ws + O_KMLA) + (size_t)(b * 8 + h) * LP * 96;
  const bf16_t* vt = (const bf16_t*)(ws + O_VT) + (size_t)(b * 8 + h) * 64 * LP;
  float m = -1e30f, ls = 0.f, acc[64];
#pragma unroll
  for (int d = 0; d < 64; ++d) acc[d] = 0.f;
  const float* q = qs + h * 96;
  for (int j = l; j < na; j += 32) {
    const bf16_t* kr = km + (size_t)j * 96;
    float s = 0.f;
#pragma unroll 8
    for (int d = 0; d < 96; ++d) s = fmaf(q[d], bf2f(kr[d]), s);
    const float mn = fmaxf(m, s), c = exp2f(m - mn), pe = exp2f(s - mn);
    ls = ls * c + pe;
#pragma unroll
    for (int d = 0; d < 64; ++d) acc[d] = acc[d] * c + pe * bf2f(vt[(size_t)d * LP + j]);
    m = mn;
  }
#pragma unroll
  for (int off = 16; off >= 1; off >>= 1) {
    const float m2 = __shfl_xor(m, off), l2 = __shfl_xor(ls, off);
    const float mn = fmaxf(m, m2), c1 = exp2f(m - mn), c2 = exp2f(m2 - mn);
    ls = ls * c1 + l2 * c2;
#pragma unroll
    for (int d = 0; d < 64; ++d) { const float a2 = __shfl_xor(acc[d], off); acc[d] = acc[d] * c1 + a2 * c2; }
    m = mn;
  }
  if (l == 0) {
    const float inv = 1.f / ls;
    bf16_t* oa = (bf16_t*)(ws + O_OA) + (size_t)vb * 512 + h * 64;
    if (CHECK) {
#if SELFCHECK
#pragma unroll
      for (int d = 0; d < 64; ++d) if (far(bf2f(oa[d]), acc[d] * inv, 0.004f, 0.03f)) chk_fail(P, 13);
#endif
    } else {
#pragma unroll
      for (int d = 0; d < 64; ++d) oa[d] = f2bf(acc[d] * inv);
    }
  }
  __syncthreads();
}

#if SELFCHECK
struct NvDsaLds { float qi[512]; float qb[512]; float wi[8]; unsigned keys[L]; int sel[256]; float sc[8][256]; int redi[8]; int scan_gt[257]; int scan_eq[257]; unsigned char mine[L]; };
DI void nv_dsa_check(const Params& P, int vb, unsigned char* lds) {
  unsigned char* ws = P.ws;
  NvDsaLds& S = *(NvDsaLds*)lds;
  const int b = vb / SEQ, p = NMETA + vb % SEQ, t = b * L + p, tid = threadIdx.x & 255;
  const bf16_t* qi_g = (const bf16_t*)(ws + O_QI) + (size_t)t * 512;
  const bf16_t* qb_g = (const bf16_t*)(ws + O_QB) + (size_t)t * 512;
  for (int i = tid; i < 512; i += 256) { S.qi[i] = bf2f(qi_g[i]); S.qb[i] = bf2f(qb_g[i]); }
  if (tid < 8) S.wi[tid] = ((const float*)(ws + O_WI))[(size_t)t * 8 + tid];
  __syncthreads();
  const int na = n_adm(p);
  const bf16_t* ki_g = (const bf16_t*)(ws + O_KI) + (size_t)b * L * 64;
  for (int j = tid; j < na; j += 256) {
    const bf16_t* ki = ki_g + (size_t)j * 64;
    float s = 0.f;
    for (int h = 0; h < 8; ++h) {
      float lg = 0.f;
#pragma unroll 8
      for (int d = 0; d < 64; ++d) lg = fmaf(S.qi[h * 64 + d], bf2f(ki[d]), lg);
      s += S.wi[h] * fmaxf(lg, 0.f);
    }
    S.keys[j] = f2key(s);
    S.mine[j] = 0;
  }
  __syncthreads();
  if (na <= 256) {
    for (int j = tid; j < na; j += 256) S.mine[j] = 1;
  } else {
    unsigned T = 0;
    for (int bit = 31; bit >= 0; --bit) {
      const unsigned cand = T | (1u << bit);
      int c = 0;
      for (int j = tid; j < na; j += 256) c += S.keys[j] >= cand;
      c = block_sumi256(c, S.redi);
      if (c >= 256) T = cand;
    }
    const int chunk = (na + 255) / 256;
    const int j0 = tid * chunk, j1 = min(j0 + chunk, na);
    int cgt = 0, ce = 0;
    for (int j = j0; j < j1; ++j) { cgt += S.keys[j] > T; ce += S.keys[j] == T; }
    S.scan_gt[tid + 1] = cgt; S.scan_eq[tid + 1] = ce;
    __syncthreads();
    if (threadIdx.x == 0) { S.scan_gt[0] = 0; S.scan_eq[0] = 0; for (int i = 1; i <= 256; ++i) { S.scan_gt[i] += S.scan_gt[i - 1]; S.scan_eq[i] += S.scan_eq[i - 1]; } }
    __syncthreads();
    const int r = 256 - S.scan_gt[256];
    int pe = S.scan_eq[tid];
    for (int j = j0; j < j1; ++j) {
      if (S.keys[j] > T) S.mine[j] = 1;
      else if (S.keys[j] == T) { if (pe < r) S.mine[j] = 1; ++pe; }
    }
  }
  __syncthreads();
  const unsigned* mrow = (const unsigned*)(P.ws + O_MASK) + (size_t)vb * MW;
  int mism = 0, cntk = 0;
  for (int j = tid; j < 4224; j += 256) {
    const int kb = (mrow[j >> 5] >> (j & 31)) & 1;
    const int me = j < na ? (int)S.mine[j] : 0;
    mism += kb != me; cntk += kb;
    if (kb && j >= na) mism += 1000;
  }
  mism = block_sumi256(mism, S.redi);
  cntk = block_sumi256(cntk, S.redi);
  if (tid == 0) { if (mism > 16) chk_fail(P, 14); if (cntk != (na < 256 ? na : 256)) chk_fail(P, 14); }
  if (tid == 0) { int k = 0; for (int j = 0; j < na && k < 256; ++j) if ((mrow[j >> 5] >> (j & 31)) & 1) S.sel[k++] = j; for (; k < 256; ++k) S.sel[k] = 0; }
  const int nsel = na < 256 ? na : 256;
  __syncthreads();
  if (tid < nsel) {
    const int j = S.sel[tid];
    const bf16_t* kb = (const bf16_t*)(ws + O_KB) + (size_t)(b * L + j) * 512;
    const int bk = t5_bucket(j - p);
    for (int h = 0; h < 8; ++h) {
      float s = 0.f;
#pragma unroll 8
      for (int d = 0; d < 64; ++d) s = fmaf(S.qb[h * 64 + d], bf2f(kb[h * 64 + d]), s);
      S.sc[h][tid] = s + P.rel_bias[bk * 8 + h] * LOG2E;
    }
  }
  __syncthreads();
  {
    const int h = tid >> 5, l = tid & 31;
    float m = -1e30f;
    for (int k = l; k < nsel; k += 32) m = fmaxf(m, S.sc[h][k]);
#pragma unroll
    for (int off = 16; off >= 1; off >>= 1) m = fmaxf(m, __shfl_xor(m, off));
    float s = 0.f;
    for (int k = l; k < nsel; k += 32) s += exp2f(S.sc[h][k] - m);
#pragma unroll
    for (int off = 16; off >= 1; off >>= 1) s += __shfl_xor(s, off);
    const float inv = 1.f / s;
    __syncthreads();
    if (threadIdx.x < 256) for (int k = l; k < nsel; k += 32) S.sc[h][k] = exp2f(S.sc[h][k] - m) * inv;
  }
  __syncthreads();
  const bf16_t* vbt = (const bf16_t*)(ws + O_VBT) + (size_t)b * 8 * 64 * LP;
  const bf16_t* ob = (const bf16_t*)(ws + O_OB) + (size_t)vb * 512;
  for (int o = tid; o < 512; o += 256) {
    const int h = o >> 6;
    float a = 0.f;
    for (int k = 0; k < nsel; ++k) a = fmaf(S.sc[h][k], bf2f(vbt[(size_t)o * LP + S.sel[k]]), a);
    if (far(bf2f(ob[o]), a, 0.006f, 0.03f)) chk_fail(P, 15);
  }
  __syncthreads();
}
#endif

DI void p7_merge_tile(const Params& P, int mt, int nt, unsigned char* lds) {
  unsigned char* ws = P.ws;
  const int m0 = mt * 256, n0 = nt * 256;
  const bf16_t* gates = (const bf16_t*)P.out;
  bf16_t* yo = (bf16_t*)(ws + O_Y);
  TilePtrs tp;
  f32x16 acc[4][2];
#pragma unroll 1
  for (int br = 0; br < 2; ++br) {
    set_ptrs(tp, (const bf16_t*)(ws + (br ? O_OB : O_OA)), 512, NR, m0, (const bf16_t*)(ws + (br ? O_WBRB : O_WBRA)), 512, 1024, n0);
    zero_acc(acc); EPI_IDS(gemm_kloop<true>(acc, tp, 512, lds));
#pragma unroll
    for (int hf = 0; hf < 2; ++hf) {
      if (hf) __syncthreads();
#pragma unroll
      for (int hb = 0; hb < 2; ++hb) {
        u32x4 gt[4], pt[4];
#pragma unroll
        for (int i = 0; i < 4; ++i) {
          const int r = 16 * w + 8 * hb + 2 * i + hh;
          gt[i] = *(const u32x4*)(gates + (size_t)(m0 + 128 * hf + r) * 2048 + br * 1024 + n0 + lc * 8);
          if (br) pt[i] = *(const u32x4*)(yo + (size_t)(m0 + 128 * hf + r) * 1024 + n0 + lc * 8);
        }
#pragma unroll
        for (int i = 0; i < 4; ++i) {
          const int r = 16 * w + 8 * hb + 2 * i + hh;
          *(u32x4*)(lds + r * 528 + lc * 16) = gt[i];
          if (br) *(u32x4*)(lds + 67584 + r * 528 + lc * 16) = pt[i];
        }
      }
      __syncthreads();
      int rowb = m0 + lc;
      asm volatile("" : "+v"(rowb));
#pragma unroll
      for (int mh = 0; mh < 2; ++mh)
#pragma unroll
        for (int ni = 0; ni < 2; ++ni) {
          const int mi = 2 * hf + mh;
          const int rl = acc_row0(wr, mi) + lc - 128 * hf;
          const int row = rowb + acc_row0(wr, mi), c0 = n0 + acc_col0(wc, ni) + 8 * hh;
          bf16_t* yp = yo + (size_t)row * 1024 + c0;
#pragma unroll
          for (int j = 0; j < 2; ++j) {
            const unsigned char* lp = lds + rl * 528 + (acc_col0(wc, ni) + 8 * hh + 16 * j) * 2;
            const u32x4 gq = *(const u32x4*)lp;
            u32x4 pq = (u32x4){0u, 0u, 0u, 0u};
            if (br) pq = *(const u32x4*)(lp + 67584);
            float a8[8];
#pragma unroll
            for (int e = 0; e < 4; ++e) {
              const auto r = __builtin_amdgcn_permlane32_swap(__float_as_uint(acc[mi][ni][8 * j + e]), __float_as_uint(acc[mi][ni][8 * j + 4 + e]), false, false);
              a8[e] = __uint_as_float(r[0]); a8[4 + e] = __uint_as_float(r[1]);
            }
            u32x4 o;
#pragma unroll
            for (int d = 0; d < 4; ++d) {
              const float ylo = __uint_as_float(gq[d] << 16) * a8[2 * d] + __uint_as_float(pq[d] << 16);
              const float yhi = __uint_as_float(gq[d] & 0xffff0000u) * a8[2 * d + 1] + __uint_as_float(pq[d] & 0xffff0000u);
              o[d] = pk2(ylo, yhi);
            }
            *(u32x4*)(yp + 16 * j) = o;
          }
        }
      __builtin_amdgcn_sched_barrier(0);
    }
    asm volatile("" ::: "memory");
    __syncthreads();
  }
}

DI void p8_out_tile(const Params& P, int mt, int nt, unsigned char* lds) {
  unsigned char* ws = P.ws;
  const int m0 = mt * 256, n0 = nt * 256;
  TilePtrs tp; set_ptrs(tp, (const bf16_t*)(ws + O_Y), 1024, NR, m0, (const bf16_t*)(ws + O_WO), 1024, 1024, n0);
  f32x16 acc[4][2]; zero_acc(acc);
  EPI_IDS(gemm_kloop<true>(acc, tp, 1024, lds));
#pragma unroll
  for (int hf = 0; hf < 2; ++hf) {
    int rowb = m0 + lc;
    asm volatile("" : "+v"(rowb));
    f32x4 xv[2][2][4];
#pragma unroll
    for (int mh = 0; mh < 2; ++mh)
#pragma unroll
      for (int ni = 0; ni < 2; ++ni) {
        const size_t off = (size_t)(rowb + acc_row0(wr, 2 * hf + mh)) * D + n0 + acc_col0(wc, ni) + 4 * hh;
#pragma unroll
        for (int g = 0; g < 4; ++g) xv[mh][ni][g] = *(const f32x4*)(P.x + off + 8 * g);
      }
#pragma unroll
    for (int mh = 0; mh < 2; ++mh)
#pragma unroll
      for (int ni = 0; ni < 2; ++ni) {
        const int mi = 2 * hf + mh;
        const size_t off = (size_t)(rowb + acc_row0(wr, mi)) * D + n0 + acc_col0(wc, ni) + 4 * hh;
#pragma unroll
        for (int j = 0; j < 2; ++j) {
          u32x2 pq[2];
#pragma unroll
          for (int t = 0; t < 2; ++t) { const int g = 2 * j + t; pq[t] = pk4(xv[mh][ni][g][0] + acc[mi][ni][4 * g], xv[mh][ni][g][1] + acc[mi][ni][4 * g + 1], xv[mh][ni][g][2] + acc[mi][ni][4 * g + 2], xv[mh][ni][g][3] + acc[mi][ni][4 * g + 3]); }
          *(u32x4*)((bf16_t*)(ws + M_XN) + off + 4 * hh + 16 * j) = pair16(pq[0], pq[1]);
        }
      }
    __builtin_amdgcn_sched_barrier(0);
  }
}

DI void p9_route(float mylog, int& x1o, int& x2o, float& w1o, float& w2o) {
  float lg[4];
#pragma unroll
  for (int i = 0; i < 4; ++i) lg[i] = __shfl(mylog, i);
  int gs = 0; float gm = lg[0];
#pragma unroll
  for (int i = 1; i < 4; ++i) if (lg[i] > gm) { gm = lg[i]; gs = i; }
  float se = 0.f;
#pragma unroll
  for (int i = 0; i < 4; ++i) se += expf(lg[i] - gm);
  const float pg = 1.f / se;
  float el[8];
#pragma unroll
  for (int i = 0; i < 8; ++i) el[i] = __shfl(mylog, 4 + gs * 8 + i);
  float em = el[0];
#pragma unroll
  for (int i = 1; i < 8; ++i) em = fmaxf(em, el[i]);
  float pe[8]; float ss = 0.f;
#pragma unroll
  for (int i = 0; i < 8; ++i) { pe[i] = expf(el[i] - em); ss += pe[i]; }
  int e1 = 0; float p1 = pe[0];
#pragma unroll
  for (int i = 1; i < 8; ++i) if (pe[i] > p1) { p1 = pe[i]; e1 = i; }
  int e2 = 0; float p2 = -1.f;
#pragma unroll
  for (int i = 0; i < 8; ++i) if (i != e1 && pe[i] > p2) { p2 = pe[i]; e2 = i; }
  p1 /= ss; p2 /= ss;
  const float den = p1 + p2;
  const float w1 = pg * p1 / den, w2 = pg * p2 / den;
  x1o = gs * 8 + e1; x2o = gs * 8 + e2; w1o = w1; w2o = w2;
}
DI void p9_route_mem(const float* lgp, int& x1o, int& x2o, float& w1o, float& w2o) {
  float lg[4];
#pragma unroll
  for (int i = 0; i < 4; ++i) lg[i] = lgp[i];
  int gs = 0; float gm = lg[0];
#pragma unroll
  for (int i = 1; i < 4; ++i) if (lg[i] > gm) { gm = lg[i]; gs = i; }
  float se = 0.f;
#pragma unroll
  for (int i = 0; i < 4; ++i) se += expf(lg[i] - gm);
  const float pg = 1.f / se;
  float el[8];
#pragma unroll
  for (int i = 0; i < 8; ++i) el[i] = lgp[4 + gs * 8 + i];
  float em = el[0];
#pragma unroll
  for (int i = 1; i < 8; ++i) em = fmaxf(em, el[i]);
  float pe[8]; float ss = 0.f;
#pragma unroll
  for (int i = 0; i < 8; ++i) { pe[i] = expf(el[i] - em); ss += pe[i]; }
  int e1 = 0; float p1 = pe[0];
#pragma unroll
  for (int i = 1; i < 8; ++i) if (pe[i] > p1) { p1 = pe[i]; e1 = i; }
  int e2 = 0; float p2 = -1.f;
#pragma unroll
  for (int i = 0; i < 8; ++i) if (i != e1 && pe[i] > p2) { p2 = pe[i]; e2 = i; }
  p1 /= ss; p2 /= ss;
  const float den = p1 + p2;
  const float w1 = pg * p1 / den, w2 = pg * p2 / den;
  x1o = gs * 8 + e1; x2o = gs * 8 + e2; w1o = w1; w2o = w2;
}
DI void p9_commit(const Params& P, int tok, int x1, int q1, float w1, int x2, int q2, float w2) {
  unsigned char* ws = P.ws;
  ((int*)(ws + M_LIST))[(size_t)x1 * NR + q1] = tok; ((int*)(ws + M_LIST))[(size_t)x2 * NR + q2] = tok;
  ((float*)(ws + M_WL))[(size_t)x1 * NR + q1] = w1; ((float*)(ws + M_WL))[(size_t)x2 * NR + q2] = w2;
  typedef int i32x4 __attribute__((ext_vector_type(4)));
  *(i32x4*)((int*)(ws + M_ASG) + (size_t)tok * 4) = (i32x4){x1, q1, x2, q2};
}
constexpr int RT = 4;
DI void p9_router_group(const Params& P, int tok0, int stride, int lane) {
  unsigned char* ws = P.ws;
  int tk[RT]; bool has[RT];
#pragma unroll
  for (int u = 0; u < RT; ++u) { const int t = tok0 + u * stride; has[u] = t < NR; tk[u] = has[u] ? t : tok0; }
  f32x4 v[RT][4];
#pragma unroll
  for (int u = 0; u < RT; ++u) {
    const bf16_t* row = (const bf16_t*)(ws + M_XN) + (size_t)tk[u] * D;
    float s = 0.f;
#pragma unroll
    for (int i = 0; i < 4; ++i) {
      const u32x2 a = *(const u32x2*)(row + 256 * i + 4 * lane);
      v[u][i][0] = __uint_as_float(a[0] << 16); v[u][i][1] = __uint_as_float(a[0] & 0xffff0000u); v[u][i][2] = __uint_as_float(a[1] << 16); v[u][i][3] = __uint_as_float(a[1] & 0xffff0000u);
      s += v[u][i][0] * v[u][i][0] + v[u][i][1] * v[u][i][1] + v[u][i][2] * v[u][i][2] + v[u][i][3] * v[u][i][3];
    }
    s = wave_sum(s);
    const float rs = rsqrtf(s * (1.f / D) + EPS);
    if (lane == 0 && has[u]) ((float*)(ws + M_RS))[tk[u]] = rs;
#pragma unroll
    for (int i = 0; i < 4; ++i) {
      const f32x4 g = *(const f32x4*)(P.g_ffn + 256 * i + 4 * lane);
      v[u][i][0] *= rs * g[0]; v[u][i][1] *= rs * g[1]; v[u][i][2] *= rs * g[2]; v[u][i][3] *= rs * g[3];
    }
  }
  const float* wr = (const float*)(ws + O_WR);
  float mylog[RT];
#pragma unroll
  for (int u = 0; u < RT; ++u) mylog[u] = 0.f;
#pragma unroll 1
  for (int c = 0; c < 36; ++c) {
    float a[RT];
#pragma unroll
    for (int u = 0; u < RT; ++u) a[u] = 0.f;
#pragma unroll
    for (int i = 0; i < 4; ++i) {
      const f32x4 w4 = *(const f32x4*)(wr + c * 1024 + 256 * i + 4 * lane);
#pragma unroll
      for (int u = 0; u < RT; ++u) a[u] += v[u][i][0] * w4[0] + v[u][i][1] * w4[1] + v[u][i][2] * w4[2] + v[u][i][3] * w4[3];
    }
    const float bias = c < 4 ? P.b_rg[c] : P.b_re[c - 4];
#pragma unroll
    for (int u = 0; u < RT; ++u) { const float r = wave_sum(a[u]); if (lane == c) mylog[u] = r + bias; }
  }
#pragma unroll
  for (int u = 0; u < RT; ++u) if (has[u]) { int a_, b_; float c_, d_; p9_route(mylog[u], a_, b_, c_, d_); if (lane == 0) { unsigned* cnt = (unsigned*)(ws + O_ECNT); const int q1 = (int)atomicAdd(cnt + a_ * ECS, 1u), q2 = (int)atomicAdd(cnt + b_ * ECS, 1u); p9_commit(P, tk[u], a_, q1, c_, b_, q2, d_); } }
}
DI void p9_router_mfma(const Params& P, unsigned char* lds) {
  unsigned char* ws = P.ws;
  int lane = threadIdx.x & 63; asm volatile("" : "+v"(lane));
  const int w = __builtin_amdgcn_readfirstlane(threadIdx.x >> 6), hh = lane >> 5, lc = lane & 31;
  float* part = (float*)lds;
  const bf16_t* wrs = (const bf16_t*)(ws + O_WRS);
  int* lcnt = (int*)(lds + LDS_RED); int* lbase = lcnt + 32;
  for (int chunk = blockIdx.x; chunk * 64 < NR; chunk += gridDim.x) {
    if (threadIdx.x < 32) lcnt[threadIdx.x] = 0;
    {
      const int task = w >> 2, kq = w & 3;
      const bf16_t* arow = (const bf16_t*)(ws + M_XN) + (size_t)(chunk * 64 + 32 * task + lc) * D + 256 * kq + 8 * hh;
      const bf16_t* brow = wrs + ((size_t)(16 * kq) * 64 + lane) * 8;
      f32x16 a0, a1;
#pragma unroll
      for (int r = 0; r < 16; ++r) { a0[r] = 0.f; a1[r] = 0.f; }
#pragma unroll 4
      for (int ks = 0; ks < 16; ++ks) {
        const bf16x8 af = *(const bf16x8*)(arow + 16 * ks);
#pragma unroll
        for (int sp = 0; sp < 3; ++sp) {
          const bf16x8 b0 = *(const bf16x8*)(brow + sp * 65536 + ks * 512), b1 = *(const bf16x8*)(brow + sp * 65536 + 32768 + ks * 512);
          a0 = __builtin_amdgcn_mfma_f32_32x32x16_bf16(af, b0, a0, 0, 0, 0);
          a1 = __builtin_amdgcn_mfma_f32_32x32x16_bf16(af, b1, a1, 0, 0, 0);
        }
      }
      float* pw = part + (size_t)w * 32 * 64 + lc;
#pragma unroll
      for (int r = 0; r < 16; ++r) { const int tr = (r & 3) + 8 * (r >> 2) + 4 * hh; pw[tr * 64] = a0[r]; pw[tr * 64 + 32] = a1[r]; }
    }
    __syncthreads();
    {
      int tk[8]; float rsv[8];
#pragma unroll
      for (int u = 0; u < 8; ++u) tk[u] = chunk * 64 + 8 * w + u;
      u32x2 rowv[8][4];
#pragma unroll
      for (int u = 0; u < 8; ++u) {
        const bf16_t* row = (const bf16_t*)(ws + M_XN) + (size_t)tk[u] * D;
#pragma unroll
        for (int i = 0; i < 4; ++i) rowv[u][i] = *(const u32x2*)(row + 256 * i + 4 * lane);
      }
      const float bias = lane < 4 ? P.b_rg[lane] : (lane < 36 ? P.b_re[lane - 4] : 0.f);
      float* lgt = (float*)(lds + 65536) + w * (8 * 40);
#pragma unroll
      for (int u = 0; u < 8; ++u) {
        float sq = 0.f;
#pragma unroll
        for (int i = 0; i < 4; ++i) {
          const float v0 = __uint_as_float(rowv[u][i][0] << 16), v1 = __uint_as_float(rowv[u][i][0] & 0xffff0000u), v2 = __uint_as_float(rowv[u][i][1] << 16), v3 = __uint_as_float(rowv[u][i][1] & 0xffff0000u);
          sq += v0 * v0 + v1 * v1 + v2 * v2 + v3 * v3;
        }
        sq = wave_sum(sq);
        rsv[u] = rsqrtf(sq * (1.f / D) + EPS);
        const int tl = 8 * w + u, task = tl >> 5, tr = tl & 31;
        const float* pp = part + ((size_t)(task * 4) * 32 + tr) * 64 + lane;
        const float acc4 = (pp[0] + pp[32 * 64]) + (pp[2 * 32 * 64] + pp[3 * 32 * 64]);
        if (lane < 36) lgt[u * 40 + lane] = acc4 * rsv[u] + bias;
      }
      if (lane == 0) {
#pragma unroll
        for (int u = 0; u < 8; ++u) ((float*)(ws + M_RS))[tk[u]] = rsv[u];
      }
      __syncthreads();
      int x1 = 0, x2 = 0, r1 = 0, r2 = 0; float w1 = 0.f, w2 = 0.f;
      if (lane < 8) {
        p9_route_mem(lgt + lane * 40, x1, x2, w1, w2);
        r1 = atomicAdd(lcnt + x1, 1); r2 = atomicAdd(lcnt + x2, 1);
      }
      __syncthreads();
      if (threadIdx.x < 32) { const int c = lcnt[threadIdx.x]; lbase[threadIdx.x] = c ? (int)atomicAdd((unsigned*)(ws + O_ECNT) + threadIdx.x * ECS, (unsigned)c) : 0; }
      __syncthreads();
      if (lane < 8) p9_commit(P, chunk * 64 + 8 * w + lane, x1, lbase[x1] + r1, w1, x2, lbase[x2] + r2, w2);
    }
    __syncthreads();
  }
}
DI void p9_conv_gu_item(const Params& P, int item, float* scr, int tid, bool valid) {
  const int e = item >> 7, r = item & 127, kb = r & 15, nb = r >> 4;
  const int k0 = kb * 64, n0 = nb * 64;
  bf16_t* dst = (bf16_t*)(P.ws + M_WGU) + (size_t)e * 512 * 1024;
  if (valid) {
    const int n = tid & 63, nd = n0 + n, q = nd >> 8, within = nd & 255, part = within >> 7, idx = within & 127;
    const float* src = (part ? P.w_eu : P.w_eg) + (size_t)e * 1024 * 256 + (q * 128 + idx);
    float r[16], gk[16];
    const float* sp0 = src + (size_t)(k0 + (tid >> 6)) * 256;
#pragma unroll
    for (int i = 0; i < 16; ++i) { r[i] = sp0[(size_t)(4 * i) * 256]; gk[i] = P.g_ffn[k0 + (tid >> 6) + 4 * i]; }
#pragma unroll
    for (int i = 0; i < 16; ++i) asm volatile("" : "+v"(r[i]));
#pragma unroll
    for (int i = 0; i < 16; ++i) { const int k = (tid >> 6) + 4 * i; scr[k * 65 + n] = r[i] * gk[i]; }
  }
  __syncthreads();
  if (valid) {
    const int kq = tid & 7;
#pragma unroll
    for (int i = 0; i < 2; ++i) {
      const int n = (tid >> 3) + 32 * i;
      const float* sp = scr + (kq * 8) * 65 + n;
      u32x4 o; o[0] = pk2(sp[0], sp[65]); o[1] = pk2(sp[2 * 65], sp[3 * 65]); o[2] = pk2(sp[4 * 65], sp[5 * 65]); o[3] = pk2(sp[6 * 65], sp[7 * 65]);
      *(u32x4*)(dst + (size_t)(n0 + n) * 1024 + k0 + kq * 8) = o;
    }
  }
  __syncthreads();
}
template <int KIND>
DI void p9_conv_loop(const Params& P, float* scr, int half, int tid) {
  const int G = gridDim.x, bx = blockIdx.x;
  constexpr int NITEM = KIND == 0 ? 32 * 128 : 32 * 64;
  const int n = tid & 63, kr = tid >> 6;
  float r[16];
  int k0 = 0, n0 = 0; bf16_t* dst = nullptr;
  auto decode = [&](int item, const float*& sp, int& k0_, int& n0_, bf16_t*& dst_) {
    if (KIND == 0) {
      const int e = item >> 7, rr = item & 127, kb = rr & 15, nb = rr >> 4;
      k0_ = kb * 64; n0_ = nb * 64;
      const int nd = n0_ + n, q = nd >> 8, within = nd & 255, part = within >> 7, idx = within & 127;
      sp = (part ? P.w_eu : P.w_eg) + (size_t)e * 1024 * 256 + (q * 128 + idx) + (size_t)(k0_ + kr) * 256;
      dst_ = (bf16_t*)(P.ws + M_WGU) + (size_t)e * 512 * 1024;
    } else {
      const int e = item >> 6, it = item & 63, kb = it & 3, nb = it >> 2;
      k0_ = kb * 64; n0_ = nb * 64;
      sp = P.w_ed + (size_t)e * 256 * 1024 + (n0_ + n) + (size_t)(k0_ + kr) * 1024;
      dst_ = (bf16_t*)(P.ws + M_WD) + (size_t)e * 1024 * 256;
    }
  };
  constexpr int LDSRC = KIND == 0 ? 256 : 1024, KD = KIND == 0 ? 1024 : 256;
  int k = bx;
  bool valid = 2 * k < NITEM;
  if (valid) {
    const float* sp; decode(2 * k + half, sp, k0, n0, dst);
#pragma unroll
    for (int i = 0; i < 16; ++i) r[i] = sp[(size_t)(4 * i) * LDSRC];
  }
  while (valid) {
#pragma unroll
    for (int i = 0; i < 16; ++i) { const int kk = kr + 4 * i; scr[kk * 65 + n] = KIND == 0 ? r[i] * P.g_ffn[k0 + kk] : r[i]; }
    __syncthreads();
    const int ck0 = k0, cn0 = n0; bf16_t* const cdst = dst;
    k += G; valid = 2 * k < NITEM;
    if (valid) {
      const float* sp; decode(2 * k + half, sp, k0, n0, dst);
#pragma unroll
      for (int i = 0; i < 16; ++i) r[i] = sp[(size_t)(4 * i) * LDSRC];
    }
    {
      const int kq = tid & 7;
#pragma unroll
      for (int i = 0; i < 2; ++i) {
        const int nn = (tid >> 3) + 32 * i;
        const float* sp2 = scr + (kq * 8) * 65 + nn;
        u32x4 o; o[0] = pk2(sp2[0], sp2[65]); o[1] = pk2(sp2[2 * 65], sp2[3 * 65]); o[2] = pk2(sp2[4 * 65], sp2[5 * 65]); o[3] = pk2(sp2[6 * 65], sp2[7 * 65]);
        *(u32x4*)(cdst + (size_t)(cn0 + nn) * KD + ck0 + kq * 8) = o;
      }
    }
    __syncthreads();
  }
}
DI void moe_table_load(const Params& P, int* etab) {
  __syncthreads();
  if (threadIdx.x < 32) etab[threadIdx.x] = (int)((const unsigned*)(P.ws + O_ECNT))[threadIdx.x * ECS];
  __syncthreads();
}
DI int moe_tile_lookup(const int* etab, int tile, int& e_out, int& rt_out, int& cnt_out, int& base_slot) {
  int acc = 0, found = 0;
  e_out = 0; rt_out = 0; cnt_out = 0; base_slot = 0;
#pragma unroll
  for (int e = 0; e < 32; ++e) {
    const int c = etab[e], nt = (c + 255) >> 8;
    if (!found && tile < acc + nt) { e_out = e; rt_out = tile - acc; cnt_out = c; base_slot = acc * 256; found = 1; }
    acc += nt;
  }
  return acc;
}
DI void p10_gu_tile(const Params& P, int tile, int e, int rt, int cnt, int base_slot, int q, unsigned char* lds) {
  unsigned char* ws = P.ws;
  const int tid = threadIdx.x;
  const int* list = (const int*)(ws + M_LIST) + (size_t)e * NR;
  TilePtrs tp;
#pragma unroll
  for (int i = 0; i < 4; ++i) { int row, kc; tile_rc(i, row, kc); int r = rt * 256 + row; r = r < cnt ? r : cnt - 1; tp.a[i] = ((unsigned)list[r] * 1024u + kc * 8) * 2u; tp.b[i] = ((unsigned)(q * 256 + row) * 1024u + kc * 8) * 2u; }
  tp.A = (const bf16_t*)(ws + M_XN); tp.B = (const bf16_t*)(ws + M_WGU) + (size_t)e * 512 * 1024;
  f32x16 acc[4][2]; zero_acc(acc);
  EPI_IDS(gemm_kloop<true>(acc, tp, 1024, lds, cnt - rt * 256 <= 128));
  bf16_t* hm = (bf16_t*)(ws + M_HMID);
  const int col = q * 128 + wc * 32 + 4 * hh;
  float rsv4[4];
  {
    int tk4[4];
#pragma unroll
    for (int mi = 0; mi < 4; ++mi) { const int rr0 = rt * 256 + acc_row0(wr, mi) + lc; tk4[mi] = list[rr0 < cnt ? rr0 : cnt - 1]; }
#pragma unroll
    for (int mi = 0; mi < 4; ++mi) rsv4[mi] = ((const float*)(ws + M_RS))[tk4[mi]];
  }
#pragma unroll
  for (int mi = 0; mi < 4; ++mi) {
    int rr = rt * 256 + acc_row0(wr, mi) + lc;
    asm volatile("" : "+v"(rr));
    bf16_t* hp = hm + (size_t)(base_slot + rr) * 256 + col;
    const float rsv = rsv4[mi];
#pragma unroll
    for (int j = 0; j < 2; ++j) {
      float hv[8];
#pragma unroll
      for (int e = 0; e < 8; ++e) { const float gt = acc[mi][0][8 * j + e] * rsv, u = acc[mi][1][8 * j + e] * rsv; hv[e] = gt * __builtin_amdgcn_rcpf(1.f + __expf(-gt)) * u; }
      const u32x4 o = pair16(pk4(hv[0], hv[1], hv[2], hv[3]), pk4(hv[4], hv[5], hv[6], hv[7]));
      if (rr < cnt) *(u32x4*)(hp + 4 * hh + 16 * j) = o;
    }
  }
  asm volatile("s_waitcnt vmcnt(0)" ::: "memory");
  __syncthreads();
  if (threadIdx.x == 0) {
    __builtin_amdgcn_fence(__ATOMIC_RELEASE, "agent");
    asm volatile("s_waitcnt vmcnt(0)" ::: "memory");
    __hip_atomic_fetch_add((unsigned*)(ws + O_DEP) + tile, 1u, __ATOMIC_RELAXED, __HIP_MEMORY_SCOPE_AGENT);
  }
}
DI void p11_down_tile(const Params& P, int tile, int e, int rt, int cnt, int base_slot, int nt, unsigned char* lds) {
  unsigned char* ws = P.ws;
  if (threadIdx.x == 0) {
    unsigned* dep = (unsigned*)(ws + O_DEP) + tile;
    unsigned spins = 0;
    while (__hip_atomic_load(dep, __ATOMIC_RELAXED, __HIP_MEMORY_SCOPE_AGENT) < 2u && ++spins < (1u << 22)) __builtin_amdgcn_s_sleep(2);
    __builtin_amdgcn_fence(__ATOMIC_ACQUIRE, "agent");
    asm volatile("s_waitcnt vmcnt(0)" ::: "memory");
  }
  __syncthreads();
  const int tid = threadIdx.x;
  TilePtrs tp;
#pragma unroll
  for (int i = 0; i < 4; ++i) { int row, kc; tile_rc(i, row, kc); int r = rt * 256 + row; r = r < cnt ? r : cnt - 1; tp.a[i] = ((unsigned)(base_slot + r) * 256u + kc * 8) * 2u; tp.b[i] = ((unsigned)(nt * 256 + row) * 256u + kc * 8) * 2u; }
  tp.A = (const bf16_t*)(ws + M_HMID); tp.B = (const bf16_t*)(ws + M_WD) + (size_t)e * 1024 * 256;
  f32x16 acc[4][2]; zero_acc(acc);
  EPI_IDS(gemm_kloop<true>(acc, tp, 256, lds, cnt - rt * 256 <= 128));
  bf16_t* ys = (bf16_t*)(ws + M_YS);
  const float* wl = (const float*)(ws + M_WL) + (size_t)e * NR;
  float wt4[4];
#pragma unroll
  for (int mi = 0; mi < 4; ++mi) { const int rr0 = rt * 256 + acc_row0(wr, mi) + lc; wt4[mi] = wl[rr0 < cnt ? rr0 : cnt - 1]; }
#pragma unroll
  for (int mi = 0; mi < 4; ++mi) {
    int rr = rt * 256 + acc_row0(wr, mi) + lc;
    asm volatile("" : "+v"(rr));
    const bool ok = rr < cnt;
    const float wt = wt4[mi];
    bf16_t* yp = ys + (size_t)(base_slot + rr) * 1024 + nt * 256 + 4 * hh;
#pragma unroll
    for (int ni = 0; ni < 2; ++ni)
#pragma unroll
      for (int j = 0; j < 2; ++j) {
        const u32x4 o = pair16(pk4(acc[mi][ni][8 * j] * wt, acc[mi][ni][8 * j + 1] * wt, acc[mi][ni][8 * j + 2] * wt, acc[mi][ni][8 * j + 3] * wt),
                               pk4(acc[mi][ni][8 * j + 4] * wt, acc[mi][ni][8 * j + 5] * wt, acc[mi][ni][8 * j + 6] * wt, acc[mi][ni][8 * j + 7] * wt));
        if (ok) *(u32x4*)(yp + acc_col0(wc, ni) + 4 * hh + 16 * j) = o;
      }
  }
}
DI void p12_final_pair(const Params& P, int tokA, int tokB, bool hasB, int lane, const int* sbase  ) {
  unsigned char* ws = P.ws;
  const int tk[2] = {tokA, hasB ? tokB : tokA};
  typedef int i32x4 __attribute__((ext_vector_type(4)));
  i32x4 ag[2];
#pragma unroll
  for (int u = 0; u < 2; ++u) ag[u] = *(const i32x4*)((const int*)(ws + M_ASG) + (size_t)tk[u] * 4);
  u32x2 hq[2][4], ya[2][4], yb[2][4];
#pragma unroll
  for (int u = 0; u < 2; ++u) {
    const bf16_t* h2b = (const bf16_t*)(ws + M_XN) + (size_t)tk[u] * D;
#pragma unroll
    for (int i = 0; i < 4; ++i) hq[u][i] = *(const u32x2*)(h2b + 256 * i + 4 * lane);
  }
#pragma unroll
  for (int u = 0; u < 2; ++u) {
    const int s1 = sbase[ag[u][0]] + ag[u][1], s2 = sbase[ag[u][2]] + ag[u][3];
    const bf16_t* y1 = (const bf16_t*)(ws + M_YS) + (size_t)s1 * 1024;
    const bf16_t* y2 = (const bf16_t*)(ws + M_YS) + (size_t)s2 * 1024;
#pragma unroll
    for (int i = 0; i < 4; ++i) { ya[u][i] = *(const u32x2*)(y1 + 256 * i + 4 * lane); yb[u][i] = *(const u32x2*)(y2 + 256 * i + 4 * lane); }
  }
  f32x4 gfin[4];
#pragma unroll
  for (int i = 0; i < 4; ++i) gfin[i] = *(const f32x4*)(P.g_fin + 256 * i + 4 * lane);
#pragma unroll
  for (int u = 0; u < 2; ++u) {
    f32x4 v[4]; float s = 0.f;
#pragma unroll
    for (int i = 0; i < 4; ++i) {
      const u32x2 h = hq[u][i], a = ya[u][i], b = yb[u][i];
      v[i][0] = __uint_as_float(h[0] << 16) + (__uint_as_float(a[0] << 16) + __uint_as_float(b[0] << 16));
      v[i][1] = __uint_as_float(h[0] & 0xffff0000u) + (__uint_as_float(a[0] & 0xffff0000u) + __uint_as_float(b[0] & 0xffff0000u));
      v[i][2] = __uint_as_float(h[1] << 16) + (__uint_as_float(a[1] << 16) + __uint_as_float(b[1] << 16));
      v[i][3] = __uint_as_float(h[1] & 0xffff0000u) + (__uint_as_float(a[1] & 0xffff0000u) + __uint_as_float(b[1] & 0xffff0000u));
      s += v[i][0] * v[i][0] + v[i][1] * v[i][1] + v[i][2] * v[i][2] + v[i][3] * v[i][3];
    }
    s = wave_sum(s);
    const float rs = rsqrtf(s * (1.f / D) + EPS);
    if (u == 0 || hasB) {
      float* row = P.out + (size_t)tk[u] * D;
#pragma unroll
      for (int i = 0; i < 4; ++i) {
        f32x4 o; o[0] = v[i][0] * rs * gfin[i][0]; o[1] = v[i][1] * rs * gfin[i][1]; o[2] = v[i][2] * rs * gfin[i][2]; o[3] = v[i][3] * rs * gfin[i][3];
        *(f32x4*)(row + 256 * i + 4 * lane) = o;
      }
    }
  }
}

struct NvMoeLds { float xr[D]; float xn[D]; float hm[256]; float red[8]; float logit[36]; float gatew[2]; int expert[2]; };


#if SELFCHECK
DI const float* h_row(const Params& P, int t) { const int b = t / L, p = t % L; return p < NMETA ? P.meta + (size_t)p * D : P.x + ((size_t)b * SEQ + (p - NMETA)) * D; }
DI void chk_load_hn(const Params& P, int t, float* hv, float* red) {
  const float* row = h_row(P, t);
  float s = 0.f;
  for (int i = (threadIdx.x & 255); i < D; i += 256) { const float v = row[i]; hv[i] = v; s += v * v; }
  s = block_sum256(s, red);
  const float rs = rsqrtf(s * (1.f / D) + EPS);
  if (threadIdx.x < 256) for (int i = threadIdx.x; i < D; i += 256) hv[i] = hv[i] * rs * P.g_mix[i];
  __syncthreads();
}
DI void chk_stageA(const Params& P, unsigned char* lds) {
  unsigned char* ws = P.ws;
  float* hv = (float*)lds; float* pj = hv + 1024; float* red = pj + 4608; float* cq = red + 8; float* ckv = cq + 256;
  const int tid = threadIdx.x & 255;
  for (int sidx = blockIdx.x; sidx < 512; sidx += gridDim.x) {
    const int t = sidx < 8 ? (sidx < 4 ? sidx * L + (sidx & 3) * 5 : NT - 1 - (sidx - 4) * 1031) : (int)(hash_u(sidx * 7919u + 13u) % NT);
    const int b = t / L, p = t % L;
    chk_load_hn(P, t, hv, red);
    for (int c = tid; c < 2536; c += 256) { float a = 0.f; for (int k = 0; k < D; ++k) a = fmaf(hv[k], P.w_in[(size_t)k * INC + c], a); pj[c] = a; }
    __syncthreads();
    const float* sm = (const float*)(ws + O_SMALL) + (size_t)t * 512;
    for (int c = tid; c < 416; c += 256) if (far(sm[c], pj[c], 0.06f, 0.02f)) chk_fail(P, 1);
    for (int c = tid; c < 8; c += 256) if (far(sm[S_WI + c], pj[2528 + c], 0.06f, 0.02f)) chk_fail(P, 1);
    for (int c = tid; c < 64; c += 256) if (far(sm[S_KI + c], pj[2464 + c], 0.06f, 0.02f)) chk_fail(P, 1);
    for (int c = tid; c < 512; c += 256) {
      if (far(bf2f(((const bf16_t*)(ws + O_QB))[(size_t)t * 512 + c]), pj[416 + c] * (0.125f * LOG2E), 0.012f, 0.02f)) chk_fail(P, 2);
      if (far(bf2f(((const bf16_t*)(ws + O_KB))[(size_t)t * 512 + c]), pj[928 + c], 0.06f, 0.02f)) chk_fail(P, 3);
      const int h = c >> 6, d = c & 63;
      if (far(bf2f(((const bf16_t*)(ws + O_VBT))[((size_t)(b * 8 + h) * 64 + d) * LP + p]), pj[1440 + c], 0.06f, 0.02f)) chk_fail(P, 4);
      if (far(bf2f(((const bf16_t*)(ws + O_QI))[(size_t)t * 512 + c]), pj[1952 + c] * 0.125f, 0.01f, 0.02f)) chk_fail(P, 5);
    }
    for (int c = tid; c < 64; c += 256) if (far(bf2f(((const bf16_t*)(ws + O_KI))[(size_t)t * 64 + c]), pj[2464 + c], 0.06f, 0.02f)) chk_fail(P, 6);
    for (int c = tid; c < 8; c += 256) if (far(((const float*)(ws + O_WI))[(size_t)t * 8 + c], pj[2528 + c] * 0.35355339f, 0.03f, 0.02f)) chk_fail(P, 6);
    { float s = 0.f; for (int i = tid; i < 256; i += 256) s += pj[i] * pj[i]; s = block_sum256(s, red);
      const float rs = rsqrtf(s * (1.f / 256) + EPS); for (int i = tid; i < 256; i += 256) cq[i] = pj[i] * rs * P.g_cq[i]; }
    { float s = 0.f; for (int i = tid; i < 128; i += 256) s += pj[256 + i] * pj[256 + i]; s = block_sum256(s, red);
      const float rs = rsqrtf(s * (1.f / 128) + EPS); for (int i = tid; i < 128; i += 256) ckv[i] = pj[256 + i] * rs * P.g_ckv[i]; }
    __syncthreads();
    const float qscale = 0.10206207261596575f * LOG2E;
    for (int c = tid; c < 768; c += 256) {
      const int h = c / 96, e = c % 96;
      float ref;
      if (e < 64) { float a = 0.f; for (int k = 0; k < 256; ++k) a = fmaf(cq[k], P.w_uq[(size_t)k * 768 + c], a); ref = a; }
      else {
        const int j = (e - 64) & 15; const int c1 = h * 96 + 64 + j, c2 = c1 + 16;
        float a1 = 0.f, a2 = 0.f; for (int k = 0; k < 256; ++k) { a1 = fmaf(cq[k], P.w_uq[(size_t)k * 768 + c1], a1); a2 = fmaf(cq[k], P.w_uq[(size_t)k * 768 + c2], a2); }
        const float inv = powf(10000.f, -(float)j / 16.f); float sn, cs; sincosf((float)p * inv, &sn, &cs);
        ref = (e - 64) < 16 ? a1 * cs - a2 * sn : a1 * sn + a2 * cs;
      }
      if (far(bf2f(((const bf16_t*)(ws + O_QA))[(size_t)t * 768 + c]), ref * qscale, 0.01f, 0.02f)) chk_fail(P, 7);
    }
    for (int c = tid; c < 1024; c += 256) {
      float a = 0.f; for (int k = 0; k < 128; ++k) a = fmaf(ckv[k], P.w_ukv[(size_t)k * 1024 + c], a);
      const int h = c >> 7, e = c & 127;
      if (e < 64) { if (far(bf2f(((const bf16_t*)(ws + O_KMLA))[((size_t)(b * 8 + h) * LP + p) * 96 + e]), a, 0.06f, 0.02f)) chk_fail(P, 8); }
      else { if (far(bf2f(((const bf16_t*)(ws + O_VT))[((size_t)(b * 8 + h) * 64 + (e - 64)) * LP + p]), a, 0.06f, 0.02f)) chk_fail(P, 9); }
    }
    for (int c = tid; c < 256; c += 256) {
      const int h = c >> 5, e = c & 31, j = e & 15;
      const float inv = powf(10000.f, -(float)j / 16.f); float sn, cs; sincosf((float)p * inv, &sn, &cs);
      const float x1 = pj[384 + j], x2 = pj[384 + 16 + j];
      const float ref = e < 16 ? x1 * cs - x2 * sn : x1 * sn + x2 * cs;
      if (far(bf2f(((const bf16_t*)(ws + O_KMLA))[((size_t)(b * 8 + h) * LP + p) * 96 + 64 + e]), ref, 0.06f, 0.02f)) chk_fail(P, 10);
    }
    __syncthreads();
  }
}
DI void chk_stageB(const Params& P, unsigned char* lds) {
  unsigned char* ws = P.ws;
  float* hv = (float*)lds; float* yv = hv + 1024; float* red = yv + 1024; float* oa = red + 8; float* ob = oa + 512;
  const int tid = threadIdx.x & 255;
  for (int sidx = blockIdx.x; sidx < 256; sidx += gridDim.x) {
    const int rt = (int)(hash_u(sidx * 104729u + 7u) % NR);
    const int b = rt / SEQ, p = NMETA + rt % SEQ, t = b * L + p;
    chk_load_hn(P, t, hv, red);
    for (int i = tid; i < 512; i += 256) { oa[i] = bf2f(((const bf16_t*)(ws + O_OA))[(size_t)rt * 512 + i]); ob[i] = bf2f(((const bf16_t*)(ws + O_OB))[(size_t)rt * 512 + i]); }
    __syncthreads();
    const bf16_t* gates = (const bf16_t*)P.out + (size_t)rt * 2048;
    for (int c = tid; c < D; c += 256) {
      float ga = 0.f, gb = 0.f, va = 0.f, vb = 0.f;
      for (int k = 0; k < D; ++k) { ga = fmaf(hv[k], P.w_in[(size_t)k * INC + 2536 + c], ga); gb = fmaf(hv[k], P.w_in[(size_t)k * INC + 3560 + c], gb); }
      for (int k = 0; k < 512; ++k) { va = fmaf(oa[k], P.w_bra[(size_t)k * D + c], va); vb = fmaf(ob[k], P.w_brb[(size_t)k * D + c], vb); }
      const float sa = 1.f / (1.f + expf(-ga)), sb = 1.f / (1.f + expf(-gb));
      if (far(bf2f(gates[c]), sa, 0.01f, 0.01f) || far(bf2f(gates[1024 + c]), sb, 0.01f, 0.01f)) chk_fail(P, 10);
      const float ref = va * sa + vb * sb;
      if (far(bf2f(((const bf16_t*)(ws + O_Y))[(size_t)rt * D + c]), ref, 0.004f, 0.03f)) chk_fail(P, 11);
    }
    __syncthreads();
  }
}
DI void chk_stageC(const Params& P, unsigned char* lds) {
  unsigned char* ws = P.ws;
  float* yv = (float*)lds;
  const int tid = threadIdx.x & 255;
  for (int sidx = blockIdx.x; sidx < 256; sidx += gridDim.x) {
    const int rt = (int)(hash_u(sidx * 15485863u + 3u) % NR);
    const int b = rt / SEQ, p = NMETA + rt % SEQ, t = b * L + p;
    for (int i = tid; i < D; i += 256) yv[i] = bf2f(((const bf16_t*)(ws + O_Y))[(size_t)rt * D + i]);
    __syncthreads();
    for (int c = tid; c < D; c += 256) {
      float a = 0.f; for (int k = 0; k < D; ++k) a = fmaf(yv[k], P.w_o[(size_t)k * D + c], a);
      const float ref = P.x[(size_t)rt * D + c] + a;
      if (far(P.out[(size_t)rt * D + c], ref, 0.003f, 0.002f)) chk_fail(P, 12);
    }
    __syncthreads();
  }
}
#endif

#if SELFCHECK
DI void chk_moe(const Params& P, unsigned char* lds) {
  unsigned char* ws = P.ws;
  NvMoeLds& S = *(NvMoeLds*)lds;
  __shared__ int sb[32];
  const int t = threadIdx.x & 255, lane = t & 63, wv = t >> 6;
  if (t == 0) { const unsigned* c = (const unsigned*)(ws + O_ECNT); int a = 0; for (int i = 0; i < 32; ++i) { sb[i] = a; a += (((int)c[i * ECS] + 255) >> 8) * 256; } }
  __syncthreads();
  for (int sidx = blockIdx.x; sidx < 192; sidx += gridDim.x) {
    const int tok = (int)(hash_u(sidx * 40503u + 77u) % NR);
    const float* row = P.out + (size_t)tok * D;
    float s = 0.f;
    for (int i = t; i < D; i += 256) { const float v = row[i]; S.xr[i] = v; s += v * v; }
    s = block_sum256(s, S.red);
    const float rs = rsqrtf(s * (1.f / D) + EPS);
    for (int i = t; i < D; i += 256) { S.xn[i] = S.xr[i] * rs * P.g_ffn[i]; if (far(bf2f(((const bf16_t*)(ws + M_XN))[(size_t)tok * D + i]), S.xn[i], 0.02f, 0.01f)) chk_fail(P, 0); }
    __syncthreads();
    for (int c = wv; c < 36; c += 4) {
      float a = 0.f;
      if (c < 4) { for (int i = lane; i < D; i += 64) a = fmaf(S.xn[i], P.w_rg[i * 4 + c], a); }
      else { for (int i = lane; i < D; i += 64) a = fmaf(S.xn[i], P.w_re[i * 32 + (c - 4)], a); }
      a = wave_sum(a);
      if (lane == 0) S.logit[c] = a + (c < 4 ? P.b_rg[c] : P.b_re[c - 4]);
    }
    __syncthreads();
    const int* asg = (const int*)(ws + M_ASG) + (size_t)tok * 4;
    if (t == 0) {
      const int gs = asg[0] >> 3;
      float gm = S.logit[0]; for (int i = 1; i < 4; ++i) gm = fmaxf(gm, S.logit[i]);
      if (S.logit[gs] < gm - 1e-4f || (asg[2] >> 3) != gs) chk_fail(P, 1);
      const float* el = S.logit + 4 + gs * 8;
      const int e1 = asg[0] & 7, e2 = asg[2] & 7;
      int nb = 0; for (int i = 0; i < 8; ++i) if (i != e1 && i != e2 && el[i] > fminf(el[e1], el[e2]) + 1e-4f) ++nb;
      if (nb || e1 == e2 || el[e1] < el[e2] - 1e-4f) chk_fail(P, 2);
      float se = 0.f; for (int i = 0; i < 4; ++i) se += expf(S.logit[i] - gm);
      const float pg = expf(S.logit[gs] - gm) / se;
      const float a = expf(el[e1] - el[e1]), b2 = expf(el[e2] - el[e1]);
      S.gatew[0] = pg * a / (a + b2); S.gatew[1] = pg * b2 / (a + b2);
      S.expert[0] = asg[0]; S.expert[1] = asg[2];
      if (far(((const float*)(ws + M_WL))[(size_t)asg[0] * NR + asg[1]], S.gatew[0], 1e-4f, 1e-3f)) chk_fail(P, 3);
      if (far(((const float*)(ws + M_WL))[(size_t)asg[2] * NR + asg[3]], S.gatew[1], 1e-4f, 1e-3f)) chk_fail(P, 3);
      if (((const int*)(ws + M_LIST))[(size_t)asg[0] * NR + asg[1]] != tok || ((const int*)(ws + M_LIST))[(size_t)asg[2] * NR + asg[3]] != tok) chk_fail(P, 4);
    }
    __syncthreads();
    for (int a = 0; a < 2; ++a) {
      const int e = S.expert[a];
      const int slot = sb[e] + asg[2 * a + 1];
      const float* wg = P.w_eg + (size_t)e * D * 256;
      const float* wu = P.w_eu + (size_t)e * D * 256;
      float g = 0.f, u = 0.f;
      for (int k = 0; k < D; ++k) { const float xv = S.xn[k]; g = fmaf(xv, wg[(size_t)k * 256 + t], g); u = fmaf(xv, wu[(size_t)k * 256 + t], u); }
      S.hm[t] = g / (1.f + expf(-g)) * u;
      if (far(bf2f(((const bf16_t*)(ws + M_HMID))[(size_t)slot * 256 + t]), S.hm[t], 0.03f, 0.03f)) chk_fail(P, 5);
      __syncthreads();
      const float* wd = P.w_ed + (size_t)e * 256 * D;
      const float gw = S.gatew[a];
      for (int i = 0; i < 4; ++i) {
        float y = 0.f;
        for (int j = 0; j < 256; ++j) y = fmaf(S.hm[j], wd[(size_t)j * D + t + 256 * i], y);
        if (far(bf2f(((const bf16_t*)(ws + M_YS))[(size_t)slot * 1024 + t + 256 * i]), gw * y, 0.02f, 0.03f)) chk_fail(P, 6);
      }
      __syncthreads();
    }
  }
}
#endif

__global__ void __launch_bounds__(NTHR, 2) mega(Params P) {
  cg::grid_group grid = cg::this_grid();
  extern __shared__ __attribute__((aligned(16))) unsigned char lds[];
  const int G = gridDim.x, bx = blockIdx.x;
  const int lane = threadIdx.x & 63, wv = threadIdx.x >> 6, gw = bx * NW + wv, NGW = G * NW;
  const int half = threadIdx.x >> 8, t2 = threadIdx.x & 255;
  constexpr int MTB = (NT + 255) / 256;
  if (threadIdx.x < 16) ((unsigned*)(lds + LDS_CTL))[threadIdx.x] = 0u;
  __syncthreads();
  if (P.use_cg) grid.sync();
  const XcdBarrier xb = xcd_barrier_post((unsigned*)(P.ws + O_BAR), (volatile LAS unsigned*)(lds + LDS_CTL));
  int* const slot = (int*)(lds + LDS_CTL + 16);
#define GSYNC() xcd_barrier(xb)
  p0_prologue(P, lds);
  GSYNC();
  { int mt, nt; for (int k = 0; p1_tile_map(bx, k, G, mt, nt); ++k) p1_inproj_tile(P, mt, nt, lds); }
  GSYNC();
  for (int t = bx; t < MTB * (768 / 256 + 1024 / 256); t += G) { if (t < MTB * 3) p2b_q_tile(P, t, lds); else p2b_kv_tile(P, t - MTB * 3, lds); }
  for (int it = next_item(P, 1, slot); it < S12_ITEMS; it = next_item(P, 1, slot)) s12_item(P, it, lds);
  GSYNC();
  for (int it = next_item(P, 0, slot); it < 512; it = next_item(P, 0, slot)) mla_item(P, it, lds);
  for (int it = next_item(P, 2, slot); it < 512; it = next_item(P, 2, slot)) dsa_item(P, it, lds);
  GSYNC();
#if SELFCHECK
  for (int sidx = bx; sidx < 384; sidx += G) nv_dsa_check(P, sidx < 8 ? (sidx < 4 ? 200 + sidx * 37 : NR - 1 - (sidx - 4) * 4096) : (int)(hash_u(sidx * 2246822519u + 5u) % NR), lds);
  GSYNC();
#endif
  { int mt, nt; for (int k = 0; p78_tile_map(bx, k, G, mt, nt); ++k) p7_merge_tile(P, mt, nt, lds); }
  GSYNC();
#if SELFCHECK
  chk_stageB(P, lds);
  GSYNC();
#endif
  { int mt, nt; for (int k = 0; p78_tile_map(bx, k, G, mt, nt); ++k) p8_out_tile(P, mt, nt, lds); }
  GSYNC();
#if SELFCHECK
  chk_stageC(P, lds);
  GSYNC();
#endif
  p9_router_mfma(P, lds);
  { float* scr = (float*)lds + half * (64 * 65 + 32);
    p9_conv_loop<0>(P, scr, half, t2);
    p9_conv_loop<1>(P, scr, half, t2); }
  GSYNC();
  {
    int e, rt, cnt, bs;
    int* etab = (int*)(lds + LDS_RED);
    moe_table_load(P, etab);
    const int ntile = moe_tile_lookup(etab, 0, e, rt, cnt, bs);
    for (int q = next_item(P, 3, slot); q < ntile * 6; q = next_item(P, 3, slot)) {
      if (q < ntile * 2) { moe_tile_lookup(etab, q >> 1, e, rt, cnt, bs); p10_gu_tile(P, q >> 1, e, rt, cnt, bs, q & 1, lds); }
      else { const int q2 = q - ntile * 2; moe_tile_lookup(etab, q2 >> 2, e, rt, cnt, bs); p11_down_tile(P, q2 >> 2, e, rt, cnt, bs, q2 & 3, lds); }
    }
    GSYNC();
#if SELFCHECK
    chk_moe(P, lds);
    GSYNC();
#endif
    int* sbase = (int*)lds;
    __syncthreads();
    if (threadIdx.x == 0) { const unsigned* c = (const unsigned*)(P.ws + O_ECNT); int a = 0; for (int i = 0; i < 32; ++i) { sbase[i] = a; a += (((int)c[i * ECS] + 255) >> 8) * 256; } }
    __syncthreads();
    int lane12 = threadIdx.x & 63; asm volatile("" : "+v"(lane12));
    for (int t = gw; t < NR; t += 2 * NGW) p12_final_pair(P, t, t + NGW, t + NGW < NR, lane12, sbase);
  }
#if SELFCHECK
  GSYNC();
  {
    const unsigned* chk = (const unsigned*)(P.ws + O_CHK);
    float f = 1.f;
    for (int k = 15; k >= 0; --k) if (chk[k]) f = 1.f + 0.25f * (float)(1 << k);
    if (f != 1.f) for (size_t i = (size_t)bx * NTHR + threadIdx.x; i < (size_t)NR * D; i += (size_t)G * NTHR) P.out[i] *= f;
  }
#endif
}
}

extern "C" void kernel_launch(void* const* d_in, const int* in_sizes, int n_in, void* d_out, int out_size, void* d_ws, size_t ws_size, hipStream_t stream) {
  using namespace mk;
  static int grid_blocks = 0;
  if (!grid_blocks) {
    int dev = 0, cus = 0, per_cu = 0;
    (void)hipGetDevice(&dev);
    (void)hipDeviceGetAttribute(&cus, hipDeviceAttributeMultiprocessorCount, dev);
    (void)hipFuncSetAttribute((const void*)mega, hipFuncAttributeMaxDynamicSharedMemorySize, LDS_BYTES);
    (void)hipOccupancyMaxActiveBlocksPerMultiprocessor(&per_cu, mega, NTHR, LDS_BYTES);
    per_cu = 1;
    grid_blocks = cus * per_cu;
    if (ws_size < WS_END) fprintf(stderr, "workspace too small: need %zu have %zu\n", (size_t)WS_END, ws_size);
  }
  Params p{};
  const float** pp = (const float**)&p;
  for (int i = 0; i < 21; ++i) pp[i] = (const float*)d_in[i];
  p.out = (float*)d_out; p.ws = (unsigned char*)d_ws;
  (void)hipMemsetAsync((unsigned char*)d_ws + O_CHK, 0, O_WR - O_CHK, stream);
  void* args[] = {&p};
  hipError_t e = hipLaunchCooperativeKernel((void*)mega, dim3(grid_blocks), dim3(NTHR), args, LDS_BYTES, stream);
  if (e != hipSuccess) fprintf(stderr, "cooperative launch failed: %s (grid %d)\n", hipGetErrorString(e), grid_blocks);
}
```
